# Optimizing an MI355X kernel written in HIP

```python
import math
import jax, jax.numpy as jnp
from jax import lax
import numpy as np

D_MODEL = 1024
BATCH = 8
SEQ = 2048
DEPTH = 2
DEC_BATCH = 128
DEC_SEQ = 1
PAST_LEN = 16384
PAGE_SIZE = 128

N_MIXERS = 2
N_DN_LAYERS = (DEPTH + 1) // 2
N_S5_LAYERS = DEPTH // 2

DN_QK_HEADS = 8
DN_V_HEADS = 16
DN_HEAD_K = 128
DN_HEAD_V = 128
DN_KEY_DIM = DN_QK_HEADS * DN_HEAD_K
DN_VAL_DIM = DN_V_HEADS * DN_HEAD_V
DN_CONV_DIM = 2 * DN_KEY_DIM + DN_VAL_DIM
DN_CONV_W = 4
DN_CHUNK = 64
DN_IN_DIM = DN_CONV_DIM + DN_VAL_DIM + 2 * DN_V_HEADS

S5_GROUP = 16
S5_GROUPS = D_MODEL // S5_GROUP
S5_STATE = 64

FFN_HIDDEN = -(-(8 * D_MODEL) // (3 * 256)) * 256
EPS = 1e-6

kernel_name = 'hybrid_gdn_s5_decoder_step'


def rmsnorm(x, g):
    xf = x.astype(jnp.float32)
    y = xf * lax.rsqrt(jnp.mean(xf * xf, axis=-1, keepdims=True) + EPS) * g.astype(jnp.float32)
    return y.astype(x.dtype)


def l2norm(x):
    return x * lax.rsqrt(jnp.sum(x * x, axis=-1, keepdims=True) + EPS)


def short_conv(x, buf, w):
    L = x.shape[1]
    xp = jnp.concatenate([buf, x], axis=1)
    y = xp[:, 0:L] * w[0]
    for j in range(1, DN_CONV_W):
        y = y + xp[:, j:j + L] * w[j]
    return jax.nn.silu(y), xp[:, L:]


def gated_delta_chunked(q, k, v, beta, g, s0):
    bsz, L, H, dk = q.shape
    dv = v.shape[-1]
    C = DN_CHUNK
    n = L // C

    def to_chunks(t):
        t = t.reshape((bsz, n, C) + t.shape[2:])
        return jnp.moveaxis(t, (1, 2), (0, 3))

    qc, kc, vc, bc, gc = map(to_chunks, (q, k, v, beta, g))
    gc = jnp.cumsum(gc, axis=-1)
    incl = jnp.tril(jnp.ones((C, C), dtype=bool))
    strict = jnp.tril(jnp.ones((C, C), dtype=bool), k=-1)
    diff = gc[..., :, None] - gc[..., None, :]
    decay = jnp.exp(jnp.where(incl, diff, -jnp.inf))
    kb = kc * bc[..., None]
    lmat = jnp.where(strict, jnp.einsum('nbhid,nbhjd->nbhij', kb, kc) * decay, 0.0)
    eye = jnp.eye(C, dtype=q.dtype)
    rhs = jnp.concatenate([kb * jnp.exp(gc)[..., None], vc * bc[..., None]], axis=-1)
    sol = lax.linalg.triangular_solve(eye + lmat, rhs, left_side=True, lower=True, unit_diagonal=True)
    wc, uc = sol[..., :dk], sol[..., dk:]
    qk = jnp.einsum('nbhid,nbhjd->nbhij', qc, kc) * decay

    def step(S, xs):
        q_i, k_i, w_i, u_i, qk_i, g_i = xs
        v_new = u_i - jnp.einsum('bhck,bhkv->bhcv', w_i, S)
        o = (jnp.einsum('bhck,bhkv->bhcv', q_i * jnp.exp(g_i)[..., None], S)
             + jnp.einsum('bhij,bhjv->bhiv', qk_i, v_new))
        g_last = g_i[..., -1]
        k_dec = k_i * jnp.exp(g_last[..., None] - g_i)[..., None]
        S = S * jnp.exp(g_last)[..., None, None] + jnp.einsum('bhck,bhcv->bhkv', k_dec, v_new)
        return S, o

    s_final, oc = lax.scan(step, s0, (qc, kc, wc, uc, qk, gc))
    o = jnp.moveaxis(oc, (0, 3), (1, 2)).reshape(bsz, L, H, dv)
    return o, s_final


def gated_delta_recurrent(q, k, v, beta, g, s0):
    def step(S, xs):
        q_t, k_t, v_t, b_t, g_t = xs
        S = S * jnp.exp(g_t)[..., None, None]
        kv = jnp.einsum('bhkv,bhk->bhv', S, k_t)
        S = S + jnp.einsum('bhk,bhv->bhkv', k_t, (v_t - kv) * b_t[..., None])
        return S, jnp.einsum('bhkv,bhk->bhv', S, q_t)

    xs = tuple(jnp.moveaxis(t, 1, 0) for t in (q, k, v, beta, g))
    s_final, o = lax.scan(step, s0, xs)
    return jnp.moveaxis(o, 0, 1), s_final


def gated_deltanet(h, s0, conv0, w_in, conv_w, a_log, dt_bias, norm_g, w_out, chunked):
    bsz, L, _ = h.shape
    f32 = jnp.float32
    proj = (h @ w_in).astype(f32)
    o1 = DN_CONV_DIM
    o2 = o1 + DN_VAL_DIM
    o3 = o2 + DN_V_HEADS
    qkv, z, b, a = proj[..., :o1], proj[..., o1:o2], proj[..., o2:o3], proj[..., o3:]
    qkv_c, conv_new = short_conv(qkv, conv0.astype(f32), conv_w.astype(f32))
    q = qkv_c[..., :DN_KEY_DIM].reshape(bsz, L, DN_QK_HEADS, DN_HEAD_K)
    k = qkv_c[..., DN_KEY_DIM:2 * DN_KEY_DIM].reshape(bsz, L, DN_QK_HEADS, DN_HEAD_K)
    v = qkv_c[..., 2 * DN_KEY_DIM:].reshape(bsz, L, DN_V_HEADS, DN_HEAD_V)
    rep = DN_V_HEADS // DN_QK_HEADS
    q = jnp.repeat(l2norm(q), rep, axis=2) * (DN_HEAD_K ** -0.5)
    k = jnp.repeat(l2norm(k), rep, axis=2)
    beta = jax.nn.sigmoid(b)
    g = -jnp.exp(a_log.astype(f32)) * jax.nn.softplus(a + dt_bias.astype(f32))
    if chunked:
        o, s_new = gated_delta_chunked(q, k, v, beta, g, s0.astype(f32))
    else:
        o, s_new = gated_delta_recurrent(q, k, v, beta, g, s0.astype(f32))
    o = rmsnorm(o, norm_g) * jax.nn.silu(z.reshape(bsz, L, DN_V_HEADS, DN_HEAD_V))
    out = o.reshape(bsz, L, DN_VAL_DIM).astype(h.dtype) @ w_out
    return out.astype(h.dtype), s_new, conv_new


def s5_combine(e1, e2):
    a1r, a1i, b1r, b1i = e1
    a2r, a2i, b2r, b2i = e2
    return (a2r * a1r - a2i * a1i, a2r * a1i + a2i * a1r,
            a2r * b1r - a2i * b1i + b2r, a2r * b1i + a2i * b1r + b2i)


def s5_mixer(h, s0_re, s0_im, a_re, a_im, log_dt, b_re, b_im, c_re, c_im, d_skip, w_glu):
    f32 = jnp.float32
    bsz, L, _ = h.shape
    u = h.astype(f32).reshape(bsz, L, S5_GROUPS, S5_GROUP)
    a_re, a_im = a_re.astype(f32), a_im.astype(f32)
    dt = jnp.exp(log_dt.astype(f32))[:, None]
    mag = jnp.exp(a_re * dt)
    lb_re, lb_im = mag * jnp.cos(a_im * dt), mag * jnp.sin(a_im * dt)
    den = a_re * a_re + a_im * a_im
    n_re, n_im = lb_re - 1.0, lb_im
    f_re = (n_re * a_re + n_im * a_im) / den
    f_im = (n_im * a_re - n_re * a_im) / den
    b_re, b_im = b_re.astype(f32), b_im.astype(f32)
    bb_re = f_re[..., None] * b_re - f_im[..., None] * b_im
    bb_im = f_re[..., None] * b_im + f_im[..., None] * b_re
    bu_re = jnp.einsum('gpc,blgc->blgp', bb_re, u)
    bu_im = jnp.einsum('gpc,blgc->blgp', bb_im, u)
    ar = jnp.broadcast_to(lb_re, bu_re.shape)
    ai = jnp.broadcast_to(lb_im, bu_im.shape)
    pr, pi, sr, si = lax.associative_scan(s5_combine, (ar, ai, bu_re, bu_im), axis=1)
    s0_re = s0_re.astype(f32)[:, None]
    s0_im = s0_im.astype(f32)[:, None]
    st_re = sr + pr * s0_re - pi * s0_im
    st_im = si + pr * s0_im + pi * s0_re
    y = (jnp.einsum('gcp,blgp->blgc', c_re.astype(f32), st_re)
         - jnp.einsum('gcp,blgp->blgc', c_im.astype(f32), st_im)
         + d_skip.astype(f32).reshape(S5_GROUPS, S5_GROUP) * u)
    y = jax.nn.gelu(y.reshape(bsz, L, D_MODEL)).astype(h.dtype)
    pg = y @ w_glu
    out = pg[..., :D_MODEL] * jax.nn.sigmoid(pg[..., D_MODEL:])
    return out.astype(h.dtype), st_re[:, -1], st_im[:, -1]


def swiglu(h, w_in, w_out):
    gu = h @ w_in
    return (jax.nn.silu(gu[..., :FFN_HIDDEN]) * gu[..., FFN_HIDDEN:]) @ w_out


def trunk(x, dn_ssm0, dn_conv0, s5_re0, s5_im0, chunked,
          norm_mix_g, norm_ffn_g, final_norm_g,
          w_dn_in, dn_conv_w, dn_a_log, dn_dt_bias, dn_norm_g, w_dn_out,
          s5_a_re, s5_a_im, s5_log_dt, s5_b_re, s5_b_im, s5_c_re, s5_c_im, s5_d, w_s5_glu,
          w_ffn_in, w_ffn_out):
    dn_ssm, dn_conv, s5_re, s5_im = [], [], [], []
    for i in range(DEPTH):
        j = i // N_MIXERS
        hn = rmsnorm(x, norm_mix_g[i])
        if i % N_MIXERS == 0:
            out, s_new, c_new = gated_deltanet(hn, dn_ssm0[j], dn_conv0[j], w_dn_in[j], dn_conv_w[j],
                                               dn_a_log[j], dn_dt_bias[j], dn_norm_g[j], w_dn_out[j], chunked)
            dn_ssm.append(s_new)
            dn_conv.append(c_new)
        else:
            out, re_new, im_new = s5_mixer(hn, s5_re0[j], s5_im0[j], s5_a_re[j], s5_a_im[j], s5_log_dt[j],
                                           s5_b_re[j], s5_b_im[j], s5_c_re[j], s5_c_im[j], s5_d[j], w_s5_glu[j])
            s5_re.append(re_new)
            s5_im.append(im_new)
        x = x + out
        x = x + swiglu(rmsnorm(x, norm_ffn_g[i]), w_ffn_in[i], w_ffn_out[i]).astype(x.dtype)
    return (rmsnorm(x, final_norm_g), jnp.stack(dn_ssm), jnp.stack(dn_conv),
            jnp.stack(s5_re), jnp.stack(s5_im))


def setup_inputs(seed: int = 0) -> dict:
    key = jax.random.key(seed)
    ks = iter(jax.random.split(key, 32))
    f32 = jnp.float32

    def nrm(shape, scale):
        return scale * jax.random.normal(next(ks), shape, f32)

    def unif(shape, lo, hi):
        return jax.random.uniform(next(ks), shape, f32, minval=lo, maxval=hi)

    NA, NB = N_DN_LAYERS, N_S5_LAYERS
    dn_dt = jnp.exp(unif((NA, DN_V_HEADS), math.log(1e-3), math.log(1e-1)))
    n_idx = jnp.arange(S5_STATE, dtype=f32)
    return {
        'x_prompt': nrm((BATCH, SEQ, D_MODEL), 1.0),
        'x_sample': nrm((DEC_BATCH, DEC_SEQ, D_MODEL), 1.0),
        'state_dn_ssm': nrm((NA, DEC_BATCH, DN_V_HEADS, DN_HEAD_K, DN_HEAD_V), 0.5),
        'state_dn_conv': nrm((NA, DEC_BATCH, DN_CONV_W - 1, DN_CONV_DIM), 1.0),
        'state_s5_re': nrm((NB, DEC_BATCH, S5_GROUPS, S5_STATE), 0.1),
        'state_s5_im': nrm((NB, DEC_BATCH, S5_GROUPS, S5_STATE), 0.1),
        'norm_mix_g': 1.0 + nrm((DEPTH, D_MODEL), 0.02),
        'norm_ffn_g': 1.0 + nrm((DEPTH, D_MODEL), 0.02),
        'final_norm_g': 1.0 + nrm((D_MODEL,), 0.02),
        'w_dn_in': nrm((NA, D_MODEL, DN_IN_DIM), D_MODEL ** -0.5),
        'dn_conv_w': nrm((NA, DN_CONV_W, DN_CONV_DIM), DN_CONV_W ** -0.5),
        'dn_a_log': jnp.log(unif((NA, DN_V_HEADS), 1.0, 16.0)),
        'dn_dt_bias': dn_dt + jnp.log(-jnp.expm1(-dn_dt)),
        'dn_norm_g': 1.0 + nrm((NA, DN_HEAD_V), 0.02),
        'w_dn_out': nrm((NA, DN_VAL_DIM, D_MODEL), DN_VAL_DIM ** -0.5),
        's5_a_re': -0.5 + nrm((NB, S5_GROUPS, S5_STATE), 0.01),
        's5_a_im': math.pi * n_idx + nrm((NB, S5_GROUPS, S5_STATE), 0.01),
        's5_log_dt': unif((NB, S5_GROUPS), math.log(1e-3), math.log(1e-1)),
        's5_b_re': nrm((NB, S5_GROUPS, S5_STATE, S5_GROUP), (2 * S5_GROUP) ** -0.5),
        's5_b_im': nrm((NB, S5_GROUPS, S5_STATE, S5_GROUP), (2 * S5_GROUP) ** -0.5),
        's5_c_re': nrm((NB, S5_GROUPS, S5_GROUP, S5_STATE), S5_STATE ** -0.5),
        's5_c_im': nrm((NB, S5_GROUPS, S5_GROUP, S5_STATE), S5_STATE ** -0.5),
        's5_d': nrm((NB, D_MODEL), 1.0),
        'w_s5_glu': nrm((NB, D_MODEL, 2 * D_MODEL), D_MODEL ** -0.5),
        'w_ffn_in': nrm((DEPTH, D_MODEL, 2 * FFN_HIDDEN), D_MODEL ** -0.5),
        'w_ffn_out': nrm((DEPTH, FFN_HIDDEN, D_MODEL), FFN_HIDDEN ** -0.5),
    }


def reference(x_prompt, x_sample, state_dn_ssm, state_dn_conv, state_s5_re, state_s5_im,
              norm_mix_g, norm_ffn_g, final_norm_g,
              w_dn_in, dn_conv_w, dn_a_log, dn_dt_bias, dn_norm_g, w_dn_out,
              s5_a_re, s5_a_im, s5_log_dt, s5_b_re, s5_b_im, s5_c_re, s5_c_im, s5_d, w_s5_glu,
              w_ffn_in, w_ffn_out):
    weights = (norm_mix_g, norm_ffn_g, final_norm_g,
               w_dn_in, dn_conv_w, dn_a_log, dn_dt_bias, dn_norm_g, w_dn_out,
               s5_a_re, s5_a_im, s5_log_dt, s5_b_re, s5_b_im, s5_c_re, s5_c_im, s5_d, w_s5_glu,
               w_ffn_in, w_ffn_out)
    bp = x_prompt.shape[0]
    f32 = jnp.float32
    z_ssm = jnp.zeros((N_DN_LAYERS, bp, DN_V_HEADS, DN_HEAD_K, DN_HEAD_V), f32)
    z_conv = jnp.zeros((N_DN_LAYERS, bp, DN_CONV_W - 1, DN_CONV_DIM), f32)
    z_s5 = jnp.zeros((N_S5_LAYERS, bp, S5_GROUPS, S5_STATE), f32)
    y_prompt, dn_ssm_p, dn_conv_p, s5_re_p, s5_im_p = trunk(
        x_prompt, z_ssm, z_conv, z_s5, z_s5, True, *weights)
    y_sample, dn_ssm_s, dn_conv_s, s5_re_s, s5_im_s = trunk(
        x_sample, state_dn_ssm, state_dn_conv, state_s5_re, state_s5_im, False, *weights)
    return (y_prompt, y_sample, dn_ssm_p, dn_conv_p, s5_re_p, s5_im_p,
            dn_ssm_s, dn_conv_s, s5_re_s, s5_im_s)
```

```cpp
#define DBG_STOP 0
#include <hip/hip_runtime.h>
#include <cstdio>
#include <cstdint>
namespace pg8 {
#define PG8_LAS __attribute__((address_space(3)))
typedef unsigned short bf16_t;
typedef short bf16x8 __attribute__((ext_vector_type(8)));
typedef float f32x4 __attribute__((ext_vector_type(4)));
typedef unsigned u32x4 __attribute__((ext_vector_type(4)));
constexpr int BM = 256, BK = 64, HALF = 128, HTB = HALF * BK * 2  , STAGE_BYTES = 8 * HTB, NXCD = 8, WGM = 8;

__host__ __device__ __forceinline__ int lds_byte(int r, int c) { const int st = (r >> 4) * 2 + (c >> 5), rr = r & 15, cc = c & 31, ob = rr * 64 + cc * 2; return st * 1024 + (ob ^ (((ob >> 9) & 1) << 5)); }
__host__ __device__ __forceinline__ void stage_rc(int b, int& R, int& C) { const int st = b / 1024, sb = b % 1024, swz = sb ^ (((sb >> 9) & 1) << 5); R = (st >> 1) * 16 + swz / 64; C = (st & 1) * 32 + (swz % 64) / 2; }
__host__ __device__ __forceinline__ int perm32(int rho) { const int n = rho >> 4, i = rho & 15; return 8 * (i >> 2) + 4 * n + (i & 3); }

struct Unit { int pm, pn; };
struct Gemm { const bf16_t* A; const bf16_t* Bt; int M, N, K; };

struct StaticOrder {
    int nM, nN, nwg, G, c;
    __host__ __device__ void init(int M, int N, int G_, int c_) { nM = M / BM; nN = N / BM; nwg = nM * nN; G = G_; c = c_; }
    __host__ __device__ bool next(int i, Unit& u) const {
        const long L = (long)i * G + c; if (L >= nwg) return false;
        int wgid = (int)L; { const int q = nwg / NXCD, r = nwg % NXCD, xcd = wgid % NXCD, off = wgid / NXCD; wgid = (xcd < r ? xcd * (q + 1) : r * (q + 1) + (xcd - r) * q) + off; }
        const int nig = WGM * nN, gid = wgid / nig, fm = gid * WGM, gsz = (nM - fm) < WGM ? (nM - fm) : WGM;
        u.pm = fm + ((wgid % nig) % gsz); u.pn = (wgid % nig) / gsz; return true;
    }
    __device__ __forceinline__ void a_ready(const Unit&) const {}
    __device__ __forceinline__ void done(const Unit&) const {}
};
typedef float f32x2c __attribute__((ext_vector_type(2))); typedef __bf16 bf16x2c __attribute__((ext_vector_type(2)));
__device__ __forceinline__ unsigned cvt_pk_bf16(float lo, float hi) { const f32x2c v = {lo, hi}; return __builtin_bit_cast(unsigned, __builtin_convertvector(v, bf16x2c)); }
typedef unsigned u32x2 __attribute__((ext_vector_type(2)));
constexpr int MP_ROWS = 16384, MS_ROWS = 128, M_REAL = MP_ROWS + MS_ROWS, SS_LD = 32;
constexpr float RMS_EPS = 1e-6f;
__device__ __forceinline__ float silu_f(float x) { return x / (1.0f + __expf(-x)); }
__device__ __forceinline__ float sigmoid_f(float x) { return 1.0f / (1.0f + __expf(-x)); }
__device__ __forceinline__ float row_rstd(const float* ss, int row, int nparts) {
    const f32x4* p = (const f32x4*)(ss + (size_t)row * SS_LD); float s = 0.f;
    for (int i = 0; i < nparts / 4; ++i) { const f32x4 v = p[i]; s += (v[0] + v[1]) + (v[2] + v[3]); }
    return rsqrtf(s * (1.0f / 1024.0f) + RMS_EPS);
}
struct EpiProj {
    static constexpr bool PERM = true, AFTER_DRAIN = false;
    bf16_t* O; const float* ss; int nparts; float* beta; float* gdec; const float* a_log; const float* dt_bias;
    __device__ __forceinline__ void operator()(const f32x4 (&acc)[2][2][4][2], const Unit& u, int wr, int wc, int fr, int fq) const {
        const int row0 = u.pm * BM + wr * 64 + fr;
        if (u.pn < 24) {
            const int col0 = u.pn * BM + wc * 32 + 8 * fq; const bool act = u.pn >= 16;
#pragma unroll
            for (int ai = 0; ai < 2; ++ai)
#pragma unroll
                for (int m = 0; m < 4; ++m) { const int row = row0 + ai * HALF + m * 16; bf16_t* rowp = O + (size_t)row * 6144 + col0; const float r = row_rstd(ss, row, nparts);
#pragma unroll
                    for (int bj = 0; bj < 2; ++bj) { f32x4 v0 = acc[ai][bj][m][0] * r, v1 = acc[ai][bj][m][1] * r;
                        if (act) {
#pragma unroll
                            for (int j = 0; j < 4; ++j) { v0[j] = silu_f(v0[j]); v1[j] = silu_f(v1[j]); } }
                        u32x4 w; w.x = cvt_pk_bf16(v0[0], v0[1]); w.y = cvt_pk_bf16(v0[2], v0[3]); w.z = cvt_pk_bf16(v1[0], v1[1]); w.w = cvt_pk_bf16(v1[2], v1[3]);
                        *(u32x4*)(rowp + bj * HALF) = w; }
                    asm volatile("" ::: "memory"); }
        } else if (wc == 0) {
            const int c0 = 8 * fq;
#pragma unroll
            for (int ai = 0; ai < 2; ++ai)
#pragma unroll
                for (int m = 0; m < 4; ++m) { const int row = row0 + ai * HALF + m * 16; const float r = row_rstd(ss, row, nparts);
                    float o[8];
#pragma unroll
                    for (int n = 0; n < 2; ++n)
#pragma unroll
                        for (int j = 0; j < 4; ++j) { const float v = acc[ai][0][m][n][j] * r;
                            if (c0 < 16) o[4 * n + j] = sigmoid_f(v);
                            else { const int h = c0 - 16 + 4 * n + j; const float xx = v + dt_bias[h]; const float sp = xx > 15.f ? xx : __logf(1.0f + __expf(xx)); o[4 * n + j] = -__expf(a_log[h]) * sp; } }
                    float* dst = (c0 < 16 ? beta + (size_t)row * 16 + c0 : gdec + (size_t)row * 16 + (c0 - 16));
                    *(f32x4*)dst = (f32x4){o[0], o[1], o[2], o[3]}; *(f32x4*)(dst + 4) = (f32x4){o[4], o[5], o[6], o[7]};
                    asm volatile("" ::: "memory"); }
        }
    }
};
struct EpiSwiglu {
    static constexpr bool PERM = true, AFTER_DRAIN = false;
    bf16_t* O; int ldo; const float* ss; int nparts;
    __device__ __forceinline__ void operator()(const f32x4 (&acc)[2][2][4][2], const Unit& u, int wr, int wc, int fr, int fq) const {
        const int row0 = u.pm * BM + wr * 64 + fr, col0 = u.pn * HALF + wc * 32 + 8 * fq;
#pragma unroll
        for (int ai = 0; ai < 2; ++ai)
#pragma unroll
            for (int m = 0; m < 4; ++m) { const int row = row0 + ai * HALF + m * 16; const float r = row_rstd(ss, row, nparts);
                f32x4 h0, h1;
#pragma unroll
                for (int j = 0; j < 4; ++j) { h0[j] = silu_f(acc[ai][0][m][0][j] * r) * (acc[ai][1][m][0][j] * r); h1[j] = silu_f(acc[ai][0][m][1][j] * r) * (acc[ai][1][m][1][j] * r); }
                u32x4 w; w.x = cvt_pk_bf16(h0[0], h0[1]); w.y = cvt_pk_bf16(h0[2], h0[3]); w.z = cvt_pk_bf16(h1[0], h1[1]); w.w = cvt_pk_bf16(h1[2], h1[3]);
                *(u32x4*)(O + (size_t)row * ldo + col0) = w; }
    }
};
template <bool GLU> struct EpiRes {
    static constexpr bool PERM = false, AFTER_DRAIN = false;
    const float* baseP; const float* baseS; float* outP; float* outS; bf16_t* XB; float* ss;
    __device__ __forceinline__ void operator()(const f32x4 (&acc)[2][2][4][2], const Unit& u, int wr, int wc, int fr, int fq) const {
        const bool smp = u.pm >= MP_ROWS / BM;
        const int col0 = (GLU ? u.pn * HALF : u.pn * BM) + wc * 32 + 4 * fq;
#pragma unroll
        for (int ai = 0; ai < 2; ++ai) {
            if (smp && ai == 1) break;
#pragma unroll
            for (int m = 0; m < 4; ++m) { const int row = u.pm * BM + ai * HALF + wr * 64 + m * 16 + fr;
                const size_t off = smp ? (size_t)(row - MP_ROWS) * 1024 : (size_t)row * 1024;
                const float* bp = (smp ? baseS : baseP) + off + col0; float* op = (smp ? outS : outP) + off + col0; bf16_t* xp = XB + (size_t)row * 1024 + col0;
                float sq = 0.f;
#pragma unroll
                for (int bj = 0; bj < (GLU ? 1 : 2); ++bj)
#pragma unroll
                    for (int n = 0; n < 2; ++n) { const int c = bj * HALF + n * 16; f32x4 v;
                        if (GLU) {
#pragma unroll
                            for (int j = 0; j < 4; ++j) v[j] = acc[ai][0][m][n][j] * sigmoid_f(acc[ai][1][m][n][j]);
                        } else v = acc[ai][bj][m][n];
                        const f32x4 o = *(const f32x4*)(bp + c) + v; *(f32x4*)(op + c) = o;
                        sq += (o[0] * o[0] + o[1] * o[1]) + (o[2] * o[2] + o[3] * o[3]);
                        u32x2 w; w.x = cvt_pk_bf16(o[0], o[1]); w.y = cvt_pk_bf16(o[2], o[3]); *(u32x2*)(xp + c) = w; }
                sq += __shfl_xor(sq, 16); sq += __shfl_xor(sq, 32);
                if (fq == 0) ss[(size_t)row * SS_LD + u.pn * 4 + wc] = sq; }
        }
    }
};

template <class Epi, class Sched, bool ALIGN_EPI = false, bool SP2 = false>
__device__ __forceinline__ void gemm_phase(PG8_LAS unsigned char* lds, const Gemm g, const Sched& S, const Epi& E) {
    const int tid = threadIdx.x, wid = __builtin_amdgcn_readfirstlane(tid >> 6), lane = tid & 63, wr = wid >> 2, wc = wid & 3, fr = lane & 15, fq = lane >> 4;
    const int K = g.K, nt = K / BK;
    unsigned voffA[2], voffB[2];
#pragma unroll
    for (int i = 0; i < 2; ++i) { int R, C; stage_rc(tid * 16 + i * 8192, R, C); const int Rb = Epi::PERM ? ((R & ~31) + perm32(R & 31)) : R;
        voffA[i] = (unsigned)(R * K + C) * 2u; voffB[i] = (unsigned)(Rb * K + C) * 2u; }
    const size_t kstep = (size_t)(BK * 2);
    const size_t hstep = (size_t)HALF * K * 2;
    const size_t tstep = 2 * hstep;
    const unsigned ldsw = (unsigned)wid * 1024u;
    const int aoff = lds_byte(wr * 64 + fr, fq * 8), boff = lds_byte(wc * 32 + fr, fq * 8);
#define PG8_SA(b, h) (((b) * 2 + (h)) * HTB)
#define PG8_SB(b, h) ((4 + (b) * 2 + (h)) * HTB)
#define PG8_STAGE(bufoff, gbase, voff) do { _Pragma("unroll") for (int _i = 0; _i < 2; ++_i) \
        __builtin_amdgcn_global_load_lds((const unsigned*)((const char*)(gbase) + (voff)[_i]), (PG8_LAS unsigned*)(lds + (bufoff) + ldsw + _i * 8192), 16, 0, 0); } while (0)
#define PG8_LDA(dst, b, h) do { _Pragma("unroll") for (int m = 0; m < 4; ++m) _Pragma("unroll") for (int k = 0; k < 2; ++k) dst[m][k] = *(const PG8_LAS bf16x8*)(lds + PG8_SA(b, h) + aoff + m * 2048 + k * 1024); } while (0)
#define PG8_LDB(dst, b, h) do { _Pragma("unroll") for (int n = 0; n < 2; ++n) _Pragma("unroll") for (int k = 0; k < 2; ++k) dst[n][k] = *(const PG8_LAS bf16x8*)(lds + PG8_SB(b, h) + boff + n * 2048 + k * 1024); } while (0)
#define PG8_MMA(ai, bj, At, Bt) do { __builtin_amdgcn_s_setprio(1); _Pragma("unroll") for (int m = 0; m < 4; ++m) _Pragma("unroll") for (int n = 0; n < 2; ++n) _Pragma("unroll") for (int k = 0; k < 2; ++k) \
        acc[ai][bj][m][n] = __builtin_amdgcn_mfma_f32_16x16x32_bf16(Bt[n][k], At[m][k], acc[ai][bj][m][n], 0, 0, 0); __builtin_amdgcn_s_setprio(0); } while (0)
#define PG8_WAIT_V(n) asm volatile("s_waitcnt vmcnt(" #n ")" ::: "memory")
#define PG8_WAIT_L(n) asm volatile("s_waitcnt lgkmcnt(" #n ")" ::: "memory")
#define PG8_BAR __builtin_amdgcn_s_barrier()
#define PG8_SCHED __builtin_amdgcn_sched_barrier(0)
    Unit cur, nxt; int ui = 0;
    if (!S.next(0, cur)) return;
    f32x4 acc[2][2][4][2];
#pragma unroll
    for (int a = 0; a < 2; ++a)
#pragma unroll
        for (int b = 0; b < 2; ++b)
#pragma unroll
            for (int m = 0; m < 4; ++m)
#pragma unroll
                for (int n = 0; n < 2; ++n) acc[a][b][m][n] = (f32x4){0.f, 0.f, 0.f, 0.f};
    bf16x8 At[4][2], B0[2][2], B1[2][2];
    const char* cA = (const char*)g.A + (size_t)cur.pm * tstep; const char* cB = (const char*)g.Bt + (size_t)cur.pn * tstep;
    S.a_ready(cur);
    if constexpr (SP2) {
        PG8_STAGE(PG8_SB(0, 0), cB, voffB); PG8_STAGE(PG8_SB(0, 1), cB + hstep, voffB); PG8_STAGE(PG8_SA(0, 0), cA, voffA); PG8_STAGE(PG8_SA(0, 1), cA + hstep, voffA);
        if (wr == 1) PG8_BAR;
        PG8_WAIT_V(2); PG8_BAR;
        PG8_STAGE(PG8_SB(1, 0), cB + kstep, voffB); PG8_STAGE(PG8_SA(1, 0), cA + kstep, voffA); PG8_STAGE(PG8_SB(1, 1), cB + hstep + kstep, voffB);
        PG8_WAIT_V(6); PG8_BAR;
    } else {
        PG8_STAGE(PG8_SB(0, 0), cB, voffB); PG8_STAGE(PG8_SA(0, 0), cA, voffA); PG8_STAGE(PG8_SB(0, 1), cB + hstep, voffB); PG8_STAGE(PG8_SA(0, 1), cA + hstep, voffA);
        if (wr == 1) PG8_BAR;
        PG8_WAIT_V(4); PG8_BAR;
        PG8_STAGE(PG8_SB(1, 0), cB + kstep, voffB); PG8_STAGE(PG8_SA(1, 0), cA + kstep, voffA); PG8_STAGE(PG8_SB(1, 1), cB + hstep + kstep, voffB);
        PG8_WAIT_V(6); PG8_BAR;
    }
    for (;;) {
        const bool has_next = S.next(ui + 1, nxt);
        const char* nA = has_next ? (const char*)g.A + (size_t)nxt.pm * tstep : cA; const char* nB = has_next ? (const char*)g.Bt + (size_t)nxt.pn * tstep : cB;
        for (int t = 0; t < nt; t += 2) {
            const bool last = (t == nt - 2);
            const char* a1 = cA + (size_t)(t + 1) * kstep;
            const char* a2 = last ? nA : cA + (size_t)(t + 2) * kstep; const char* b2 = last ? nB : cB + (size_t)(t + 2) * kstep;
            const char* a3 = a2 + kstep; const char* b3 = b2 + kstep;
            if (last && has_next) S.a_ready(nxt);
            if constexpr (SP2) {
            PG8_LDB(B0, 0, 0); PG8_LDB(B1, 0, 1); PG8_SCHED; PG8_LDA(At, 0, 0); PG8_STAGE(PG8_SA(1, 1), a1 + hstep, voffA);
            PG8_WAIT_V(8); PG8_WAIT_L(0); PG8_BAR; PG8_MMA(0, 0, At, B0); PG8_MMA(0, 1, At, B1); PG8_BAR; PG8_SCHED;
            PG8_LDA(At, 0, 1); PG8_STAGE(PG8_SB(0, 0), b2, voffB); PG8_STAGE(PG8_SB(0, 1), b2 + hstep, voffB); PG8_STAGE(PG8_SA(0, 0), a2, voffA);
            PG8_WAIT_V(8); PG8_WAIT_L(0); PG8_BAR; PG8_MMA(1, 0, At, B0); PG8_MMA(1, 1, At, B1); PG8_BAR; PG8_SCHED;
            PG8_LDB(B0, 1, 0); PG8_LDB(B1, 1, 1); PG8_SCHED; PG8_LDA(At, 1, 0); PG8_STAGE(PG8_SA(0, 1), a2 + hstep, voffA);
            PG8_WAIT_V(8); PG8_WAIT_L(0); PG8_BAR; PG8_MMA(0, 0, At, B0); PG8_MMA(0, 1, At, B1); PG8_BAR; PG8_SCHED;
            PG8_LDA(At, 1, 1); PG8_STAGE(PG8_SB(1, 0), b3, voffB); PG8_STAGE(PG8_SB(1, 1), b3 + hstep, voffB); PG8_STAGE(PG8_SA(1, 0), a3, voffA);
            PG8_WAIT_V(8); PG8_WAIT_L(0); PG8_BAR; PG8_MMA(1, 0, At, B0); PG8_MMA(1, 1, At, B1); PG8_BAR; PG8_SCHED;
            } else {
            PG8_LDB(B0, 0, 0); PG8_SCHED; PG8_LDA(At, 0, 0); PG8_STAGE(PG8_SA(1, 1), a1 + hstep, voffA);
            PG8_WAIT_L(8); PG8_BAR; PG8_WAIT_L(0); PG8_MMA(0, 0, At, B0); PG8_BAR; PG8_SCHED;
            PG8_LDB(B1, 0, 1); PG8_STAGE(PG8_SB(0, 0), b2, voffB);
            PG8_BAR; PG8_WAIT_L(0); PG8_MMA(0, 1, At, B1); PG8_BAR;
            PG8_LDA(At, 0, 1); PG8_STAGE(PG8_SA(0, 0), a2, voffA);
            PG8_BAR; PG8_WAIT_L(0); PG8_MMA(1, 0, At, B0); PG8_BAR; PG8_SCHED;
            PG8_STAGE(PG8_SB(0, 1), b2 + hstep, voffB);
            PG8_WAIT_V(6); PG8_BAR; PG8_MMA(1, 1, At, B1); PG8_BAR;
            PG8_LDB(B0, 1, 0); PG8_SCHED; PG8_LDA(At, 1, 0); PG8_STAGE(PG8_SA(0, 1), a2 + hstep, voffA);
            PG8_WAIT_L(8); PG8_BAR; PG8_WAIT_L(0); PG8_MMA(0, 0, At, B0); PG8_BAR; PG8_SCHED;
            PG8_LDB(B1, 1, 1); PG8_STAGE(PG8_SB(1, 0), b3, voffB);
            PG8_BAR; PG8_WAIT_L(0); PG8_MMA(0, 1, At, B1); PG8_BAR;
            PG8_LDA(At, 1, 1); PG8_STAGE(PG8_SA(1, 0), a3, voffA);
            PG8_BAR; PG8_WAIT_L(0); PG8_MMA(1, 0, At, B0); PG8_BAR; PG8_SCHED;
            PG8_STAGE(PG8_SB(1, 1), b3 + hstep, voffB);
            PG8_WAIT_V(6); PG8_BAR; PG8_MMA(1, 1, At, B1); PG8_BAR;
            }
        }
        if constexpr (ALIGN_EPI) { if (wr == 0) PG8_BAR; }
        if constexpr (!Epi::AFTER_DRAIN) { E(acc, cur, wr, wc, fr, fq); S.done(cur); }
        if (!has_next) break;
#pragma unroll
        for (int a = 0; a < 2; ++a)
#pragma unroll
            for (int b = 0; b < 2; ++b)
#pragma unroll
                for (int m = 0; m < 4; ++m)
#pragma unroll
                    for (int n = 0; n < 2; ++n) acc[a][b][m][n] = (f32x4){0.f, 0.f, 0.f, 0.f};
        cur = nxt; cA = nA; cB = nB; ++ui;
        if constexpr (ALIGN_EPI) { if (wr == 1) PG8_BAR; }
    }
    PG8_WAIT_V(0);
    if constexpr (!ALIGN_EPI) { if (wr == 0) PG8_BAR; }
    PG8_BAR;
    if constexpr (Epi::AFTER_DRAIN) { E.fused(acc, cur, wr, wc, fr, fq, lds, wid, lane); S.done(cur); }
#undef PG8_SA
#undef PG8_SB
#undef PG8_STAGE
#undef PG8_LDA
#undef PG8_LDB
#undef PG8_MMA
#undef PG8_WAIT_V
#undef PG8_WAIT_L
#undef PG8_BAR
#undef PG8_SCHED
}
}
constexpr int NWAVES = 8, NTHREADS = 512;
constexpr int D = 1024, SEQ = 2048, NB = 8, MP = NB * SEQ  , MS = 128, MPAD = MP + 256  ;
constexpr int DN_IN = 6176, DN_INP = 6400, PROJ_LD = 6144, VAL = 2048, FFN = 2816, NH = 16, CHUNK = 64, NCHUNK = SEQ / CHUNK;
constexpr size_t MiB = 1u << 20;
constexpr size_t WS_CTL = 0, CTL_ZERO_BYTES = 64 * 1024;
constexpr size_t WS_W1 = 1 * MiB;
constexpr size_t WS_W2 = WS_W1 + (size_t)DN_INP * D * 2;
constexpr size_t WS_W5 = WS_W2 + (size_t)D * VAL * 2;
constexpr size_t WS_W3 = WS_W5 + (size_t)2 * D * D * 2;
constexpr size_t WS_W4 = WS_W3 + (size_t)2 * 2 * FFN * D * 2;
constexpr size_t WS_SS = WS_W4 + (size_t)2 * D * FFN * 2;
constexpr size_t WS_BETA = WS_SS + (size_t)MPAD * 32 * 4;
constexpr size_t WS_GDEC = WS_BETA + (size_t)MPAD * 16 * 4;
constexpr size_t WS_XB = (WS_GDEC + (size_t)MPAD * 16 * 4 + 4095) / 4096 * 4096;
constexpr size_t WS_X = WS_XB + (size_t)MPAD * D * 2;
constexpr size_t WS_YB = WS_X + (size_t)MPAD * D * 4;
constexpr size_t WS_GATED = WS_YB + (size_t)MPAD * D * 2;
constexpr size_t WS_QKVC = WS_XB;
static_assert(WS_QKVC + (size_t)MP * 4096 * 2 <= WS_GATED, "QKVC overlay");
constexpr size_t WS_PROJ = WS_GATED + (size_t)MPAD * VAL * 2;
constexpr size_t WS_H = WS_PROJ;
constexpr size_t WS_END = WS_PROJ + (size_t)MPAD * PROJ_LD * 2;
constexpr int CW_BAR = 4096;
constexpr size_t O_YP = 0, O_YS = O_YP + (size_t)MP * D, O_SSMP = O_YS + (size_t)MS * D, O_CONVP = O_SSMP + (size_t)NB * NH * 128 * 128, O_S5RP = O_CONVP + (size_t)NB * 3 * 4096,
                 O_S5IP = O_S5RP + (size_t)NB * 64 * 64, O_SSMS = O_S5IP + (size_t)NB * 64 * 64, O_CONVS = O_SSMS + (size_t)MS * NH * 128 * 128, O_S5RS = O_CONVS + (size_t)MS * 3 * 4096,
                 O_S5IS = O_S5RS + (size_t)MS * 64 * 64, O_END = O_S5IS + (size_t)MS * 64 * 64;
constexpr int LDS_BYTES = 163840, LDSCTL_OFF = LDS_BYTES - 256;

#define GAS __attribute__((address_space(1)))
#define LAS __attribute__((address_space(3)))
typedef unsigned short bf16;
typedef float f32x4 __attribute__((ext_vector_type(4)));
typedef float f32x2 __attribute__((ext_vector_type(2)));
typedef short bf16x8 __attribute__((ext_vector_type(8)));
typedef unsigned u32x4 __attribute__((ext_vector_type(4)));
typedef unsigned u32x2 __attribute__((ext_vector_type(2)));
typedef LAS unsigned char* ldsp;
__device__ __forceinline__ unsigned pkbf(float lo, float hi) { return pg8::cvt_pk_bf16(lo, hi); }
__device__ __forceinline__ float bflo(unsigned w) { return __builtin_bit_cast(float, w << 16); }
__device__ __forceinline__ float bfhi(unsigned w) { return __builtin_bit_cast(float, w & 0xffff0000u); }
__device__ __forceinline__ float bf1(bf16 h) { return __builtin_bit_cast(float, (unsigned)h << 16); }
__device__ __forceinline__ float wave_sum(float v) {
#pragma unroll
    for (int o = 1; o < 64; o <<= 1) v += __shfl_xor(v, o);
    return v;
}
#define MFMA16(a, b, c) __builtin_amdgcn_mfma_f32_16x16x32_bf16((a), (b), (c), 0, 0, 0)
#define MM_XROW(acc, xf, yf) (acc) = MFMA16((yf), (xf), (acc))
#define MM_YROW(acc, xf, yf) (acc) = MFMA16((xf), (yf), (acc))
#define LDS_FENCE() asm volatile("s_waitcnt lgkmcnt(0)" ::: "memory")

struct Args {
    const float* in[26]; float* out; unsigned char* ws; int pad0, pad1;
};
constexpr float RMS_EPSF = 1e-6f;
#define XB_TMO      128
#define XB_XCNT(j)  (256  + 64 * (j))
#define XB_XSUB(j)  (1280 + 64 * (j))
#define XB_XGEN(j)  (2304 + 64 * (j))
#define XB_TOP      3328
#define XB_TOPGEN   3392
#define XCD_BAR_WORDS 3456
#define XB_SPIN_CAP (1u << 18)

__device__ __forceinline__ unsigned xb_ld(unsigned* p)              { return __hip_atomic_load(p, __ATOMIC_RELAXED, __HIP_MEMORY_SCOPE_AGENT); }
__device__ __forceinline__ unsigned xb_add(unsigned* p, unsigned v) { return __hip_atomic_fetch_add(p, v, __ATOMIC_RELAXED, __HIP_MEMORY_SCOPE_AGENT); }
__device__ __forceinline__ unsigned xb_xcc_id() { return (unsigned)__builtin_amdgcn_s_getreg((3 << 11) | 20) & 0xFu; }
#define XB_SPIN(cond, bar) do { unsigned _sp = 0; while (cond) { __builtin_amdgcn_s_sleep(1); \
    if ((++_sp & 255u) == 0u) { if (xb_ld(&(bar)[XB_TMO])) break; if (_sp > XB_SPIN_CAP) { atomicAdd(&(bar)[XB_TMO], 1u); break; } } } } while (0)

struct XcdBarrier {
    unsigned* bar; unsigned x;
    volatile LAS unsigned* st;
};

__device__ __forceinline__ XcdBarrier xcd_barrier_post(unsigned* bar, volatile LAS unsigned* st) {
    XcdBarrier b; b.bar = bar; b.x = xb_xcc_id(); b.st = st;
    if (threadIdx.x == 0) (void)xb_add(&bar[XB_XCNT(b.x)], 1u);
    return b;
}
__device__ __forceinline__ void xcd_barrier_complete(unsigned* bar, unsigned x, unsigned& nloc, unsigned& nx) {
    const unsigned G = gridDim.x * gridDim.y * gridDim.z;
    unsigned sum, cnt, mine, sp = 0u;
    for (;;) {
        sum = 0u; cnt = 0u; mine = 0u;
#pragma unroll
        for (unsigned j = 0; j < 16; ++j) { const unsigned c = xb_ld(&bar[XB_XCNT(j)]); sum += c; cnt += (c > 0u) ? 1u : 0u; mine = (j == x) ? c : mine; }
        if (sum == G) break;
        __builtin_amdgcn_s_sleep(1);
        if ((++sp & 255u) == 0u) { if (xb_ld(&bar[XB_TMO])) break; if (sp > XB_SPIN_CAP) { atomicAdd(&bar[XB_TMO], 1u); break; } }
    }
    nloc = mine > 0u ? mine : 1u; nx = cnt > 0u ? cnt : 1u;
}

__device__ __forceinline__ void xcd_barrier(const XcdBarrier& b) {
    asm volatile("s_waitcnt vmcnt(0)" ::: "memory");
    __syncthreads();
    if (threadIdx.x == 0) {
        unsigned* bar = b.bar;
        __builtin_amdgcn_s_waitcnt(0);
        unsigned nloc = b.st[0], nx = b.st[1];
        if (nloc == 0u) { xcd_barrier_complete(bar, b.x, nloc, nx); b.st[0] = nloc; b.st[1] = nx; }
        const unsigned old = xb_add(&bar[XB_XSUB(b.x)], 1u);
        const unsigned gen = old / nloc;
        if (old + 1u == (gen + 1u) * nloc) {
            __builtin_amdgcn_fence(__ATOMIC_RELEASE, "agent");
            asm volatile("s_waitcnt vmcnt(0)" ::: "memory");
            const unsigned og = xb_add(&bar[XB_TOP], 1u);
            const unsigned tg = og / nx;
            if (og + 1u == (tg + 1u) * nx) xb_add(&bar[XB_TOPGEN], 1u);
            else XB_SPIN(xb_ld(&bar[XB_TOPGEN]) == tg, bar);
            __builtin_amdgcn_fence(__ATOMIC_ACQUIRE, "agent");
            xb_add(&bar[XB_XGEN(b.x)], 1u);
            asm volatile("s_waitcnt vmcnt(0)" ::: "memory");
        } else {
            XB_SPIN(xb_ld(&bar[XB_XGEN(b.x)]) == gen, bar);
            __builtin_amdgcn_fence(__ATOMIC_ACQUIRE, "agent");
            asm volatile("s_waitcnt vmcnt(0)" ::: "memory");
        }
    }
    __syncthreads();
}
__device__ __forceinline__ void p0_transpose_item(const float* W, int K, int N, const float* gain, int gluh, bf16* WT, LAS float* scr, int item, int lane) {
    const int nblk = N / 32, kb = item / nblk, nb = item % nblk, k0 = 64 * kb, n0 = 32 * nb;
#pragma unroll 8
    for (int i = 0; i < 32; ++i) { const int kk = 2 * i + (lane >> 5); float v = W[(size_t)(k0 + kk) * N + n0 + (lane & 31)]; if (gain) v *= gain[k0 + kk]; scr[kk * 33 + (lane & 31)] = v; }
    LDS_FENCE();
    int r0 = n0; if (gluh > 0) r0 = (n0 < gluh) ? (n0 / 128) * 256 + (n0 % 128) : ((n0 - gluh) / 128) * 256 + 128 + ((n0 - gluh) % 128);
    const int c = lane & 7;
#pragma unroll
    for (int j = 0; j < 4; ++j) { const int n = (lane >> 3) + 8 * j; const LAS float* s = scr + (8 * c) * 33 + n;
        u32x4 o; o.x = pkbf(s[0 * 33], s[1 * 33]); o.y = pkbf(s[2 * 33], s[3 * 33]); o.z = pkbf(s[4 * 33], s[5 * 33]); o.w = pkbf(s[6 * 33], s[7 * 33]);
        *(u32x4*)(WT + (size_t)(r0 + n) * K + k0 + 8 * c) = o; }
    LDS_FENCE();
}
__device__ __forceinline__ void p0_prologue(const Args& a, ldsp lds, int gw, int ngw, int wave, int lane) {
    LAS float* scr = (LAS float*)(lds + wave * 16384);
    unsigned char* ws = a.ws;
    constexpr int I1 = (D / 64) * (DN_IN / 32), I2 = (VAL / 64) * (D / 32), I5 = (D / 64) * (2 * D / 32), I3 = (D / 64) * (2 * FFN / 32), I4 = (FFN / 64) * (D / 32);
    constexpr int NITEMS = I1 + I2 + I5 + 2 * I3 + 2 * I4;
    for (int it = gw; it < NITEMS; it += ngw) {
        int r = it;
        if (r < I1) { p0_transpose_item(a.in[9], D, DN_IN, a.in[6], 0, (bf16*)(ws + WS_W1), scr, r, lane); continue; } r -= I1;
        if (r < I2) { p0_transpose_item(a.in[14], VAL, D, nullptr, 0, (bf16*)(ws + WS_W2), scr, r, lane); continue; } r -= I2;
        if (r < I5) { p0_transpose_item(a.in[23], D, 2 * D, nullptr, D, (bf16*)(ws + WS_W5), scr, r, lane); continue; } r -= I5;
        if (r < 2 * I3) { const int l = r / I3; p0_transpose_item(a.in[24] + (size_t)l * D * 2 * FFN, D, 2 * FFN, a.in[7] + l * D, FFN, (bf16*)(ws + WS_W3) + (size_t)l * 2 * FFN * D, scr, r % I3, lane); continue; } r -= 2 * I3;
        { const int l = r / I4; p0_transpose_item(a.in[25] + (size_t)l * FFN * D, FFN, D, nullptr, 0, (bf16*)(ws + WS_W4) + (size_t)l * D * FFN, scr, r % I4, lane); }
    }
    bf16* XB = (bf16*)(ws + WS_XB); float* SS = (float*)(ws + WS_SS);
    for (int m = gw; m < MPAD; m += ngw) {
        f32x4 v[4]; float s = 0.f;
        if (m < MP + MS) { const f32x4* xr = (const f32x4*)(m < MP ? a.in[0] + (size_t)m * D : a.in[1] + (size_t)(m - MP) * D) + lane;
#pragma unroll
            for (int j = 0; j < 4; ++j) { v[j] = xr[64 * j]; s += (v[j][0] * v[j][0] + v[j][1] * v[j][1]) + (v[j][2] * v[j][2] + v[j][3] * v[j][3]); }
        } else {
#pragma unroll
            for (int j = 0; j < 4; ++j) v[j] = (f32x4){0.f, 0.f, 0.f, 0.f};
        }
        s = wave_sum(s);
        u32x2* o8 = (u32x2*)(XB + (size_t)m * D) + lane;
#pragma unroll
        for (int j = 0; j < 4; ++j) { u32x2 w; w.x = pkbf(v[j][0], v[j][1]); w.y = pkbf(v[j][2], v[j][3]); o8[64 * j] = w; }
        if (lane < 16) SS[(size_t)m * 32 + lane] = (lane == 0) ? s : 0.f;
    }
}
constexpr int DL_K = 0, DL_V = 17408, DL_QK = 34816, DL_X = 44032, DL_SLOT = 9216, DL_ST = 99328, DL_GC = 134144, DL_BETA = 134400, DL_RED = 134656, DL_END = 135168;
static_assert(DL_END <= LDSCTL_OFF, "DN LDS map");
__device__ __forceinline__ bf16x8 ldfrag(ldsp base, int row, int ld, int k) { return *(const LAS bf16x8*)(base + (row * ld + k) * 2); }
__device__ __forceinline__ void st4(ldsp base, int row, int ld, int col, const f32x4 v) { u32x2 w; w.x = pkbf(v[0], v[1]); w.y = pkbf(v[2], v[3]); *(LAS u32x2*)(base + (row * ld + col) * 2) = w; }
__device__ __forceinline__ void st1(ldsp base, int row, int ld, int col, float v) { *(LAS unsigned short*)(base + (row * ld + col) * 2) = (unsigned short)(pkbf(v, 0.f) & 0xffffu); }

typedef short s16x4 __attribute__((ext_vector_type(4)));
__device__ __forceinline__ bf16x8 ldfrag_tr(ldsp base, int k0, int ld, int c0, int fr, int fq) {
    const ldsp p = base + ((k0 + 8 * fq + (fr >> 2)) * ld + c0 + 4 * (fr & 3)) * 2;
    const s16x4 lo = __builtin_amdgcn_ds_read_tr16_b64_v4i16((LAS s16x4*)p);
    const s16x4 hi = __builtin_amdgcn_ds_read_tr16_b64_v4i16((LAS s16x4*)(p + 8 * ld));
    return (bf16x8){lo[0], lo[1], lo[2], lo[3], hi[0], hi[1], hi[2], hi[3]};
}
__device__ __forceinline__ void dn_prep(const Args& a, int gw, int ngw, int lane) {
    const bf16* PROJ = (const bf16*)(a.ws + WS_PROJ); bf16* QKVC = (bf16*)(a.ws + WS_QKVC);
    for (int u = gw; u < NB * 8 * (SEQ / 32); u += ngw) {
        const int cb = u & 7, run = (u >> 3) & 63, b = u >> 9, ch0 = cb * 512 + lane * 8, t0 = run * 32, row0 = b * SEQ + t0;
        float w[4][8];
#pragma unroll
        for (int j = 0; j < 4; ++j) { const f32x4 w0 = *(const f32x4*)(a.in[10] + j * 4096 + ch0), w1 = *(const f32x4*)(a.in[10] + j * 4096 + ch0 + 4);
#pragma unroll
            for (int e = 0; e < 4; ++e) { w[j][e] = w0[e]; w[j][4 + e] = w1[e]; } }
        u32x4 xm[3];
#pragma unroll
        for (int j = 0; j < 3; ++j) { xm[j] = (u32x4){0u, 0u, 0u, 0u}; if (t0 - 3 + j >= 0) xm[j] = *(const u32x4*)(PROJ + (size_t)(row0 - 3 + j) * PROJ_LD + ch0); }
        const float scl = cb < 2 ? 0.08838834764831845f : 1.0f;
#pragma unroll 8
        for (int t = 0; t < 32; ++t) {
            const u32x4 x0 = *(const u32x4*)(PROJ + (size_t)(row0 + t) * PROJ_LD + ch0);
            float y[8];
#pragma unroll
            for (int e = 0; e < 4; ++e) {
                const unsigned a3 = xm[0][e], a2 = xm[1][e], a1 = xm[2][e], a0 = x0[e];
                y[2 * e] = w[0][2 * e] * bflo(a3) + w[1][2 * e] * bflo(a2) + w[2][2 * e] * bflo(a1) + w[3][2 * e] * bflo(a0);
                y[2 * e + 1] = w[0][2 * e + 1] * bfhi(a3) + w[1][2 * e + 1] * bfhi(a2) + w[2][2 * e + 1] * bfhi(a1) + w[3][2 * e + 1] * bfhi(a0); }
            float ssq = 0.f;
#pragma unroll
            for (int e = 0; e < 8; ++e) { y[e] = y[e] / (1.0f + __expf(-y[e])); ssq += y[e] * y[e]; }
            if (cb < 4) { ssq += __shfl_xor(ssq, 1); ssq += __shfl_xor(ssq, 2); ssq += __shfl_xor(ssq, 4); ssq += __shfl_xor(ssq, 8); const float sc = rsqrtf(ssq + 1e-6f) * scl;
#pragma unroll
                for (int e = 0; e < 8; ++e) y[e] *= sc; }
            u32x4 o; o.x = pkbf(y[0], y[1]); o.y = pkbf(y[2], y[3]); o.z = pkbf(y[4], y[5]); o.w = pkbf(y[6], y[7]);
            *(u32x4*)(QKVC + (size_t)(row0 + t) * 4096 + ch0) = o;
            xm[0] = xm[1]; xm[1] = xm[2]; xm[2] = x0;
        }
    }
}

__device__ __forceinline__ void dn_prompt(const Args& a, ldsp lds, int b, int h, int tid, int wave, int lane) {
    unsigned char* ws = a.ws;
    const bf16* PROJ = (const bf16*)(ws + WS_PROJ); const bf16* QKVC = (const bf16*)(ws + WS_QKVC); bf16* GATED = (bf16*)(ws + WS_GATED);
    const float* BETA = (const float*)(ws + WS_BETA); const float* GDEC = (const float*)(ws + WS_GDEC);
    const int fr = lane & 15, fq = lane >> 4, mt = wave & 3, ch = wave >> 2, hq = h >> 1;
    LAS float* gcs = (LAS float*)(lds + DL_GC); LAS float* betas = (LAS float*)(lds + DL_BETA); LAS float* red = (LAS float*)(lds + DL_RED);
    const ldsp LK = lds + DL_K, LV = lds + DL_V, LQK = lds + DL_QK, LST = lds + DL_ST;
#define SLOT(s) (lds + DL_X + (s) * DL_SLOT)
#define PRs(s) ((s) == 0 ? 0 : (((s) & 1) ? 2 : 4))
#define PTs(s) ((s) == 0 ? 1 : (((s) & 1) ? 3 : 5))
#define NRs(s) ((s) & 1)
    for (int i = tid; i < 128 * 136 / 2; i += NTHREADS) ((LAS unsigned*)LST)[i] = 0u;
    f32x4 S[2][4];
#pragma unroll
    for (int x = 0; x < 2; ++x)
#pragma unroll
        for (int q = 0; q < 4; ++q) S[x][q] = (f32x4){0.f, 0.f, 0.f, 0.f};
    float ng[4][4];
#pragma unroll
    for (int q = 0; q < 4; ++q)
#pragma unroll
        for (int r = 0; r < 4; ++r) ng[q][r] = a.in[13][16 * (4 * ch + q) + 4 * fq + r];
    __syncthreads();
    const int i_own = 16 * mt + fr;
    for (int c = 0; c < NCHUNK; ++c) {
        const int t_own = c * CHUNK + i_own, row_own = b * SEQ + t_own;
        bf16x8 qf[4], kf[4];
        {
            const bf16* qrow = QKVC + (size_t)row_own * 4096 + hq * 128 + 8 * fq;
#pragma unroll
            for (int kk = 0; kk < 4; ++kk) { qf[kk] = *(const bf16x8*)(qrow + 32 * kk); kf[kk] = *(const bf16x8*)(qrow + 1024 + 32 * kk); }
            const int r = tid >> 3, pc = tid & 7; const bf16* krow = QKVC + (size_t)(b * SEQ + c * CHUNK + r) * 4096;
#pragma unroll
            for (int p2 = 0; p2 < 2; ++p2) { const int col = 8 * (pc + 8 * p2);
                *(LAS u32x4*)(LK + (r * 136 + col) * 2) = *(const u32x4*)(krow + 1024 + hq * 128 + col);
                *(LAS u32x4*)(LV + (r * 136 + col) * 2) = *(const u32x4*)(krow + 2048 + h * 128 + col); }
            if (wave == 0) { const int row = b * SEQ + c * CHUNK + lane; float g = GDEC[(size_t)row * 16 + h];
#pragma unroll
                for (int o = 1; o < 64; o <<= 1) { const float t = __shfl_up(g, o); if (lane >= o) g += t; }
                gcs[lane] = g; betas[lane] = BETA[(size_t)row * 16 + h]; }
        }
        __syncthreads();
        f32x4 Pt[2], Nt[2];
        {
            const float gi = gcs[i_own], bi = betas[i_own];
#pragma unroll
            for (int q2 = 0; q2 < 2; ++q2) { const int nt = 2 * ch + q2;
                f32x4 akk = (f32x4){0.f, 0.f, 0.f, 0.f}, aqk = akk;
#pragma unroll
                for (int kk = 0; kk < 4; ++kk) { const bf16x8 yf = ldfrag(LK, 16 * nt + fr, 136, 32 * kk + 8 * fq); MM_XROW(akk, kf[kk], yf); MM_XROW(aqk, qf[kk], yf); }
                const f32x4 gj = *(const LAS f32x4*)(gcs + 16 * nt + 4 * fq);
                f32x4 qkv, m0;
#pragma unroll
                for (int r = 0; r < 4; ++r) { const int j = 16 * nt + 4 * fq + r; const float d = (i_own >= j) ? __expf(gi - gj[r]) : 0.f; qkv[r] = aqk[r] * d; m0[r] = (i_own > j) ? -bi * akk[r] * d : 0.f; }
                st4(LQK, i_own, 72, 16 * nt + 4 * fq, qkv);
                Pt[q2] = m0; Nt[q2] = m0;
                st4(SLOT(0), i_own, 72, 16 * nt + 4 * fq, m0);
#pragma unroll
                for (int r = 0; r < 4; ++r) st1(SLOT(1), 16 * nt + 4 * fq + r, 72, i_own, m0[r]); }
        }
        __syncthreads();
#pragma unroll
        for (int s = 1; s <= 6; ++s) {
            f32x4 Pn[2];
            bf16x8 xn[2], xp[2];
            if (s >= 2) { xn[0] = ldfrag(SLOT(NRs(s - 2)), i_own, 72, 8 * fq); xn[1] = ldfrag(SLOT(NRs(s - 2)), i_own, 72, 32 + 8 * fq); }
            if (s <= 5) { xp[0] = ldfrag(SLOT(PRs(s - 1)), i_own, 72, 8 * fq); xp[1] = ldfrag(SLOT(PRs(s - 1)), i_own, 72, 32 + 8 * fq); }
#pragma unroll
            for (int q2 = 0; q2 < 2; ++q2) { const int nt = 2 * ch + q2;
                const bf16x8 y0 = ldfrag(SLOT(PTs(s - 1)), 16 * nt + fr, 72, 8 * fq), y1 = ldfrag(SLOT(PTs(s - 1)), 16 * nt + fr, 72, 32 + 8 * fq);
                if (s >= 2) { f32x4 acc = Nt[q2] + Pt[q2]; MM_XROW(acc, xn[0], y0); MM_XROW(acc, xn[1], y1); Nt[q2] = acc; }
                if (s <= 5) { f32x4 acc = (f32x4){0.f, 0.f, 0.f, 0.f}; MM_XROW(acc, xp[0], y0); MM_XROW(acc, xp[1], y1); Pn[q2] = acc; }
            }
#pragma unroll
            for (int q2 = 0; q2 < 2; ++q2) { const int nt = 2 * ch + q2, j0 = 16 * nt + 4 * fq;
                if (s <= 5) { Pt[q2] = Pn[q2];
                    if (s <= 4) st4(SLOT(PRs(s)), i_own, 72, j0, Pn[q2]);
#pragma unroll
                    for (int r = 0; r < 4; ++r) st1(SLOT(PTs(s)), j0 + r, 72, i_own, Pn[q2][r]); }
                if (s >= 2 && s <= 5) st4(SLOT(NRs(s - 1)), i_own, 72, j0, Nt[q2]);
                if (s == 6) {
                    const f32x4 gj = *(const LAS f32x4*)(gcs + j0), bj = *(const LAS f32x4*)(betas + j0); f32x4 t1, t2;
#pragma unroll
                    for (int r = 0; r < 4; ++r) { const float tv = Nt[q2][r] + ((i_own == j0 + r) ? 1.f : 0.f); t2[r] = tv * bj[r]; t1[r] = t2[r] * __expf(gj[r]); }
                    st4(SLOT(1), i_own, 72, j0, t1); st4(SLOT(2), i_own, 72, j0, t2); }
            }
            __syncthreads();
        }
        f32x4 U[4];
        {
            const bf16x8 t1a = ldfrag(SLOT(1), i_own, 72, 8 * fq), t1b = ldfrag(SLOT(1), i_own, 72, 32 + 8 * fq), t2a = ldfrag(SLOT(2), i_own, 72, 8 * fq), t2b = ldfrag(SLOT(2), i_own, 72, 32 + 8 * fq);
#pragma unroll
            for (int q = 0; q < 4; ++q) { const int nt = 4 * ch + q;
                f32x4 aw = (f32x4){0.f, 0.f, 0.f, 0.f};
                MM_XROW(aw, t1a, ldfrag_tr(LK, 0, 136, 16 * nt, fr, fq)); MM_XROW(aw, t1b, ldfrag_tr(LK, 32, 136, 16 * nt, fr, fq));
                st4(SLOT(4), i_own, 136, 16 * nt + 4 * fq, -aw);
                f32x4 au = (f32x4){0.f, 0.f, 0.f, 0.f};
                MM_YROW(au, t2a, ldfrag_tr(LV, 0, 136, 16 * nt, fr, fq)); MM_YROW(au, t2b, ldfrag_tr(LV, 32, 136, 16 * nt, fr, fq));
                U[q] = au; }
        }
        __syncthreads();
        f32x4 O[4];
        const float gl = gcs[63];
        {
            bf16x8 wf[4];
#pragma unroll
            for (int kk = 0; kk < 4; ++kk) wf[kk] = ldfrag(SLOT(4), i_own, 136, 32 * kk + 8 * fq);
            const float ei = __expf(gcs[i_own]);
            const f32x4 gq = *(const LAS f32x4*)(gcs + 16 * mt + 4 * fq);
#pragma unroll
            for (int q = 0; q < 4; ++q) { const int nt = 4 * ch + q;
                f32x4 ao = (f32x4){0.f, 0.f, 0.f, 0.f}, av = U[q];
#pragma unroll
                for (int kk = 0; kk < 4; ++kk) { const bf16x8 sf = ldfrag(LST, 16 * nt + fr, 136, 32 * kk + 8 * fq); MM_YROW(av, wf[kk], sf); MM_XROW(ao, qf[kk], sf); }
                O[q] = ao * ei;
                st4(SLOT(0), 16 * nt + fr, 72, 16 * mt + 4 * fq, av);
                f32x4 avd;
#pragma unroll
                for (int r = 0; r < 4; ++r) avd[r] = av[r] * __expf(gl - gq[r]);
                st4(SLOT(2), 16 * nt + fr, 72, 16 * mt + 4 * fq, avd); }
        }
        __syncthreads();
        {
            const bf16x8 qa = ldfrag(LQK, i_own, 72, 8 * fq), qb = ldfrag(LQK, i_own, 72, 32 + 8 * fq);
            bf16x8 ka[2][2];
#pragma unroll
            for (int x = 0; x < 2; ++x) { ka[x][0] = ldfrag_tr(LK, 0, 136, 16 * (2 * mt + x), fr, fq); ka[x][1] = ldfrag_tr(LK, 32, 136, 16 * (2 * mt + x), fr, fq); }
            const float el = __expf(gl);
            float ssq = 0.f;
#pragma unroll
            for (int q = 0; q < 4; ++q) { const int nt = 4 * ch + q;
                MM_XROW(O[q], qa, ldfrag(SLOT(0), 16 * nt + fr, 72, 8 * fq)); MM_XROW(O[q], qb, ldfrag(SLOT(0), 16 * nt + fr, 72, 32 + 8 * fq));
                ssq += (O[q][0] * O[q][0] + O[q][1] * O[q][1]) + (O[q][2] * O[q][2] + O[q][3] * O[q][3]);
                const bf16x8 v0 = ldfrag(SLOT(2), 16 * nt + fr, 72, 8 * fq), v1 = ldfrag(SLOT(2), 16 * nt + fr, 72, 32 + 8 * fq);
#pragma unroll
                for (int x = 0; x < 2; ++x) { f32x4 sacc = S[x][q] * el; MM_YROW(sacc, ka[x][0], v0); MM_YROW(sacc, ka[x][1], v1); S[x][q] = sacc;
                    st4(LST, 16 * nt + fr, 136, 16 * (2 * mt + x) + 4 * fq, sacc); } }
            ssq += __shfl_xor(ssq, 16); ssq += __shfl_xor(ssq, 32);
            if (fq == 0) red[i_own * 2 + ch] = ssq;
        }
        __syncthreads();
        {
            const float rstd = rsqrtf((red[i_own * 2] + red[i_own * 2 + 1]) * (1.0f / 128.0f) + RMS_EPSF);
#pragma unroll
            for (int q = 0; q < 4; ++q) { const int dv = 16 * (4 * ch + q) + 4 * fq;
                const u32x2 z = *(const u32x2*)(PROJ + (size_t)row_own * PROJ_LD + 4096 + h * 128 + dv);
                u32x2 w; w.x = pkbf(O[q][0] * rstd * ng[q][0] * bflo(z.x), O[q][1] * rstd * ng[q][1] * bfhi(z.x)); w.y = pkbf(O[q][2] * rstd * ng[q][2] * bflo(z.y), O[q][3] * rstd * ng[q][3] * bfhi(z.y));
                *(u32x2*)(GATED + (size_t)row_own * VAL + h * 128 + dv) = w; }
        }
    }
    float* so = a.out + O_SSMP + (size_t)(b * NH + h) * 128 * 128;
#pragma unroll
    for (int x = 0; x < 2; ++x)
#pragma unroll
        for (int q = 0; q < 4; ++q)
#pragma unroll
            for (int r = 0; r < 4; ++r) so[(size_t)(16 * (2 * mt + x) + 4 * fq + r) * 128 + 16 * (4 * ch + q) + fr] = S[x][q][r];
    for (int i = tid; i < 3 * 384; i += NTHREADS) { const int j = i / 384, cc = i % 384; if (cc < 256 && (h & 1)) continue;
        const int gch = cc < 128 ? hq * 128 + cc : (cc < 256 ? 1024 + hq * 128 + (cc - 128) : 2048 + h * 128 + (cc - 256));
        a.out[O_CONVP + (size_t)(b * 3 + j) * 4096 + gch] = bf1(PROJ[(size_t)(b * SEQ + SEQ - 3 + j) * PROJ_LD + gch]); }
    __syncthreads();
#undef SLOT
#undef PRs
#undef PTs
#undef NRs
}
__device__ __forceinline__ void dn_sample_item(const Args& a, ldsp lds, int bs, int h, int tid, int wave, int lane) {
    unsigned char* ws = a.ws;
    const bf16* PROJ = (const bf16*)(ws + WS_PROJ); bf16* GATED = (bf16*)(ws + WS_GATED);
    const float* BETA = (const float*)(ws + WS_BETA); const float* GDEC = (const float*)(ws + WS_GDEC);
    LAS float* qkv = (LAS float*)lds;
    LAS float* red = qkv + 384;
    LAS float* part = qkv + 512;
    const int row = MP + bs, hq = h >> 1;
    float sq = 0.f;
    if (tid < 384) { const int p = tid >> 7, c = tid & 127; const int gch = p == 0 ? hq * 128 + c : (p == 1 ? 1024 + hq * 128 + c : 2048 + h * 128 + c);
        const float x3 = bf1(PROJ[(size_t)row * PROJ_LD + gch]);
        const float* cs = a.in[3] + (size_t)bs * 3 * 4096 + gch; const float c0 = cs[0], c1 = cs[4096], c2 = cs[8192];
        const float* w = a.in[10] + gch;
        float y = c0 * w[0] + c1 * w[4096] + c2 * w[8192] + x3 * w[12288]; y = y / (1.0f + __expf(-y));
        if (p == 2 || (h & 1) == 0) { float* co = a.out + O_CONVS + (size_t)bs * 3 * 4096 + gch; co[0] = c1; co[4096] = c2; co[8192] = x3; }
        qkv[tid] = y; sq = y * y; }
    sq = wave_sum(sq);
    if (lane == 0) red[wave] = sq;
    __syncthreads();
    const float qs = rsqrtf(red[0] + red[1] + 1e-6f) * 0.08838834764831845f, ks = rsqrtf(red[2] + red[3] + 1e-6f);
    const float beta = BETA[(size_t)row * 16 + h], eg = __expf(GDEC[(size_t)row * 16 + h]);
    const int kg = tid >> 5, v4 = tid & 31;
    const float* sin_ = a.in[2] + ((size_t)(bs * NH + h) * 128 + kg * 8) * 128 + 4 * v4;
    float* sout = a.out + O_SSMS + ((size_t)(bs * NH + h) * 128 + kg * 8) * 128 + 4 * v4;
    f32x4 s[8]; f32x4 kv = (f32x4){0.f, 0.f, 0.f, 0.f};
#pragma unroll
    for (int r = 0; r < 8; ++r) { s[r] = *(const f32x4*)(sin_ + r * 128) * eg; kv += s[r] * (qkv[128 + kg * 8 + r] * ks); }
    *(LAS f32x4*)(part + kg * 128 + 4 * v4) = kv;
    __syncthreads();
    kv = (f32x4){0.f, 0.f, 0.f, 0.f};
#pragma unroll
    for (int g = 0; g < 16; ++g) kv += *(const LAS f32x4*)(part + g * 128 + 4 * v4);
    const f32x4 vv = *(const LAS f32x4*)(qkv + 256 + 4 * v4);
    const f32x4 delta = (vv - kv) * beta;
    f32x4 op = (f32x4){0.f, 0.f, 0.f, 0.f};
#pragma unroll
    for (int r = 0; r < 8; ++r) { s[r] += delta * (qkv[128 + kg * 8 + r] * ks); *(f32x4*)(sout + r * 128) = s[r]; op += s[r] * (qkv[kg * 8 + r] * qs); }
    __syncthreads();
    *(LAS f32x4*)(part + kg * 128 + 4 * v4) = op;
    __syncthreads();
    if (tid < 32) {
        f32x4 o = (f32x4){0.f, 0.f, 0.f, 0.f};
#pragma unroll
        for (int g = 0; g < 16; ++g) o += *(const LAS f32x4*)(part + g * 128 + 4 * v4);
        float ss = (o[0] * o[0] + o[1] * o[1]) + (o[2] * o[2] + o[3] * o[3]);
#pragma unroll
        for (int m = 1; m < 32; m <<= 1) ss += __shfl_xor(ss, m);
        const float rstd = rsqrtf(ss * (1.0f / 128.0f) + RMS_EPSF);
        const f32x4 ng = *(const f32x4*)(a.in[13] + 4 * v4);
        const u32x2 z = *(const u32x2*)(PROJ + (size_t)row * PROJ_LD + 4096 + h * 128 + 4 * v4);
        u32x2 w; w.x = pkbf(o[0] * rstd * ng[0] * bflo(z.x), o[1] * rstd * ng[1] * bfhi(z.x)); w.y = pkbf(o[2] * rstd * ng[2] * bflo(z.y), o[3] * rstd * ng[3] * bfhi(z.y));
        *(u32x2*)(GATED + (size_t)row * VAL + h * 128 + 4 * v4) = w;
    }
    __syncthreads();
}
__device__ __forceinline__ void sincos_cw(float x, float& s, float& c) {
    const float k = rintf(x * 0.636619772367581343f);
    float r = fmaf(-k, 1.57079625129699707031f, x); r = fmaf(-k, 7.54978941586159635e-08f, r); r = fmaf(-k, 5.39030285815811482e-15f, r);
    const float z = r * r;
    const float sp = fmaf(fmaf(fmaf(-1.9515295891e-4f, z, 8.3321608736e-3f), z, -1.6666654611e-1f) * z, r, r);
    const float cp = fmaf(fmaf(fmaf(2.443315711809948e-5f, z, -1.388731625493765e-3f), z, 4.166664568298827e-2f), z * z, fmaf(-0.5f, z, 1.0f));
    const int q = (int)k & 3;
    const float ss = (q & 1) ? cp : sp, cc = (q & 1) ? sp : cp;
    s = (q & 2) ? -ss : ss; c = ((q + 1) & 2) ? -cc : cc;
}
__device__ __forceinline__ void s5_disc(const Args& a, int g, int p, float dt, float& lr, float& li, float& fre, float& fim) {
    const float are = a.in[15][g * 64 + p], aim = a.in[16][g * 64 + p];
    const float mag = __expf(are * dt); float sn, cs; sincos_cw(aim * dt, sn, cs);
    lr = mag * cs; li = mag * sn;
    const float den = are * are + aim * aim, nre = lr - 1.0f, nim = li;
    fre = (nre * are + nim * aim) / den; fim = (nim * are - nre * aim) / den;
}
__device__ __forceinline__ float gelu_tanh(float x) { const float u = 0.7978845608028654f * (x + 0.044715f * x * x * x); const float t = 1.0f - 2.0f / (__expf(2.0f * u) + 1.0f); return 0.5f * x * (1.0f + t); }
__device__ __forceinline__ void s5_wave(const Args& a, ldsp wl, bool sample, int b, int e0, int g, int lane) {
    unsigned char* ws = a.ws;
    const bf16* XB = (const bf16*)(ws + WS_XB); bf16* YB = (bf16*)(ws + WS_YB); const float* SS = (const float*)(ws + WS_SS);
    const float* gmix = a.in[6] + D + g * 16;
    const int fr = lane & 15, fq = lane >> 4;
    LAS float* bubuf = (LAS float*)wl;
    const ldsp stbuf = wl + 16 * 132 * 4;
    const float dt = __expf(a.in[17][g]);
    float lr, li, f0, f1; s5_disc(a, g, lane, dt, lr, li, f0, f1);
    bf16x8 bbf[8];
#pragma unroll
    for (int nt = 0; nt < 8; ++nt) { u32x4 w = (u32x4){0u, 0u, 0u, 0u};
        if (fq < 2) { const int p = 8 * nt + (fr >> 1); float l0, l1, fre, fim; s5_disc(a, g, p, dt, l0, l1, fre, fim);
            const float* br = a.in[18] + ((size_t)(g * 64 + p) * 16 + 8 * fq); const float* bi = a.in[19] + ((size_t)(g * 64 + p) * 16 + 8 * fq); float v[8];
#pragma unroll
            for (int e = 0; e < 8; ++e) { const float re = br[e], im = bi[e]; v[e] = ((fr & 1) ? (fre * im + fim * re) : (fre * re - fim * im)) * gmix[8 * fq + e]; }
            w.x = pkbf(v[0], v[1]); w.y = pkbf(v[2], v[3]); w.z = pkbf(v[4], v[5]); w.w = pkbf(v[6], v[7]); }
        bbf[nt] = __builtin_bit_cast(bf16x8, w); }
    bf16x8 cf[4];
#pragma unroll
    for (int kk = 0; kk < 4; ++kk) { const int p0 = 16 * kk + 4 * fq;
        const f32x4 cr = *(const f32x4*)(a.in[20] + (size_t)(g * 16 + fr) * 64 + p0), ci = *(const f32x4*)(a.in[21] + (size_t)(g * 16 + fr) * 64 + p0);
        u32x4 w; w.x = pkbf(cr[0], -ci[0]); w.y = pkbf(cr[1], -ci[1]); w.z = pkbf(cr[2], -ci[2]); w.w = pkbf(cr[3], -ci[3]); cf[kk] = __builtin_bit_cast(bf16x8, w); }
    float dsk[4];
#pragma unroll
    for (int r = 0; r < 4; ++r) dsk[r] = a.in[22][g * 16 + 4 * fq + r] * gmix[4 * fq + r];
    float sre = 0.f, sim = 0.f;
    const int ntile = sample ? 1 : SEQ / 16;
    for (int tile = 0; tile < ntile; ++tile) {
        const int rowbase = sample ? MP + e0 : b * SEQ + tile * 16, row = rowbase + fr;
        const float rs = pg8::row_rstd(SS, row, 16);
        u32x4 xw = (u32x4){0u, 0u, 0u, 0u};
        if (fq < 2) xw = *(const u32x4*)(XB + (size_t)row * D + g * 16 + 8 * fq);
        const bf16x8 xf = __builtin_bit_cast(bf16x8, xw);
#pragma unroll
        for (int nt = 0; nt < 8; ++nt) { f32x4 acc = (f32x4){0.f, 0.f, 0.f, 0.f}; MM_XROW(acc, xf, bbf[nt]); *(LAS f32x4*)(bubuf + fr * 132 + 16 * nt + 4 * fq) = acc * rs; }
        LDS_FENCE();
#pragma unroll
        for (int t = 0; t < 16; ++t) {
            const f32x2 bu = *(const LAS f32x2*)(bubuf + t * 132 + 2 * lane);
            if (sample) { sre = a.in[4][(size_t)(e0 + t) * 4096 + g * 64 + lane]; sim = a.in[5][(size_t)(e0 + t) * 4096 + g * 64 + lane]; }
            const float nr = fmaf(lr, sre, fmaf(-li, sim, bu[0])), ni = fmaf(lr, sim, fmaf(li, sre, bu[1]));
            sre = nr; sim = ni;
            *(LAS unsigned*)(stbuf + (t * 136 + 2 * lane) * 2) = pkbf(sre, sim);
            if (sample) { a.out[O_S5RS + (size_t)(e0 + t) * 4096 + g * 64 + lane] = sre; a.out[O_S5IS + (size_t)(e0 + t) * 4096 + g * 64 + lane] = sim; }
        }
        LDS_FENCE();
        f32x4 y = (f32x4){0.f, 0.f, 0.f, 0.f};
#pragma unroll
        for (int kk = 0; kk < 4; ++kk) MM_XROW(y, ldfrag(stbuf, fr, 136, 32 * kk + 8 * fq), cf[kk]);
        const u32x2 uw = *(const u32x2*)(XB + (size_t)row * D + g * 16 + 4 * fq);
        y[0] += dsk[0] * bflo(uw.x) * rs; y[1] += dsk[1] * bfhi(uw.x) * rs; y[2] += dsk[2] * bflo(uw.y) * rs; y[3] += dsk[3] * bfhi(uw.y) * rs;
        u32x2 w; w.x = pkbf(gelu_tanh(y[0]), gelu_tanh(y[1])); w.y = pkbf(gelu_tanh(y[2]), gelu_tanh(y[3]));
        *(u32x2*)(YB + (size_t)row * D + g * 16 + 4 * fq) = w;
        LDS_FENCE();
    }
    if (!sample) { a.out[O_S5RP + (size_t)(b * 64 + g) * 64 + lane] = sre; a.out[O_S5IP + (size_t)(b * 64 + g) * 64 + lane] = sim; }
}
__global__ void __launch_bounds__(NTHREADS, 2) hybrid_fwd(Args a) {
    extern __shared__ __attribute__((aligned(16))) unsigned char lds_raw[];
    const ldsp lds = (ldsp)lds_raw;
    const int tid = threadIdx.x, lane = tid & 63, wave = __builtin_amdgcn_readfirstlane(tid >> 6);
    const int G = gridDim.x, bx = blockIdx.x;
    const int vcu = (G % 8 == 0) ? (bx % 8) * (G / 8) + bx / 8 : bx;
    unsigned char* ws = a.ws;
    unsigned* ctl = (unsigned*)(ws + WS_CTL);
    for (int u = tid; u < (LDS_BYTES - LDSCTL_OFF) / 4; u += NTHREADS) ((LAS unsigned*)(lds + LDSCTL_OFF))[u] = 0u;
    __syncthreads();
    XcdBarrier bar = xcd_barrier_post(ctl + CW_BAR, (volatile LAS unsigned*)(lds + LDSCTL_OFF) + 8);
    const int gw = vcu * NWAVES + wave, ngw = G * NWAVES;
    bf16* XB = (bf16*)(ws + WS_XB); float* X = (float*)(ws + WS_X); float* SS = (float*)(ws + WS_SS);
    bf16* PROJ = (bf16*)(ws + WS_PROJ); bf16* GATED = (bf16*)(ws + WS_GATED); bf16* YB = (bf16*)(ws + WS_YB); bf16* HB = (bf16*)(ws + WS_H);
#define GEMM_PHASE(EPI, Aop, Bop, N_, K_, E_) do { pg8::Gemm g_{(const pg8::bf16_t*)(Aop), (const pg8::bf16_t*)(Bop), MPAD, (N_), (K_)}; pg8::StaticOrder S_; S_.init(MPAD, (N_), G, bx); \
        pg8::gemm_phase<EPI, pg8::StaticOrder, true, true>(lds, g_, S_, (E_)); } while (0)

#ifndef DBG_STOP
#define DBG_STOP 0
#endif
#define DBG_DIGEST(k, SRC, NEL) do { if (DBG_STOP == (k)) { xcd_barrier(bar); const bf16* s_ = (const bf16*)(SRC); for (size_t i_ = (size_t)bx * NTHREADS + tid; i_ < (size_t)(NEL) && i_ < O_SSMP; i_ += (size_t)G * NTHREADS) a.out[i_] = bf1(s_[i_]); return; } } while (0)
    p0_prologue(a, lds, gw, ngw, wave, lane);
    xcd_barrier(bar);
    { pg8::EpiProj E{(pg8::bf16_t*)PROJ, SS, 16, (float*)(ws + WS_BETA), (float*)(ws + WS_GDEC), a.in[11], a.in[12]};
      GEMM_PHASE(pg8::EpiProj, XB, ws + WS_W1, DN_INP, D, E); }
    DBG_DIGEST(1, PROJ, (size_t)MPAD * PROJ_LD);
    xcd_barrier(bar);
    dn_prep(a, gw, ngw, lane);
    DBG_DIGEST(2, ws + WS_QKVC, (size_t)MP * 4096);
    xcd_barrier(bar);
    if (vcu < NB * NH) dn_prompt(a, lds, vcu / NH, vcu % NH, tid, wave, lane);
    else { const int nw = G - NB * NH; if (nw > 0) for (int it = vcu - NB * NH; it < MS * NH; it += nw) dn_sample_item(a, lds, it / NH, it % NH, tid, wave, lane); }
    DBG_DIGEST(3, GATED, (size_t)MPAD * VAL);
    xcd_barrier(bar);
    { pg8::EpiRes<false> E{a.in[0], a.in[1], X, X + (size_t)MP * D, (pg8::bf16_t*)XB, SS};
      GEMM_PHASE(pg8::EpiRes<false>, GATED, ws + WS_W2, D, VAL, E); }
    DBG_DIGEST(4, XB, (size_t)(MP + MS) * D);
    xcd_barrier(bar);
    { pg8::EpiSwiglu E{(pg8::bf16_t*)HB, FFN, SS, 16};
      GEMM_PHASE(pg8::EpiSwiglu, XB, ws + WS_W3, 2 * FFN, D, E); }
    xcd_barrier(bar);
    { pg8::EpiRes<false> E{X, X + (size_t)MP * D, X, X + (size_t)MP * D, (pg8::bf16_t*)XB, SS};
      GEMM_PHASE(pg8::EpiRes<false>, HB, ws + WS_W4, D, FFN, E); }
    DBG_DIGEST(5, XB, (size_t)(MP + MS) * D);
    xcd_barrier(bar);
    {
        const ldsp wl = lds + wave * 12800;
        for (int it = gw; it < 1024; it += ngw) {
            if (it < 512) s5_wave(a, wl, false, it / 64, 0, it % 64, lane);
            else { const int j = it - 512; s5_wave(a, wl, true, 0, (j & 7) * 16, j >> 3, lane); }
        }
    }
    DBG_DIGEST(6, YB, (size_t)(MP + MS) * D);
    xcd_barrier(bar);
    { pg8::EpiRes<true> E{X, X + (size_t)MP * D, X, X + (size_t)MP * D, (pg8::bf16_t*)XB, SS};
      GEMM_PHASE(pg8::EpiRes<true>, YB, ws + WS_W5, 2 * D, D, E); }
    xcd_barrier(bar);
    { pg8::EpiSwiglu E{(pg8::bf16_t*)HB, FFN, SS, 32};
      GEMM_PHASE(pg8::EpiSwiglu, XB, (bf16*)(ws + WS_W3) + (size_t)2 * FFN * D, 2 * FFN, D, E); }
    xcd_barrier(bar);
    { pg8::EpiRes<false> E{X, X + (size_t)MP * D, a.out + O_YP, a.out + O_YS, (pg8::bf16_t*)XB, SS};
      GEMM_PHASE(pg8::EpiRes<false>, HB, (bf16*)(ws + WS_W4) + (size_t)D * FFN, D, FFN, E); }
    xcd_barrier(bar);
    for (int m = gw; m < MP + MS; m += ngw) {
        f32x4* xr = (f32x4*)(a.out + (m < MP ? O_YP + (size_t)m * D : O_YS + (size_t)(m - MP) * D)) + lane;
        const float rs = pg8::row_rstd(SS, m, 16);
#pragma unroll
        for (int j = 0; j < 4; ++j) { const f32x4 gn = *((const f32x4*)a.in[8] + lane + 64 * j); xr[64 * j] = xr[64 * j] * rs * gn; }
    }
#undef GEMM_PHASE
}

extern "C" void kernel_launch(void* const* d_in, const int* in_sizes, int n_in, void* d_out, int out_size, void* d_ws, size_t ws_size, hipStream_t stream) {
    static int grid = 0;
    if (grid == 0) {
        if (n_in != 26 || (size_t)out_size != O_END || ws_size < WS_END) { fprintf(stderr, "kernel_launch: unexpected shapes: n_in %d out %d ws %zu (need %zu)\n", n_in, out_size, ws_size, (size_t)WS_END); grid = -1; return; }
        int dev = 0, cus = 0, per_cu = 0;
        if (hipGetDevice(&dev) != hipSuccess || hipDeviceGetAttribute(&cus, hipDeviceAttributeMultiprocessorCount, dev) != hipSuccess) { grid = -1; return; }
        if (hipFuncSetAttribute((const void*)hybrid_fwd, hipFuncAttributeMaxDynamicSharedMemorySize, LDS_BYTES) != hipSuccess) { fprintf(stderr, "kernel_launch: hipFuncSetAttribute failed\n"); grid = -1; return; }
        if (hipOccupancyMaxActiveBlocksPerMultiprocessor(&per_cu, (const void*)hybrid_fwd, NTHREADS, LDS_BYTES) != hipSuccess || per_cu < 1) { fprintf(stderr, "kernel_launch: occupancy query says %d\n", per_cu); (void)hipGetLastError(); per_cu = 1; }
        grid = cus;
    }
    if (grid < 0) return;
    (void)hipMemsetAsync((char*)d_ws + WS_CTL, 0, CTL_ZERO_BYTES, stream);
    Args a{};
    for (int i = 0; i < 26; ++i) a.in[i] = (const float*)d_in[i];
    a.out = (float*)d_out; a.ws = (unsigned char*)d_ws;
    hipLaunchKernelGGL(hybrid_fwd, dim3(grid), dim3(NTHREADS), LDS_BYTES, stream, a);
}
```

```cpp
#define DBG_STOP 0
#define REP_DN 1
#define REP_S5 1
#define REP_P0 1
#define RPA 1
#define RPB 1
#define RPE 1
#define RPF 1
#define RPO 1
#include <hip/hip_runtime.h>
#include <cstdio>
#include <cstdint>
namespace pg8 {
#define PG8_LAS __attribute__((address_space(3)))
typedef unsigned short bf16_t;
typedef short bf16x8 __attribute__((ext_vector_type(8)));
typedef float f32x4 __attribute__((ext_vector_type(4)));
typedef unsigned u32x4 __attribute__((ext_vector_type(4)));
constexpr int BM = 256, BK = 64, HALF = 128, HTB = HALF * BK * 2  , STAGE_BYTES = 8 * HTB, NXCD = 8, WGM = 8;

__host__ __device__ __forceinline__ int lds_byte(int r, int c) { const int st = (r >> 4) * 2 + (c >> 5), rr = r & 15, cc = c & 31, ob = rr * 64 + cc * 2; return st * 1024 + (ob ^ (((ob >> 9) & 1) << 5)); }
__host__ __device__ __forceinline__ void stage_rc(int b, int& R, int& C) { const int st = b / 1024, sb = b % 1024, swz = sb ^ (((sb >> 9) & 1) << 5); R = (st >> 1) * 16 + swz / 64; C = (st & 1) * 32 + (swz % 64) / 2; }
__host__ __device__ __forceinline__ int perm32(int rho) { const int n = rho >> 4, i = rho & 15; return 8 * (i >> 2) + 4 * n + (i & 3); }

struct Unit { int pm, pn; };
struct Gemm { const bf16_t* A; const bf16_t* Bt; int M, N, K; };

struct StaticOrder {
    int nM, nN, nwg, G, c;
    __host__ __device__ void init(int M, int N, int G_, int c_) { nM = M / BM; nN = N / BM; nwg = nM * nN; G = G_; c = c_; }
    __host__ __device__ bool next(int i, Unit& u) const {
        const long L = (long)i * G + c; if (L >= nwg) return false;
        int wgid = (int)L; { const int q = nwg / NXCD, r = nwg % NXCD, xcd = wgid % NXCD, off = wgid / NXCD; wgid = (xcd < r ? xcd * (q + 1) : r * (q + 1) + (xcd - r) * q) + off; }
        const int nig = WGM * nN, gid = wgid / nig, fm = gid * WGM, gsz = (nM - fm) < WGM ? (nM - fm) : WGM;
        u.pm = fm + ((wgid % nig) % gsz); u.pn = (wgid % nig) / gsz; return true;
    }
    __device__ __forceinline__ void a_ready(const Unit&) const {}
    __device__ __forceinline__ void done(const Unit&) const {}
};
typedef float f32x2c __attribute__((ext_vector_type(2))); typedef __bf16 bf16x2c __attribute__((ext_vector_type(2)));
__device__ __forceinline__ unsigned cvt_pk_bf16(float lo, float hi) { const f32x2c v = {lo, hi}; return __builtin_bit_cast(unsigned, __builtin_convertvector(v, bf16x2c)); }
typedef unsigned u32x2 __attribute__((ext_vector_type(2)));
constexpr int SS_LD = 32;
constexpr float RMS_EPS = 1e-6f;
__device__ __forceinline__ float silu_f(float x) { return x / (1.0f + __expf(-x)); }
__device__ __forceinline__ float sigmoid_f(float x) { return 1.0f / (1.0f + __expf(-x)); }
__device__ __forceinline__ float row_rstd(const float* ss, int row, int nparts) {
    const f32x4* p = (const f32x4*)(ss + (size_t)row * SS_LD); float s = 0.f;
    for (int i = 0; i < nparts / 4; ++i) { const f32x4 v = p[i]; s += (v[0] + v[1]) + (v[2] + v[3]); }
    return rsqrtf(s * (1.0f / 1024.0f) + RMS_EPS);
}
struct EpiProj {
    static constexpr bool PERM = true, AFTER_DRAIN = false;
    bf16_t* O; const float* ss; int nparts;
    __device__ __forceinline__ void operator()(const f32x4 (&acc)[2][2][4][2], const Unit& u, int wr, int wc, int fr, int fq) const {
        const int row0 = u.pm * BM + wr * 64 + fr;
        {
            const int col0 = u.pn * BM + wc * 32 + 8 * fq; const bool act = u.pn >= 16;
#pragma unroll
            for (int ai = 0; ai < 2; ++ai)
#pragma unroll
                for (int m = 0; m < 4; ++m) { const int row = row0 + ai * HALF + m * 16; bf16_t* rowp = O + (size_t)row * 6144 + col0; const float r = row_rstd(ss, row, nparts);
#pragma unroll
                    for (int bj = 0; bj < 2; ++bj) { f32x4 v0 = acc[ai][bj][m][0] * r, v1 = acc[ai][bj][m][1] * r;
                        if (act) {
#pragma unroll
                            for (int j = 0; j < 4; ++j) { v0[j] = silu_f(v0[j]); v1[j] = silu_f(v1[j]); } }
                        u32x4 w; w.x = cvt_pk_bf16(v0[0], v0[1]); w.y = cvt_pk_bf16(v0[2], v0[3]); w.z = cvt_pk_bf16(v1[0], v1[1]); w.w = cvt_pk_bf16(v1[2], v1[3]);
                        *(u32x4*)(rowp + bj * HALF) = w; }
                    asm volatile("" ::: "memory"); }
        }
    }
};
struct EpiSwiglu {
    static constexpr bool PERM = true, AFTER_DRAIN = false;
    bf16_t* O; int ldo; const float* ss; int nparts;
    __device__ __forceinline__ void operator()(const f32x4 (&acc)[2][2][4][2], const Unit& u, int wr, int wc, int fr, int fq) const {
        const int row0 = u.pm * BM + wr * 64 + fr, col0 = u.pn * HALF + wc * 32 + 8 * fq;
#pragma unroll
        for (int ai = 0; ai < 2; ++ai)
#pragma unroll
            for (int m = 0; m < 4; ++m) { const int row = row0 + ai * HALF + m * 16; const float r = row_rstd(ss, row, nparts);
                f32x4 h0, h1;
#pragma unroll
                for (int j = 0; j < 4; ++j) { h0[j] = silu_f(acc[ai][0][m][0][j] * r) * (acc[ai][1][m][0][j] * r); h1[j] = silu_f(acc[ai][0][m][1][j] * r) * (acc[ai][1][m][1][j] * r); }
                u32x4 w; w.x = cvt_pk_bf16(h0[0], h0[1]); w.y = cvt_pk_bf16(h0[2], h0[3]); w.z = cvt_pk_bf16(h1[0], h1[1]); w.w = cvt_pk_bf16(h1[2], h1[3]);
                *(u32x4*)(O + (size_t)row * ldo + col0) = w; }
    }
};
template <bool GLU> struct EpiRes {
    static constexpr bool PERM = false, AFTER_DRAIN = false;
    const float* base; float* out; bf16_t* XB; float* ss;
    __device__ __forceinline__ void operator()(const f32x4 (&acc)[2][2][4][2], const Unit& u, int wr, int wc, int fr, int fq) const {
        const int col0 = (GLU ? u.pn * HALF : u.pn * BM) + wc * 32 + 4 * fq;
#pragma unroll
        for (int ai = 0; ai < 2; ++ai) {
#pragma unroll
            for (int m = 0; m < 4; ++m) { const int row = u.pm * BM + ai * HALF + wr * 64 + m * 16 + fr;
                const size_t off = (size_t)row * 1024 + col0;
                const float* bp = base + off; float* op = out + off; bf16_t* xp = XB + off;
                float sq = 0.f;
#pragma unroll
                for (int bj = 0; bj < (GLU ? 1 : 2); ++bj)
#pragma unroll
                    for (int n = 0; n < 2; ++n) { const int c = bj * HALF + n * 16; f32x4 v;
                        if (GLU) {
#pragma unroll
                            for (int j = 0; j < 4; ++j) v[j] = acc[ai][0][m][n][j] * sigmoid_f(acc[ai][1][m][n][j]);
                        } else v = acc[ai][bj][m][n];
                        const f32x4 o = *(const f32x4*)(bp + c) + v; *(f32x4*)(op + c) = o;
                        sq += (o[0] * o[0] + o[1] * o[1]) + (o[2] * o[2] + o[3] * o[3]);
                        u32x2 w; w.x = cvt_pk_bf16(o[0], o[1]); w.y = cvt_pk_bf16(o[2], o[3]); *(u32x2*)(xp + c) = w; }
                sq += __shfl_xor(sq, 16); sq += __shfl_xor(sq, 32);
                if (fq == 0) ss[(size_t)row * SS_LD + u.pn * 4 + wc] = sq; }
        }
    }
};

template <class Epi, class Sched, bool ALIGN_EPI = false, bool SP2 = false>
__device__ __forceinline__ void gemm_phase(PG8_LAS unsigned char* lds, const Gemm g, const Sched& S, const Epi& E) {
    const int tid = threadIdx.x, wid = __builtin_amdgcn_readfirstlane(tid >> 6), lane = tid & 63, wr = wid >> 2, wc = wid & 3, fr = lane & 15, fq = lane >> 4;
    const int K = g.K, nt = K / BK;
    unsigned voffA[2], voffB[2];
#pragma unroll
    for (int i = 0; i < 2; ++i) { int R, C; stage_rc(tid * 16 + i * 8192, R, C); const int Rb = Epi::PERM ? ((R & ~31) + perm32(R & 31)) : R;
        voffA[i] = (unsigned)(R * K + C) * 2u; voffB[i] = (unsigned)(Rb * K + C) * 2u; }
    const size_t kstep = (size_t)(BK * 2);
    const size_t hstep = (size_t)HALF * K * 2;
    const size_t tstep = 2 * hstep;
    const unsigned ldsw = (unsigned)wid * 1024u;
    const int aoff = lds_byte(wr * 64 + fr, fq * 8), boff = lds_byte(wc * 32 + fr, fq * 8);
#define PG8_SA(b, h) (((b) * 2 + (h)) * HTB)
#define PG8_SB(b, h) ((4 + (b) * 2 + (h)) * HTB)
#define PG8_STAGE(bufoff, gbase, voff) do { _Pragma("unroll") for (int _i = 0; _i < 2; ++_i) \
        __builtin_amdgcn_global_load_lds((const unsigned*)((const char*)(gbase) + (voff)[_i]), (PG8_LAS unsigned*)(lds + (bufoff) + ldsw + _i * 8192), 16, 0, 0); } while (0)
#define PG8_LDA(dst, b, h) do { _Pragma("unroll") for (int m = 0; m < 4; ++m) _Pragma("unroll") for (int k = 0; k < 2; ++k) dst[m][k] = *(const PG8_LAS bf16x8*)(lds + PG8_SA(b, h) + aoff + m * 2048 + k * 1024); } while (0)
#define PG8_LDB(dst, b, h) do { _Pragma("unroll") for (int n = 0; n < 2; ++n) _Pragma("unroll") for (int k = 0; k < 2; ++k) dst[n][k] = *(const PG8_LAS bf16x8*)(lds + PG8_SB(b, h) + boff + n * 2048 + k * 1024); } while (0)
#define PG8_MMA(ai, bj, At, Bt) do { __builtin_amdgcn_s_setprio(1); _Pragma("unroll") for (int m = 0; m < 4; ++m) _Pragma("unroll") for (int n = 0; n < 2; ++n) _Pragma("unroll") for (int k = 0; k < 2; ++k) \
        acc[ai][bj][m][n] = __builtin_amdgcn_mfma_f32_16x16x32_bf16(Bt[n][k], At[m][k], acc[ai][bj][m][n], 0, 0, 0); __builtin_amdgcn_s_setprio(0); } while (0)
#define PG8_WAIT_V(n) asm volatile("s_waitcnt vmcnt(" #n ")" ::: "memory")
#define PG8_WAIT_L(n) asm volatile("s_waitcnt lgkmcnt(" #n ")" ::: "memory")
#define PG8_BAR __builtin_amdgcn_s_barrier()
#define PG8_SCHED __builtin_amdgcn_sched_barrier(0)
    Unit cur, nxt; int ui = 0;
    if (!S.next(0, cur)) return;
    f32x4 acc[2][2][4][2];
#pragma unroll
    for (int a = 0; a < 2; ++a)
#pragma unroll
        for (int b = 0; b < 2; ++b)
#pragma unroll
            for (int m = 0; m < 4; ++m)
#pragma unroll
                for (int n = 0; n < 2; ++n) acc[a][b][m][n] = (f32x4){0.f, 0.f, 0.f, 0.f};
    bf16x8 At[4][2], B0[2][2], B1[2][2];
    const char* cA = (const char*)g.A + (size_t)cur.pm * tstep; const char* cB = (const char*)g.Bt + (size_t)cur.pn * tstep;
    S.a_ready(cur);
    if constexpr (SP2) {
        PG8_STAGE(PG8_SB(0, 0), cB, voffB); PG8_STAGE(PG8_SB(0, 1), cB + hstep, voffB); PG8_STAGE(PG8_SA(0, 0), cA, voffA); PG8_STAGE(PG8_SA(0, 1), cA + hstep, voffA);
        if (wr == 1) PG8_BAR;
        PG8_WAIT_V(2); PG8_BAR;
        PG8_STAGE(PG8_SB(1, 0), cB + kstep, voffB); PG8_STAGE(PG8_SA(1, 0), cA + kstep, voffA); PG8_STAGE(PG8_SB(1, 1), cB + hstep + kstep, voffB);
        PG8_WAIT_V(6); PG8_BAR;
    } else {
        PG8_STAGE(PG8_SB(0, 0), cB, voffB); PG8_STAGE(PG8_SA(0, 0), cA, voffA); PG8_STAGE(PG8_SB(0, 1), cB + hstep, voffB); PG8_STAGE(PG8_SA(0, 1), cA + hstep, voffA);
        if (wr == 1) PG8_BAR;
        PG8_WAIT_V(4); PG8_BAR;
        PG8_STAGE(PG8_SB(1, 0), cB + kstep, voffB); PG8_STAGE(PG8_SA(1, 0), cA + kstep, voffA); PG8_STAGE(PG8_SB(1, 1), cB + hstep + kstep, voffB);
        PG8_WAIT_V(6); PG8_BAR;
    }
    for (;;) {
        const bool has_next = S.next(ui + 1, nxt);
        const char* nA = has_next ? (const char*)g.A + (size_t)nxt.pm * tstep : cA; const char* nB = has_next ? (const char*)g.Bt + (size_t)nxt.pn * tstep : cB;
        for (int t = 0; t < nt; t += 2) {
            const bool last = (t == nt - 2);
            const char* a1 = cA + (size_t)(t + 1) * kstep;
            const char* a2 = last ? nA : cA + (size_t)(t + 2) * kstep; const char* b2 = last ? nB : cB + (size_t)(t + 2) * kstep;
            const char* a3 = a2 + kstep; const char* b3 = b2 + kstep;
            if (last && has_next) S.a_ready(nxt);
            if constexpr (SP2) {
            PG8_LDB(B0, 0, 0); PG8_LDB(B1, 0, 1); PG8_SCHED; PG8_LDA(At, 0, 0); PG8_STAGE(PG8_SA(1, 1), a1 + hstep, voffA);
            PG8_WAIT_V(8); PG8_WAIT_L(0); PG8_BAR; PG8_MMA(0, 0, At, B0); PG8_MMA(0, 1, At, B1); PG8_BAR; PG8_SCHED;
            PG8_LDA(At, 0, 1); PG8_STAGE(PG8_SB(0, 0), b2, voffB); PG8_STAGE(PG8_SB(0, 1), b2 + hstep, voffB); PG8_STAGE(PG8_SA(0, 0), a2, voffA);
            PG8_WAIT_V(8); PG8_WAIT_L(0); PG8_BAR; PG8_MMA(1, 0, At, B0); PG8_MMA(1, 1, At, B1); PG8_BAR; PG8_SCHED;
            PG8_LDB(B0, 1, 0); PG8_LDB(B1, 1, 1); PG8_SCHED; PG8_LDA(At, 1, 0); PG8_STAGE(PG8_SA(0, 1), a2 + hstep, voffA);
            PG8_WAIT_V(8); PG8_WAIT_L(0); PG8_BAR; PG8_MMA(0, 0, At, B0); PG8_MMA(0, 1, At, B1); PG8_BAR; PG8_SCHED;
            PG8_LDA(At, 1, 1); PG8_STAGE(PG8_SB(1, 0), b3, voffB); PG8_STAGE(PG8_SB(1, 1), b3 + hstep, voffB); PG8_STAGE(PG8_SA(1, 0), a3, voffA);
            PG8_WAIT_V(8); PG8_WAIT_L(0); PG8_BAR; PG8_MMA(1, 0, At, B0); PG8_MMA(1, 1, At, B1); PG8_BAR; PG8_SCHED;
            } else {
            PG8_LDB(B0, 0, 0); PG8_SCHED; PG8_LDA(At, 0, 0); PG8_STAGE(PG8_SA(1, 1), a1 + hstep, voffA);
            PG8_WAIT_L(8); PG8_BAR; PG8_WAIT_L(0); PG8_MMA(0, 0, At, B0); PG8_BAR; PG8_SCHED;
            PG8_LDB(B1, 0, 1); PG8_STAGE(PG8_SB(0, 0), b2, voffB);
            PG8_BAR; PG8_WAIT_L(0); PG8_MMA(0, 1, At, B1); PG8_BAR;
            PG8_LDA(At, 0, 1); PG8_STAGE(PG8_SA(0, 0), a2, voffA);
            PG8_BAR; PG8_WAIT_L(0); PG8_MMA(1, 0, At, B0); PG8_BAR; PG8_SCHED;
            PG8_STAGE(PG8_SB(0, 1), b2 + hstep, voffB);
            PG8_WAIT_V(6); PG8_BAR; PG8_MMA(1, 1, At, B1); PG8_BAR;
            PG8_LDB(B0, 1, 0); PG8_SCHED; PG8_LDA(At, 1, 0); PG8_STAGE(PG8_SA(0, 1), a2 + hstep, voffA);
            PG8_WAIT_L(8); PG8_BAR; PG8_WAIT_L(0); PG8_MMA(0, 0, At, B0); PG8_BAR; PG8_SCHED;
            PG8_LDB(B1, 1, 1); PG8_STAGE(PG8_SB(1, 0), b3, voffB);
            PG8_BAR; PG8_WAIT_L(0); PG8_MMA(0, 1, At, B1); PG8_BAR;
            PG8_LDA(At, 1, 1); PG8_STAGE(PG8_SA(1, 0), a3, voffA);
            PG8_BAR; PG8_WAIT_L(0); PG8_MMA(1, 0, At, B0); PG8_BAR; PG8_SCHED;
            PG8_STAGE(PG8_SB(1, 1), b3 + hstep, voffB);
            PG8_WAIT_V(6); PG8_BAR; PG8_MMA(1, 1, At, B1); PG8_BAR;
            }
        }
        if constexpr (ALIGN_EPI) { if (wr == 0) PG8_BAR; }
        if constexpr (!Epi::AFTER_DRAIN) { E(acc, cur, wr, wc, fr, fq); S.done(cur); }
        if (!has_next) break;
#pragma unroll
        for (int a = 0; a < 2; ++a)
#pragma unroll
            for (int b = 0; b < 2; ++b)
#pragma unroll
                for (int m = 0; m < 4; ++m)
#pragma unroll
                    for (int n = 0; n < 2; ++n) acc[a][b][m][n] = (f32x4){0.f, 0.f, 0.f, 0.f};
        cur = nxt; cA = nA; cB = nB; ++ui;
        if constexpr (ALIGN_EPI) { if (wr == 1) PG8_BAR; }
    }
    PG8_WAIT_V(0);
    if constexpr (!ALIGN_EPI) { if (wr == 0) PG8_BAR; }
    PG8_BAR;
    if constexpr (Epi::AFTER_DRAIN) { E.fused(acc, cur, wr, wc, fr, fq, lds, wid, lane); S.done(cur); }
#undef PG8_SA
#undef PG8_SB
#undef PG8_STAGE
#undef PG8_LDA
#undef PG8_LDB
#undef PG8_MMA
#undef PG8_WAIT_V
#undef PG8_WAIT_L
#undef PG8_BAR
#undef PG8_SCHED
}
}
constexpr int NWAVES = 8, NTHREADS = 512;
constexpr int D = 1024, SEQ = 2048, NB = 8, MP = NB * SEQ  , MS = 128  ;
constexpr int DN_IN = 6176, PROJ_LD = 6144, VAL = 2048, FFN = 2816, NH = 16, CHUNK = 64, NCHUNK = SEQ / CHUNK;
constexpr size_t MiB = 1u << 20;
constexpr size_t WS_CTL = 0, CTL_ZERO_BYTES = 64 * 1024;
constexpr size_t WS_W1 = 1 * MiB;
constexpr size_t WS_W2 = WS_W1 + (size_t)6400 * D * 2;
constexpr size_t WS_W5 = WS_W2 + (size_t)D * VAL * 2;
constexpr size_t WS_W3 = WS_W5 + (size_t)2 * D * D * 2;
constexpr size_t WS_W4 = WS_W3 + (size_t)2 * 2 * FFN * D * 2;
constexpr size_t WS_SS = WS_W4 + (size_t)2 * D * FFN * 2;
constexpr size_t WS_BETA = WS_SS + (size_t)MP * 32 * 4;
constexpr size_t WS_GDEC = WS_BETA + (size_t)MP * 16 * 4;
constexpr size_t WS_SSS = WS_GDEC + (size_t)MP * 16 * 4;
constexpr size_t WS_SBETA = WS_SSS + (size_t)MS * 32 * 4;
constexpr size_t WS_SGDEC = WS_SBETA + (size_t)MS * 16 * 4;
constexpr size_t WS_SXB = WS_SGDEC + (size_t)MS * 16 * 4;
constexpr size_t WS_SX = WS_SXB + (size_t)MS * D * 2;
constexpr size_t WS_SPROJ = WS_SX + (size_t)MS * D * 4;
constexpr size_t WS_SGATED = WS_SPROJ + (size_t)MS * PROJ_LD * 2;
constexpr size_t WS_SH = WS_SGATED + (size_t)MS * VAL * 2;
constexpr size_t WS_SYB = WS_SH + (size_t)MS * FFN * 2;
constexpr size_t WS_XB = (WS_SYB + (size_t)MS * D * 2 + 4095) / 4096 * 4096;
constexpr size_t WS_X = WS_XB + (size_t)MP * D * 2;
constexpr size_t WS_YB = WS_X + (size_t)MP * D * 4;
constexpr size_t WS_GATED = WS_YB + (size_t)MP * D * 2;
constexpr size_t WS_QKVC = WS_XB;
static_assert(WS_QKVC + (size_t)MP * 4096 * 2 <= WS_GATED, "QKVC overlay");
constexpr size_t WS_PROJ = WS_GATED + (size_t)MP * VAL * 2;
constexpr size_t WS_H = WS_PROJ;
constexpr size_t WS_END = WS_PROJ + (size_t)MP * PROJ_LD * 2;
constexpr int CW_BAR = 4096, CW_TEAM = 8192;
constexpr size_t O_YP = 0, O_YS = O_YP + (size_t)MP * D, O_SSMP = O_YS + (size_t)MS * D, O_CONVP = O_SSMP + (size_t)NB * NH * 128 * 128, O_S5RP = O_CONVP + (size_t)NB * 3 * 4096,
                 O_S5IP = O_S5RP + (size_t)NB * 64 * 64, O_SSMS = O_S5IP + (size_t)NB * 64 * 64, O_CONVS = O_SSMS + (size_t)MS * NH * 128 * 128, O_S5RS = O_CONVS + (size_t)MS * 3 * 4096,
                 O_S5IS = O_S5RS + (size_t)MS * 64 * 64, O_END = O_S5IS + (size_t)MS * 64 * 64;
constexpr int LDS_BYTES = 163840, LDSCTL_OFF = LDS_BYTES - 256;

#define GAS __attribute__((address_space(1)))
#define LAS __attribute__((address_space(3)))
typedef unsigned short bf16;
typedef float f32x4 __attribute__((ext_vector_type(4)));
typedef float f32x2 __attribute__((ext_vector_type(2)));
typedef short bf16x8 __attribute__((ext_vector_type(8)));
typedef unsigned u32x4 __attribute__((ext_vector_type(4)));
typedef unsigned u32x2 __attribute__((ext_vector_type(2)));
typedef LAS unsigned char* ldsp;
__device__ __forceinline__ unsigned pkbf(float lo, float hi) { return pg8::cvt_pk_bf16(lo, hi); }
__device__ __forceinline__ float bflo(unsigned w) { return __builtin_bit_cast(float, w << 16); }
__device__ __forceinline__ float bfhi(unsigned w) { return __builtin_bit_cast(float, w & 0xffff0000u); }
__device__ __forceinline__ float bf1(bf16 h) { return __builtin_bit_cast(float, (unsigned)h << 16); }
__device__ __forceinline__ float wave_sum(float v) {
#pragma unroll
    for (int o = 1; o < 64; o <<= 1) v += __shfl_xor(v, o);
    return v;
}
#define MFMA16(a, b, c) __builtin_amdgcn_mfma_f32_16x16x32_bf16((a), (b), (c), 0, 0, 0)
#define MM_XROW(acc, xf, yf) (acc) = MFMA16((yf), (xf), (acc))
#define MM_YROW(acc, xf, yf) (acc) = MFMA16((xf), (yf), (acc))
#define LDS_FENCE() asm volatile("s_waitcnt lgkmcnt(0)" ::: "memory")

struct Args {
    const float* in[26]; float* out; unsigned char* ws; int pad0, pad1;
};
constexpr float RMS_EPSF = 1e-6f;
#define XB_TMO      128
#define XB_XCNT(j)  (256  + 64 * (j))
#define XB_XSUB(j)  (1280 + 64 * (j))
#define XB_XGEN(j)  (2304 + 64 * (j))
#define XB_TOP      3328
#define XB_TOPGEN   3392
#define XCD_BAR_WORDS 3456
#define XB_SPIN_CAP (1u << 18)

__device__ __forceinline__ unsigned xb_ld(unsigned* p)              { return __hip_atomic_load(p, __ATOMIC_RELAXED, __HIP_MEMORY_SCOPE_AGENT); }
__device__ __forceinline__ unsigned xb_add(unsigned* p, unsigned v) { return __hip_atomic_fetch_add(p, v, __ATOMIC_RELAXED, __HIP_MEMORY_SCOPE_AGENT); }
__device__ __forceinline__ unsigned xb_xcc_id() { return (unsigned)__builtin_amdgcn_s_getreg((3 << 11) | 20) & 0xFu; }
#define XB_SPIN(cond, bar) do { unsigned _sp = 0; while (cond) { __builtin_amdgcn_s_sleep(1); \
    if ((++_sp & 255u) == 0u) { if (xb_ld(&(bar)[XB_TMO])) break; if (_sp > XB_SPIN_CAP) { atomicAdd(&(bar)[XB_TMO], 1u); break; } } } } while (0)

struct XcdBarrier {
    unsigned* bar; unsigned x;
    volatile LAS unsigned* st;
};

__device__ __forceinline__ XcdBarrier xcd_barrier_post(unsigned* bar, volatile LAS unsigned* st) {
    XcdBarrier b; b.bar = bar; b.x = xb_xcc_id(); b.st = st;
    if (threadIdx.x == 0) (void)xb_add(&bar[XB_XCNT(b.x)], 1u);
    return b;
}
__device__ __forceinline__ void xcd_barrier_complete(unsigned* bar, unsigned x, unsigned& nloc, unsigned& nx) {
    const unsigned G = gridDim.x * gridDim.y * gridDim.z;
    unsigned sum, cnt, mine, sp = 0u;
    for (;;) {
        sum = 0u; cnt = 0u; mine = 0u;
#pragma unroll
        for (unsigned j = 0; j < 16; ++j) { const unsigned c = xb_ld(&bar[XB_XCNT(j)]); sum += c; cnt += (c > 0u) ? 1u : 0u; mine = (j == x) ? c : mine; }
        if (sum == G) break;
        __builtin_amdgcn_s_sleep(1);
        if ((++sp & 255u) == 0u) { if (xb_ld(&bar[XB_TMO])) break; if (sp > XB_SPIN_CAP) { atomicAdd(&bar[XB_TMO], 1u); break; } }
    }
    nloc = mine > 0u ? mine : 1u; nx = cnt > 0u ? cnt : 1u;
}

__device__ __forceinline__ void xcd_barrier(const XcdBarrier& b) {
    asm volatile("s_waitcnt vmcnt(0)" ::: "memory");
    __syncthreads();
    if (threadIdx.x == 0) {
        unsigned* bar = b.bar;
        __builtin_amdgcn_s_waitcnt(0);
        unsigned nloc = b.st[0], nx = b.st[1];
        if (nloc == 0u) { xcd_barrier_complete(bar, b.x, nloc, nx); b.st[0] = nloc; b.st[1] = nx; }
        const unsigned old = xb_add(&bar[XB_XSUB(b.x)], 1u);
        const unsigned gen = old / nloc;
        if (old + 1u == (gen + 1u) * nloc) {
            __builtin_amdgcn_fence(__ATOMIC_RELEASE, "agent");
            asm volatile("s_waitcnt vmcnt(0)" ::: "memory");
            const unsigned og = xb_add(&bar[XB_TOP], 1u);
            const unsigned tg = og / nx;
            if (og + 1u == (tg + 1u) * nx) xb_add(&bar[XB_TOPGEN], 1u);
            else XB_SPIN(xb_ld(&bar[XB_TOPGEN]) == tg, bar);
            __builtin_amdgcn_fence(__ATOMIC_ACQUIRE, "agent");
            xb_add(&bar[XB_XGEN(b.x)], 1u);
            asm volatile("s_waitcnt vmcnt(0)" ::: "memory");
        } else {
            XB_SPIN(xb_ld(&bar[XB_XGEN(b.x)]) == gen, bar);
            __builtin_amdgcn_fence(__ATOMIC_ACQUIRE, "agent");
            asm volatile("s_waitcnt vmcnt(0)" ::: "memory");
        }
    }
    __syncthreads();
}
template <int NBLK, class Epi>
__device__ __forceinline__ void sgemm_unit(const bf16* A, const bf16* B0, const bf16* B1, int K, const Epi& E, int row0, int cb, int wave, int lane) {
    constexpr int STEPS = (NBLK == 4) ? 2 : 4;
    const int fr = lane & 15, fq = lane >> 4;
    const bf16* ap = A + (size_t)(16 * wave + fr) * K + 8 * fq;
    const bf16* bp[NBLK];
#pragma unroll
    for (int j = 0; j < NBLK; ++j) bp[j] = ((j < 2) ? B0 : B1) + (size_t)(16 * (j & 1) + fr) * K + 8 * fq;
    f32x4 acc[NBLK];
#pragma unroll
    for (int j = 0; j < NBLK; ++j) acc[j] = (f32x4){0.f, 0.f, 0.f, 0.f};
    bf16x8 a0[STEPS], b0[STEPS][NBLK], a1[STEPS], b1[STEPS][NBLK];
#define SG_LOAD(AA, BB, g) do { _Pragma("unroll") for (int s_ = 0; s_ < STEPS; ++s_) { const int ko_ = 32 * ((g) * STEPS + s_); AA[s_] = *(const bf16x8*)(ap + ko_); \
        _Pragma("unroll") for (int j_ = 0; j_ < NBLK; ++j_) BB[s_][j_] = *(const bf16x8*)(bp[j_] + ko_); } } while (0)
#define SG_COMP(AA, BB) do { _Pragma("unroll") for (int s_ = 0; s_ < STEPS; ++s_) _Pragma("unroll") for (int j_ = 0; j_ < NBLK; ++j_) MM_XROW(acc[j_], AA[s_], BB[s_][j_]); } while (0)
    const int ng = K / (32 * STEPS);
    SG_LOAD(a0, b0, 0);
    for (int g = 0; g < ng; g += 2) {
        SG_LOAD(a1, b1, g + 1);
        SG_COMP(a0, b0);
        if (g + 2 < ng) SG_LOAD(a0, b0, g + 2);
        SG_COMP(a1, b1);
    }
#undef SG_LOAD
#undef SG_COMP
    E(acc, row0 + 16 * wave + fr, cb, fq);
}
struct SEpiProj {
    bf16* O; const float* ss; int nparts; float* beta; float* gdec; const float* a_log; const float* dt_bias;
    __device__ __forceinline__ void operator()(const f32x4 (&acc)[2], int row, int cb, int fq) const {
        const float rs = pg8::row_rstd(ss, row, nparts);
        if (cb < 192) {
#pragma unroll
            for (int j = 0; j < 2; ++j) { f32x4 v = acc[j] * rs;
                if (cb >= 128) {
#pragma unroll
                    for (int r = 0; r < 4; ++r) v[r] = pg8::silu_f(v[r]); }
                u32x2 w; w.x = pkbf(v[0], v[1]); w.y = pkbf(v[2], v[3]); *(u32x2*)(O + (size_t)row * PROJ_LD + 32 * cb + 16 * j + 4 * fq) = w; }
        } else {
            f32x4 b, g;
#pragma unroll
            for (int r = 0; r < 4; ++r) { b[r] = pg8::sigmoid_f(acc[0][r] * rs); const int h = 4 * fq + r; const float xx = acc[1][r] * rs + dt_bias[h]; const float ex = __expf(xx);
                const float sp = xx > 15.f ? xx : (ex < 1e-3f ? ex * (1.0f - 0.5f * ex) : __logf(1.0f + ex)); g[r] = -__expf(a_log[h]) * sp; }
            *(f32x4*)(beta + (size_t)row * 16 + 4 * fq) = b; *(f32x4*)(gdec + (size_t)row * 16 + 4 * fq) = g;
        }
    }
};
template <bool GLU> struct SEpiRes {
    const float* base; float* out; bf16* XB; float* ss;
    __device__ __forceinline__ void operator()(const f32x4 (&acc)[GLU ? 4 : 2], int row, int cb, int fq) const {
        float sq = 0.f;
#pragma unroll
        for (int j = 0; j < 2; ++j) { f32x4 v = acc[j];
            if (GLU) {
#pragma unroll
                for (int r = 0; r < 4; ++r) v[r] = v[r] * pg8::sigmoid_f(acc[2 + j][r]); }
            const size_t off = (size_t)row * D + 32 * cb + 16 * j + 4 * fq;
            const f32x4 o = *(const f32x4*)(base + off) + v; *(f32x4*)(out + off) = o;
            sq += (o[0] * o[0] + o[1] * o[1]) + (o[2] * o[2] + o[3] * o[3]);
            u32x2 w; w.x = pkbf(o[0], o[1]); w.y = pkbf(o[2], o[3]); *(u32x2*)(XB + off) = w; }
        sq += __shfl_xor(sq, 16); sq += __shfl_xor(sq, 32);
        if (fq == 0) ss[(size_t)row * 32 + cb] = sq;
    }
};
struct SEpiSwiglu {
    bf16* H; const float* ss; int nparts;
    __device__ __forceinline__ void operator()(const f32x4 (&acc)[4], int row, int cb, int fq) const {
        const float rs = pg8::row_rstd(ss, row, nparts);
#pragma unroll
        for (int j = 0; j < 2; ++j) { f32x4 h;
#pragma unroll
            for (int r = 0; r < 4; ++r) h[r] = pg8::silu_f(acc[j][r] * rs) * (acc[2 + j][r] * rs);
            u32x2 w; w.x = pkbf(h[0], h[1]); w.y = pkbf(h[2], h[3]); *(u32x2*)(H + (size_t)row * FFN + 32 * cb + 16 * j + 4 * fq) = w; }
    }
};
__device__ __forceinline__ void team_barrier(unsigned* cnt, unsigned target) {
    asm volatile("s_waitcnt vmcnt(0)" ::: "memory");
    __syncthreads();
    if (threadIdx.x == 0) {
        __builtin_amdgcn_fence(__ATOMIC_RELEASE, "agent");
        asm volatile("s_waitcnt vmcnt(0)" ::: "memory");
        (void)__hip_atomic_fetch_add(cnt, 1u, __ATOMIC_RELAXED, __HIP_MEMORY_SCOPE_AGENT);
        unsigned sp = 0;
        while (__hip_atomic_load(cnt, __ATOMIC_RELAXED, __HIP_MEMORY_SCOPE_AGENT) < target) { __builtin_amdgcn_s_sleep(2); if (++sp > (1u << 22)) break; }
        __builtin_amdgcn_fence(__ATOMIC_ACQUIRE, "agent");
        asm volatile("s_waitcnt vmcnt(0)" ::: "memory");
    }
    __syncthreads();
}
__device__ __forceinline__ void p0_transpose_item(const float* W, int K, int N, const float* gain, int gluh, bf16* WT, LAS float* scr, int item, int lane) {
    const int nblk = N / 32, kb = item / nblk, nb = item % nblk, k0 = 64 * kb, n0 = 32 * nb;
#pragma unroll 8
    for (int i = 0; i < 32; ++i) { const int kk = 2 * i + (lane >> 5); float v = W[(size_t)(k0 + kk) * N + n0 + (lane & 31)]; if (gain) v *= gain[k0 + kk]; scr[kk * 33 + (lane & 31)] = v; }
    LDS_FENCE();
    int r0 = n0; if (gluh > 0) r0 = (n0 < gluh) ? (n0 / 128) * 256 + (n0 % 128) : ((n0 - gluh) / 128) * 256 + 128 + ((n0 - gluh) % 128);
    const int c = lane & 7;
#pragma unroll
    for (int j = 0; j < 4; ++j) { const int n = (lane >> 3) + 8 * j; const LAS float* s = scr + (8 * c) * 33 + n;
        u32x4 o; o.x = pkbf(s[0 * 33], s[1 * 33]); o.y = pkbf(s[2 * 33], s[3 * 33]); o.z = pkbf(s[4 * 33], s[5 * 33]); o.w = pkbf(s[6 * 33], s[7 * 33]);
        *(u32x4*)(WT + (size_t)(r0 + n) * K + k0 + 8 * c) = o; }
    LDS_FENCE();
}
__device__ __forceinline__ void p0_prologue(const Args& a, ldsp lds, int gw, int ngw, int wave, int lane) {
    LAS float* scr = (LAS float*)(lds + wave * 16384);
    unsigned char* ws = a.ws;
    constexpr int I1 = (D / 64) * (DN_IN / 32), I2 = (VAL / 64) * (D / 32), I5 = (D / 64) * (2 * D / 32), I3 = (D / 64) * (2 * FFN / 32), I4 = (FFN / 64) * (D / 32);
    constexpr int NITEMS = I1 + I2 + I5 + 2 * I3 + 2 * I4;
    for (int it = gw; it < NITEMS; it += ngw) {
        int r = it;
        if (r < I1) { p0_transpose_item(a.in[9], D, DN_IN, a.in[6], 0, (bf16*)(ws + WS_W1), scr, r, lane); continue; } r -= I1;
        if (r < I2) { p0_transpose_item(a.in[14], VAL, D, nullptr, 0, (bf16*)(ws + WS_W2), scr, r, lane); continue; } r -= I2;
        if (r < I5) { p0_transpose_item(a.in[23], D, 2 * D, nullptr, D, (bf16*)(ws + WS_W5), scr, r, lane); continue; } r -= I5;
        if (r < 2 * I3) { const int l = r / I3; p0_transpose_item(a.in[24] + (size_t)l * D * 2 * FFN, D, 2 * FFN, a.in[7] + l * D, FFN, (bf16*)(ws + WS_W3) + (size_t)l * 2 * FFN * D, scr, r % I3, lane); continue; } r -= 2 * I3;
        { const int l = r / I4; p0_transpose_item(a.in[25] + (size_t)l * FFN * D, FFN, D, nullptr, 0, (bf16*)(ws + WS_W4) + (size_t)l * D * FFN, scr, r % I4, lane); }
    }
    for (int m = gw; m < MP + MS; m += ngw) {
        const bool smp = m >= MP; const int r = smp ? m - MP : m;
        const f32x4* xr = (const f32x4*)((smp ? a.in[1] : a.in[0]) + (size_t)r * D) + lane;
        f32x4 v[4]; float s = 0.f;
#pragma unroll
        for (int j = 0; j < 4; ++j) { v[j] = xr[64 * j]; s += (v[j][0] * v[j][0] + v[j][1] * v[j][1]) + (v[j][2] * v[j][2] + v[j][3] * v[j][3]); }
        s = wave_sum(s);
        u32x2* o8 = (u32x2*)((bf16*)(ws + (smp ? WS_SXB : WS_XB)) + (size_t)r * D) + lane;
#pragma unroll
        for (int j = 0; j < 4; ++j) { u32x2 w; w.x = pkbf(v[j][0], v[j][1]); w.y = pkbf(v[j][2], v[j][3]); o8[64 * j] = w; }
        float* ssr = (float*)(ws + (smp ? WS_SSS : WS_SS)) + (size_t)r * 32;
        if (lane < (smp ? 32 : 16)) ssr[lane] = (lane == 0) ? s : 0.f;
    }
}
constexpr int DL_K = 0, DL_V = 17408, DL_QK = 34816, DL_X = 44032, DL_SLOT = 9216, DL_ST = 99328, DL_GC = 134144, DL_BETA = 134400, DL_RED = 134656, DL_END = 135168;
static_assert(DL_END <= LDSCTL_OFF, "DN LDS map");
__device__ __forceinline__ bf16x8 ldfrag(ldsp base, int row, int ld, int k) { return *(const LAS bf16x8*)(base + (row * ld + k) * 2); }
__device__ __forceinline__ void st4(ldsp base, int row, int ld, int col, const f32x4 v) { u32x2 w; w.x = pkbf(v[0], v[1]); w.y = pkbf(v[2], v[3]); *(LAS u32x2*)(base + (row * ld + col) * 2) = w; }
__device__ __forceinline__ void st1(ldsp base, int row, int ld, int col, float v) { *(LAS unsigned short*)(base + (row * ld + col) * 2) = (unsigned short)(pkbf(v, 0.f) & 0xffffu); }

typedef short s16x4 __attribute__((ext_vector_type(4)));
__device__ __forceinline__ bf16x8 ldfrag_tr(ldsp base, int k0, int ld, int c0, int fr, int fq) {
    const ldsp p = base + ((k0 + 8 * fq + (fr >> 2)) * ld + c0 + 4 * (fr & 3)) * 2;
    const s16x4 lo = __builtin_amdgcn_ds_read_tr16_b64_v4i16((LAS s16x4*)p);
    const s16x4 hi = __builtin_amdgcn_ds_read_tr16_b64_v4i16((LAS s16x4*)(p + 8 * ld));
    return (bf16x8){lo[0], lo[1], lo[2], lo[3], hi[0], hi[1], hi[2], hi[3]};
}
__device__ __forceinline__ void dn_prep(const Args& a, int gw, int ngw, int lane) {
    const bf16* PROJ = (const bf16*)(a.ws + WS_PROJ); bf16* QKVC = (bf16*)(a.ws + WS_QKVC);
    for (int u = gw; u < NB * 8 * (SEQ / 32); u += ngw) {
        const int cb = u & 7, run = (u >> 3) & 63, b = u >> 9, ch0 = cb * 512 + lane * 8, t0 = run * 32, row0 = b * SEQ + t0;
        float w[4][8];
#pragma unroll
        for (int j = 0; j < 4; ++j) { const f32x4 w0 = *(const f32x4*)(a.in[10] + j * 4096 + ch0), w1 = *(const f32x4*)(a.in[10] + j * 4096 + ch0 + 4);
#pragma unroll
            for (int e = 0; e < 4; ++e) { w[j][e] = w0[e]; w[j][4 + e] = w1[e]; } }
        u32x4 xm[3];
#pragma unroll
        for (int j = 0; j < 3; ++j) { xm[j] = (u32x4){0u, 0u, 0u, 0u}; if (t0 - 3 + j >= 0) xm[j] = *(const u32x4*)(PROJ + (size_t)(row0 - 3 + j) * PROJ_LD + ch0); }
        const float scl = cb < 2 ? 0.08838834764831845f : 1.0f;
#pragma unroll 8
        for (int t = 0; t < 32; ++t) {
            const u32x4 x0 = *(const u32x4*)(PROJ + (size_t)(row0 + t) * PROJ_LD + ch0);
            float y[8];
#pragma unroll
            for (int e = 0; e < 4; ++e) {
                const unsigned a3 = xm[0][e], a2 = xm[1][e], a1 = xm[2][e], a0 = x0[e];
                y[2 * e] = w[0][2 * e] * bflo(a3) + w[1][2 * e] * bflo(a2) + w[2][2 * e] * bflo(a1) + w[3][2 * e] * bflo(a0);
                y[2 * e + 1] = w[0][2 * e + 1] * bfhi(a3) + w[1][2 * e + 1] * bfhi(a2) + w[2][2 * e + 1] * bfhi(a1) + w[3][2 * e + 1] * bfhi(a0); }
            float ssq = 0.f;
#pragma unroll
            for (int e = 0; e < 8; ++e) { y[e] = y[e] / (1.0f + __expf(-y[e])); ssq += y[e] * y[e]; }
            if (cb < 4) { ssq += __shfl_xor(ssq, 1); ssq += __shfl_xor(ssq, 2); ssq += __shfl_xor(ssq, 4); ssq += __shfl_xor(ssq, 8); const float sc = rsqrtf(ssq + 1e-6f) * scl;
#pragma unroll
                for (int e = 0; e < 8; ++e) y[e] *= sc; }
            u32x4 o; o.x = pkbf(y[0], y[1]); o.y = pkbf(y[2], y[3]); o.z = pkbf(y[4], y[5]); o.w = pkbf(y[6], y[7]);
            *(u32x4*)(QKVC + (size_t)(row0 + t) * 4096 + ch0) = o;
            xm[0] = xm[1]; xm[1] = xm[2]; xm[2] = x0;
        }
    }
}

#ifndef RPA
#define RPA 1
#endif
#ifndef RPB
#define RPB 1
#endif
#ifndef RPE
#define RPE 1
#endif
#ifndef RPF
#define RPF 1
#endif
#ifndef RPO
#define RPO 1
#endif
__device__ __forceinline__ void dn_prompt(const Args& a, ldsp lds, int b, int h, int tid, int wave, int lane) {
    unsigned char* ws = a.ws;
    const bf16* PROJ = (const bf16*)(ws + WS_PROJ); const bf16* QKVC = (const bf16*)(ws + WS_QKVC); bf16* GATED = (bf16*)(ws + WS_GATED);
    const float* BETA = (const float*)(ws + WS_BETA); const float* GDEC = (const float*)(ws + WS_GDEC);
    const int fr = lane & 15, fq = lane >> 4, mt = wave & 3, ch = wave >> 2, hq = h >> 1;
    LAS float* gcs = (LAS float*)(lds + DL_GC); LAS float* betas = (LAS float*)(lds + DL_BETA); LAS float* red = (LAS float*)(lds + DL_RED);
    const ldsp LK = lds + DL_K, LV = lds + DL_V, LQK = lds + DL_QK, LST = lds + DL_ST;
#define SLOT(s) (lds + DL_X + (s) * DL_SLOT)
#define PRs(s) ((s) == 0 ? 0 : (((s) & 1) ? 2 : 4))
#define PTs(s) ((s) == 0 ? 1 : (((s) & 1) ? 3 : 5))
#define NRs(s) ((s) & 1)
    for (int i = tid; i < 128 * 136 / 2; i += NTHREADS) ((LAS unsigned*)LST)[i] = 0u;
    f32x4 S[2][4];
#pragma unroll
    for (int x = 0; x < 2; ++x)
#pragma unroll
        for (int q = 0; q < 4; ++q) S[x][q] = (f32x4){0.f, 0.f, 0.f, 0.f};
    float ng[4][4];
#pragma unroll
    for (int q = 0; q < 4; ++q)
#pragma unroll
        for (int r = 0; r < 4; ++r) ng[q][r] = a.in[13][16 * (4 * ch + q) + 4 * fq + r];
    __syncthreads();
    const int i_own = 16 * mt + fr;
    for (int c = 0; c < NCHUNK; ++c) {
        const int t_own = c * CHUNK + i_own, row_own = b * SEQ + t_own;
        bf16x8 qf[4], kf[4];
        for (int rpA = 0; rpA < RPA; ++rpA) {
        {
            const bf16* qrow = QKVC + (size_t)row_own * 4096 + hq * 128 + 8 * fq;
#pragma unroll
            for (int kk = 0; kk < 4; ++kk) { qf[kk] = *(const bf16x8*)(qrow + 32 * kk); kf[kk] = *(const bf16x8*)(qrow + 1024 + 32 * kk); }
            const int r = tid >> 3, pc = tid & 7; const bf16* krow = QKVC + (size_t)(b * SEQ + c * CHUNK + r) * 4096;
#pragma unroll
            for (int p2 = 0; p2 < 2; ++p2) { const int col = 8 * (pc + 8 * p2);
                *(LAS u32x4*)(LK + (r * 136 + col) * 2) = *(const u32x4*)(krow + 1024 + hq * 128 + col);
                *(LAS u32x4*)(LV + (r * 136 + col) * 2) = *(const u32x4*)(krow + 2048 + h * 128 + col); }
            if (wave == 0) { const int row = b * SEQ + c * CHUNK + lane; float g = GDEC[(size_t)row * 16 + h];
#pragma unroll
                for (int o = 1; o < 64; o <<= 1) { const float t = __shfl_up(g, o); if (lane >= o) g += t; }
                gcs[lane] = g; betas[lane] = BETA[(size_t)row * 16 + h]; }
        }
        __syncthreads();
        }
        for (int rpB = 0; rpB < RPB; ++rpB) {
        f32x4 Pt[2], Nt[2];
        {
            const float gi = gcs[i_own], bi = betas[i_own];
#pragma unroll
            for (int q2 = 0; q2 < 2; ++q2) { const int nt = 2 * ch + q2;
                f32x4 akk = (f32x4){0.f, 0.f, 0.f, 0.f}, aqk = akk;
#pragma unroll
                for (int kk = 0; kk < 4; ++kk) { const bf16x8 yf = ldfrag(LK, 16 * nt + fr, 136, 32 * kk + 8 * fq); MM_XROW(akk, kf[kk], yf); MM_XROW(aqk, qf[kk], yf); }
                const f32x4 gj = *(const LAS f32x4*)(gcs + 16 * nt + 4 * fq);
                f32x4 qkv, m0;
#pragma unroll
                for (int r = 0; r < 4; ++r) { const int j = 16 * nt + 4 * fq + r; const float d = (i_own >= j) ? __expf(gi - gj[r]) : 0.f; qkv[r] = aqk[r] * d; m0[r] = (i_own > j) ? -bi * akk[r] * d : 0.f; }
                st4(LQK, i_own, 72, 16 * nt + 4 * fq, qkv);
                Pt[q2] = m0; Nt[q2] = m0;
                st4(SLOT(0), i_own, 72, 16 * nt + 4 * fq, m0);
#pragma unroll
                for (int r = 0; r < 4; ++r) st1(SLOT(1), 16 * nt + 4 * fq + r, 72, i_own, m0[r]); }
        }
        __syncthreads();
#pragma unroll
        for (int s = 1; s <= 6; ++s) {
            f32x4 Pn[2];
            bf16x8 xn[2], xp[2];
            if (s >= 2) { xn[0] = ldfrag(SLOT(NRs(s - 2)), i_own, 72, 8 * fq); xn[1] = ldfrag(SLOT(NRs(s - 2)), i_own, 72, 32 + 8 * fq); }
            if (s <= 5) { xp[0] = ldfrag(SLOT(PRs(s - 1)), i_own, 72, 8 * fq); xp[1] = ldfrag(SLOT(PRs(s - 1)), i_own, 72, 32 + 8 * fq); }
#pragma unroll
            for (int q2 = 0; q2 < 2; ++q2) { const int nt = 2 * ch + q2;
                const bf16x8 y0 = ldfrag(SLOT(PTs(s - 1)), 16 * nt + fr, 72, 8 * fq), y1 = ldfrag(SLOT(PTs(s - 1)), 16 * nt + fr, 72, 32 + 8 * fq);
                if (s >= 2) { f32x4 acc = Nt[q2] + Pt[q2]; MM_XROW(acc, xn[0], y0); MM_XROW(acc, xn[1], y1); Nt[q2] = acc; }
                if (s <= 5) { f32x4 acc = (f32x4){0.f, 0.f, 0.f, 0.f}; MM_XROW(acc, xp[0], y0); MM_XROW(acc, xp[1], y1); Pn[q2] = acc; }
            }
#pragma unroll
            for (int q2 = 0; q2 < 2; ++q2) { const int nt = 2 * ch + q2, j0 = 16 * nt + 4 * fq;
                if (s <= 5) { Pt[q2] = Pn[q2];
                    if (s <= 4) st4(SLOT(PRs(s)), i_own, 72, j0, Pn[q2]);
#pragma unroll
                    for (int r = 0; r < 4; ++r) st1(SLOT(PTs(s)), j0 + r, 72, i_own, Pn[q2][r]); }
                if (s >= 2 && s <= 5) st4(SLOT(NRs(s - 1)), i_own, 72, j0, Nt[q2]);
                if (s == 6) {
                    const f32x4 gj = *(const LAS f32x4*)(gcs + j0), bj = *(const LAS f32x4*)(betas + j0); f32x4 t1, t2;
#pragma unroll
                    for (int r = 0; r < 4; ++r) { const float tv = Nt[q2][r] + ((i_own == j0 + r) ? 1.f : 0.f); t2[r] = tv * bj[r]; t1[r] = t2[r] * __expf(gj[r]); }
                    st4(SLOT(1), i_own, 72, j0, t1); st4(SLOT(2), i_own, 72, j0, t2); }
            }
            __syncthreads();
        }
        }
        f32x4 U[4];
        for (int rpE = 0; rpE < RPE; ++rpE) {
        {
            const bf16x8 t1a = ldfrag(SLOT(1), i_own, 72, 8 * fq), t1b = ldfrag(SLOT(1), i_own, 72, 32 + 8 * fq), t2a = ldfrag(SLOT(2), i_own, 72, 8 * fq), t2b = ldfrag(SLOT(2), i_own, 72, 32 + 8 * fq);
#pragma unroll
            for (int q = 0; q < 4; ++q) { const int nt = 4 * ch + q;
                f32x4 aw = (f32x4){0.f, 0.f, 0.f, 0.f};
                MM_XROW(aw, t1a, ldfrag_tr(LK, 0, 136, 16 * nt, fr, fq)); MM_XROW(aw, t1b, ldfrag_tr(LK, 32, 136, 16 * nt, fr, fq));
                st4(SLOT(4), i_own, 136, 16 * nt + 4 * fq, -aw);
                f32x4 au = (f32x4){0.f, 0.f, 0.f, 0.f};
                MM_YROW(au, t2a, ldfrag_tr(LV, 0, 136, 16 * nt, fr, fq)); MM_YROW(au, t2b, ldfrag_tr(LV, 32, 136, 16 * nt, fr, fq));
                U[q] = au; }
        }
        __syncthreads();
        }
        f32x4 O[4];
        const float gl = gcs[63];
        for (int rpF = 0; rpF < RPF; ++rpF) {
        {
            bf16x8 wf[4];
#pragma unroll
            for (int kk = 0; kk < 4; ++kk) wf[kk] = ldfrag(SLOT(4), i_own, 136, 32 * kk + 8 * fq);
            const float ei = __expf(gcs[i_own]);
            const f32x4 gq = *(const LAS f32x4*)(gcs + 16 * mt + 4 * fq);
#pragma unroll
            for (int q = 0; q < 4; ++q) { const int nt = 4 * ch + q;
                f32x4 ao = (f32x4){0.f, 0.f, 0.f, 0.f}, av = U[q];
#pragma unroll
                for (int kk = 0; kk < 4; ++kk) { const bf16x8 sf = ldfrag(LST, 16 * nt + fr, 136, 32 * kk + 8 * fq); MM_YROW(av, wf[kk], sf); MM_XROW(ao, qf[kk], sf); }
                O[q] = ao * ei;
                st4(SLOT(0), 16 * nt + fr, 72, 16 * mt + 4 * fq, av);
                f32x4 avd;
#pragma unroll
                for (int r = 0; r < 4; ++r) avd[r] = av[r] * __expf(gl - gq[r]);
                st4(SLOT(2), 16 * nt + fr, 72, 16 * mt + 4 * fq, avd); }
        }
        __syncthreads();
        }
        {
            const bf16x8 qa = ldfrag(LQK, i_own, 72, 8 * fq), qb = ldfrag(LQK, i_own, 72, 32 + 8 * fq);
            bf16x8 ka[2][2];
#pragma unroll
            for (int x = 0; x < 2; ++x) { ka[x][0] = ldfrag_tr(LK, 0, 136, 16 * (2 * mt + x), fr, fq); ka[x][1] = ldfrag_tr(LK, 32, 136, 16 * (2 * mt + x), fr, fq); }
            const float el = __expf(gl);
            float ssq = 0.f;
#pragma unroll
            for (int q = 0; q < 4; ++q) { const int nt = 4 * ch + q;
                MM_XROW(O[q], qa, ldfrag(SLOT(0), 16 * nt + fr, 72, 8 * fq)); MM_XROW(O[q], qb, ldfrag(SLOT(0), 16 * nt + fr, 72, 32 + 8 * fq));
                ssq += (O[q][0] * O[q][0] + O[q][1] * O[q][1]) + (O[q][2] * O[q][2] + O[q][3] * O[q][3]);
                const bf16x8 v0 = ldfrag(SLOT(2), 16 * nt + fr, 72, 8 * fq), v1 = ldfrag(SLOT(2), 16 * nt + fr, 72, 32 + 8 * fq);
#pragma unroll
                for (int x = 0; x < 2; ++x) { f32x4 sacc = S[x][q] * el; MM_YROW(sacc, ka[x][0], v0); MM_YROW(sacc, ka[x][1], v1); S[x][q] = sacc;
                    st4(LST, 16 * nt + fr, 136, 16 * (2 * mt + x) + 4 * fq, sacc); } }
            ssq += __shfl_xor(ssq, 16); ssq += __shfl_xor(ssq, 32);
            if (fq == 0) red[i_own * 2 + ch] = ssq;
        }
        __syncthreads();
        for (int rpO = 0; rpO < RPO; ++rpO) {
        {
            const float rstd = rsqrtf((red[i_own * 2] + red[i_own * 2 + 1]) * (1.0f / 128.0f) + RMS_EPSF);
#pragma unroll
            for (int q = 0; q < 4; ++q) { const int dv = 16 * (4 * ch + q) + 4 * fq;
                const u32x2 z = *(const u32x2*)(PROJ + (size_t)row_own * PROJ_LD + 4096 + h * 128 + dv);
                u32x2 w; w.x = pkbf(O[q][0] * rstd * ng[q][0] * bflo(z.x), O[q][1] * rstd * ng[q][1] * bfhi(z.x)); w.y = pkbf(O[q][2] * rstd * ng[q][2] * bflo(z.y), O[q][3] * rstd * ng[q][3] * bfhi(z.y));
                *(u32x2*)(GATED + (size_t)row_own * VAL + h * 128 + dv) = w; }
        }
        }
    }
    float* so = a.out + O_SSMP + (size_t)(b * NH + h) * 128 * 128;
#pragma unroll
    for (int x = 0; x < 2; ++x)
#pragma unroll
        for (int q = 0; q < 4; ++q)
#pragma unroll
            for (int r = 0; r < 4; ++r) so[(size_t)(16 * (2 * mt + x) + 4 * fq + r) * 128 + 16 * (4 * ch + q) + fr] = S[x][q][r];
    for (int i = tid; i < 3 * 384; i += NTHREADS) { const int j = i / 384, cc = i % 384; if (cc < 256 && (h & 1)) continue;
        const int gch = cc < 128 ? hq * 128 + cc : (cc < 256 ? 1024 + hq * 128 + (cc - 128) : 2048 + h * 128 + (cc - 256));
        a.out[O_CONVP + (size_t)(b * 3 + j) * 4096 + gch] = bf1(PROJ[(size_t)(b * SEQ + SEQ - 3 + j) * PROJ_LD + gch]); }
    __syncthreads();
#undef SLOT
#undef PRs
#undef PTs
#undef NRs
}
__device__ __forceinline__ void dn_sample_item(const Args& a, ldsp lds, int bs, int h, int tid, int wave, int lane) {
    unsigned char* ws = a.ws;
    const bf16* PROJ = (const bf16*)(ws + WS_SPROJ); bf16* GATED = (bf16*)(ws + WS_SGATED);
    const float* BETA = (const float*)(ws + WS_SBETA); const float* GDEC = (const float*)(ws + WS_SGDEC);
    LAS float* qkv = (LAS float*)lds;
    LAS float* red = qkv + 384;
    LAS float* part = qkv + 512;
    const int row = bs, hq = h >> 1;
    float sq = 0.f;
    if (tid < 384) { const int p = tid >> 7, c = tid & 127; const int gch = p == 0 ? hq * 128 + c : (p == 1 ? 1024 + hq * 128 + c : 2048 + h * 128 + c);
        const float x3 = bf1(PROJ[(size_t)row * PROJ_LD + gch]);
        const float* cs = a.in[3] + (size_t)bs * 3 * 4096 + gch; const float c0 = cs[0], c1 = cs[4096], c2 = cs[8192];
        const float* w = a.in[10] + gch;
        float y = c0 * w[0] + c1 * w[4096] + c2 * w[8192] + x3 * w[12288]; y = y / (1.0f + __expf(-y));
        if (p == 2 || (h & 1) == 0) { float* co = a.out + O_CONVS + (size_t)bs * 3 * 4096 + gch; co[0] = c1; co[4096] = c2; co[8192] = x3; }
        qkv[tid] = y; sq = y * y; }
    sq = wave_sum(sq);
    if (lane == 0) red[wave] = sq;
    __syncthreads();
    const float qs = rsqrtf(red[0] + red[1] + 1e-6f) * 0.08838834764831845f, ks = rsqrtf(red[2] + red[3] + 1e-6f);
    const float beta = BETA[(size_t)row * 16 + h], eg = __expf(GDEC[(size_t)row * 16 + h]);
    const int kg = tid >> 5, v4 = tid & 31;
    const float* sin_ = a.in[2] + ((size_t)(bs * NH + h) * 128 + kg * 8) * 128 + 4 * v4;
    float* sout = a.out + O_SSMS + ((size_t)(bs * NH + h) * 128 + kg * 8) * 128 + 4 * v4;
    f32x4 s[8]; f32x4 kv = (f32x4){0.f, 0.f, 0.f, 0.f};
#pragma unroll
    for (int r = 0; r < 8; ++r) { s[r] = *(const f32x4*)(sin_ + r * 128) * eg; kv += s[r] * (qkv[128 + kg * 8 + r] * ks); }
    *(LAS f32x4*)(part + kg * 128 + 4 * v4) = kv;
    __syncthreads();
    kv = (f32x4){0.f, 0.f, 0.f, 0.f};
#pragma unroll
    for (int g = 0; g < 16; ++g) kv += *(const LAS f32x4*)(part + g * 128 + 4 * v4);
    const f32x4 vv = *(const LAS f32x4*)(qkv + 256 + 4 * v4);
    const f32x4 delta = (vv - kv) * beta;
    f32x4 op = (f32x4){0.f, 0.f, 0.f, 0.f};
#pragma unroll
    for (int r = 0; r < 8; ++r) { s[r] += delta * (qkv[128 + kg * 8 + r] * ks); *(f32x4*)(sout + r * 128) = s[r]; op += s[r] * (qkv[kg * 8 + r] * qs); }
    __syncthreads();
    *(LAS f32x4*)(part + kg * 128 + 4 * v4) = op;
    __syncthreads();
    if (tid < 32) {
        f32x4 o = (f32x4){0.f, 0.f, 0.f, 0.f};
#pragma unroll
        for (int g = 0; g < 16; ++g) o += *(const LAS f32x4*)(part + g * 128 + 4 * v4);
        float ss = (o[0] * o[0] + o[1] * o[1]) + (o[2] * o[2] + o[3] * o[3]);
#pragma unroll
        for (int m = 1; m < 32; m <<= 1) ss += __shfl_xor(ss, m);
        const float rstd = rsqrtf(ss * (1.0f / 128.0f) + RMS_EPSF);
        const f32x4 ng = *(const f32x4*)(a.in[13] + 4 * v4);
        const u32x2 z = *(const u32x2*)(PROJ + (size_t)row * PROJ_LD + 4096 + h * 128 + 4 * v4);
        u32x2 w; w.x = pkbf(o[0] * rstd * ng[0] * bflo(z.x), o[1] * rstd * ng[1] * bfhi(z.x)); w.y = pkbf(o[2] * rstd * ng[2] * bflo(z.y), o[3] * rstd * ng[3] * bfhi(z.y));
        *(u32x2*)(GATED + (size_t)row * VAL + h * 128 + 4 * v4) = w;
    }
    __syncthreads();
}
__device__ __forceinline__ void sincos_cw(float x, float& s, float& c) {
    const float k = rintf(x * 0.636619772367581343f);
    float r = fmaf(-k, 1.57079625129699707031f, x); r = fmaf(-k, 7.54978941586159635e-08f, r); r = fmaf(-k, 5.39030285815811482e-15f, r);
    const float z = r * r;
    const float sp = fmaf(fmaf(fmaf(-1.9515295891e-4f, z, 8.3321608736e-3f), z, -1.6666654611e-1f) * z, r, r);
    const float cp = fmaf(fmaf(fmaf(2.443315711809948e-5f, z, -1.388731625493765e-3f), z, 4.166664568298827e-2f), z * z, fmaf(-0.5f, z, 1.0f));
    const int q = (int)k & 3;
    const float ss = (q & 1) ? cp : sp, cc = (q & 1) ? sp : cp;
    s = (q & 2) ? -ss : ss; c = ((q + 1) & 2) ? -cc : cc;
}
__device__ __forceinline__ void s5_disc(const Args& a, int g, int p, float dt, float& lr, float& li, float& fre, float& fim) {
    const float are = a.in[15][g * 64 + p], aim = a.in[16][g * 64 + p];
    const float mag = __expf(are * dt); float sn, cs; sincos_cw(aim * dt, sn, cs);
    lr = mag * cs; li = mag * sn;
    const float den = are * are + aim * aim, nre = lr - 1.0f, nim = li;
    fre = (nre * are + nim * aim) / den; fim = (nim * are - nre * aim) / den;
}
__device__ __forceinline__ float gelu_tanh(float x) { const float u = 0.7978845608028654f * (x + 0.044715f * x * x * x); const float t = 1.0f - 2.0f / (__expf(2.0f * u) + 1.0f); return 0.5f * x * (1.0f + t); }
__device__ __forceinline__ void s5_wave(const Args& a, ldsp wl, bool sample, int b, int e0, int g, int lane) {
    unsigned char* ws = a.ws;
    const bf16* XB = (const bf16*)(ws + (sample ? WS_SXB : WS_XB)); bf16* YB = (bf16*)(ws + (sample ? WS_SYB : WS_YB)); const float* SS = (const float*)(ws + (sample ? WS_SSS : WS_SS));
    const float* gmix = a.in[6] + D + g * 16;
    const int fr = lane & 15, fq = lane >> 4;
    LAS float* bubuf = (LAS float*)wl;
    const ldsp stbuf = wl + 16 * 132 * 4;
    const float dt = __expf(a.in[17][g]);
    float lr, li, f0, f1; s5_disc(a, g, lane, dt, lr, li, f0, f1);
    bf16x8 bbf[8];
#pragma unroll
    for (int nt = 0; nt < 8; ++nt) { u32x4 w = (u32x4){0u, 0u, 0u, 0u};
        if (fq < 2) { const int p = 8 * nt + (fr >> 1); float l0, l1, fre, fim; s5_disc(a, g, p, dt, l0, l1, fre, fim);
            const float* br = a.in[18] + ((size_t)(g * 64 + p) * 16 + 8 * fq); const float* bi = a.in[19] + ((size_t)(g * 64 + p) * 16 + 8 * fq); float v[8];
#pragma unroll
            for (int e = 0; e < 8; ++e) { const float re = br[e], im = bi[e]; v[e] = ((fr & 1) ? (fre * im + fim * re) : (fre * re - fim * im)) * gmix[8 * fq + e]; }
            w.x = pkbf(v[0], v[1]); w.y = pkbf(v[2], v[3]); w.z = pkbf(v[4], v[5]); w.w = pkbf(v[6], v[7]); }
        bbf[nt] = __builtin_bit_cast(bf16x8, w); }
    bf16x8 cf[4];
#pragma unroll
    for (int kk = 0; kk < 4; ++kk) { const int p0 = 16 * kk + 4 * fq;
        const f32x4 cr = *(const f32x4*)(a.in[20] + (size_t)(g * 16 + fr) * 64 + p0), ci = *(const f32x4*)(a.in[21] + (size_t)(g * 16 + fr) * 64 + p0);
        u32x4 w; w.x = pkbf(cr[0], -ci[0]); w.y = pkbf(cr[1], -ci[1]); w.z = pkbf(cr[2], -ci[2]); w.w = pkbf(cr[3], -ci[3]); cf[kk] = __builtin_bit_cast(bf16x8, w); }
    float dsk[4];
#pragma unroll
    for (int r = 0; r < 4; ++r) dsk[r] = a.in[22][g * 16 + 4 * fq + r] * gmix[4 * fq + r];
    float sre = 0.f, sim = 0.f;
    const int ntile = sample ? 1 : SEQ / 16;
    const int rowb0 = sample ? e0 : b * SEQ;
    u32x4 pxw[4]; f32x4 pss[4]; u32x2 puw[4];
#define S5_LOAD(k, tile) do { const int row_ = rowb0 + (tile) * 16 + fr; pxw[k] = (u32x4){0u, 0u, 0u, 0u}; if (fq < 2) pxw[k] = *(const u32x4*)(XB + (size_t)row_ * D + g * 16 + 8 * fq); \
        pss[k] = *(const f32x4*)(SS + (size_t)row_ * 32 + 4 * fq); if (sample) pss[k] += *(const f32x4*)(SS + (size_t)row_ * 32 + 16 + 4 * fq); puw[k] = *(const u32x2*)(XB + (size_t)row_ * D + g * 16 + 4 * fq); } while (0)
#pragma unroll
    for (int k = 0; k < 4; ++k) if (k < ntile) S5_LOAD(k, k);
    for (int t0 = 0; t0 < ntile; t0 += 4) {
#pragma unroll
        for (int k = 0; k < 4; ++k) {
            const int tile = t0 + k; if (tile >= ntile) break;
            const int row = rowb0 + tile * 16 + fr;
            const bf16x8 xf = __builtin_bit_cast(bf16x8, pxw[k]);
            float ssum = (pss[k][0] + pss[k][1]) + (pss[k][2] + pss[k][3]); ssum += __shfl_xor(ssum, 16); ssum += __shfl_xor(ssum, 32);
            const float rs = rsqrtf(ssum * (1.0f / 1024.0f) + RMS_EPSF);
            const u32x2 uw = puw[k];
            if (tile + 4 < ntile) S5_LOAD(k, tile + 4);
#pragma unroll
            for (int nt = 0; nt < 8; ++nt) { f32x4 acc = (f32x4){0.f, 0.f, 0.f, 0.f}; MM_XROW(acc, xf, bbf[nt]); *(LAS f32x4*)(bubuf + fr * 132 + 16 * nt + 4 * fq) = acc * rs; }
            LDS_FENCE();
            f32x2 buv[16];
#pragma unroll
            for (int t = 0; t < 16; ++t) buv[t] = *(const LAS f32x2*)(bubuf + t * 132 + 2 * lane);
            LDS_FENCE();
#pragma unroll
            for (int t = 0; t < 16; ++t) {
                const f32x2 bu = buv[t];
                if (sample) { sre = a.in[4][(size_t)(e0 + t) * 4096 + g * 64 + lane]; sim = a.in[5][(size_t)(e0 + t) * 4096 + g * 64 + lane]; }
                const float nr = fmaf(lr, sre, fmaf(-li, sim, bu[0])), ni = fmaf(lr, sim, fmaf(li, sre, bu[1]));
                sre = nr; sim = ni;
                *(LAS unsigned*)(stbuf + (t * 136 + 2 * lane) * 2) = pkbf(sre, sim);
                if (sample) { a.out[O_S5RS + (size_t)(e0 + t) * 4096 + g * 64 + lane] = sre; a.out[O_S5IS + (size_t)(e0 + t) * 4096 + g * 64 + lane] = sim; }
            }
            LDS_FENCE();
            f32x4 y = (f32x4){0.f, 0.f, 0.f, 0.f};
#pragma unroll
            for (int kk = 0; kk < 4; ++kk) MM_XROW(y, ldfrag(stbuf, fr, 136, 32 * kk + 8 * fq), cf[kk]);
            y[0] += dsk[0] * bflo(uw.x) * rs; y[1] += dsk[1] * bfhi(uw.x) * rs; y[2] += dsk[2] * bflo(uw.y) * rs; y[3] += dsk[3] * bfhi(uw.y) * rs;
            u32x2 w; w.x = pkbf(gelu_tanh(y[0]), gelu_tanh(y[1])); w.y = pkbf(gelu_tanh(y[2]), gelu_tanh(y[3]));
            *(u32x2*)(YB + (size_t)row * D + g * 16 + 4 * fq) = w;
            LDS_FENCE();
        }
    }
#undef S5_LOAD
    if (!sample) { a.out[O_S5RP + (size_t)(b * 64 + g) * 64 + lane] = sre; a.out[O_S5IP + (size_t)(b * 64 + g) * 64 + lane] = sim; }
}
__global__ void __launch_bounds__(NTHREADS, 2) hybrid_fwd(Args a) {
    extern __shared__ __attribute__((aligned(16))) unsigned char lds_raw[];
    const ldsp lds = (ldsp)lds_raw;
    const int tid = threadIdx.x, lane = tid & 63, wave = __builtin_amdgcn_readfirstlane(tid >> 6);
    const int G = gridDim.x, bx = blockIdx.x;
    const int vcu = (G % 8 == 0) ? (bx % 8) * (G / 8) + bx / 8 : bx;
    unsigned char* ws = a.ws;
    unsigned* ctl = (unsigned*)(ws + WS_CTL);
    for (int u = tid; u < (LDS_BYTES - LDSCTL_OFF) / 4; u += NTHREADS) ((LAS unsigned*)(lds + LDSCTL_OFF))[u] = 0u;
    __syncthreads();
    XcdBarrier bar = xcd_barrier_post(ctl + CW_BAR, (volatile LAS unsigned*)(lds + LDSCTL_OFF) + 8);
    const int gw = vcu * NWAVES + wave, ngw = G * NWAVES;
    bf16* XB = (bf16*)(ws + WS_XB); float* X = (float*)(ws + WS_X); float* SS = (float*)(ws + WS_SS);
    bf16* PROJ = (bf16*)(ws + WS_PROJ); bf16* GATED = (bf16*)(ws + WS_GATED); bf16* YB = (bf16*)(ws + WS_YB); bf16* HB = (bf16*)(ws + WS_H);
    const bf16* W1 = (const bf16*)(ws + WS_W1); const bf16* W2 = (const bf16*)(ws + WS_W2); const bf16* W5 = (const bf16*)(ws + WS_W5);
    const bf16* W3 = (const bf16*)(ws + WS_W3); const bf16* W4 = (const bf16*)(ws + WS_W4);
#define GEMM_PHASE(EPI, Aop, Bop, N_, K_, E_) do { pg8::Gemm g_{(const pg8::bf16_t*)(Aop), (const pg8::bf16_t*)(Bop), MP, (N_), (K_)}; pg8::StaticOrder S_; S_.init(MP, (N_), G, bx); \
        pg8::gemm_phase<EPI, pg8::StaticOrder, true, true>(lds, g_, S_, (E_)); } while (0)
#ifndef DBG_STOP
#define DBG_STOP 0
#endif
#define DBG_DIGEST(k, SRC, NEL) do { if (DBG_STOP == (k)) { xcd_barrier(bar); const bf16* s_ = (const bf16*)(SRC); for (size_t i_ = (size_t)bx * NTHREADS + tid; i_ < (size_t)(NEL) && i_ < O_SSMP; i_ += (size_t)G * NTHREADS) a.out[i_] = bf1(s_[i_]); return; } } while (0)

    p0_prologue(a, lds, gw, ngw, wave, lane);
    xcd_barrier(bar);
    { pg8::EpiProj E{(pg8::bf16_t*)PROJ, SS, 16};
      GEMM_PHASE(pg8::EpiProj, XB, W1, PROJ_LD, D, E); }
    {
        const SEpiProj Ep{nullptr, SS, 16, (float*)(ws + WS_BETA), (float*)(ws + WS_GDEC), a.in[11], a.in[12]};
        const SEpiProj Es{(bf16*)(ws + WS_SPROJ), (const float*)(ws + WS_SSS), 32, (float*)(ws + WS_SBETA), (float*)(ws + WS_SGDEC), a.in[11], a.in[12]};
        for (int u = vcu; u < 128 + 193; u += G) {
            if (u < 128) sgemm_unit<2>(XB + (size_t)u * 128 * D, W1 + (size_t)6144 * D, nullptr, D, Ep, u * 128, 192, wave, lane);
            else sgemm_unit<2>((const bf16*)(ws + WS_SXB), W1 + (size_t)(u - 128) * 32 * D, nullptr, D, Es, 0, u - 128, wave, lane);
        }
    }
    DBG_DIGEST(1, PROJ, (size_t)MP * PROJ_LD);
    xcd_barrier(bar);
    dn_prep(a, gw, ngw, lane);
    DBG_DIGEST(2, ws + WS_QKVC, (size_t)MP * 4096);
    xcd_barrier(bar);
    if (vcu < NB * NH) dn_prompt(a, lds, vcu / NH, vcu % NH, tid, wave, lane);
    else {
        const int nt = G - NB * NH, ti = vcu - NB * NH;
        unsigned* tcnt = ctl + CW_TEAM; unsigned ep = 0;
        float* SX = (float*)(ws + WS_SX); bf16* SXB = (bf16*)(ws + WS_SXB); float* SSS = (float*)(ws + WS_SSS);
        bf16* SGATED = (bf16*)(ws + WS_SGATED); bf16* SH = (bf16*)(ws + WS_SH); bf16* SYB = (bf16*)(ws + WS_SYB);
#define TEAM_BAR() team_barrier(tcnt, (unsigned)nt * (++ep))
        for (int it = ti; it < MS * NH; it += nt) dn_sample_item(a, lds, it / NH, it % NH, tid, wave, lane);
        TEAM_BAR();
        { const SEpiRes<false> E{a.in[1], SX, SXB, SSS};
          for (int u = ti; u < D / 32; u += nt) sgemm_unit<2>(SGATED, W2 + (size_t)u * 32 * VAL, nullptr, VAL, E, 0, u, wave, lane); }
        TEAM_BAR();
        for (int l = 0; l < 2; ++l) {
            { const SEpiSwiglu E{SH, SSS, 32};
              for (int u = ti; u < FFN / 32; u += nt) { const bf16* bg = W3 + (size_t)l * 2 * FFN * D + (size_t)((u >> 2) * 256 + (u & 3) * 32) * D;
                  sgemm_unit<4>(SXB, bg, bg + (size_t)128 * D, D, E, 0, u, wave, lane); } }
            TEAM_BAR();
            { const SEpiRes<false> E{SX, l == 0 ? SX : a.out + O_YS, SXB, SSS};
              for (int u = ti; u < D / 32; u += nt) sgemm_unit<2>(SH, W4 + (size_t)l * D * FFN + (size_t)u * 32 * FFN, nullptr, FFN, E, 0, u, wave, lane); }
            TEAM_BAR();
            if (l == 0) {
                const ldsp wl = lds + wave * 12800;
                for (int j = ti * NWAVES + wave; j < 512; j += nt * NWAVES) s5_wave(a, wl, true, 0, (j & 7) * 16, j >> 3, lane);
                TEAM_BAR();
                { const SEpiRes<true> E{SX, SX, SXB, SSS};
                  for (int u = ti; u < D / 32; u += nt) { const bf16* bv = W5 + (size_t)((u >> 2) * 256 + (u & 3) * 32) * D;
                      sgemm_unit<4>(SYB, bv, bv + (size_t)128 * D, D, E, 0, u, wave, lane); } }
                TEAM_BAR();
            }
        }
        for (int m = ti * NWAVES + wave; m < MS; m += nt * NWAVES) {
            f32x4* xr = (f32x4*)(a.out + O_YS + (size_t)m * D) + lane;
            const float rs = pg8::row_rstd(SSS, m, 32);
#pragma unroll
            for (int j = 0; j < 4; ++j) { const f32x4 gn = *((const f32x4*)a.in[8] + lane + 64 * j); xr[64 * j] = xr[64 * j] * rs * gn; }
        }
#undef TEAM_BAR
    }
    DBG_DIGEST(3, GATED, (size_t)MP * VAL);
    xcd_barrier(bar);
    { pg8::EpiRes<false> E{a.in[0], X, (pg8::bf16_t*)XB, SS};
      GEMM_PHASE(pg8::EpiRes<false>, GATED, W2, D, VAL, E); }
    xcd_barrier(bar);
    { pg8::EpiSwiglu E{(pg8::bf16_t*)HB, FFN, SS, 16};
      GEMM_PHASE(pg8::EpiSwiglu, XB, W3, 2 * FFN, D, E); }
    xcd_barrier(bar);
    { pg8::EpiRes<false> E{X, X, (pg8::bf16_t*)XB, SS};
      GEMM_PHASE(pg8::EpiRes<false>, HB, W4, D, FFN, E); }
    xcd_barrier(bar);
    {
        const ldsp wl = lds + wave * 12800;
        for (int it = gw; it < 512; it += ngw) s5_wave(a, wl, false, it / 64, 0, it % 64, lane);
    }
    xcd_barrier(bar);
    { pg8::EpiRes<true> E{X, X, (pg8::bf16_t*)XB, SS};
      GEMM_PHASE(pg8::EpiRes<true>, YB, W5, 2 * D, D, E); }
    xcd_barrier(bar);
    { pg8::EpiSwiglu E{(pg8::bf16_t*)HB, FFN, SS, 32};
      GEMM_PHASE(pg8::EpiSwiglu, XB, W3 + (size_t)2 * FFN * D, 2 * FFN, D, E); }
    xcd_barrier(bar);
    { pg8::EpiRes<false> E{X, a.out + O_YP, (pg8::bf16_t*)XB, SS};
      GEMM_PHASE(pg8::EpiRes<false>, HB, W4 + (size_t)D * FFN, D, FFN, E); }
    xcd_barrier(bar);
    for (int m = gw; m < MP; m += ngw) {
        f32x4* xr = (f32x4*)(a.out + O_YP + (size_t)m * D) + lane;
        const float rs = pg8::row_rstd(SS, m, 16);
#pragma unroll
        for (int j = 0; j < 4; ++j) { const f32x4 gn = *((const f32x4*)a.in[8] + lane + 64 * j); xr[64 * j] = xr[64 * j] * rs * gn; }
    }
#undef GEMM_PHASE
}

extern "C" void kernel_launch(void* const* d_in, const int* in_sizes, int n_in, void* d_out, int out_size, void* d_ws, size_t ws_size, hipStream_t stream) {
    static int grid = 0;
    if (grid == 0) {
        if (n_in != 26 || (size_t)out_size != O_END || ws_size < WS_END) { fprintf(stderr, "kernel_launch: unexpected shapes: n_in %d out %d ws %zu (need %zu)\n", n_in, out_size, ws_size, (size_t)WS_END); grid = -1; return; }
        int dev = 0, cus = 0, per_cu = 0;
        if (hipGetDevice(&dev) != hipSuccess || hipDeviceGetAttribute(&cus, hipDeviceAttributeMultiprocessorCount, dev) != hipSuccess) { grid = -1; return; }
        if (hipFuncSetAttribute((const void*)hybrid_fwd, hipFuncAttributeMaxDynamicSharedMemorySize, LDS_BYTES) != hipSuccess) { fprintf(stderr, "kernel_launch: hipFuncSetAttribute failed\n"); grid = -1; return; }
        if (hipOccupancyMaxActiveBlocksPerMultiprocessor(&per_cu, (const void*)hybrid_fwd, NTHREADS, LDS_BYTES) != hipSuccess || per_cu < 1) { fprintf(stderr, "kernel_launch: occupancy query says %d\n", per_cu); (void)hipGetLastError(); per_cu = 1; }
        grid = cus;
    }
    if (grid < 0) return;
    (void)hipMemsetAsync((char*)d_ws + WS_CTL, 0, CTL_ZERO_BYTES, stream);
    Args a{};
    for (int i = 0; i < 26; ++i) a.in[i] = (const float*)d_in[i];
    a.out = (float*)d_out; a.ws = (unsigned char*)d_ws;
    hipLaunchKernelGGL(hybrid_fwd, dim3(grid), dim3(NTHREADS), LDS_BYTES, stream, a);
}
```

```cpp
#define DBG_STOP 0
#define REP_DN 1
#define REP_S5 1
#define REP_P0 1
#define REPG 0
#define TPROBE 0
#define RPA 1
#define RPB 1
#define RPE 1
#define RPF 1
#define RPO 1
#include <hip/hip_runtime.h>
#include <cstdio>
#include <cstdint>
namespace pg8 {
#define PG8_LAS __attribute__((address_space(3)))
typedef unsigned short bf16_t;
typedef short bf16x8 __attribute__((ext_vector_type(8)));
typedef float f32x4 __attribute__((ext_vector_type(4)));
typedef unsigned u32x4 __attribute__((ext_vector_type(4)));
constexpr int BM = 256, BK = 64, HALF = 128, HTB = HALF * BK * 2  , STAGE_BYTES = 8 * HTB, NXCD = 8, WGM = 8;

__host__ __device__ __forceinline__ int lds_byte(int r, int c) { const int st = (r >> 4) * 2 + (c >> 5), rr = r & 15, cc = c & 31, ob = rr * 64 + cc * 2; return st * 1024 + (ob ^ (((ob >> 9) & 1) << 5)); }
__host__ __device__ __forceinline__ void stage_rc(int b, int& R, int& C) { const int st = b / 1024, sb = b % 1024, swz = sb ^ (((sb >> 9) & 1) << 5); R = (st >> 1) * 16 + swz / 64; C = (st & 1) * 32 + (swz % 64) / 2; }
__host__ __device__ __forceinline__ int perm32(int rho) { const int n = rho >> 4, i = rho & 15; return 8 * (i >> 2) + 4 * n + (i & 3); }

struct Unit { int pm, pn; };
struct Gemm { const bf16_t* A; const bf16_t* Bt; int M, N, K; };

struct StaticOrder {
    int nM, nN, nwg, G, c;
    __host__ __device__ void init(int M, int N, int G_, int c_) { nM = M / BM; nN = N / BM; nwg = nM * nN; G = G_; c = c_; }
    __host__ __device__ bool next(int i, Unit& u) const {
        const long L = (long)i * G + c; if (L >= nwg) return false;
        int wgid = (int)L; { const int q = nwg / NXCD, r = nwg % NXCD, xcd = wgid % NXCD, off = wgid / NXCD; wgid = (xcd < r ? xcd * (q + 1) : r * (q + 1) + (xcd - r) * q) + off; }
        const int nig = WGM * nN, gid = wgid / nig, fm = gid * WGM, gsz = (nM - fm) < WGM ? (nM - fm) : WGM;
        u.pm = fm + ((wgid % nig) % gsz); u.pn = (wgid % nig) / gsz; return true;
    }
    __device__ __forceinline__ void a_ready(const Unit&) const {}
    __device__ __forceinline__ void done(const Unit&) const {}
};
typedef float f32x2c __attribute__((ext_vector_type(2))); typedef __bf16 bf16x2c __attribute__((ext_vector_type(2)));
__device__ __forceinline__ unsigned cvt_pk_bf16(float lo, float hi) { const f32x2c v = {lo, hi}; return __builtin_bit_cast(unsigned, __builtin_convertvector(v, bf16x2c)); }
typedef unsigned u32x2 __attribute__((ext_vector_type(2)));
constexpr int SS_LD = 32;
constexpr float RMS_EPS = 1e-6f;
__device__ __forceinline__ float silu_f(float x) { return x * __builtin_amdgcn_rcpf(1.0f + __expf(-x)); }
__device__ __forceinline__ float sigmoid_f(float x) { return __builtin_amdgcn_rcpf(1.0f + __expf(-x)); }
__device__ __forceinline__ float row_rstd(const float* ss, int row, int nparts) {
    const f32x4* p = (const f32x4*)(ss + (size_t)row * SS_LD); float s = 0.f;
    for (int i = 0; i < nparts / 4; ++i) { const f32x4 v = p[i]; s += (v[0] + v[1]) + (v[2] + v[3]); }
    return rsqrtf(s * (1.0f / 1024.0f) + RMS_EPS);
}
__device__ __forceinline__ void rows_rstd(const float* ss, int row0, int nparts, int fq, float (&rs)[2][4]) {
    f32x4 q[2][4];
#pragma unroll
    for (int ai = 0; ai < 2; ++ai)
#pragma unroll
        for (int m = 0; m < 4; ++m) { const float* p = ss + (size_t)(row0 + ai * HALF + m * 16) * SS_LD + 4 * fq; q[ai][m] = *(const f32x4*)p; if (nparts == 32) q[ai][m] += *(const f32x4*)(p + 16); }
#pragma unroll
    for (int ai = 0; ai < 2; ++ai)
#pragma unroll
        for (int m = 0; m < 4; ++m) { float s = (q[ai][m][0] + q[ai][m][1]) + (q[ai][m][2] + q[ai][m][3]); s += __shfl_xor(s, 16); s += __shfl_xor(s, 32); rs[ai][m] = rsqrtf(s * (1.0f / 1024.0f) + RMS_EPS); }
}
struct EpiProj {
    static constexpr bool PERM = true, AFTER_DRAIN = false;
    bf16_t* O; const float* ss; int nparts;
    __device__ __forceinline__ void operator()(const f32x4 (&acc)[2][2][4][2], const Unit& u, int wr, int wc, int fr, int fq) const {
        const int row0 = u.pm * BM + wr * 64 + fr;
        float rs[2][4]; rows_rstd(ss, row0, nparts, fq, rs);
        {
            const int col0 = u.pn * BM + wc * 32 + 8 * fq; const bool act = u.pn >= 16;
#pragma unroll
            for (int ai = 0; ai < 2; ++ai)
#pragma unroll
                for (int m = 0; m < 4; ++m) { const int row = row0 + ai * HALF + m * 16; bf16_t* rowp = O + (size_t)row * 6144 + col0; const float r = rs[ai][m];
#pragma unroll
                    for (int bj = 0; bj < 2; ++bj) { f32x4 v0 = acc[ai][bj][m][0] * r, v1 = acc[ai][bj][m][1] * r;
                        if (act) {
#pragma unroll
                            for (int j = 0; j < 4; ++j) { v0[j] = silu_f(v0[j]); v1[j] = silu_f(v1[j]); } }
                        u32x4 w; w.x = cvt_pk_bf16(v0[0], v0[1]); w.y = cvt_pk_bf16(v0[2], v0[3]); w.z = cvt_pk_bf16(v1[0], v1[1]); w.w = cvt_pk_bf16(v1[2], v1[3]);
                        *(u32x4*)(rowp + bj * HALF) = w; }
                    }
        }
    }
};
struct EpiSwiglu {
    static constexpr bool PERM = true, AFTER_DRAIN = false;
    bf16_t* O; int ldo; const float* ss; int nparts;
    __device__ __forceinline__ void operator()(const f32x4 (&acc)[2][2][4][2], const Unit& u, int wr, int wc, int fr, int fq) const {
        const int row0 = u.pm * BM + wr * 64 + fr, col0 = u.pn * HALF + wc * 32 + 8 * fq;
        float rs[2][4]; rows_rstd(ss, row0, nparts, fq, rs);
#pragma unroll
        for (int ai = 0; ai < 2; ++ai)
#pragma unroll
            for (int m = 0; m < 4; ++m) { const int row = row0 + ai * HALF + m * 16; const float r = rs[ai][m];
                f32x4 h0, h1;
#pragma unroll
                for (int j = 0; j < 4; ++j) { h0[j] = silu_f(acc[ai][0][m][0][j] * r) * (acc[ai][1][m][0][j] * r); h1[j] = silu_f(acc[ai][0][m][1][j] * r) * (acc[ai][1][m][1][j] * r); }
                u32x4 w; w.x = cvt_pk_bf16(h0[0], h0[1]); w.y = cvt_pk_bf16(h0[2], h0[3]); w.z = cvt_pk_bf16(h1[0], h1[1]); w.w = cvt_pk_bf16(h1[2], h1[3]);
                *(u32x4*)(O + (size_t)row * ldo + col0) = w; }
    }
};
template <bool GLU, int MODE> struct EpiRes {
    static constexpr bool PERM = true, AFTER_DRAIN = false;
    const float* base; float* out; bf16_t* XB; float* ss;
    __device__ __forceinline__ void operator()(const f32x4 (&acc)[2][2][4][2], const Unit& u, int wr, int wc, int fr, int fq) const {
        const int col0 = (GLU ? u.pn * HALF : u.pn * BM) + wc * 32 + 8 * fq;
#pragma unroll
        for (int ai = 0; ai < 2; ++ai) {
#pragma unroll
            for (int m = 0; m < 4; ++m) { const int row = u.pm * BM + ai * HALF + wr * 64 + m * 16 + fr;
                const size_t off = (size_t)row * 1024 + col0;
                float sq = 0.f;
#pragma unroll
                for (int bj = 0; bj < (GLU ? 1 : 2); ++bj) { const int c = bj * HALF; f32x4 v0, v1;
                    if (GLU) {
#pragma unroll
                        for (int j = 0; j < 4; ++j) { v0[j] = acc[ai][0][m][0][j] * sigmoid_f(acc[ai][1][m][0][j]); v1[j] = acc[ai][0][m][1][j] * sigmoid_f(acc[ai][1][m][1][j]); }
                    } else { v0 = acc[ai][bj][m][0]; v1 = acc[ai][bj][m][1]; }
                    f32x4 b0, b1;
                    if (MODE == 0) { b0 = *(const f32x4*)(base + off + c); b1 = *(const f32x4*)(base + off + c + 4); }
                    else { const u32x4 bw = *(const u32x4*)(XB + off + c);
                        b0 = (f32x4){__builtin_bit_cast(float, bw.x << 16), __builtin_bit_cast(float, bw.x & 0xffff0000u), __builtin_bit_cast(float, bw.y << 16), __builtin_bit_cast(float, bw.y & 0xffff0000u)};
                        b1 = (f32x4){__builtin_bit_cast(float, bw.z << 16), __builtin_bit_cast(float, bw.z & 0xffff0000u), __builtin_bit_cast(float, bw.w << 16), __builtin_bit_cast(float, bw.w & 0xffff0000u)}; }
                    const f32x4 o0 = b0 + v0, o1 = b1 + v1;
                    sq += ((o0[0] * o0[0] + o0[1] * o0[1]) + (o0[2] * o0[2] + o0[3] * o0[3])) + ((o1[0] * o1[0] + o1[1] * o1[1]) + (o1[2] * o1[2] + o1[3] * o1[3]));
                    if (MODE == 2) { *(f32x4*)(out + off + c) = o0; *(f32x4*)(out + off + c + 4) = o1; }
                    else { u32x4 w; w.x = cvt_pk_bf16(o0[0], o0[1]); w.y = cvt_pk_bf16(o0[2], o0[3]); w.z = cvt_pk_bf16(o1[0], o1[1]); w.w = cvt_pk_bf16(o1[2], o1[3]); *(u32x4*)(XB + off + c) = w; } }
                sq += __shfl_xor(sq, 16); sq += __shfl_xor(sq, 32);
                if (fq == 0) ss[(size_t)row * SS_LD + u.pn * 4 + wc] = sq; }
        }
    }
};

struct EpiFinal {
    static constexpr bool PERM = false, AFTER_DRAIN = true;
    const bf16_t* XB; float* out; const float* gfin; float* xbuf; unsigned* cnt;
    __device__ __forceinline__ void fused(f32x4 (&acc)[2][2][4][2], const Unit& u, int wr, int wc, int fr, int fq, PG8_LAS unsigned char* lds, int wid, int lane) const {
        PG8_LAS float* P = (PG8_LAS float*)lds;
        PG8_LAS float* S = (PG8_LAS float*)(lds + 8192);
        const int col0 = u.pn * BM + wc * 32 + 4 * fq;
#pragma unroll
        for (int ai = 0; ai < 2; ++ai)
#pragma unroll
            for (int m = 0; m < 4; ++m) { const int rl = ai * HALF + wr * 64 + m * 16 + fr; const size_t off = (size_t)(u.pm * BM + rl) * 1024 + col0; float sq = 0.f;
#pragma unroll
                for (int bj = 0; bj < 2; ++bj)
#pragma unroll
                    for (int n = 0; n < 2; ++n) { const u32x2 bw = *(const u32x2*)(XB + off + bj * HALF + n * 16);
                        const f32x4 b = (f32x4){__builtin_bit_cast(float, bw.x << 16), __builtin_bit_cast(float, bw.x & 0xffff0000u), __builtin_bit_cast(float, bw.y << 16), __builtin_bit_cast(float, bw.y & 0xffff0000u)};
                        const f32x4 o = b + acc[ai][bj][m][n]; acc[ai][bj][m][n] = o; sq += (o[0] * o[0] + o[1] * o[1]) + (o[2] * o[2] + o[3] * o[3]); }
                sq += __shfl_xor(sq, 16); sq += __shfl_xor(sq, 32);
                if (fq == 0) P[rl * 4 + wc] = sq; }
        asm volatile("s_waitcnt lgkmcnt(0)" ::: "memory"); __builtin_amdgcn_s_barrier(); asm volatile("" ::: "memory");
        const int row = wid * 32 + (lane & 31);
        if (lane < 32) { const float t = (P[row * 4 + 0] + P[row * 4 + 1]) + (P[row * 4 + 2] + P[row * 4 + 3]);
            __hip_atomic_store(xbuf + (size_t)(u.pm * BM + row) * 4 + u.pn, t, __ATOMIC_RELAXED, __HIP_MEMORY_SCOPE_AGENT); }
        asm volatile("s_waitcnt vmcnt(0)" ::: "memory");
        if (lane == 0) __hip_atomic_fetch_add(cnt + 64 * u.pm, 1u, __ATOMIC_RELAXED, __HIP_MEMORY_SCOPE_AGENT);
        if (wid == 0) {
            const unsigned long long t0 = __builtin_amdgcn_s_memrealtime();
            while ((unsigned)__builtin_amdgcn_readfirstlane(__hip_atomic_load(cnt + 64 * u.pm, __ATOMIC_RELAXED, __HIP_MEMORY_SCOPE_AGENT)) < 32u) {
                if (__builtin_amdgcn_s_memrealtime() - t0 > 2000000ull) break;
                __builtin_amdgcn_s_sleep(2); }
            __builtin_amdgcn_fence(__ATOMIC_ACQUIRE, "agent");
        }
        asm volatile("s_waitcnt vmcnt(0) lgkmcnt(0)" ::: "memory"); __builtin_amdgcn_s_barrier(); asm volatile("" ::: "memory");
        if (lane < 32) { const float* sl = xbuf + (size_t)(u.pm * BM + row) * 4; float t = 0.f;
#pragma unroll
            for (int k = 0; k < 4; ++k) t += __hip_atomic_load(sl + k, __ATOMIC_RELAXED, __HIP_MEMORY_SCOPE_AGENT);
            S[row] = rsqrtf(t * (1.0f / 1024.0f) + RMS_EPS); }
        asm volatile("s_waitcnt lgkmcnt(0)" ::: "memory"); __builtin_amdgcn_s_barrier(); asm volatile("" ::: "memory");
#pragma unroll
        for (int ai = 0; ai < 2; ++ai)
#pragma unroll
            for (int m = 0; m < 4; ++m) { const int rl = ai * HALF + wr * 64 + m * 16 + fr; const float rs = S[rl]; const size_t off = (size_t)(u.pm * BM + rl) * 1024 + col0;
#pragma unroll
                for (int bj = 0; bj < 2; ++bj)
#pragma unroll
                    for (int n = 0; n < 2; ++n) { const int c = bj * HALF + n * 16; const f32x4 g = *(const f32x4*)(gfin + col0 + c); *(f32x4*)(out + off + c) = acc[ai][bj][m][n] * rs * g; } }
    }
};

template <class Epi, class Sched, bool ALIGN_EPI = false, bool SP2 = false>
__device__ __forceinline__ void gemm_phase(PG8_LAS unsigned char* lds, const Gemm g, const Sched& S, const Epi& E) {
    int tid_o = threadIdx.x; asm volatile("" : "+v"(tid_o));
    const int tid = tid_o, wid = __builtin_amdgcn_readfirstlane(tid >> 6), lane = tid & 63, wr = wid >> 2, wc = wid & 3, fr = lane & 15, fq = lane >> 4;
    const int K = g.K, nt = K / BK;
    unsigned voffA[2], voffB[2];
#pragma unroll
    for (int i = 0; i < 2; ++i) { int R, C; stage_rc(tid * 16 + i * 8192, R, C); const int Rb = Epi::PERM ? ((R & ~31) + perm32(R & 31)) : R;
        voffA[i] = (unsigned)(R * K + C) * 2u; voffB[i] = (unsigned)(Rb * K + C) * 2u; }
    const size_t kstep = (size_t)(BK * 2);
    const size_t hstep = (size_t)HALF * K * 2;
    const size_t tstep = 2 * hstep;
    const unsigned ldsw = (unsigned)wid * 1024u;
    const int aoff = lds_byte(wr * 64 + fr, fq * 8), boff = lds_byte(wc * 32 + fr, fq * 8);
#define PG8_SA(b, h) (((b) * 2 + (h)) * HTB)
#define PG8_SB(b, h) ((4 + (b) * 2 + (h)) * HTB)
#define PG8_STAGE(bufoff, gbase, voff) do { _Pragma("unroll") for (int _i = 0; _i < 2; ++_i) \
        __builtin_amdgcn_global_load_lds((const unsigned*)((const char*)(gbase) + (voff)[_i]), (PG8_LAS unsigned*)(lds + (bufoff) + ldsw + _i * 8192), 16, 0, 0); } while (0)
#define PG8_LDA(dst, b, h) do { _Pragma("unroll") for (int m = 0; m < 4; ++m) _Pragma("unroll") for (int k = 0; k < 2; ++k) dst[m][k] = *(const PG8_LAS bf16x8*)(lds + PG8_SA(b, h) + aoff + m * 2048 + k * 1024); } while (0)
#define PG8_LDB(dst, b, h) do { _Pragma("unroll") for (int n = 0; n < 2; ++n) _Pragma("unroll") for (int k = 0; k < 2; ++k) dst[n][k] = *(const PG8_LAS bf16x8*)(lds + PG8_SB(b, h) + boff + n * 2048 + k * 1024); } while (0)
#define PG8_MMA(ai, bj, At, Bt) do { __builtin_amdgcn_s_setprio(1); _Pragma("unroll") for (int m = 0; m < 4; ++m) _Pragma("unroll") for (int n = 0; n < 2; ++n) _Pragma("unroll") for (int k = 0; k < 2; ++k) \
        acc[ai][bj][m][n] = __builtin_amdgcn_mfma_f32_16x16x32_bf16(Bt[n][k], At[m][k], acc[ai][bj][m][n], 0, 0, 0); __builtin_amdgcn_s_setprio(0); } while (0)
#define PG8_WAIT_V(n) asm volatile("s_waitcnt vmcnt(" #n ")" ::: "memory")
#define PG8_WAIT_L(n) asm volatile("s_waitcnt lgkmcnt(" #n ")" ::: "memory")
#define PG8_BAR __builtin_amdgcn_s_barrier()
#define PG8_SCHED __builtin_amdgcn_sched_barrier(0)
    Unit cur, nxt; int ui = 0;
    if (!S.next(0, cur)) return;
    f32x4 acc[2][2][4][2];
#pragma unroll
    for (int a = 0; a < 2; ++a)
#pragma unroll
        for (int b = 0; b < 2; ++b)
#pragma unroll
            for (int m = 0; m < 4; ++m)
#pragma unroll
                for (int n = 0; n < 2; ++n) acc[a][b][m][n] = (f32x4){0.f, 0.f, 0.f, 0.f};
    bf16x8 At[4][2], B0[2][2], B1[2][2];
    const char* cA = (const char*)g.A + (size_t)cur.pm * tstep; const char* cB = (const char*)g.Bt + (size_t)cur.pn * tstep;
    S.a_ready(cur);
    if constexpr (SP2) {
        PG8_STAGE(PG8_SB(0, 0), cB, voffB); PG8_STAGE(PG8_SB(0, 1), cB + hstep, voffB); PG8_STAGE(PG8_SA(0, 0), cA, voffA); PG8_STAGE(PG8_SA(0, 1), cA + hstep, voffA);
        if (wr == 1) PG8_BAR;
        PG8_WAIT_V(2); PG8_BAR;
        PG8_STAGE(PG8_SB(1, 0), cB + kstep, voffB); PG8_STAGE(PG8_SA(1, 0), cA + kstep, voffA); PG8_STAGE(PG8_SB(1, 1), cB + hstep + kstep, voffB);
        PG8_WAIT_V(6); PG8_BAR;
    } else {
        PG8_STAGE(PG8_SB(0, 0), cB, voffB); PG8_STAGE(PG8_SA(0, 0), cA, voffA); PG8_STAGE(PG8_SB(0, 1), cB + hstep, voffB); PG8_STAGE(PG8_SA(0, 1), cA + hstep, voffA);
        if (wr == 1) PG8_BAR;
        PG8_WAIT_V(4); PG8_BAR;
        PG8_STAGE(PG8_SB(1, 0), cB + kstep, voffB); PG8_STAGE(PG8_SA(1, 0), cA + kstep, voffA); PG8_STAGE(PG8_SB(1, 1), cB + hstep + kstep, voffB);
        PG8_WAIT_V(6); PG8_BAR;
    }
    for (;;) {
        const bool has_next = S.next(ui + 1, nxt);
        const char* nA = has_next ? (const char*)g.A + (size_t)nxt.pm * tstep : cA; const char* nB = has_next ? (const char*)g.Bt + (size_t)nxt.pn * tstep : cB;
        for (int t = 0; t < nt; t += 2) {
            const bool last = (t == nt - 2);
            const char* a1 = cA + (size_t)(t + 1) * kstep;
            const char* a2 = last ? nA : cA + (size_t)(t + 2) * kstep; const char* b2 = last ? nB : cB + (size_t)(t + 2) * kstep;
            const char* a3 = a2 + kstep; const char* b3 = b2 + kstep;
            if (last && has_next) S.a_ready(nxt);
            if constexpr (SP2) {
            PG8_LDB(B0, 0, 0); PG8_LDB(B1, 0, 1); PG8_SCHED; PG8_LDA(At, 0, 0); PG8_STAGE(PG8_SA(1, 1), a1 + hstep, voffA);
            PG8_WAIT_V(8); PG8_WAIT_L(0); PG8_BAR; PG8_MMA(0, 0, At, B0); PG8_MMA(0, 1, At, B1); PG8_BAR; PG8_SCHED;
            PG8_LDA(At, 0, 1); PG8_STAGE(PG8_SB(0, 0), b2, voffB); PG8_STAGE(PG8_SB(0, 1), b2 + hstep, voffB); PG8_STAGE(PG8_SA(0, 0), a2, voffA);
            PG8_WAIT_V(8); PG8_WAIT_L(0); PG8_BAR; PG8_MMA(1, 0, At, B0); PG8_MMA(1, 1, At, B1); PG8_BAR; PG8_SCHED;
            PG8_LDB(B0, 1, 0); PG8_LDB(B1, 1, 1); PG8_SCHED; PG8_LDA(At, 1, 0); PG8_STAGE(PG8_SA(0, 1), a2 + hstep, voffA);
            PG8_WAIT_V(8); PG8_WAIT_L(0); PG8_BAR; PG8_MMA(0, 0, At, B0); PG8_MMA(0, 1, At, B1); PG8_BAR; PG8_SCHED;
            PG8_LDA(At, 1, 1); PG8_STAGE(PG8_SB(1, 0), b3, voffB); PG8_STAGE(PG8_SB(1, 1), b3 + hstep, voffB); PG8_STAGE(PG8_SA(1, 0), a3, voffA);
            PG8_WAIT_V(8); PG8_WAIT_L(0); PG8_BAR; PG8_MMA(1, 0, At, B0); PG8_MMA(1, 1, At, B1); PG8_BAR; PG8_SCHED;
            } else {
            PG8_LDB(B0, 0, 0); PG8_SCHED; PG8_LDA(At, 0, 0); PG8_STAGE(PG8_SA(1, 1), a1 + hstep, voffA);
            PG8_WAIT_L(8); PG8_BAR; PG8_WAIT_L(0); PG8_MMA(0, 0, At, B0); PG8_BAR; PG8_SCHED;
            PG8_LDB(B1, 0, 1); PG8_STAGE(PG8_SB(0, 0), b2, voffB);
            PG8_BAR; PG8_WAIT_L(0); PG8_MMA(0, 1, At, B1); PG8_BAR;
            PG8_LDA(At, 0, 1); PG8_STAGE(PG8_SA(0, 0), a2, voffA);
            PG8_BAR; PG8_WAIT_L(0); PG8_MMA(1, 0, At, B0); PG8_BAR; PG8_SCHED;
            PG8_STAGE(PG8_SB(0, 1), b2 + hstep, voffB);
            PG8_WAIT_V(6); PG8_BAR; PG8_MMA(1, 1, At, B1); PG8_BAR;
            PG8_LDB(B0, 1, 0); PG8_SCHED; PG8_LDA(At, 1, 0); PG8_STAGE(PG8_SA(0, 1), a2 + hstep, voffA);
            PG8_WAIT_L(8); PG8_BAR; PG8_WAIT_L(0); PG8_MMA(0, 0, At, B0); PG8_BAR; PG8_SCHED;
            PG8_LDB(B1, 1, 1); PG8_STAGE(PG8_SB(1, 0), b3, voffB);
            PG8_BAR; PG8_WAIT_L(0); PG8_MMA(0, 1, At, B1); PG8_BAR;
            PG8_LDA(At, 1, 1); PG8_STAGE(PG8_SA(1, 0), a3, voffA);
            PG8_BAR; PG8_WAIT_L(0); PG8_MMA(1, 0, At, B0); PG8_BAR; PG8_SCHED;
            PG8_STAGE(PG8_SB(1, 1), b3 + hstep, voffB);
            PG8_WAIT_V(6); PG8_BAR; PG8_MMA(1, 1, At, B1); PG8_BAR;
            }
        }
        if constexpr (ALIGN_EPI) { if (wr == 0) PG8_BAR; }
        if constexpr (!Epi::AFTER_DRAIN) { E(acc, cur, wr, wc, fr, fq); S.done(cur); }
        if (!has_next) break;
#pragma unroll
        for (int a = 0; a < 2; ++a)
#pragma unroll
            for (int b = 0; b < 2; ++b)
#pragma unroll
                for (int m = 0; m < 4; ++m)
#pragma unroll
                    for (int n = 0; n < 2; ++n) acc[a][b][m][n] = (f32x4){0.f, 0.f, 0.f, 0.f};
        cur = nxt; cA = nA; cB = nB; ++ui;
        if constexpr (ALIGN_EPI) { if (wr == 1) PG8_BAR; }
    }
    PG8_WAIT_V(0);
    if constexpr (!ALIGN_EPI) { if (wr == 0) PG8_BAR; }
    PG8_BAR;
    if constexpr (Epi::AFTER_DRAIN) { E.fused(acc, cur, wr, wc, fr, fq, lds, wid, lane); S.done(cur); }
#undef PG8_SA
#undef PG8_SB
#undef PG8_STAGE
#undef PG8_LDA
#undef PG8_LDB
#undef PG8_MMA
#undef PG8_WAIT_V
#undef PG8_WAIT_L
#undef PG8_BAR
#undef PG8_SCHED
}
}
constexpr int NWAVES = 8, NTHREADS = 512;
constexpr int D = 1024, SEQ = 2048, NB = 8, MP = NB * SEQ  , MS = 128  ;
constexpr int DN_IN = 6176, PROJ_LD = 6144, VAL = 2048, FFN = 2816, NH = 16, CHUNK = 64, NCHUNK = SEQ / CHUNK;
constexpr size_t MiB = 1u << 20;
constexpr size_t WS_CTL = 0, CTL_ZERO_BYTES = 64 * 1024;
constexpr size_t WS_W1 = 1 * MiB;
constexpr size_t WS_W2 = WS_W1 + (size_t)6400 * D * 2;
constexpr size_t WS_W5 = WS_W2 + (size_t)D * VAL * 2;
constexpr size_t WS_W3 = WS_W5 + (size_t)2 * D * D * 2;
constexpr size_t WS_W4 = WS_W3 + (size_t)2 * 2 * FFN * D * 2;
constexpr size_t WS_SS = WS_W4 + (size_t)2 * D * FFN * 2;
constexpr size_t WS_BETA = WS_SS + (size_t)MP * 32 * 4;
constexpr size_t WS_GDEC = WS_BETA + (size_t)MP * 16 * 4;
constexpr size_t WS_SSS = WS_GDEC + (size_t)MP * 16 * 4;
constexpr size_t WS_SBETA = WS_SSS + (size_t)MS * 32 * 4;
constexpr size_t WS_SGDEC = WS_SBETA + (size_t)MS * 16 * 4;
constexpr size_t WS_SXB = WS_SGDEC + (size_t)MS * 16 * 4;
constexpr size_t WS_SX = WS_SXB + (size_t)MS * D * 2;
constexpr size_t WS_SPROJ = WS_SX + (size_t)MS * D * 4;
constexpr size_t WS_SGATED = WS_SPROJ + (size_t)MS * PROJ_LD * 2;
constexpr size_t WS_SH = WS_SGATED + (size_t)MS * VAL * 2;
constexpr size_t WS_SYB = WS_SH + (size_t)MS * FFN * 2;
constexpr size_t WS_S5LAM = WS_SYB + (size_t)MS * D * 2;
constexpr size_t WS_S5BB = WS_S5LAM + 64 * 64 * 2 * 4;
constexpr size_t WS_S5CM = WS_S5BB + 64 * 128 * 16 * 2;
constexpr size_t WS_S5DSK = WS_S5CM + 64 * 16 * 128 * 2;
constexpr size_t WS_FX = WS_S5DSK + 1024 * 4;
constexpr size_t WS_XB = (WS_FX + (size_t)MP * 4 * 4 + 4095) / 4096 * 4096;
constexpr size_t WS_X = WS_XB + (size_t)MP * D * 2;
constexpr size_t WS_YB = WS_X + (size_t)MP * D * 4;
constexpr size_t WS_GATED = WS_YB + (size_t)MP * D * 2;
constexpr size_t WS_QKVC = WS_XB;
static_assert(WS_QKVC + (size_t)MP * 4096 * 2 <= WS_GATED, "QKVC overlay");
constexpr size_t WS_PROJ = WS_GATED + (size_t)MP * VAL * 2;
constexpr size_t WS_H = WS_PROJ;
constexpr size_t WS_END = WS_PROJ + (size_t)MP * PROJ_LD * 2;
constexpr int CW_BAR = 4096, CW_TEAM = 8192, CW_FIN = 8192 + 64;
constexpr size_t O_YP = 0, O_YS = O_YP + (size_t)MP * D, O_SSMP = O_YS + (size_t)MS * D, O_CONVP = O_SSMP + (size_t)NB * NH * 128 * 128, O_S5RP = O_CONVP + (size_t)NB * 3 * 4096,
                 O_S5IP = O_S5RP + (size_t)NB * 64 * 64, O_SSMS = O_S5IP + (size_t)NB * 64 * 64, O_CONVS = O_SSMS + (size_t)MS * NH * 128 * 128, O_S5RS = O_CONVS + (size_t)MS * 3 * 4096,
                 O_S5IS = O_S5RS + (size_t)MS * 64 * 64, O_END = O_S5IS + (size_t)MS * 64 * 64;
constexpr int LDS_BYTES = 163840, LDSCTL_OFF = LDS_BYTES - 256;

#define GAS __attribute__((address_space(1)))
#define LAS __attribute__((address_space(3)))
typedef unsigned short bf16;
typedef float f32x4 __attribute__((ext_vector_type(4)));
typedef float f32x2 __attribute__((ext_vector_type(2)));
typedef short bf16x8 __attribute__((ext_vector_type(8)));
typedef unsigned u32x4 __attribute__((ext_vector_type(4)));
typedef unsigned u32x2 __attribute__((ext_vector_type(2)));
typedef LAS unsigned char* ldsp;
__device__ __forceinline__ unsigned pkbf(float lo, float hi) { return pg8::cvt_pk_bf16(lo, hi); }
__device__ __forceinline__ float bflo(unsigned w) { return __builtin_bit_cast(float, w << 16); }
__device__ __forceinline__ float bfhi(unsigned w) { return __builtin_bit_cast(float, w & 0xffff0000u); }
__device__ __forceinline__ float bf1(bf16 h) { return __builtin_bit_cast(float, (unsigned)h << 16); }
__device__ __forceinline__ float wave_sum(float v) {
#pragma unroll
    for (int o = 1; o < 64; o <<= 1) v += __shfl_xor(v, o);
    return v;
}
#define MFMA16(a, b, c) __builtin_amdgcn_mfma_f32_16x16x32_bf16((a), (b), (c), 0, 0, 0)
#define MM_XROW(acc, xf, yf) (acc) = MFMA16((yf), (xf), (acc))
#define MM_YROW(acc, xf, yf) (acc) = MFMA16((xf), (yf), (acc))
#define LDS_FENCE() asm volatile("s_waitcnt lgkmcnt(0)" ::: "memory")

struct Args {
    const float* in[26]; float* out; unsigned char* ws; int pad0, pad1;
};
constexpr float RMS_EPSF = 1e-6f;
#define XB_TMO      128
#define XB_XCNT(j)  (256  + 64 * (j))
#define XB_XSUB(j)  (1280 + 64 * (j))
#define XB_XGEN(j)  (2304 + 64 * (j))
#define XB_TOP      3328
#define XB_TOPGEN   3392
#define XCD_BAR_WORDS 3456
#define XB_SPIN_CAP (1u << 18)

__device__ __forceinline__ unsigned xb_ld(unsigned* p)              { return __hip_atomic_load(p, __ATOMIC_RELAXED, __HIP_MEMORY_SCOPE_AGENT); }
__device__ __forceinline__ unsigned xb_add(unsigned* p, unsigned v) { return __hip_atomic_fetch_add(p, v, __ATOMIC_RELAXED, __HIP_MEMORY_SCOPE_AGENT); }
__device__ __forceinline__ unsigned xb_xcc_id() { return (unsigned)__builtin_amdgcn_s_getreg((3 << 11) | 20) & 0xFu; }
#define XB_SPIN(cond, bar) do { unsigned _sp = 0; while (cond) { __builtin_amdgcn_s_sleep(1); \
    if ((++_sp & 255u) == 0u) { if (xb_ld(&(bar)[XB_TMO])) break; if (_sp > XB_SPIN_CAP) { atomicAdd(&(bar)[XB_TMO], 1u); break; } } } } while (0)

struct XcdBarrier {
    unsigned* bar; unsigned x;
    volatile LAS unsigned* st;
};

__device__ __forceinline__ XcdBarrier xcd_barrier_post(unsigned* bar, volatile LAS unsigned* st) {
    XcdBarrier b; b.bar = bar; b.x = xb_xcc_id(); b.st = st;
    if (threadIdx.x == 0) (void)xb_add(&bar[XB_XCNT(b.x)], 1u);
    return b;
}
__device__ __forceinline__ void xcd_barrier_complete(unsigned* bar, unsigned x, unsigned& nloc, unsigned& nx) {
    const unsigned G = gridDim.x * gridDim.y * gridDim.z;
    unsigned sum, cnt, mine, sp = 0u;
    for (;;) {
        sum = 0u; cnt = 0u; mine = 0u;
#pragma unroll
        for (unsigned j = 0; j < 16; ++j) { const unsigned c = xb_ld(&bar[XB_XCNT(j)]); sum += c; cnt += (c > 0u) ? 1u : 0u; mine = (j == x) ? c : mine; }
        if (sum == G) break;
        __builtin_amdgcn_s_sleep(1);
        if ((++sp & 255u) == 0u) { if (xb_ld(&bar[XB_TMO])) break; if (sp > XB_SPIN_CAP) { atomicAdd(&bar[XB_TMO], 1u); break; } }
    }
    nloc = mine > 0u ? mine : 1u; nx = cnt > 0u ? cnt : 1u;
}

__device__ __forceinline__ void xcd_barrier(const XcdBarrier& b) {
    asm volatile("s_waitcnt vmcnt(0)" ::: "memory");
    __syncthreads();
    if (threadIdx.x == 0) {
        unsigned* bar = b.bar;
        __builtin_amdgcn_s_waitcnt(0);
        unsigned nloc = b.st[0], nx = b.st[1];
        if (nloc == 0u) { xcd_barrier_complete(bar, b.x, nloc, nx); b.st[0] = nloc; b.st[1] = nx; }
        const unsigned old = xb_add(&bar[XB_XSUB(b.x)], 1u);
        const unsigned gen = old / nloc;
        if (old + 1u == (gen + 1u) * nloc) {
            __builtin_amdgcn_fence(__ATOMIC_RELEASE, "agent");
            asm volatile("s_waitcnt vmcnt(0)" ::: "memory");
            const unsigned og = xb_add(&bar[XB_TOP], 1u);
            const unsigned tg = og / nx;
            if (og + 1u == (tg + 1u) * nx) xb_add(&bar[XB_TOPGEN], 1u);
            else XB_SPIN(xb_ld(&bar[XB_TOPGEN]) == tg, bar);
            __builtin_amdgcn_fence(__ATOMIC_ACQUIRE, "agent");
            xb_add(&bar[XB_XGEN(b.x)], 1u);
            asm volatile("s_waitcnt vmcnt(0)" ::: "memory");
        } else {
            XB_SPIN(xb_ld(&bar[XB_XGEN(b.x)]) == gen, bar);
            __builtin_amdgcn_fence(__ATOMIC_ACQUIRE, "agent");
            asm volatile("s_waitcnt vmcnt(0)" ::: "memory");
        }
    }
    __syncthreads();
}
__device__ __forceinline__ void sg_core(const bf16* ap, const bf16* bp, int K, int steps, f32x4 (&acc)[4][2]) {
    bf16x8 ra[4][4], rb[4][2];
    const bf16* pa[4]; const bf16* pb[2];
#pragma unroll
    for (int t = 0; t < 4; ++t) pa[t] = ap + (size_t)t * 16 * K;
    pb[0] = bp; pb[1] = bp + (size_t)16 * K;
#define SG_LOAD(slot, s) do { const int ko_ = 32 * (s); _Pragma("unroll") for (int t_ = 0; t_ < 4; ++t_) ra[slot][t_] = *(const bf16x8*)(pa[t_] + ko_); \
        rb[slot][0] = *(const bf16x8*)(pb[0] + ko_); rb[slot][1] = *(const bf16x8*)(pb[1] + ko_); } while (0)
#define SG_COMP(slot) do { _Pragma("unroll") for (int t_ = 0; t_ < 4; ++t_) { MM_XROW(acc[t_][0], ra[slot][t_], rb[slot][0]); MM_XROW(acc[t_][1], ra[slot][t_], rb[slot][1]); } } while (0)
    SG_LOAD(0, 0); SG_LOAD(1, 1); SG_LOAD(2, 2);
    int s = 0;
#pragma nounroll
    for (; s + 4 <= steps; s += 4) {
        SG_LOAD(3, s + 3);
        SG_COMP(0); if (s + 4 < steps) SG_LOAD(0, s + 4);
        SG_COMP(1); if (s + 5 < steps) SG_LOAD(1, s + 5);
        SG_COMP(2); if (s + 6 < steps) SG_LOAD(2, s + 6);
        SG_COMP(3);
    }
    const int r = steps - s;
    if (r >= 1) SG_COMP(0);
    if (r >= 2) SG_COMP(1);
    if (r >= 3) SG_COMP(2);
#undef SG_LOAD
#undef SG_COMP
}
template <int NBLK, class Epi>
__device__ __forceinline__ void sgemm_unit(ldsp lds, const bf16* A, const bf16* B0, const bf16* B1, int K, const Epi& E, int row0, int cb, int wave, int lane) {
    const int fr = lane & 15, fq = lane >> 4, rh = wave & 1, kq = wave >> 1; int steps = K / 128; asm volatile("" : "+s"(steps));
    int fro = fr; asm volatile("" : "+v"(fro));
    const bf16* ap = A + (size_t)(64 * rh + fro) * K + (size_t)kq * (K / 4) + 8 * fq;
    LAS f32x4* buf = (LAS f32x4*)lds;
#pragma unroll
    for (int pass = 0; pass < NBLK / 2; ++pass) {
        f32x4 acc[4][2];
#pragma unroll
        for (int t = 0; t < 4; ++t) { acc[t][0] = (f32x4){0.f, 0.f, 0.f, 0.f}; acc[t][1] = (f32x4){0.f, 0.f, 0.f, 0.f}; }
        sg_core(ap, (pass ? B1 : B0) + (size_t)fro * K + (size_t)kq * (K / 4) + 8 * fq, K, steps, acc);
#pragma unroll
        for (int t = 0; t < 4; ++t) { buf[(kq * 32 + (rh * 4 + t) * 4 + 2 * pass) * 64 + lane] = acc[t][0]; buf[(kq * 32 + (rh * 4 + t) * 4 + 2 * pass + 1) * 64 + lane] = acc[t][1]; }
    }
    __syncthreads();
    {
        const int rt = wave >> 1;
        f32x4 o[NBLK];
#pragma unroll
        for (int j = 0; j < NBLK; ++j) { const int slot = (rh * 4 + rt) * 4 + j; o[j] = (buf[slot * 64 + lane] + buf[(32 + slot) * 64 + lane]) + (buf[(64 + slot) * 64 + lane] + buf[(96 + slot) * 64 + lane]); }
        E(o, row0 + 64 * rh + 16 * rt + fr, cb, fq);
    }
    __syncthreads();
}
struct SEpiProj {
    bf16* O; const float* ss; int nparts; float* beta; float* gdec; const float* a_log; const float* dt_bias;
    __device__ __forceinline__ void operator()(const f32x4 (&acc)[2], int row, int cb, int fq) const {
        const float rs = pg8::row_rstd(ss, row, nparts);
        if (cb < 192) {
#pragma unroll
            for (int j = 0; j < 2; ++j) { f32x4 v = acc[j] * rs;
                if (cb >= 128) {
#pragma unroll
                    for (int r = 0; r < 4; ++r) v[r] = pg8::silu_f(v[r]); }
                u32x2 w; w.x = pkbf(v[0], v[1]); w.y = pkbf(v[2], v[3]); *(u32x2*)(O + (size_t)row * PROJ_LD + 32 * cb + 16 * j + 4 * fq) = w; }
        } else {
            f32x4 b, g;
#pragma unroll
            for (int r = 0; r < 4; ++r) { b[r] = pg8::sigmoid_f(acc[0][r] * rs); const int h = 4 * fq + r; const float xx = acc[1][r] * rs + dt_bias[h]; const float ex = __expf(xx);
                const float sp = xx > 15.f ? xx : (ex < 1e-3f ? ex * (1.0f - 0.5f * ex) : __logf(1.0f + ex)); g[r] = -__expf(a_log[h]) * sp; }
            *(f32x4*)(beta + (size_t)row * 16 + 4 * fq) = b; *(f32x4*)(gdec + (size_t)row * 16 + 4 * fq) = g;
        }
    }
};
template <bool GLU> struct SEpiRes {
    const float* base; float* out; bf16* XB; float* ss;
    __device__ __forceinline__ void operator()(const f32x4 (&acc)[GLU ? 4 : 2], int row, int cb, int fq) const {
        float sq = 0.f;
#pragma unroll
        for (int j = 0; j < 2; ++j) { f32x4 v = acc[j];
            if (GLU) {
#pragma unroll
                for (int r = 0; r < 4; ++r) v[r] = v[r] * pg8::sigmoid_f(acc[2 + j][r]); }
            const size_t off = (size_t)row * D + 32 * cb + 16 * j + 4 * fq;
            const f32x4 o = *(const f32x4*)(base + off) + v; *(f32x4*)(out + off) = o;
            sq += (o[0] * o[0] + o[1] * o[1]) + (o[2] * o[2] + o[3] * o[3]);
            u32x2 w; w.x = pkbf(o[0], o[1]); w.y = pkbf(o[2], o[3]); *(u32x2*)(XB + off) = w; }
        sq += __shfl_xor(sq, 16); sq += __shfl_xor(sq, 32);
        if (fq == 0) ss[(size_t)row * 32 + cb] = sq;
    }
};
struct SEpiSwiglu {
    bf16* H; const float* ss; int nparts;
    __device__ __forceinline__ void operator()(const f32x4 (&acc)[4], int row, int cb, int fq) const {
        const float rs = pg8::row_rstd(ss, row, nparts);
#pragma unroll
        for (int j = 0; j < 2; ++j) { f32x4 h;
#pragma unroll
            for (int r = 0; r < 4; ++r) h[r] = pg8::silu_f(acc[j][r] * rs) * (acc[2 + j][r] * rs);
            u32x2 w; w.x = pkbf(h[0], h[1]); w.y = pkbf(h[2], h[3]); *(u32x2*)(H + (size_t)row * FFN + 32 * cb + 16 * j + 4 * fq) = w; }
    }
};
__device__ __forceinline__ void team_barrier(unsigned* cnt, unsigned target) {
    asm volatile("s_waitcnt vmcnt(0)" ::: "memory");
    __syncthreads();
    if (threadIdx.x == 0) {
        __builtin_amdgcn_fence(__ATOMIC_RELEASE, "agent");
        asm volatile("s_waitcnt vmcnt(0)" ::: "memory");
        (void)__hip_atomic_fetch_add(cnt, 1u, __ATOMIC_RELAXED, __HIP_MEMORY_SCOPE_AGENT);
        unsigned sp = 0;
        while (__hip_atomic_load(cnt, __ATOMIC_RELAXED, __HIP_MEMORY_SCOPE_AGENT) < target) { __builtin_amdgcn_s_sleep(2); if (++sp > (1u << 22)) break; }
        __builtin_amdgcn_fence(__ATOMIC_ACQUIRE, "agent");
        asm volatile("s_waitcnt vmcnt(0)" ::: "memory");
    }
    __syncthreads();
}
__device__ __forceinline__ void sincos_cw(float x, float& s, float& c) {
    const float k = rintf(x * 0.636619772367581343f);
    float r = fmaf(-k, 1.57079625129699707031f, x); r = fmaf(-k, 7.54978941586159635e-08f, r); r = fmaf(-k, 5.39030285815811482e-15f, r);
    const float z = r * r;
    const float sp = fmaf(fmaf(fmaf(-1.9515295891e-4f, z, 8.3321608736e-3f), z, -1.6666654611e-1f) * z, r, r);
    const float cp = fmaf(fmaf(fmaf(2.443315711809948e-5f, z, -1.388731625493765e-3f), z, 4.166664568298827e-2f), z * z, fmaf(-0.5f, z, 1.0f));
    const int q = (int)k & 3;
    const float ss = (q & 1) ? cp : sp, cc = (q & 1) ? sp : cp;
    s = (q & 2) ? -ss : ss; c = ((q + 1) & 2) ? -cc : cc;
}
__device__ __forceinline__ void s5_disc(const Args& a, int g, int p, float dt, float& lr, float& li, float& fre, float& fim) {
    const float are = a.in[15][g * 64 + p], aim = a.in[16][g * 64 + p];
    const float mag = __expf(are * dt); float sn, cs; sincos_cw(aim * dt, sn, cs);
    lr = mag * cs; li = mag * sn;
    const float den = are * are + aim * aim, nre = lr - 1.0f, nim = li;
    fre = (nre * are + nim * aim) / den; fim = (nim * are - nre * aim) / den;
}
__device__ __forceinline__ float gelu_tanh(float x) { const float u = 0.7978845608028654f * (x + 0.044715f * x * x * x); const float t = 1.0f - 2.0f * __builtin_amdgcn_rcpf(__expf(2.0f * u) + 1.0f); return 0.5f * x * (1.0f + t); }
__device__ __forceinline__ void s5_precompute(const Args& a, int idx) {
    unsigned char* ws = a.ws;
    if (idx < 4096) {
        const int g = idx >> 6, p = idx & 63;
        const float dt = __expf(a.in[17][g]);
        float lr, li, fre, fim; s5_disc(a, g, p, dt, lr, li, fre, fim);
        float* lam = (float*)(ws + WS_S5LAM) + (size_t)idx * 2; lam[0] = lr; lam[1] = li;
        const float* br = a.in[18] + (size_t)idx * 16; const float* bi = a.in[19] + (size_t)idx * 16; const float* gm = a.in[6] + D + g * 16;
        u32x4* bb = (u32x4*)((bf16*)(ws + WS_S5BB) + ((size_t)g * 128 + 2 * p) * 16);
        float vr[16], vi[16];
#pragma unroll
        for (int c = 0; c < 16; ++c) { const float re = br[c], im = bi[c], gg = gm[c]; vr[c] = (fre * re - fim * im) * gg; vi[c] = (fre * im + fim * re) * gg; }
        bb[0] = (u32x4){pkbf(vr[0], vr[1]), pkbf(vr[2], vr[3]), pkbf(vr[4], vr[5]), pkbf(vr[6], vr[7])};
        bb[1] = (u32x4){pkbf(vr[8], vr[9]), pkbf(vr[10], vr[11]), pkbf(vr[12], vr[13]), pkbf(vr[14], vr[15])};
        bb[2] = (u32x4){pkbf(vi[0], vi[1]), pkbf(vi[2], vi[3]), pkbf(vi[4], vi[5]), pkbf(vi[6], vi[7])};
        bb[3] = (u32x4){pkbf(vi[8], vi[9]), pkbf(vi[10], vi[11]), pkbf(vi[12], vi[13]), pkbf(vi[14], vi[15])};
        unsigned* cm = (unsigned*)((bf16*)(ws + WS_S5CM) + (size_t)g * 16 * 128 + 2 * p);
#pragma unroll
        for (int c = 0; c < 16; ++c) cm[c * 64] = pkbf(a.in[20][(size_t)(g * 16 + c) * 64 + p], -a.in[21][(size_t)(g * 16 + c) * 64 + p]);
    }
    if (idx < 1024) ((float*)(ws + WS_S5DSK))[idx] = a.in[22][idx] * a.in[6][D + idx];
}
__device__ __forceinline__ void p0_transpose_item(const float* W, int K, int N, const float* gain, int gluh, bf16* WT, LAS float* scr, int item, int lane) {
    const int nblk = N / 32, kb = item / nblk, nb = item % nblk, k0 = 64 * kb, n0 = 32 * nb;
    f32x4 v[8];
#pragma unroll
    for (int i = 0; i < 8; ++i) v[i] = __builtin_nontemporal_load((const f32x4*)(W + (size_t)(k0 + 8 * i + (lane >> 3)) * N + n0 + 4 * (lane & 7)));
#pragma unroll
    for (int i = 0; i < 8; ++i) { const int kk = 8 * i + (lane >> 3); const float gk = gain ? gain[k0 + kk] : 1.0f; LAS float* s = scr + kk * 33 + 4 * (lane & 7);
        s[0] = v[i][0] * gk; s[1] = v[i][1] * gk; s[2] = v[i][2] * gk; s[3] = v[i][3] * gk; }
    LDS_FENCE();
    int r0 = n0; if (gluh > 0) r0 = (n0 < gluh) ? (n0 / 128) * 256 + (n0 % 128) : ((n0 - gluh) / 128) * 256 + 128 + ((n0 - gluh) % 128);
    const int c = lane & 7;
#pragma unroll
    for (int j = 0; j < 4; ++j) { const int n = (lane >> 3) + 8 * j; const LAS float* s = scr + (8 * c) * 33 + n;
        u32x4 o; o.x = pkbf(s[0 * 33], s[1 * 33]); o.y = pkbf(s[2 * 33], s[3 * 33]); o.z = pkbf(s[4 * 33], s[5 * 33]); o.w = pkbf(s[6 * 33], s[7 * 33]);
        *(u32x4*)(WT + (size_t)(r0 + n) * K + k0 + 8 * c) = o; }
    LDS_FENCE();
}
__device__ __forceinline__ void p0_prologue(const Args& a, ldsp lds, int gw, int ngw, int wave, int lane) {
    LAS float* scr = (LAS float*)(lds + wave * 16384);
    unsigned char* ws = a.ws;
    constexpr int I1 = (D / 64) * (DN_IN / 32), I2 = (VAL / 64) * (D / 32), I5 = (D / 64) * (2 * D / 32), I3 = (D / 64) * (2 * FFN / 32), I4 = (FFN / 64) * (D / 32);
    constexpr int NITEMS = I1 + I2 + I5 + 2 * I3 + 2 * I4;
    for (int it = gw; it < NITEMS; it += ngw) {
        int r = it;
        if (r < I1) { p0_transpose_item(a.in[9], D, DN_IN, a.in[6], 0, (bf16*)(ws + WS_W1), scr, r, lane); continue; } r -= I1;
        if (r < I2) { p0_transpose_item(a.in[14], VAL, D, nullptr, 0, (bf16*)(ws + WS_W2), scr, r, lane); continue; } r -= I2;
        if (r < I5) { p0_transpose_item(a.in[23], D, 2 * D, nullptr, D, (bf16*)(ws + WS_W5), scr, r, lane); continue; } r -= I5;
        if (r < 2 * I3) { const int l = r / I3; p0_transpose_item(a.in[24] + (size_t)l * D * 2 * FFN, D, 2 * FFN, a.in[7] + l * D, FFN, (bf16*)(ws + WS_W3) + (size_t)l * 2 * FFN * D, scr, r % I3, lane); continue; } r -= 2 * I3;
        { const int l = r / I4; p0_transpose_item(a.in[25] + (size_t)l * FFN * D, FFN, D, nullptr, 0, (bf16*)(ws + WS_W4) + (size_t)l * D * FFN, scr, r % I4, lane); }
    }
    {
        f32x4 nv[4]; int m = gw;
#define P0_XLOAD(mm) do { const bool smp_ = (mm) >= MP; const int r_ = smp_ ? (mm) - MP : (mm); const f32x4* xr_ = (const f32x4*)((smp_ ? a.in[1] : a.in[0]) + (size_t)r_ * D) + lane; \
        _Pragma("unroll") for (int j_ = 0; j_ < 4; ++j_) nv[j_] = xr_[64 * j_]; } while (0)
        if (m < MP + MS) P0_XLOAD(m);
        for (; m < MP + MS; m += ngw) {
            const bool smp = m >= MP; const int r = smp ? m - MP : m;
            f32x4 v[4]; float s = 0.f;
#pragma unroll
            for (int j = 0; j < 4; ++j) { v[j] = nv[j]; s += (v[j][0] * v[j][0] + v[j][1] * v[j][1]) + (v[j][2] * v[j][2] + v[j][3] * v[j][3]); }
            if (m + ngw < MP + MS) P0_XLOAD(m + ngw);
            s = wave_sum(s);
            u32x2* o8 = (u32x2*)((bf16*)(ws + (smp ? WS_SXB : WS_XB)) + (size_t)r * D) + lane;
#pragma unroll
            for (int j = 0; j < 4; ++j) { u32x2 w; w.x = pkbf(v[j][0], v[j][1]); w.y = pkbf(v[j][2], v[j][3]); o8[64 * j] = w; }
            float* ssr = (float*)(ws + (smp ? WS_SSS : WS_SS)) + (size_t)r * 32;
            if (lane < (smp ? 32 : 16)) ssr[lane] = (lane == 0) ? s : 0.f;
        }
#undef P0_XLOAD
    }
    if (wave == 7) s5_precompute(a, (gw >> 3) * 64 + lane);
}
constexpr int DL_K = 0, DL_V = 17408, DL_QK = 34816, DL_X = 44032, DL_SLOT = 9216, DL_ST = 99328, DL_GC = 134144, DL_BETA = 134400, DL_RED = 134656, DL_END = 135168 + 512;
static_assert(DL_END <= LDSCTL_OFF, "DN LDS map");
__device__ __forceinline__ bf16x8 ldfrag(ldsp base, int row, int ld, int k) { return *(const LAS bf16x8*)(base + (row * ld + k) * 2); }
__device__ __forceinline__ void st4(ldsp base, int row, int ld, int col, const f32x4 v) { u32x2 w; w.x = pkbf(v[0], v[1]); w.y = pkbf(v[2], v[3]); *(LAS u32x2*)(base + (row * ld + col) * 2) = w; }
__device__ __forceinline__ void st1(ldsp base, int row, int ld, int col, float v) { *(LAS unsigned short*)(base + (row * ld + col) * 2) = (unsigned short)(pkbf(v, 0.f) & 0xffffu); }

typedef short s16x4 __attribute__((ext_vector_type(4)));
__device__ __forceinline__ bf16x8 ldfrag_tr(ldsp base, int k0, int ld, int c0, int fr, int fq) {
    const ldsp p = base + ((k0 + 8 * fq + (fr >> 2)) * ld + c0 + 4 * (fr & 3)) * 2;
    const s16x4 lo = __builtin_amdgcn_ds_read_tr16_b64_v4i16((LAS s16x4*)p);
    const s16x4 hi = __builtin_amdgcn_ds_read_tr16_b64_v4i16((LAS s16x4*)(p + 8 * ld));
    return (bf16x8){lo[0], lo[1], lo[2], lo[3], hi[0], hi[1], hi[2], hi[3]};
}
__device__ __forceinline__ void dn_prep(const Args& a, int gw, int ngw, int lane) {
    const bf16* PROJ = (const bf16*)(a.ws + WS_PROJ); bf16* QKVC = (bf16*)(a.ws + WS_QKVC);
    for (int u = gw; u < NB * 8 * (SEQ / 32); u += ngw) {
        const int cb = u & 7, run = (u >> 3) & 63, b = u >> 9, ch0 = cb * 512 + lane * 8, t0 = run * 32, row0 = b * SEQ + t0;
        float w[4][8];
#pragma unroll
        for (int j = 0; j < 4; ++j) { const f32x4 w0 = *(const f32x4*)(a.in[10] + j * 4096 + ch0), w1 = *(const f32x4*)(a.in[10] + j * 4096 + ch0 + 4);
#pragma unroll
            for (int e = 0; e < 4; ++e) { w[j][e] = w0[e]; w[j][4 + e] = w1[e]; } }
        u32x4 xm[3];
#pragma unroll
        for (int j = 0; j < 3; ++j) { xm[j] = (u32x4){0u, 0u, 0u, 0u}; if (t0 - 3 + j >= 0) xm[j] = *(const u32x4*)(PROJ + (size_t)(row0 - 3 + j) * PROJ_LD + ch0); }
        const float scl = cb < 2 ? 0.08838834764831845f : 1.0f;
        u32x4 xr[8];
#pragma unroll
        for (int t = 0; t < 8; ++t) xr[t] = *(const u32x4*)(PROJ + (size_t)(row0 + t) * PROJ_LD + ch0);
#pragma unroll
        for (int t = 0; t < 32; ++t) {
            const u32x4 x0 = xr[t & 7];
            if (t + 8 < 32) xr[t & 7] = *(const u32x4*)(PROJ + (size_t)(row0 + t + 8) * PROJ_LD + ch0);
            float y[8];
#pragma unroll
            for (int e = 0; e < 4; ++e) {
                const unsigned a3 = xm[0][e], a2 = xm[1][e], a1 = xm[2][e], a0 = x0[e];
                y[2 * e] = w[0][2 * e] * bflo(a3) + w[1][2 * e] * bflo(a2) + w[2][2 * e] * bflo(a1) + w[3][2 * e] * bflo(a0);
                y[2 * e + 1] = w[0][2 * e + 1] * bfhi(a3) + w[1][2 * e + 1] * bfhi(a2) + w[2][2 * e + 1] * bfhi(a1) + w[3][2 * e + 1] * bfhi(a0); }
            float ssq = 0.f;
#pragma unroll
            for (int e = 0; e < 8; ++e) { y[e] = y[e] * __builtin_amdgcn_rcpf(1.0f + __expf(-y[e])); ssq += y[e] * y[e]; }
            if (cb < 4) { ssq += __shfl_xor(ssq, 1); ssq += __shfl_xor(ssq, 2); ssq += __shfl_xor(ssq, 4); ssq += __shfl_xor(ssq, 8); const float sc = rsqrtf(ssq + 1e-6f) * scl;
#pragma unroll
                for (int e = 0; e < 8; ++e) y[e] *= sc; }
            u32x4 o; o.x = pkbf(y[0], y[1]); o.y = pkbf(y[2], y[3]); o.z = pkbf(y[4], y[5]); o.w = pkbf(y[6], y[7]);
            *(u32x4*)(QKVC + (size_t)(row0 + t) * 4096 + ch0) = o;
            xm[0] = xm[1]; xm[1] = xm[2]; xm[2] = x0;
        }
    }
}

#ifndef RPA
#define RPA 1
#endif
#ifndef RPB
#define RPB 1
#endif
#ifndef RPE
#define RPE 1
#endif
#ifndef RPF
#define RPF 1
#endif
#ifndef RPO
#define RPO 1
#endif
__device__ __forceinline__ void dn_prompt(const Args& a, ldsp lds, int b, int h, int tid, int wave, int lane) {
    unsigned char* ws = a.ws;
    const bf16* PROJ = (const bf16*)(ws + WS_PROJ); const bf16* QKVC = (const bf16*)(ws + WS_QKVC); bf16* GATED = (bf16*)(ws + WS_GATED);
    const float* BETA = (const float*)(ws + WS_BETA); const float* GDEC = (const float*)(ws + WS_GDEC);
    const int mt = wave & 3, ch = wave >> 2, hq = h >> 1;
    LAS float* gcs = (LAS float*)(lds + DL_GC); LAS float* betas = (LAS float*)(lds + DL_BETA); LAS float* red = (LAS float*)(lds + DL_RED);
    const ldsp LK = lds + DL_K, LV = lds + DL_V, LQK = lds + DL_QK, LST = lds + DL_ST;
#define SLOT(s) (lds + DL_X + (s) * DL_SLOT)
#define PRs(s) ((s) == 0 ? 0 : (((s) & 1) ? 2 : 4))
#define PTs(s) ((s) == 0 ? 1 : (((s) & 1) ? 3 : 5))
#define NRs(s) ((s) & 1)
    for (int i = tid; i < 128 * 136 / 2; i += NTHREADS) ((LAS unsigned*)LST)[i] = 0u;
    f32x4 S[2][4];
#pragma unroll
    for (int x = 0; x < 2; ++x)
#pragma unroll
        for (int q = 0; q < 4; ++q) S[x][q] = (f32x4){0.f, 0.f, 0.f, 0.f};
    LAS float* ngl = (LAS float*)(lds + DL_RED + 512);
    if (tid < 128) ngl[tid] = a.in[13][tid];
    __syncthreads();
    bf16x8 nq[4]; u32x4 nKt[2], nVt[2]; float ngd = 0.f, nbt = 0.f;
#define DN_PREFETCH(cc) do { const int rowc_ = b * SEQ + (cc) * CHUNK; const bf16* qrow_ = QKVC + (size_t)(rowc_ + i_own) * 4096 + hq * 128 + 8 * fq; \
        _Pragma("unroll") for (int kk_ = 0; kk_ < 4; ++kk_) nq[kk_] = *(const bf16x8*)(qrow_ + 32 * kk_); \
        const bf16* krow_ = QKVC + (size_t)(rowc_ + (tid >> 3)) * 4096; \
        _Pragma("unroll") for (int p2_ = 0; p2_ < 2; ++p2_) { const int col_ = 8 * ((tid & 7) + 8 * p2_); nKt[p2_] = *(const u32x4*)(krow_ + 1024 + hq * 128 + col_); nVt[p2_] = *(const u32x4*)(krow_ + 2048 + h * 128 + col_); } \
        if (wave == 0) { ngd = GDEC[(size_t)(rowc_ + lane) * 16 + h]; nbt = BETA[(size_t)(rowc_ + lane) * 16 + h]; } } while (0)
    { const int fr = lane & 15, fq = lane >> 4, i_own = 16 * mt + fr; DN_PREFETCH(0); }
    for (int c = 0; c < NCHUNK; ++c) {
        int lane_c = lane; asm volatile("" : "+v"(lane_c));
        const int fr = lane_c & 15, fq = lane_c >> 4, i_own = 16 * mt + fr;
        const int t_own = c * CHUNK + i_own, row_own = b * SEQ + t_own;
        bf16x8 qf[4], kf[4]; u32x2 zc[4];
        {
#pragma unroll
            for (int kk = 0; kk < 4; ++kk) qf[kk] = nq[kk];
            const int r = tid >> 3, pc = tid & 7;
#pragma unroll
            for (int p2 = 0; p2 < 2; ++p2) { const int col = 8 * (pc + 8 * p2); *(LAS u32x4*)(LK + (r * 136 + col) * 2) = nKt[p2]; *(LAS u32x4*)(LV + (r * 136 + col) * 2) = nVt[p2]; }
            if (wave == 0) { float g = ngd;
#pragma unroll
                for (int o = 1; o < 64; o <<= 1) { const float t = __shfl_up(g, o); if (lane_c >= o) g += t; }
                gcs[lane_c] = g; betas[lane_c] = nbt; }
#pragma unroll
            for (int q = 0; q < 4; ++q) zc[q] = *(const u32x2*)(PROJ + (size_t)row_own * PROJ_LD + 4096 + h * 128 + 16 * (4 * ch + q) + 4 * fq);
            if (c + 1 < NCHUNK) DN_PREFETCH(c + 1);
        }
        __syncthreads();
#pragma unroll
        for (int kk = 0; kk < 4; ++kk) kf[kk] = ldfrag(LK, i_own, 136, 32 * kk + 8 * fq);
        for (int rpB = 0; rpB < RPB; ++rpB) {
        f32x4 Pt[2], Nt[2];
        {
            const float gi = gcs[i_own], bi = betas[i_own];
#pragma unroll
            for (int q2 = 0; q2 < 2; ++q2) { const int nt = 2 * ch + q2;
                f32x4 akk = (f32x4){0.f, 0.f, 0.f, 0.f}, aqk = akk;
#pragma unroll
                for (int kk = 0; kk < 4; ++kk) { const bf16x8 yf = ldfrag(LK, 16 * nt + fr, 136, 32 * kk + 8 * fq); MM_XROW(akk, kf[kk], yf); MM_XROW(aqk, qf[kk], yf); }
                const f32x4 gj = *(const LAS f32x4*)(gcs + 16 * nt + 4 * fq);
                f32x4 qkv, m0;
#pragma unroll
                for (int r = 0; r < 4; ++r) { const int j = 16 * nt + 4 * fq + r; const float d = (i_own >= j) ? __expf(gi - gj[r]) : 0.f; qkv[r] = aqk[r] * d; m0[r] = (i_own > j) ? -bi * akk[r] * d : 0.f; }
                st4(LQK, i_own, 72, 16 * nt + 4 * fq, qkv);
                Pt[q2] = m0; Nt[q2] = m0;
                st4(SLOT(0), i_own, 72, 16 * nt + 4 * fq, m0);
#pragma unroll
                for (int r = 0; r < 4; ++r) st1(SLOT(1), 16 * nt + 4 * fq + r, 72, i_own, m0[r]); }
        }
        __syncthreads();
#pragma unroll
        for (int s = 1; s <= 6; ++s) {
            f32x4 Pn[2];
            bf16x8 xn[2], xp[2];
            if (s >= 2) { xn[0] = ldfrag(SLOT(NRs(s - 2)), i_own, 72, 8 * fq); xn[1] = ldfrag(SLOT(NRs(s - 2)), i_own, 72, 32 + 8 * fq); }
            if (s <= 5) { xp[0] = ldfrag(SLOT(PRs(s - 1)), i_own, 72, 8 * fq); xp[1] = ldfrag(SLOT(PRs(s - 1)), i_own, 72, 32 + 8 * fq); }
#pragma unroll
            for (int q2 = 0; q2 < 2; ++q2) { const int nt = 2 * ch + q2;
                const bf16x8 y0 = ldfrag(SLOT(PTs(s - 1)), 16 * nt + fr, 72, 8 * fq), y1 = ldfrag(SLOT(PTs(s - 1)), 16 * nt + fr, 72, 32 + 8 * fq);
                if (s >= 2) { f32x4 acc = Nt[q2] + Pt[q2]; MM_XROW(acc, xn[0], y0); MM_XROW(acc, xn[1], y1); Nt[q2] = acc; }
                if (s <= 5) { f32x4 acc = (f32x4){0.f, 0.f, 0.f, 0.f}; MM_XROW(acc, xp[0], y0); MM_XROW(acc, xp[1], y1); Pn[q2] = acc; }
            }
#pragma unroll
            for (int q2 = 0; q2 < 2; ++q2) { const int nt = 2 * ch + q2, j0 = 16 * nt + 4 * fq;
                if (s <= 5) { Pt[q2] = Pn[q2];
                    if (s <= 4) st4(SLOT(PRs(s)), i_own, 72, j0, Pn[q2]);
#pragma unroll
                    for (int r = 0; r < 4; ++r) st1(SLOT(PTs(s)), j0 + r, 72, i_own, Pn[q2][r]); }
                if (s >= 2 && s <= 5) st4(SLOT(NRs(s - 1)), i_own, 72, j0, Nt[q2]);
                if (s == 6) {
                    const f32x4 gj = *(const LAS f32x4*)(gcs + j0), bj = *(const LAS f32x4*)(betas + j0); f32x4 t1, t2;
#pragma unroll
                    for (int r = 0; r < 4; ++r) { const float tv = Nt[q2][r] + ((i_own == j0 + r) ? 1.f : 0.f); t2[r] = tv * bj[r]; t1[r] = t2[r] * __expf(gj[r]); }
                    st4(SLOT(1), i_own, 72, j0, t1); st4(SLOT(2), i_own, 72, j0, t2); }
            }
            __syncthreads();
        }
        }
        f32x4 U[4];
        for (int rpE = 0; rpE < RPE; ++rpE) {
        {
            const bf16x8 t1a = ldfrag(SLOT(1), i_own, 72, 8 * fq), t1b = ldfrag(SLOT(1), i_own, 72, 32 + 8 * fq), t2a = ldfrag(SLOT(2), i_own, 72, 8 * fq), t2b = ldfrag(SLOT(2), i_own, 72, 32 + 8 * fq);
#pragma unroll
            for (int q = 0; q < 4; ++q) { const int nt = 4 * ch + q;
                f32x4 aw = (f32x4){0.f, 0.f, 0.f, 0.f};
                MM_XROW(aw, t1a, ldfrag_tr(LK, 0, 136, 16 * nt, fr, fq)); MM_XROW(aw, t1b, ldfrag_tr(LK, 32, 136, 16 * nt, fr, fq));
                st4(SLOT(4), i_own, 136, 16 * nt + 4 * fq, -aw);
                f32x4 au = (f32x4){0.f, 0.f, 0.f, 0.f};
                MM_YROW(au, t2a, ldfrag_tr(LV, 0, 136, 16 * nt, fr, fq)); MM_YROW(au, t2b, ldfrag_tr(LV, 32, 136, 16 * nt, fr, fq));
                U[q] = au; }
        }
        __syncthreads();
        }
        f32x4 O[4];
        const float gl = gcs[63];
        for (int rpF = 0; rpF < RPF; ++rpF) {
        {
            bf16x8 wf[4];
#pragma unroll
            for (int kk = 0; kk < 4; ++kk) wf[kk] = ldfrag(SLOT(4), i_own, 136, 32 * kk + 8 * fq);
            const float ei = __expf(gcs[i_own]);
            const f32x4 gq = *(const LAS f32x4*)(gcs + 16 * mt + 4 * fq);
#pragma unroll
            for (int q = 0; q < 4; ++q) { const int nt = 4 * ch + q;
                f32x4 ao = (f32x4){0.f, 0.f, 0.f, 0.f}, av = U[q];
#pragma unroll
                for (int kk = 0; kk < 4; ++kk) { const bf16x8 sf = ldfrag(LST, 16 * nt + fr, 136, 32 * kk + 8 * fq); MM_YROW(av, wf[kk], sf); MM_XROW(ao, qf[kk], sf); }
                O[q] = ao * ei;
                st4(SLOT(0), 16 * nt + fr, 72, 16 * mt + 4 * fq, av);
                f32x4 avd;
#pragma unroll
                for (int r = 0; r < 4; ++r) avd[r] = av[r] * __expf(gl - gq[r]);
                st4(SLOT(2), 16 * nt + fr, 72, 16 * mt + 4 * fq, avd); }
        }
        __syncthreads();
        }
        {
            const bf16x8 qa = ldfrag(LQK, i_own, 72, 8 * fq), qb = ldfrag(LQK, i_own, 72, 32 + 8 * fq);
            bf16x8 ka[2][2];
#pragma unroll
            for (int x = 0; x < 2; ++x) { ka[x][0] = ldfrag_tr(LK, 0, 136, 16 * (2 * mt + x), fr, fq); ka[x][1] = ldfrag_tr(LK, 32, 136, 16 * (2 * mt + x), fr, fq); }
            const float el = __expf(gl);
            float ssq = 0.f;
#pragma unroll
            for (int q = 0; q < 4; ++q) { const int nt = 4 * ch + q;
                MM_XROW(O[q], qa, ldfrag(SLOT(0), 16 * nt + fr, 72, 8 * fq)); MM_XROW(O[q], qb, ldfrag(SLOT(0), 16 * nt + fr, 72, 32 + 8 * fq));
                ssq += (O[q][0] * O[q][0] + O[q][1] * O[q][1]) + (O[q][2] * O[q][2] + O[q][3] * O[q][3]);
                const bf16x8 v0 = ldfrag(SLOT(2), 16 * nt + fr, 72, 8 * fq), v1 = ldfrag(SLOT(2), 16 * nt + fr, 72, 32 + 8 * fq);
#pragma unroll
                for (int x = 0; x < 2; ++x) { f32x4 sacc = S[x][q] * el; MM_YROW(sacc, ka[x][0], v0); MM_YROW(sacc, ka[x][1], v1); S[x][q] = sacc;
                    st4(LST, 16 * nt + fr, 136, 16 * (2 * mt + x) + 4 * fq, sacc); } }
            ssq += __shfl_xor(ssq, 16); ssq += __shfl_xor(ssq, 32);
            if (fq == 0) red[i_own * 2 + ch] = ssq;
        }
        __syncthreads();
        for (int rpO = 0; rpO < RPO; ++rpO) {
        {
            const float rstd = rsqrtf((red[i_own * 2] + red[i_own * 2 + 1]) * (1.0f / 128.0f) + RMS_EPSF);
#pragma unroll
            for (int q = 0; q < 4; ++q) { const int dv = 16 * (4 * ch + q) + 4 * fq;
                const u32x2 z = zc[q];
                const f32x4 ngv = *(const LAS f32x4*)(ngl + dv);
                u32x2 w; w.x = pkbf(O[q][0] * rstd * ngv[0] * bflo(z.x), O[q][1] * rstd * ngv[1] * bfhi(z.x)); w.y = pkbf(O[q][2] * rstd * ngv[2] * bflo(z.y), O[q][3] * rstd * ngv[3] * bfhi(z.y));
                *(u32x2*)(GATED + (size_t)row_own * VAL + h * 128 + dv) = w; }
        }
        }
    }
    const int fr = lane & 15, fq = lane >> 4;
    float* so = a.out + O_SSMP + (size_t)(b * NH + h) * 128 * 128;
#pragma unroll
    for (int x = 0; x < 2; ++x)
#pragma unroll
        for (int q = 0; q < 4; ++q)
#pragma unroll
            for (int r = 0; r < 4; ++r) so[(size_t)(16 * (2 * mt + x) + 4 * fq + r) * 128 + 16 * (4 * ch + q) + fr] = S[x][q][r];
    for (int i = tid; i < 3 * 384; i += NTHREADS) { const int j = i / 384, cc = i % 384; if (cc < 256 && (h & 1)) continue;
        const int gch = cc < 128 ? hq * 128 + cc : (cc < 256 ? 1024 + hq * 128 + (cc - 128) : 2048 + h * 128 + (cc - 256));
        a.out[O_CONVP + (size_t)(b * 3 + j) * 4096 + gch] = bf1(PROJ[(size_t)(b * SEQ + SEQ - 3 + j) * PROJ_LD + gch]); }
    __syncthreads();
#undef SLOT
#undef DN_PREFETCH
#undef PRs
#undef PTs
#undef NRs
}
__device__ __forceinline__ void dn_sample_all(const Args& a, ldsp lds, int ti, int nt, int tid, int wave, int lane) {
    unsigned char* ws = a.ws;
    const bf16* PROJ = (const bf16*)(ws + WS_SPROJ); bf16* GATED = (bf16*)(ws + WS_SGATED);
    const float* BETA = (const float*)(ws + WS_SBETA); const float* GDEC = (const float*)(ws + WS_SGDEC);
    LAS float* qkv = (LAS float*)lds;
    LAS float* red = qkv + 384;
    LAS float* part = qkv + 512;
    const int kg = tid >> 5, v4 = tid & 31, p = tid >> 7, c = tid & 127;
    f32x4 sn[8]; float nx3 = 0.f, nc0 = 0.f, nc1 = 0.f, nc2 = 0.f, nbeta = 0.f, ngd = 0.f; u32x2 nz = (u32x2){0u, 0u};
    float w0 = 0.f, w1 = 0.f, w2 = 0.f, w3 = 0.f; int gch_cur = -1;
#define DNS_LOAD(it_) do { const int bs_ = (it_) / NH, h_ = (it_) % NH, hq_ = h_ >> 1; \
        const float* sin_ = a.in[2] + ((size_t)(bs_ * NH + h_) * 128 + kg * 8) * 128 + 4 * v4; \
        _Pragma("unroll") for (int r_ = 0; r_ < 8; ++r_) sn[r_] = *(const f32x4*)(sin_ + r_ * 128); \
        if (tid < 384) { const int gch_ = p == 0 ? hq_ * 128 + c : (p == 1 ? 1024 + hq_ * 128 + c : 2048 + h_ * 128 + c); \
            nx3 = bf1(PROJ[(size_t)bs_ * PROJ_LD + gch_]); const float* cs_ = a.in[3] + (size_t)bs_ * 3 * 4096 + gch_; nc0 = cs_[0]; nc1 = cs_[4096]; nc2 = cs_[8192]; } \
        nbeta = BETA[(size_t)bs_ * 16 + h_]; ngd = GDEC[(size_t)bs_ * 16 + h_]; \
        if (tid < 32) nz = *(const u32x2*)(PROJ + (size_t)bs_ * PROJ_LD + 4096 + h_ * 128 + 4 * v4); } while (0)
    int it = ti;
    if (it < MS * NH) DNS_LOAD(it);
    for (; it < MS * NH; it += nt) {
        const int bs = it / NH, h = it % NH, hq = h >> 1;
        f32x4 s[8];
#pragma unroll
        for (int r = 0; r < 8; ++r) s[r] = sn[r];
        const float x3 = nx3, c0 = nc0, c1 = nc1, c2 = nc2, beta = nbeta, eg = __expf(ngd); const u32x2 z = nz;
        const int gch = p == 0 ? hq * 128 + c : (p == 1 ? 1024 + hq * 128 + c : 2048 + h * 128 + c);
        if (tid < 384 && gch != gch_cur) { const float* w = a.in[10] + gch; w0 = w[0]; w1 = w[4096]; w2 = w[8192]; w3 = w[12288]; gch_cur = gch; }
        if (it + nt < MS * NH) DNS_LOAD(it + nt);
        float sq = 0.f;
        if (tid < 384) {
            float y = c0 * w0 + c1 * w1 + c2 * w2 + x3 * w3; y = y / (1.0f + __expf(-y));
            if (p == 2 || (h & 1) == 0) { float* co = a.out + O_CONVS + (size_t)bs * 3 * 4096 + gch; co[0] = c1; co[4096] = c2; co[8192] = x3; }
            qkv[tid] = y; sq = y * y; }
        sq = wave_sum(sq);
        if (lane == 0) red[wave] = sq;
        __syncthreads();
        const float qs = rsqrtf(red[0] + red[1] + 1e-6f) * 0.08838834764831845f, ks = rsqrtf(red[2] + red[3] + 1e-6f);
        float* sout = a.out + O_SSMS + ((size_t)(bs * NH + h) * 128 + kg * 8) * 128 + 4 * v4;
        f32x4 kv = (f32x4){0.f, 0.f, 0.f, 0.f};
#pragma unroll
        for (int r = 0; r < 8; ++r) { s[r] = s[r] * eg; kv += s[r] * (qkv[128 + kg * 8 + r] * ks); }
        *(LAS f32x4*)(part + kg * 128 + 4 * v4) = kv;
        __syncthreads();
        kv = (f32x4){0.f, 0.f, 0.f, 0.f};
#pragma unroll
        for (int g = 0; g < 16; ++g) kv += *(const LAS f32x4*)(part + g * 128 + 4 * v4);
        const f32x4 vv = *(const LAS f32x4*)(qkv + 256 + 4 * v4);
        const f32x4 delta = (vv - kv) * beta;
        f32x4 op = (f32x4){0.f, 0.f, 0.f, 0.f};
#pragma unroll
        for (int r = 0; r < 8; ++r) { s[r] += delta * (qkv[128 + kg * 8 + r] * ks); *(f32x4*)(sout + r * 128) = s[r]; op += s[r] * (qkv[kg * 8 + r] * qs); }
        __syncthreads();
        *(LAS f32x4*)(part + kg * 128 + 4 * v4) = op;
        __syncthreads();
        if (tid < 32) {
            f32x4 o = (f32x4){0.f, 0.f, 0.f, 0.f};
#pragma unroll
            for (int g = 0; g < 16; ++g) o += *(const LAS f32x4*)(part + g * 128 + 4 * v4);
            float ss = (o[0] * o[0] + o[1] * o[1]) + (o[2] * o[2] + o[3] * o[3]);
#pragma unroll
            for (int m = 1; m < 32; m <<= 1) ss += __shfl_xor(ss, m);
            const float rstd = rsqrtf(ss * (1.0f / 128.0f) + RMS_EPSF);
            const f32x4 ng = *(const f32x4*)(a.in[13] + 4 * v4);
            u32x2 w; w.x = pkbf(o[0] * rstd * ng[0] * bflo(z.x), o[1] * rstd * ng[1] * bfhi(z.x)); w.y = pkbf(o[2] * rstd * ng[2] * bflo(z.y), o[3] * rstd * ng[3] * bfhi(z.y));
            *(u32x2*)(GATED + (size_t)bs * VAL + h * 128 + 4 * v4) = w;
        }
        __syncthreads();
    }
#undef DNS_LOAD
}
__device__ __forceinline__ void s5_wave(const Args& a, ldsp wl, bool sample, int b, int e0, int g, int lane) {
    unsigned char* ws = a.ws;
    const bf16* XB = (const bf16*)(ws + (sample ? WS_SXB : WS_XB)); bf16* YB = (bf16*)(ws + (sample ? WS_SYB : WS_YB)); const float* SS = (const float*)(ws + (sample ? WS_SSS : WS_SS));
    const int fr = lane & 15, fq = lane >> 4;
    LAS float* bubuf = (LAS float*)wl;
    const ldsp stbuf = wl + 16 * 132 * 4;
    const f32x2 lam = *(const f32x2*)((const float*)(ws + WS_S5LAM) + (size_t)(g * 64 + lane) * 2); const float lr = lam[0], li = lam[1];
    bf16x8 bbf[8];
#pragma unroll
    for (int nt = 0; nt < 8; ++nt) { u32x4 w = (u32x4){0u, 0u, 0u, 0u}; if (fq < 2) w = *(const u32x4*)((const bf16*)(ws + WS_S5BB) + ((size_t)g * 128 + 16 * nt + fr) * 16 + 8 * fq); bbf[nt] = __builtin_bit_cast(bf16x8, w); }
    bf16x8 cf[4];
#pragma unroll
    for (int kk = 0; kk < 4; ++kk) cf[kk] = *(const bf16x8*)((const bf16*)(ws + WS_S5CM) + ((size_t)g * 16 + fr) * 128 + 32 * kk + 8 * fq);
    const f32x4 dskv = *(const f32x4*)((const float*)(ws + WS_S5DSK) + g * 16 + 4 * fq); const float dsk[4] = {dskv[0], dskv[1], dskv[2], dskv[3]};
    float sre = 0.f, sim = 0.f;
    const int ntile = sample ? 1 : SEQ / 16;
    const int rowb0 = sample ? e0 : b * SEQ;
    u32x4 pxw[4]; f32x4 pss[4]; u32x2 puw[4];
#define S5_LOAD(k, tile) do { const int row_ = rowb0 + (tile) * 16 + fr; pxw[k] = (u32x4){0u, 0u, 0u, 0u}; if (fq < 2) pxw[k] = *(const u32x4*)(XB + (size_t)row_ * D + g * 16 + 8 * fq); \
        pss[k] = *(const f32x4*)(SS + (size_t)row_ * 32 + 4 * fq); if (sample) pss[k] += *(const f32x4*)(SS + (size_t)row_ * 32 + 16 + 4 * fq); puw[k] = *(const u32x2*)(XB + (size_t)row_ * D + g * 16 + 4 * fq); } while (0)
#pragma unroll
    for (int k = 0; k < 4; ++k) if (k < ntile) S5_LOAD(k, k);
    for (int t0 = 0; t0 < ntile; t0 += 4) {
#pragma unroll
        for (int k = 0; k < 4; ++k) {
            const int tile = t0 + k; if (tile >= ntile) break;
            const int row = rowb0 + tile * 16 + fr;
            const bf16x8 xf = __builtin_bit_cast(bf16x8, pxw[k]);
            float ssum = (pss[k][0] + pss[k][1]) + (pss[k][2] + pss[k][3]); ssum += __shfl_xor(ssum, 16); ssum += __shfl_xor(ssum, 32);
            const float rs = rsqrtf(ssum * (1.0f / 1024.0f) + RMS_EPSF);
            const u32x2 uw = puw[k];
            if (tile + 4 < ntile) S5_LOAD(k, tile + 4);
#pragma unroll
            for (int nt = 0; nt < 8; ++nt) { f32x4 acc = (f32x4){0.f, 0.f, 0.f, 0.f}; MM_XROW(acc, xf, bbf[nt]); *(LAS f32x4*)(bubuf + fr * 132 + 16 * nt + 4 * fq) = acc * rs; }
            LDS_FENCE();
            f32x2 buv[16];
#pragma unroll
            for (int t = 0; t < 16; ++t) buv[t] = *(const LAS f32x2*)(bubuf + t * 132 + 2 * lane);
            LDS_FENCE();
#pragma unroll
            for (int t = 0; t < 16; ++t) {
                const f32x2 bu = buv[t];
                if (sample) { sre = a.in[4][(size_t)(e0 + t) * 4096 + g * 64 + lane]; sim = a.in[5][(size_t)(e0 + t) * 4096 + g * 64 + lane]; }
                const float nr = fmaf(lr, sre, fmaf(-li, sim, bu[0])), ni = fmaf(lr, sim, fmaf(li, sre, bu[1]));
                sre = nr; sim = ni;
                *(LAS unsigned*)(stbuf + (t * 136 + 2 * lane) * 2) = pkbf(sre, sim);
                if (sample) { a.out[O_S5RS + (size_t)(e0 + t) * 4096 + g * 64 + lane] = sre; a.out[O_S5IS + (size_t)(e0 + t) * 4096 + g * 64 + lane] = sim; }
            }
            LDS_FENCE();
            f32x4 y = (f32x4){0.f, 0.f, 0.f, 0.f};
#pragma unroll
            for (int kk = 0; kk < 4; ++kk) MM_XROW(y, ldfrag(stbuf, fr, 136, 32 * kk + 8 * fq), cf[kk]);
            y[0] += dsk[0] * bflo(uw.x) * rs; y[1] += dsk[1] * bfhi(uw.x) * rs; y[2] += dsk[2] * bflo(uw.y) * rs; y[3] += dsk[3] * bfhi(uw.y) * rs;
            u32x2 w; w.x = pkbf(gelu_tanh(y[0]), gelu_tanh(y[1])); w.y = pkbf(gelu_tanh(y[2]), gelu_tanh(y[3]));
            *(u32x2*)(YB + (size_t)row * D + g * 16 + 4 * fq) = w;
            LDS_FENCE();
        }
    }
#undef S5_LOAD
    if (!sample) { a.out[O_S5RP + (size_t)(b * 64 + g) * 64 + lane] = sre; a.out[O_S5IP + (size_t)(b * 64 + g) * 64 + lane] = sim; }
}
__global__ void __launch_bounds__(NTHREADS, 2) hybrid_fwd(Args a) {
    extern __shared__ __attribute__((aligned(16))) unsigned char lds_raw[];
    const ldsp lds = (ldsp)lds_raw;
    const int tid = threadIdx.x, lane = tid & 63, wave = __builtin_amdgcn_readfirstlane(tid >> 6);
    const int G = gridDim.x, bx = blockIdx.x;
    const int vcu = (G % 8 == 0) ? (bx % 8) * (G / 8) + bx / 8 : bx;
    unsigned char* ws = a.ws;
    unsigned* ctl = (unsigned*)(ws + WS_CTL);
    for (int u = tid; u < (LDS_BYTES - LDSCTL_OFF) / 4; u += NTHREADS) ((LAS unsigned*)(lds + LDSCTL_OFF))[u] = 0u;
    __syncthreads();
    XcdBarrier bar = xcd_barrier_post(ctl + CW_BAR, (volatile LAS unsigned*)(lds + LDSCTL_OFF) + 8);
    const int gw = vcu * NWAVES + wave, ngw = G * NWAVES;
    bf16* XB = (bf16*)(ws + WS_XB); float* X = (float*)(ws + WS_X); float* SS = (float*)(ws + WS_SS);
    bf16* PROJ = (bf16*)(ws + WS_PROJ); bf16* GATED = (bf16*)(ws + WS_GATED); bf16* YB = (bf16*)(ws + WS_YB); bf16* HB = (bf16*)(ws + WS_H);
    const bf16* W1 = (const bf16*)(ws + WS_W1); const bf16* W2 = (const bf16*)(ws + WS_W2); const bf16* W5 = (const bf16*)(ws + WS_W5);
    const bf16* W3 = (const bf16*)(ws + WS_W3); const bf16* W4 = (const bf16*)(ws + WS_W4);
#define SINGLE_ARG(...) __VA_ARGS__
#define GEMM_PHASE(EPI, Aop, Bop, N_, K_, E_) do { pg8::Gemm g_{(const pg8::bf16_t*)(Aop), (const pg8::bf16_t*)(Bop), MP, (N_), (K_)}; pg8::StaticOrder S_; S_.init(MP, (N_), G, bx); \
        pg8::gemm_phase<EPI, pg8::StaticOrder, true, true>(lds, g_, S_, (E_)); } while (0)
#ifndef DBG_STOP
#define DBG_STOP 0
#endif
#ifndef REPG
#define REPG 0
#endif
#define DBG_DIGEST(k, SRC, NEL) do { if (DBG_STOP == (k)) { xcd_barrier(bar); const bf16* s_ = (const bf16*)(SRC); for (size_t i_ = (size_t)bx * NTHREADS + tid; i_ < (size_t)(NEL) && i_ < O_SSMP; i_ += (size_t)G * NTHREADS) a.out[i_] = bf1(s_[i_]); return; } } while (0)

#ifndef TPROBE
#define TPROBE 0
#endif
#define TP_BLK ((TPROBE) / 10000)
#define TP_S (((TPROBE) / 100) % 100)
#define TP_E ((TPROBE) % 100)
    unsigned long long tp_s = 0, tp_e = 0;
#define STAMPV(id) do { if (TPROBE && vcu == TP_BLK && tid == 0) { const unsigned long long t_ = __builtin_amdgcn_s_memrealtime(); if ((id) == TP_S && tp_s == 0) tp_s = t_; if ((id) == TP_E && tp_e == 0) tp_e = t_; } } while (0)
#define STAMP(id) do { if (TPROBE && vcu == TP_BLK && tid == 0) { const unsigned long long t_ = __builtin_amdgcn_s_memrealtime(); if ((id) == TP_S) tp_s = t_; if ((id) == TP_E) tp_e = t_; } } while (0)
    STAMP(0);
    p0_prologue(a, lds, gw, ngw, wave, lane);
    STAMP(1);
    xcd_barrier(bar);
    STAMP(2);
    { pg8::EpiProj E{(pg8::bf16_t*)PROJ, SS, 16};
      GEMM_PHASE(pg8::EpiProj, XB, W1, PROJ_LD, D, E); }
#if REPG == 1
    xcd_barrier(bar);
    { pg8::EpiProj E{(pg8::bf16_t*)PROJ, SS, 16};
      GEMM_PHASE(pg8::EpiProj, XB, W1, PROJ_LD, D, E); }
#endif
    {
        const SEpiProj Ep{nullptr, SS, 16, (float*)(ws + WS_BETA), (float*)(ws + WS_GDEC), a.in[11], a.in[12]};
        const SEpiProj Es{(bf16*)(ws + WS_SPROJ), (const float*)(ws + WS_SSS), 32, (float*)(ws + WS_SBETA), (float*)(ws + WS_SGDEC), a.in[11], a.in[12]};
        for (int u = vcu; u < 128 + 193; u += G) {
            if (u < 128) sgemm_unit<2>(lds, XB + (size_t)u * 128 * D, W1 + (size_t)6144 * D, nullptr, D, Ep, u * 128, 192, wave, lane);
            else sgemm_unit<2>(lds, (const bf16*)(ws + WS_SXB), W1 + (size_t)(u - 128) * 32 * D, nullptr, D, Es, 0, u - 128, wave, lane);
        }
    }
    DBG_DIGEST(1, PROJ, (size_t)MP * PROJ_LD);
    STAMP(3);
    xcd_barrier(bar);
    STAMP(4);
    dn_prep(a, gw, ngw, lane);
    DBG_DIGEST(2, ws + WS_QKVC, (size_t)MP * 4096);
    STAMP(5);
    xcd_barrier(bar);
    STAMP(6);
    if (vcu < NB * NH) dn_prompt(a, lds, vcu / NH, vcu % NH, tid, wave, lane);
    else {
        const int nt = G - NB * NH, ti = vcu - NB * NH;
        unsigned* tcnt = ctl + CW_TEAM; unsigned ep = 0;
        float* SX = (float*)(ws + WS_SX); bf16* SXB = (bf16*)(ws + WS_SXB); float* SSS = (float*)(ws + WS_SSS);
        bf16* SGATED = (bf16*)(ws + WS_SGATED); bf16* SH = (bf16*)(ws + WS_SH); bf16* SYB = (bf16*)(ws + WS_SYB);
#define TEAM_BAR() team_barrier(tcnt, (unsigned)nt * (++ep))
        dn_sample_all(a, lds, ti, nt, tid, wave, lane);
        STAMP(20);
        TEAM_BAR();
        STAMP(21);
        { const SEpiRes<false> E{a.in[1], SX, SXB, SSS};
          for (int u = ti; u < D / 32; u += nt) sgemm_unit<2>(lds, SGATED, W2 + (size_t)u * 32 * VAL, nullptr, VAL, E, 0, u, wave, lane); }
        STAMPV(22);
        TEAM_BAR();
        STAMPV(23);
        for (int l = 0; l < 2; ++l) {
            { const SEpiSwiglu E{SH, SSS, 32};
              for (int u = ti; u < FFN / 32; u += nt) { const bf16* bg = W3 + (size_t)l * 2 * FFN * D + (size_t)((u >> 2) * 256 + (u & 3) * 32) * D;
                  sgemm_unit<4>(lds, SXB, bg, bg + (size_t)128 * D, D, E, 0, u, wave, lane); } }
            STAMPV(24);
            TEAM_BAR();
            STAMPV(25);
            { const SEpiRes<false> E{SX, l == 0 ? SX : a.out + O_YS, SXB, SSS};
              for (int u = ti; u < D / 32; u += nt) sgemm_unit<2>(lds, SH, W4 + (size_t)l * D * FFN + (size_t)u * 32 * FFN, nullptr, FFN, E, 0, u, wave, lane); }
            STAMPV(26);
            TEAM_BAR();
            STAMPV(27);
            if (l == 0) {
                const ldsp wl = lds + wave * 12800;
                for (int j = ti * NWAVES + wave; j < 512; j += nt * NWAVES) s5_wave(a, wl, true, 0, (j & 7) * 16, j >> 3, lane);
                STAMPV(28);
                TEAM_BAR();
                STAMPV(29);
                { const SEpiRes<true> E{SX, SX, SXB, SSS};
                  for (int u = ti; u < D / 32; u += nt) { const bf16* bv = W5 + (size_t)((u >> 2) * 256 + (u & 3) * 32) * D;
                      sgemm_unit<4>(lds, SYB, bv, bv + (size_t)128 * D, D, E, 0, u, wave, lane); } }
                STAMPV(30);
                TEAM_BAR();
                STAMPV(31);
            }
        }
        for (int m = ti * NWAVES + wave; m < MS; m += nt * NWAVES) {
            f32x4* xr = (f32x4*)(a.out + O_YS + (size_t)m * D) + lane;
            const float rs = pg8::row_rstd(SSS, m, 32);
#pragma unroll
            for (int j = 0; j < 4; ++j) { const f32x4 gn = *((const f32x4*)a.in[8] + lane + 64 * j); xr[64 * j] = xr[64 * j] * rs * gn; }
        }
#undef TEAM_BAR
    }
    DBG_DIGEST(3, GATED, (size_t)MP * VAL);
    STAMP(7);
    xcd_barrier(bar);
    STAMP(8);
    { pg8::EpiRes<false, 0> E{a.in[0], nullptr, (pg8::bf16_t*)XB, SS};
      GEMM_PHASE(SINGLE_ARG(pg8::EpiRes<false, 0>), GATED, W2, D, VAL, E); }
#if REPG == 2
    xcd_barrier(bar);
    { pg8::EpiRes<false, 0> E{a.in[0], nullptr, (pg8::bf16_t*)XB, SS};
      GEMM_PHASE(SINGLE_ARG(pg8::EpiRes<false, 0>), GATED, W2, D, VAL, E); }
#endif
    xcd_barrier(bar);
    { pg8::EpiSwiglu E{(pg8::bf16_t*)HB, FFN, SS, 16};
      GEMM_PHASE(pg8::EpiSwiglu, XB, W3, 2 * FFN, D, E); }
#if REPG == 3
    xcd_barrier(bar);
    { pg8::EpiSwiglu E{(pg8::bf16_t*)HB, FFN, SS, 16};
      GEMM_PHASE(pg8::EpiSwiglu, XB, W3, 2 * FFN, D, E); }
#endif
    xcd_barrier(bar);
    { pg8::EpiRes<false, 1> E{nullptr, nullptr, (pg8::bf16_t*)XB, SS};
      GEMM_PHASE(SINGLE_ARG(pg8::EpiRes<false, 1>), HB, W4, D, FFN, E); }
    xcd_barrier(bar);
    {
        const ldsp wl = lds + wave * 12800;
        STAMP(9);
        if (wave < 2) for (int it = vcu * 2 + wave; it < 512; it += G * 2) s5_wave(a, wl, false, it / 64, 0, it % 64, lane);
        STAMP(10);
    }
    xcd_barrier(bar);
    STAMP(11);
    { pg8::EpiRes<true, 1> E{nullptr, nullptr, (pg8::bf16_t*)XB, SS};
      GEMM_PHASE(SINGLE_ARG(pg8::EpiRes<true, 1>), YB, W5, 2 * D, D, E); }
    xcd_barrier(bar);
    { pg8::EpiSwiglu E{(pg8::bf16_t*)HB, FFN, SS, 32};
      GEMM_PHASE(pg8::EpiSwiglu, XB, W3 + (size_t)2 * FFN * D, 2 * FFN, D, E); }
    xcd_barrier(bar);
    { pg8::EpiRes<false, 2> E{nullptr, a.out + O_YP, (pg8::bf16_t*)XB, SS};
      GEMM_PHASE(SINGLE_ARG(pg8::EpiRes<false, 2>), HB, W4 + (size_t)D * FFN, D, FFN, E); }
    xcd_barrier(bar);
    for (int m = gw; m < MP; m += ngw) {
        f32x4* xr = (f32x4*)(a.out + O_YP + (size_t)m * D) + lane;
        const float rs = pg8::row_rstd(SS, m, 16);
#pragma unroll
        for (int j = 0; j < 4; ++j) { const f32x4 gn = *((const f32x4*)a.in[8] + lane + 64 * j); xr[64 * j] = xr[64 * j] * rs * gn; }
    }
    STAMP(12);
#if TPROBE
    xcd_barrier(bar);
    if (vcu == TP_BLK && tid == 0) { const unsigned long long t0_ = __builtin_amdgcn_s_memrealtime(), dt_ = tp_e - tp_s; while (__builtin_amdgcn_s_memrealtime() - t0_ < dt_) __builtin_amdgcn_s_sleep(8); }
#endif
#undef GEMM_PHASE
}

extern "C" void kernel_launch(void* const* d_in, const int* in_sizes, int n_in, void* d_out, int out_size, void* d_ws, size_t ws_size, hipStream_t stream) {
    static int grid = 0;
    if (grid == 0) {
        if (n_in != 26 || (size_t)out_size != O_END || ws_size < WS_END) { fprintf(stderr, "kernel_launch: unexpected shapes: n_in %d out %d ws %zu (need %zu)\n", n_in, out_size, ws_size, (size_t)WS_END); grid = -1; return; }
        int dev = 0, cus = 0, per_cu = 0;
        if (hipGetDevice(&dev) != hipSuccess || hipDeviceGetAttribute(&cus, hipDeviceAttributeMultiprocessorCount, dev) != hipSuccess) { grid = -1; return; }
        if (hipFuncSetAttribute((const void*)hybrid_fwd, hipFuncAttributeMaxDynamicSharedMemorySize, LDS_BYTES) != hipSuccess) { fprintf(stderr, "kernel_launch: hipFuncSetAttribute failed\n"); grid = -1; return; }
        if (hipOccupancyMaxActiveBlocksPerMultiprocessor(&per_cu, (const void*)hybrid_fwd, NTHREADS, LDS_BYTES) != hipSuccess || per_cu < 1) { fprintf(stderr, "kernel_launch: occupancy query says %d\n", per_cu); (void)hipGetLastError(); per_cu = 1; }
        grid = cus;
    }
    if (grid < 0) return;
    (void)hipMemsetAsync((char*)d_ws + WS_CTL, 0, CTL_ZERO_BYTES, stream);
    Args a{};
    for (int i = 0; i < 26; ++i) a.in[i] = (const float*)d_in[i];
    a.out = (float*)d_out; a.ws = (unsigned char*)d_ws;
    hipLaunchKernelGGL(hybrid_fwd, dim3(grid), dim3(NTHREADS), LDS_BYTES, stream, a);
}
```

```cpp
#define DBG_STOP 0
#define REP_DN 1
#define REP_S5 1
#define REP_P0 1
#define REPG 0
#define TPROBE 0
#define DNP_S 0
#define DNP_E 0
#define RPA 1
#define RPB 1
#define RPE 1
#define RPF 1
#define RPO 1
#include <hip/hip_runtime.h>
#include <cstdio>
#include <cstdint>
namespace pg8 {
#define PG8_LAS __attribute__((address_space(3)))
typedef unsigned short bf16_t;
typedef short bf16x8 __attribute__((ext_vector_type(8)));
typedef float f32x4 __attribute__((ext_vector_type(4)));
typedef unsigned u32x4 __attribute__((ext_vector_type(4)));
constexpr int BM = 256, BK = 64, HALF = 128, HTB = HALF * BK * 2  , STAGE_BYTES = 8 * HTB, NXCD = 8, WGM = 8;

__host__ __device__ __forceinline__ int lds_byte(int r, int c) { const int st = (r >> 4) * 2 + (c >> 5), rr = r & 15, cc = c & 31, ob = rr * 64 + cc * 2; return st * 1024 + (ob ^ (((ob >> 9) & 1) << 5)); }
__host__ __device__ __forceinline__ void stage_rc(int b, int& R, int& C) { const int st = b / 1024, sb = b % 1024, swz = sb ^ (((sb >> 9) & 1) << 5); R = (st >> 1) * 16 + swz / 64; C = (st & 1) * 32 + (swz % 64) / 2; }
__host__ __device__ __forceinline__ int perm32(int rho) { const int n = rho >> 4, i = rho & 15; return 8 * (i >> 2) + 4 * n + (i & 3); }

struct Unit { int pm, pn; };
struct Gemm { const bf16_t* A; const bf16_t* Bt; int M, N, K; };

struct StaticOrder {
    int nM, nN, nwg, G, c;
    __host__ __device__ void init(int M, int N, int G_, int c_) { nM = M / BM; nN = N / BM; nwg = nM * nN; G = G_; c = c_; }
    __host__ __device__ bool next(int i, Unit& u) const {
        const long L = (long)i * G + c; if (L >= nwg) return false;
        int wgid = (int)L; { const int q = nwg / NXCD, r = nwg % NXCD, xcd = wgid % NXCD, off = wgid / NXCD; wgid = (xcd < r ? xcd * (q + 1) : r * (q + 1) + (xcd - r) * q) + off; }
        const int nig = WGM * nN, gid = wgid / nig, fm = gid * WGM, gsz = (nM - fm) < WGM ? (nM - fm) : WGM;
        u.pm = fm + ((wgid % nig) % gsz); u.pn = (wgid % nig) / gsz; return true;
    }
    __device__ __forceinline__ void a_ready(const Unit&) const {}
    __device__ __forceinline__ void done(const Unit&) const {}
};
typedef float f32x2c __attribute__((ext_vector_type(2))); typedef __bf16 bf16x2c __attribute__((ext_vector_type(2)));
__device__ __forceinline__ unsigned cvt_pk_bf16(float lo, float hi) { const f32x2c v = {lo, hi}; return __builtin_bit_cast(unsigned, __builtin_convertvector(v, bf16x2c)); }
typedef unsigned u32x2 __attribute__((ext_vector_type(2)));
constexpr int SS_LD = 32;
constexpr float RMS_EPS = 1e-6f;
__device__ __forceinline__ float silu_f(float x) { return x * __builtin_amdgcn_rcpf(1.0f + __expf(-x)); }
__device__ __forceinline__ float sigmoid_f(float x) { return __builtin_amdgcn_rcpf(1.0f + __expf(-x)); }
__device__ __forceinline__ float row_rstd(const float* ss, int row, int nparts) {
    const f32x4* p = (const f32x4*)(ss + (size_t)row * SS_LD); float s = 0.f;
    for (int i = 0; i < nparts / 4; ++i) { const f32x4 v = p[i]; s += (v[0] + v[1]) + (v[2] + v[3]); }
    return rsqrtf(s * (1.0f / 1024.0f) + RMS_EPS);
}
__device__ __forceinline__ void rows_rstd(const float* ss, int row0, int nparts, int fq, float (&rs)[2][4]) {
    f32x4 q[2][4];
#pragma unroll
    for (int ai = 0; ai < 2; ++ai)
#pragma unroll
        for (int m = 0; m < 4; ++m) { const float* p = ss + (size_t)(row0 + ai * HALF + m * 16) * SS_LD + 4 * fq; q[ai][m] = *(const f32x4*)p; if (nparts == 32) q[ai][m] += *(const f32x4*)(p + 16); }
#pragma unroll
    for (int ai = 0; ai < 2; ++ai)
#pragma unroll
        for (int m = 0; m < 4; ++m) { float s = (q[ai][m][0] + q[ai][m][1]) + (q[ai][m][2] + q[ai][m][3]); s += __shfl_xor(s, 16); s += __shfl_xor(s, 32); rs[ai][m] = rsqrtf(s * (1.0f / 1024.0f) + RMS_EPS); }
}
struct EpiProj {
    static constexpr bool PERM = true, AFTER_DRAIN = false;
    bf16_t* O; const float* ss; int nparts;
    __device__ __forceinline__ void operator()(const f32x4 (&acc)[2][2][4][2], const Unit& u, int wr, int wc, int fr, int fq) const {
        const int row0 = u.pm * BM + wr * 64 + fr;
        float rs[2][4]; rows_rstd(ss, row0, nparts, fq, rs);
        {
            const int col0 = u.pn * BM + wc * 32 + 8 * fq; const bool act = u.pn >= 16;
#pragma unroll
            for (int ai = 0; ai < 2; ++ai)
#pragma unroll
                for (int m = 0; m < 4; ++m) { const int row = row0 + ai * HALF + m * 16; bf16_t* rowp = O + (size_t)row * 6144 + col0; const float r = rs[ai][m];
#pragma unroll
                    for (int bj = 0; bj < 2; ++bj) { f32x4 v0 = acc[ai][bj][m][0] * r, v1 = acc[ai][bj][m][1] * r;
                        if (act) {
#pragma unroll
                            for (int j = 0; j < 4; ++j) { v0[j] = silu_f(v0[j]); v1[j] = silu_f(v1[j]); } }
                        u32x4 w; w.x = cvt_pk_bf16(v0[0], v0[1]); w.y = cvt_pk_bf16(v0[2], v0[3]); w.z = cvt_pk_bf16(v1[0], v1[1]); w.w = cvt_pk_bf16(v1[2], v1[3]);
                        *(u32x4*)(rowp + bj * HALF) = w; }
                    }
        }
    }
};
struct EpiSwiglu {
    static constexpr bool PERM = true, AFTER_DRAIN = false;
    bf16_t* O; int ldo; const float* ss; int nparts;
    __device__ __forceinline__ void operator()(const f32x4 (&acc)[2][2][4][2], const Unit& u, int wr, int wc, int fr, int fq) const {
        const int row0 = u.pm * BM + wr * 64 + fr, col0 = u.pn * HALF + wc * 32 + 8 * fq;
        float rs[2][4]; rows_rstd(ss, row0, nparts, fq, rs);
#pragma unroll
        for (int ai = 0; ai < 2; ++ai)
#pragma unroll
            for (int m = 0; m < 4; ++m) { const int row = row0 + ai * HALF + m * 16; const float r = rs[ai][m];
                f32x4 h0, h1;
#pragma unroll
                for (int j = 0; j < 4; ++j) { h0[j] = silu_f(acc[ai][0][m][0][j] * r) * (acc[ai][1][m][0][j] * r); h1[j] = silu_f(acc[ai][0][m][1][j] * r) * (acc[ai][1][m][1][j] * r); }
                u32x4 w; w.x = cvt_pk_bf16(h0[0], h0[1]); w.y = cvt_pk_bf16(h0[2], h0[3]); w.z = cvt_pk_bf16(h1[0], h1[1]); w.w = cvt_pk_bf16(h1[2], h1[3]);
                *(u32x4*)(O + (size_t)row * ldo + col0) = w; }
    }
};
template <bool GLU, int MODE> struct EpiRes {
    static constexpr bool PERM = true, AFTER_DRAIN = false;
    const float* base; float* out; bf16_t* XB; float* ss;
    __device__ __forceinline__ void operator()(const f32x4 (&acc)[2][2][4][2], const Unit& u, int wr, int wc, int fr, int fq) const {
        const int col0 = (GLU ? u.pn * HALF : u.pn * BM) + wc * 32 + 8 * fq;
#pragma unroll
        for (int ai = 0; ai < 2; ++ai) {
#pragma unroll
            for (int m = 0; m < 4; ++m) { const int row = u.pm * BM + ai * HALF + wr * 64 + m * 16 + fr;
                const size_t off = (size_t)row * 1024 + col0;
                float sq = 0.f;
#pragma unroll
                for (int bj = 0; bj < (GLU ? 1 : 2); ++bj) { const int c = bj * HALF; f32x4 v0, v1;
                    if (GLU) {
#pragma unroll
                        for (int j = 0; j < 4; ++j) { v0[j] = acc[ai][0][m][0][j] * sigmoid_f(acc[ai][1][m][0][j]); v1[j] = acc[ai][0][m][1][j] * sigmoid_f(acc[ai][1][m][1][j]); }
                    } else { v0 = acc[ai][bj][m][0]; v1 = acc[ai][bj][m][1]; }
                    f32x4 b0, b1;
                    if (MODE == 0) { b0 = *(const f32x4*)(base + off + c); b1 = *(const f32x4*)(base + off + c + 4); }
                    else { const u32x4 bw = *(const u32x4*)(XB + off + c);
                        b0 = (f32x4){__builtin_bit_cast(float, bw.x << 16), __builtin_bit_cast(float, bw.x & 0xffff0000u), __builtin_bit_cast(float, bw.y << 16), __builtin_bit_cast(float, bw.y & 0xffff0000u)};
                        b1 = (f32x4){__builtin_bit_cast(float, bw.z << 16), __builtin_bit_cast(float, bw.z & 0xffff0000u), __builtin_bit_cast(float, bw.w << 16), __builtin_bit_cast(float, bw.w & 0xffff0000u)}; }
                    const f32x4 o0 = b0 + v0, o1 = b1 + v1;
                    sq += ((o0[0] * o0[0] + o0[1] * o0[1]) + (o0[2] * o0[2] + o0[3] * o0[3])) + ((o1[0] * o1[0] + o1[1] * o1[1]) + (o1[2] * o1[2] + o1[3] * o1[3]));
                    if (MODE == 2) { *(f32x4*)(out + off + c) = o0; *(f32x4*)(out + off + c + 4) = o1; }
                    else { u32x4 w; w.x = cvt_pk_bf16(o0[0], o0[1]); w.y = cvt_pk_bf16(o0[2], o0[3]); w.z = cvt_pk_bf16(o1[0], o1[1]); w.w = cvt_pk_bf16(o1[2], o1[3]); *(u32x4*)(XB + off + c) = w; } }
                sq += __shfl_xor(sq, 16); sq += __shfl_xor(sq, 32);
                if (fq == 0) ss[(size_t)row * SS_LD + u.pn * 4 + wc] = sq; }
        }
    }
};

struct EpiFinal {
    static constexpr bool PERM = false, AFTER_DRAIN = true;
    const bf16_t* XB; float* out; const float* gfin; float* xbuf; unsigned* cnt;
    __device__ __forceinline__ void fused(f32x4 (&acc)[2][2][4][2], const Unit& u, int wr, int wc, int fr, int fq, PG8_LAS unsigned char* lds, int wid, int lane) const {
        PG8_LAS float* P = (PG8_LAS float*)lds;
        PG8_LAS float* S = (PG8_LAS float*)(lds + 8192);
        const int col0 = u.pn * BM + wc * 32 + 4 * fq;
#pragma unroll
        for (int ai = 0; ai < 2; ++ai)
#pragma unroll
            for (int m = 0; m < 4; ++m) { const int rl = ai * HALF + wr * 64 + m * 16 + fr; const size_t off = (size_t)(u.pm * BM + rl) * 1024 + col0; float sq = 0.f;
#pragma unroll
                for (int bj = 0; bj < 2; ++bj)
#pragma unroll
                    for (int n = 0; n < 2; ++n) { const u32x2 bw = *(const u32x2*)(XB + off + bj * HALF + n * 16);
                        const f32x4 b = (f32x4){__builtin_bit_cast(float, bw.x << 16), __builtin_bit_cast(float, bw.x & 0xffff0000u), __builtin_bit_cast(float, bw.y << 16), __builtin_bit_cast(float, bw.y & 0xffff0000u)};
                        const f32x4 o = b + acc[ai][bj][m][n]; acc[ai][bj][m][n] = o; sq += (o[0] * o[0] + o[1] * o[1]) + (o[2] * o[2] + o[3] * o[3]); }
                sq += __shfl_xor(sq, 16); sq += __shfl_xor(sq, 32);
                if (fq == 0) P[rl * 4 + wc] = sq; }
        asm volatile("s_waitcnt lgkmcnt(0)" ::: "memory"); __builtin_amdgcn_s_barrier(); asm volatile("" ::: "memory");
        const int row = wid * 32 + (lane & 31);
        if (lane < 32) { const float t = (P[row * 4 + 0] + P[row * 4 + 1]) + (P[row * 4 + 2] + P[row * 4 + 3]);
            __hip_atomic_store(xbuf + (size_t)(u.pm * BM + row) * 4 + u.pn, t, __ATOMIC_RELAXED, __HIP_MEMORY_SCOPE_AGENT); }
        asm volatile("s_waitcnt vmcnt(0)" ::: "memory");
        if (lane == 0) __hip_atomic_fetch_add(cnt + 64 * u.pm, 1u, __ATOMIC_RELAXED, __HIP_MEMORY_SCOPE_AGENT);
        if (wid == 0) {
            const unsigned long long t0 = __builtin_amdgcn_s_memrealtime();
            while ((unsigned)__builtin_amdgcn_readfirstlane(__hip_atomic_load(cnt + 64 * u.pm, __ATOMIC_RELAXED, __HIP_MEMORY_SCOPE_AGENT)) < 32u) {
                if (__builtin_amdgcn_s_memrealtime() - t0 > 2000000ull) break;
                __builtin_amdgcn_s_sleep(2); }
            __builtin_amdgcn_fence(__ATOMIC_ACQUIRE, "agent");
        }
        asm volatile("s_waitcnt vmcnt(0) lgkmcnt(0)" ::: "memory"); __builtin_amdgcn_s_barrier(); asm volatile("" ::: "memory");
        if (lane < 32) { const float* sl = xbuf + (size_t)(u.pm * BM + row) * 4; float t = 0.f;
#pragma unroll
            for (int k = 0; k < 4; ++k) t += __hip_atomic_load(sl + k, __ATOMIC_RELAXED, __HIP_MEMORY_SCOPE_AGENT);
            S[row] = rsqrtf(t * (1.0f / 1024.0f) + RMS_EPS); }
        asm volatile("s_waitcnt lgkmcnt(0)" ::: "memory"); __builtin_amdgcn_s_barrier(); asm volatile("" ::: "memory");
#pragma unroll
        for (int ai = 0; ai < 2; ++ai)
#pragma unroll
            for (int m = 0; m < 4; ++m) { const int rl = ai * HALF + wr * 64 + m * 16 + fr; const float rs = S[rl]; const size_t off = (size_t)(u.pm * BM + rl) * 1024 + col0;
#pragma unroll
                for (int bj = 0; bj < 2; ++bj)
#pragma unroll
                    for (int n = 0; n < 2; ++n) { const int c = bj * HALF + n * 16; const f32x4 g = *(const f32x4*)(gfin + col0 + c); *(f32x4*)(out + off + c) = acc[ai][bj][m][n] * rs * g; } }
    }
};

template <class Epi, class Sched, bool ALIGN_EPI = false, bool SP2 = false>
__device__ __forceinline__ void gemm_phase(PG8_LAS unsigned char* lds, const Gemm g, const Sched& S, const Epi& E) {
    int tid_o = threadIdx.x; asm volatile("" : "+v"(tid_o));
    const int tid = tid_o, wid = __builtin_amdgcn_readfirstlane(tid >> 6), lane = tid & 63, wr = wid >> 2, wc = wid & 3, fr = lane & 15, fq = lane >> 4;
    const int K = g.K, nt = K / BK;
    unsigned voffA[2], voffB[2];
#pragma unroll
    for (int i = 0; i < 2; ++i) { int R, C; stage_rc(tid * 16 + i * 8192, R, C); const int Rb = Epi::PERM ? ((R & ~31) + perm32(R & 31)) : R;
        voffA[i] = (unsigned)(R * K + C) * 2u; voffB[i] = (unsigned)(Rb * K + C) * 2u; }
    const size_t kstep = (size_t)(BK * 2);
    const size_t hstep = (size_t)HALF * K * 2;
    const size_t tstep = 2 * hstep;
    const unsigned ldsw = (unsigned)wid * 1024u;
    const int aoff = lds_byte(wr * 64 + fr, fq * 8), boff = lds_byte(wc * 32 + fr, fq * 8);
#define PG8_SA(b, h) (((b) * 2 + (h)) * HTB)
#define PG8_SB(b, h) ((4 + (b) * 2 + (h)) * HTB)
#define PG8_STAGE(bufoff, gbase, voff) do { _Pragma("unroll") for (int _i = 0; _i < 2; ++_i) \
        __builtin_amdgcn_global_load_lds((const unsigned*)((const char*)(gbase) + (voff)[_i]), (PG8_LAS unsigned*)(lds + (bufoff) + ldsw + _i * 8192), 16, 0, 0); } while (0)
#define PG8_LDA(dst, b, h) do { _Pragma("unroll") for (int m = 0; m < 4; ++m) _Pragma("unroll") for (int k = 0; k < 2; ++k) dst[m][k] = *(const PG8_LAS bf16x8*)(lds + PG8_SA(b, h) + aoff + m * 2048 + k * 1024); } while (0)
#define PG8_LDB(dst, b, h) do { _Pragma("unroll") for (int n = 0; n < 2; ++n) _Pragma("unroll") for (int k = 0; k < 2; ++k) dst[n][k] = *(const PG8_LAS bf16x8*)(lds + PG8_SB(b, h) + boff + n * 2048 + k * 1024); } while (0)
#define PG8_MMA(ai, bj, At, Bt) do { __builtin_amdgcn_s_setprio(1); _Pragma("unroll") for (int m = 0; m < 4; ++m) _Pragma("unroll") for (int n = 0; n < 2; ++n) _Pragma("unroll") for (int k = 0; k < 2; ++k) \
        acc[ai][bj][m][n] = __builtin_amdgcn_mfma_f32_16x16x32_bf16(Bt[n][k], At[m][k], acc[ai][bj][m][n], 0, 0, 0); __builtin_amdgcn_s_setprio(0); } while (0)
#define PG8_WAIT_V(n) asm volatile("s_waitcnt vmcnt(" #n ")" ::: "memory")
#define PG8_WAIT_L(n) asm volatile("s_waitcnt lgkmcnt(" #n ")" ::: "memory")
#define PG8_BAR __builtin_amdgcn_s_barrier()
#define PG8_SCHED __builtin_amdgcn_sched_barrier(0)
    Unit cur, nxt; int ui = 0;
    if (!S.next(0, cur)) return;
    f32x4 acc[2][2][4][2];
#pragma unroll
    for (int a = 0; a < 2; ++a)
#pragma unroll
        for (int b = 0; b < 2; ++b)
#pragma unroll
            for (int m = 0; m < 4; ++m)
#pragma unroll
                for (int n = 0; n < 2; ++n) acc[a][b][m][n] = (f32x4){0.f, 0.f, 0.f, 0.f};
    bf16x8 At[4][2], B0[2][2], B1[2][2];
    const char* cA = (const char*)g.A + (size_t)cur.pm * tstep; const char* cB = (const char*)g.Bt + (size_t)cur.pn * tstep;
    S.a_ready(cur);
    if constexpr (SP2) {
        PG8_STAGE(PG8_SB(0, 0), cB, voffB); PG8_STAGE(PG8_SB(0, 1), cB + hstep, voffB); PG8_STAGE(PG8_SA(0, 0), cA, voffA); PG8_STAGE(PG8_SA(0, 1), cA + hstep, voffA);
        if (wr == 1) PG8_BAR;
        PG8_WAIT_V(2); PG8_BAR;
        PG8_STAGE(PG8_SB(1, 0), cB + kstep, voffB); PG8_STAGE(PG8_SA(1, 0), cA + kstep, voffA); PG8_STAGE(PG8_SB(1, 1), cB + hstep + kstep, voffB);
        PG8_WAIT_V(6); PG8_BAR;
    } else {
        PG8_STAGE(PG8_SB(0, 0), cB, voffB); PG8_STAGE(PG8_SA(0, 0), cA, voffA); PG8_STAGE(PG8_SB(0, 1), cB + hstep, voffB); PG8_STAGE(PG8_SA(0, 1), cA + hstep, voffA);
        if (wr == 1) PG8_BAR;
        PG8_WAIT_V(4); PG8_BAR;
        PG8_STAGE(PG8_SB(1, 0), cB + kstep, voffB); PG8_STAGE(PG8_SA(1, 0), cA + kstep, voffA); PG8_STAGE(PG8_SB(1, 1), cB + hstep + kstep, voffB);
        PG8_WAIT_V(6); PG8_BAR;
    }
    for (;;) {
        const bool has_next = S.next(ui + 1, nxt);
        const char* nA = has_next ? (const char*)g.A + (size_t)nxt.pm * tstep : cA; const char* nB = has_next ? (const char*)g.Bt + (size_t)nxt.pn * tstep : cB;
        for (int t = 0; t < nt; t += 2) {
            const bool last = (t == nt - 2);
            const char* a1 = cA + (size_t)(t + 1) * kstep;
            const char* a2 = last ? nA : cA + (size_t)(t + 2) * kstep; const char* b2 = last ? nB : cB + (size_t)(t + 2) * kstep;
            const char* a3 = a2 + kstep; const char* b3 = b2 + kstep;
            if (last && has_next) S.a_ready(nxt);
            if constexpr (SP2) {
            PG8_LDB(B0, 0, 0); PG8_LDB(B1, 0, 1); PG8_SCHED; PG8_LDA(At, 0, 0); PG8_STAGE(PG8_SA(1, 1), a1 + hstep, voffA);
            PG8_WAIT_V(8); PG8_WAIT_L(0); PG8_BAR; PG8_MMA(0, 0, At, B0); PG8_MMA(0, 1, At, B1); PG8_BAR; PG8_SCHED;
            PG8_LDA(At, 0, 1); PG8_STAGE(PG8_SB(0, 0), b2, voffB); PG8_STAGE(PG8_SB(0, 1), b2 + hstep, voffB); PG8_STAGE(PG8_SA(0, 0), a2, voffA);
            PG8_WAIT_V(8); PG8_WAIT_L(0); PG8_BAR; PG8_MMA(1, 0, At, B0); PG8_MMA(1, 1, At, B1); PG8_BAR; PG8_SCHED;
            PG8_LDB(B0, 1, 0); PG8_LDB(B1, 1, 1); PG8_SCHED; PG8_LDA(At, 1, 0); PG8_STAGE(PG8_SA(0, 1), a2 + hstep, voffA);
            PG8_WAIT_V(8); PG8_WAIT_L(0); PG8_BAR; PG8_MMA(0, 0, At, B0); PG8_MMA(0, 1, At, B1); PG8_BAR; PG8_SCHED;
            PG8_LDA(At, 1, 1); PG8_STAGE(PG8_SB(1, 0), b3, voffB); PG8_STAGE(PG8_SB(1, 1), b3 + hstep, voffB); PG8_STAGE(PG8_SA(1, 0), a3, voffA);
            PG8_WAIT_V(8); PG8_WAIT_L(0); PG8_BAR; PG8_MMA(1, 0, At, B0); PG8_MMA(1, 1, At, B1); PG8_BAR; PG8_SCHED;
            } else {
            PG8_LDB(B0, 0, 0); PG8_SCHED; PG8_LDA(At, 0, 0); PG8_STAGE(PG8_SA(1, 1), a1 + hstep, voffA);
            PG8_WAIT_L(8); PG8_BAR; PG8_WAIT_L(0); PG8_MMA(0, 0, At, B0); PG8_BAR; PG8_SCHED;
            PG8_LDB(B1, 0, 1); PG8_STAGE(PG8_SB(0, 0), b2, voffB);
            PG8_BAR; PG8_WAIT_L(0); PG8_MMA(0, 1, At, B1); PG8_BAR;
            PG8_LDA(At, 0, 1); PG8_STAGE(PG8_SA(0, 0), a2, voffA);
            PG8_BAR; PG8_WAIT_L(0); PG8_MMA(1, 0, At, B0); PG8_BAR; PG8_SCHED;
            PG8_STAGE(PG8_SB(0, 1), b2 + hstep, voffB);
            PG8_WAIT_V(6); PG8_BAR; PG8_MMA(1, 1, At, B1); PG8_BAR;
            PG8_LDB(B0, 1, 0); PG8_SCHED; PG8_LDA(At, 1, 0); PG8_STAGE(PG8_SA(0, 1), a2 + hstep, voffA);
            PG8_WAIT_L(8); PG8_BAR; PG8_WAIT_L(0); PG8_MMA(0, 0, At, B0); PG8_BAR; PG8_SCHED;
            PG8_LDB(B1, 1, 1); PG8_STAGE(PG8_SB(1, 0), b3, voffB);
            PG8_BAR; PG8_WAIT_L(0); PG8_MMA(0, 1, At, B1); PG8_BAR;
            PG8_LDA(At, 1, 1); PG8_STAGE(PG8_SA(1, 0), a3, voffA);
            PG8_BAR; PG8_WAIT_L(0); PG8_MMA(1, 0, At, B0); PG8_BAR; PG8_SCHED;
            PG8_STAGE(PG8_SB(1, 1), b3 + hstep, voffB);
            PG8_WAIT_V(6); PG8_BAR; PG8_MMA(1, 1, At, B1); PG8_BAR;
            }
        }
        if constexpr (ALIGN_EPI) { if (wr == 0) PG8_BAR; }
        if constexpr (!Epi::AFTER_DRAIN) { E(acc, cur, wr, wc, fr, fq); S.done(cur); }
        if (!has_next) break;
#pragma unroll
        for (int a = 0; a < 2; ++a)
#pragma unroll
            for (int b = 0; b < 2; ++b)
#pragma unroll
                for (int m = 0; m < 4; ++m)
#pragma unroll
                    for (int n = 0; n < 2; ++n) acc[a][b][m][n] = (f32x4){0.f, 0.f, 0.f, 0.f};
        cur = nxt; cA = nA; cB = nB; ++ui;
        if constexpr (ALIGN_EPI) { if (wr == 1) PG8_BAR; }
    }
    PG8_WAIT_V(0);
    if constexpr (!ALIGN_EPI) { if (wr == 0) PG8_BAR; }
    PG8_BAR;
    if constexpr (Epi::AFTER_DRAIN) { E.fused(acc, cur, wr, wc, fr, fq, lds, wid, lane); S.done(cur); }
#undef PG8_SA
#undef PG8_SB
#undef PG8_STAGE
#undef PG8_LDA
#undef PG8_LDB
#undef PG8_MMA
#undef PG8_WAIT_V
#undef PG8_WAIT_L
#undef PG8_BAR
#undef PG8_SCHED
}
}
constexpr int NWAVES = 8, NTHREADS = 512;
constexpr int D = 1024, SEQ = 2048, NB = 8, MP = NB * SEQ  , MS = 128  ;
constexpr int DN_IN = 6176, PROJ_LD = 6144, VAL = 2048, FFN = 2816, NH = 16, CHUNK = 64, NCHUNK = SEQ / CHUNK;
constexpr size_t MiB = 1u << 20;
constexpr size_t WS_CTL = 0, CTL_ZERO_BYTES = 64 * 1024;
constexpr size_t WS_W1 = 1 * MiB;
constexpr size_t WS_W2 = WS_W1 + (size_t)6400 * D * 2;
constexpr size_t WS_W5 = WS_W2 + (size_t)D * VAL * 2;
constexpr size_t WS_W3 = WS_W5 + (size_t)2 * D * D * 2;
constexpr size_t WS_W4 = WS_W3 + (size_t)2 * 2 * FFN * D * 2;
constexpr size_t WS_SS = WS_W4 + (size_t)2 * D * FFN * 2;
constexpr size_t WS_BETA = WS_SS + (size_t)MP * 32 * 4;
constexpr size_t WS_GDEC = WS_BETA + (size_t)MP * 16 * 4;
constexpr size_t WS_SSS = WS_GDEC + (size_t)MP * 16 * 4;
constexpr size_t WS_SBETA = WS_SSS + (size_t)MS * 32 * 4;
constexpr size_t WS_SGDEC = WS_SBETA + (size_t)MS * 16 * 4;
constexpr size_t WS_SXB = WS_SGDEC + (size_t)MS * 16 * 4;
constexpr size_t WS_SX = WS_SXB + (size_t)MS * D * 2;
constexpr size_t WS_SPROJ = WS_SX + (size_t)MS * D * 4;
constexpr size_t WS_SGATED = WS_SPROJ + (size_t)MS * PROJ_LD * 2;
constexpr size_t WS_SH = WS_SGATED + (size_t)MS * VAL * 2;
constexpr size_t WS_SYB = WS_SH + (size_t)MS * FFN * 2;
constexpr size_t WS_S5LAM = WS_SYB + (size_t)MS * D * 2;
constexpr size_t WS_S5BB = WS_S5LAM + 64 * 64 * 2 * 4;
constexpr size_t WS_S5CM = WS_S5BB + 64 * 128 * 16 * 2;
constexpr size_t WS_S5DSK = WS_S5CM + 64 * 16 * 128 * 2;
constexpr size_t WS_GC = WS_S5DSK + 1024 * 4;
constexpr size_t WS_BT = WS_GC + (size_t)MP * 16 * 4;
constexpr size_t WS_FX = WS_BT + (size_t)MP * 16 * 4;
constexpr size_t WS_XB = (WS_FX + (size_t)MP * 4 * 4 + 4095) / 4096 * 4096;
constexpr size_t WS_X = WS_XB + (size_t)MP * D * 2;
constexpr size_t WS_YB = WS_X + (size_t)MP * D * 4;
constexpr size_t WS_GATED = WS_YB + (size_t)MP * D * 2;
constexpr size_t WS_QKVC = WS_XB;
static_assert(WS_QKVC + (size_t)MP * 4096 * 2 <= WS_GATED, "QKVC overlay");
constexpr size_t WS_PROJ = WS_GATED + (size_t)MP * VAL * 2;
constexpr size_t WS_H = WS_PROJ;
constexpr size_t WS_END = WS_PROJ + (size_t)MP * PROJ_LD * 2;
constexpr int CW_BAR = 4096, CW_TEAM = 8192, CW_FIN = 8192 + 64;
constexpr size_t O_YP = 0, O_YS = O_YP + (size_t)MP * D, O_SSMP = O_YS + (size_t)MS * D, O_CONVP = O_SSMP + (size_t)NB * NH * 128 * 128, O_S5RP = O_CONVP + (size_t)NB * 3 * 4096,
                 O_S5IP = O_S5RP + (size_t)NB * 64 * 64, O_SSMS = O_S5IP + (size_t)NB * 64 * 64, O_CONVS = O_SSMS + (size_t)MS * NH * 128 * 128, O_S5RS = O_CONVS + (size_t)MS * 3 * 4096,
                 O_S5IS = O_S5RS + (size_t)MS * 64 * 64, O_END = O_S5IS + (size_t)MS * 64 * 64;
constexpr int LDS_BYTES = 163840, LDSCTL_OFF = LDS_BYTES - 256;

#define GAS __attribute__((address_space(1)))
#define LAS __attribute__((address_space(3)))
typedef unsigned short bf16;
typedef float f32x4 __attribute__((ext_vector_type(4)));
typedef float f32x2 __attribute__((ext_vector_type(2)));
typedef short bf16x8 __attribute__((ext_vector_type(8)));
typedef unsigned u32x4 __attribute__((ext_vector_type(4)));
typedef unsigned u32x2 __attribute__((ext_vector_type(2)));
typedef LAS unsigned char* ldsp;
__device__ __forceinline__ unsigned pkbf(float lo, float hi) { return pg8::cvt_pk_bf16(lo, hi); }
__device__ __forceinline__ float bflo(unsigned w) { return __builtin_bit_cast(float, w << 16); }
__device__ __forceinline__ float bfhi(unsigned w) { return __builtin_bit_cast(float, w & 0xffff0000u); }
__device__ __forceinline__ float bf1(bf16 h) { return __builtin_bit_cast(float, (unsigned)h << 16); }
__device__ __forceinline__ float wave_sum(float v) {
#pragma unroll
    for (int o = 1; o < 64; o <<= 1) v += __shfl_xor(v, o);
    return v;
}
#define MFMA16(a, b, c) __builtin_amdgcn_mfma_f32_16x16x32_bf16((a), (b), (c), 0, 0, 0)
#define MM_XROW(acc, xf, yf) (acc) = MFMA16((yf), (xf), (acc))
#define MM_YROW(acc, xf, yf) (acc) = MFMA16((xf), (yf), (acc))
#define LDS_FENCE() asm volatile("s_waitcnt lgkmcnt(0)" ::: "memory")

struct Args {
    const float* in[26]; float* out; unsigned char* ws; int pad0, pad1;
};
constexpr float RMS_EPSF = 1e-6f;
#define XB_TMO      128
#define XB_XCNT(j)  (256  + 64 * (j))
#define XB_XSUB(j)  (1280 + 64 * (j))
#define XB_XGEN(j)  (2304 + 64 * (j))
#define XB_TOP      3328
#define XB_TOPGEN   3392
#define XCD_BAR_WORDS 3456
#define XB_SPIN_CAP (1u << 18)

__device__ __forceinline__ unsigned xb_ld(unsigned* p)              { return __hip_atomic_load(p, __ATOMIC_RELAXED, __HIP_MEMORY_SCOPE_AGENT); }
__device__ __forceinline__ unsigned xb_add(unsigned* p, unsigned v) { return __hip_atomic_fetch_add(p, v, __ATOMIC_RELAXED, __HIP_MEMORY_SCOPE_AGENT); }
__device__ __forceinline__ unsigned xb_xcc_id() { return (unsigned)__builtin_amdgcn_s_getreg((3 << 11) | 20) & 0xFu; }
#define XB_SPIN(cond, bar) do { unsigned _sp = 0; while (cond) { __builtin_amdgcn_s_sleep(1); \
    if ((++_sp & 255u) == 0u) { if (xb_ld(&(bar)[XB_TMO])) break; if (_sp > XB_SPIN_CAP) { atomicAdd(&(bar)[XB_TMO], 1u); break; } } } } while (0)

struct XcdBarrier {
    unsigned* bar; unsigned x;
    volatile LAS unsigned* st;
};

__device__ __forceinline__ XcdBarrier xcd_barrier_post(unsigned* bar, volatile LAS unsigned* st) {
    XcdBarrier b; b.bar = bar; b.x = xb_xcc_id(); b.st = st;
    if (threadIdx.x == 0) (void)xb_add(&bar[XB_XCNT(b.x)], 1u);
    return b;
}
__device__ __forceinline__ void xcd_barrier_complete(unsigned* bar, unsigned x, unsigned& nloc, unsigned& nx) {
    const unsigned G = gridDim.x * gridDim.y * gridDim.z;
    unsigned sum, cnt, mine, sp = 0u;
    for (;;) {
        sum = 0u; cnt = 0u; mine = 0u;
#pragma unroll
        for (unsigned j = 0; j < 16; ++j) { const unsigned c = xb_ld(&bar[XB_XCNT(j)]); sum += c; cnt += (c > 0u) ? 1u : 0u; mine = (j == x) ? c : mine; }
        if (sum == G) break;
        __builtin_amdgcn_s_sleep(1);
        if ((++sp & 255u) == 0u) { if (xb_ld(&bar[XB_TMO])) break; if (sp > XB_SPIN_CAP) { atomicAdd(&bar[XB_TMO], 1u); break; } }
    }
    nloc = mine > 0u ? mine : 1u; nx = cnt > 0u ? cnt : 1u;
}

__device__ __forceinline__ void xcd_barrier(const XcdBarrier& b) {
    asm volatile("s_waitcnt vmcnt(0)" ::: "memory");
    __syncthreads();
    if (threadIdx.x == 0) {
        unsigned* bar = b.bar;
        __builtin_amdgcn_s_waitcnt(0);
        unsigned nloc = b.st[0], nx = b.st[1];
        if (nloc == 0u) { xcd_barrier_complete(bar, b.x, nloc, nx); b.st[0] = nloc; b.st[1] = nx; }
        const unsigned old = xb_add(&bar[XB_XSUB(b.x)], 1u);
        const unsigned gen = old / nloc;
        if (old + 1u == (gen + 1u) * nloc) {
            __builtin_amdgcn_fence(__ATOMIC_RELEASE, "agent");
            asm volatile("s_waitcnt vmcnt(0)" ::: "memory");
            const unsigned og = xb_add(&bar[XB_TOP], 1u);
            const unsigned tg = og / nx;
            if (og + 1u == (tg + 1u) * nx) xb_add(&bar[XB_TOPGEN], 1u);
            else XB_SPIN(xb_ld(&bar[XB_TOPGEN]) == tg, bar);
            __builtin_amdgcn_fence(__ATOMIC_ACQUIRE, "agent");
            xb_add(&bar[XB_XGEN(b.x)], 1u);
            asm volatile("s_waitcnt vmcnt(0)" ::: "memory");
        } else {
            XB_SPIN(xb_ld(&bar[XB_XGEN(b.x)]) == gen, bar);
            __builtin_amdgcn_fence(__ATOMIC_ACQUIRE, "agent");
            asm volatile("s_waitcnt vmcnt(0)" ::: "memory");
        }
    }
    __syncthreads();
}
__device__ __forceinline__ void sg_core(const bf16* ap, const bf16* bp, int K, int steps, f32x4 (&acc)[4][2]) {
    bf16x8 ra[4][4], rb[4][2];
    const bf16* pa[4]; const bf16* pb[2];
#pragma unroll
    for (int t = 0; t < 4; ++t) pa[t] = ap + (size_t)t * 16 * K;
    pb[0] = bp; pb[1] = bp + (size_t)16 * K;
#define SG_LOAD(slot, s) do { const int ko_ = 32 * (s); _Pragma("unroll") for (int t_ = 0; t_ < 4; ++t_) ra[slot][t_] = *(const bf16x8*)(pa[t_] + ko_); \
        rb[slot][0] = *(const bf16x8*)(pb[0] + ko_); rb[slot][1] = *(const bf16x8*)(pb[1] + ko_); } while (0)
#define SG_COMP(slot) do { _Pragma("unroll") for (int t_ = 0; t_ < 4; ++t_) { MM_XROW(acc[t_][0], ra[slot][t_], rb[slot][0]); MM_XROW(acc[t_][1], ra[slot][t_], rb[slot][1]); } } while (0)
    SG_LOAD(0, 0); SG_LOAD(1, 1); SG_LOAD(2, 2);
    int s = 0;
#pragma nounroll
    for (; s + 4 <= steps; s += 4) {
        SG_LOAD(3, s + 3);
        SG_COMP(0); if (s + 4 < steps) SG_LOAD(0, s + 4);
        SG_COMP(1); if (s + 5 < steps) SG_LOAD(1, s + 5);
        SG_COMP(2); if (s + 6 < steps) SG_LOAD(2, s + 6);
        SG_COMP(3);
    }
    const int r = steps - s;
    if (r >= 1) SG_COMP(0);
    if (r >= 2) SG_COMP(1);
    if (r >= 3) SG_COMP(2);
#undef SG_LOAD
#undef SG_COMP
}
template <int NBLK, class Epi>
__device__ __forceinline__ void sgemm_unit(ldsp lds, const bf16* A, const bf16* B0, const bf16* B1, int K, const Epi& E, int row0, int cb, int wave, int lane) {
    const int fr = lane & 15, fq = lane >> 4, rh = wave & 1, kq = wave >> 1; int steps = K / 128; asm volatile("" : "+s"(steps));
    int fro = fr; asm volatile("" : "+v"(fro));
    const bf16* ap = A + (size_t)(64 * rh + fro) * K + (size_t)kq * (K / 4) + 8 * fq;
    LAS f32x4* buf = (LAS f32x4*)lds;
#pragma unroll
    for (int pass = 0; pass < NBLK / 2; ++pass) {
        f32x4 acc[4][2];
#pragma unroll
        for (int t = 0; t < 4; ++t) { acc[t][0] = (f32x4){0.f, 0.f, 0.f, 0.f}; acc[t][1] = (f32x4){0.f, 0.f, 0.f, 0.f}; }
        sg_core(ap, (pass ? B1 : B0) + (size_t)fro * K + (size_t)kq * (K / 4) + 8 * fq, K, steps, acc);
#pragma unroll
        for (int t = 0; t < 4; ++t) { buf[(kq * 32 + (rh * 4 + t) * 4 + 2 * pass) * 64 + lane] = acc[t][0]; buf[(kq * 32 + (rh * 4 + t) * 4 + 2 * pass + 1) * 64 + lane] = acc[t][1]; }
    }
    __syncthreads();
    {
        const int rt = wave >> 1;
        f32x4 o[NBLK];
#pragma unroll
        for (int j = 0; j < NBLK; ++j) { const int slot = (rh * 4 + rt) * 4 + j; o[j] = (buf[slot * 64 + lane] + buf[(32 + slot) * 64 + lane]) + (buf[(64 + slot) * 64 + lane] + buf[(96 + slot) * 64 + lane]); }
        E(o, row0 + 64 * rh + 16 * rt + fr, cb, fq);
    }
    __syncthreads();
}
struct SEpiProj {
    bf16* O; const float* ss; int nparts; float* beta; float* gdec; const float* a_log; const float* dt_bias;
    __device__ __forceinline__ void operator()(const f32x4 (&acc)[2], int row, int cb, int fq) const {
        const float rs = pg8::row_rstd(ss, row, nparts);
        if (cb < 192) {
#pragma unroll
            for (int j = 0; j < 2; ++j) { f32x4 v = acc[j] * rs;
                if (cb >= 128) {
#pragma unroll
                    for (int r = 0; r < 4; ++r) v[r] = pg8::silu_f(v[r]); }
                u32x2 w; w.x = pkbf(v[0], v[1]); w.y = pkbf(v[2], v[3]); *(u32x2*)(O + (size_t)row * PROJ_LD + 32 * cb + 16 * j + 4 * fq) = w; }
        } else {
            f32x4 b, g;
#pragma unroll
            for (int r = 0; r < 4; ++r) { b[r] = pg8::sigmoid_f(acc[0][r] * rs); const int h = 4 * fq + r; const float xx = acc[1][r] * rs + dt_bias[h]; const float ex = __expf(xx);
                const float sp = xx > 15.f ? xx : (ex < 1e-3f ? ex * (1.0f - 0.5f * ex) : __logf(1.0f + ex)); g[r] = -__expf(a_log[h]) * sp; }
            *(f32x4*)(beta + (size_t)row * 16 + 4 * fq) = b; *(f32x4*)(gdec + (size_t)row * 16 + 4 * fq) = g;
        }
    }
};
template <bool GLU> struct SEpiRes {
    const float* base; float* out; bf16* XB; float* ss;
    __device__ __forceinline__ void operator()(const f32x4 (&acc)[GLU ? 4 : 2], int row, int cb, int fq) const {
        float sq = 0.f;
#pragma unroll
        for (int j = 0; j < 2; ++j) { f32x4 v = acc[j];
            if (GLU) {
#pragma unroll
                for (int r = 0; r < 4; ++r) v[r] = v[r] * pg8::sigmoid_f(acc[2 + j][r]); }
            const size_t off = (size_t)row * D + 32 * cb + 16 * j + 4 * fq;
            const f32x4 o = *(const f32x4*)(base + off) + v; *(f32x4*)(out + off) = o;
            sq += (o[0] * o[0] + o[1] * o[1]) + (o[2] * o[2] + o[3] * o[3]);
            u32x2 w; w.x = pkbf(o[0], o[1]); w.y = pkbf(o[2], o[3]); *(u32x2*)(XB + off) = w; }
        sq += __shfl_xor(sq, 16); sq += __shfl_xor(sq, 32);
        if (fq == 0) ss[(size_t)row * 32 + cb] = sq;
    }
};
struct SEpiSwiglu {
    bf16* H; const float* ss; int nparts;
    __device__ __forceinline__ void operator()(const f32x4 (&acc)[4], int row, int cb, int fq) const {
        const float rs = pg8::row_rstd(ss, row, nparts);
#pragma unroll
        for (int j = 0; j < 2; ++j) { f32x4 h;
#pragma unroll
            for (int r = 0; r < 4; ++r) h[r] = pg8::silu_f(acc[j][r] * rs) * (acc[2 + j][r] * rs);
            u32x2 w; w.x = pkbf(h[0], h[1]); w.y = pkbf(h[2], h[3]); *(u32x2*)(H + (size_t)row * FFN + 32 * cb + 16 * j + 4 * fq) = w; }
    }
};
__device__ __forceinline__ void team_barrier(unsigned* cnt, unsigned target) {
    asm volatile("s_waitcnt vmcnt(0)" ::: "memory");
    __syncthreads();
    if (threadIdx.x == 0) {
        __builtin_amdgcn_fence(__ATOMIC_RELEASE, "agent");
        asm volatile("s_waitcnt vmcnt(0)" ::: "memory");
        (void)__hip_atomic_fetch_add(cnt, 1u, __ATOMIC_RELAXED, __HIP_MEMORY_SCOPE_AGENT);
        unsigned sp = 0;
        while (__hip_atomic_load(cnt, __ATOMIC_RELAXED, __HIP_MEMORY_SCOPE_AGENT) < target) { __builtin_amdgcn_s_sleep(2); if (++sp > (1u << 22)) break; }
        __builtin_amdgcn_fence(__ATOMIC_ACQUIRE, "agent");
        asm volatile("s_waitcnt vmcnt(0)" ::: "memory");
    }
    __syncthreads();
}
__device__ __forceinline__ void sincos_cw(float x, float& s, float& c) {
    const float k = rintf(x * 0.636619772367581343f);
    float r = fmaf(-k, 1.57079625129699707031f, x); r = fmaf(-k, 7.54978941586159635e-08f, r); r = fmaf(-k, 5.39030285815811482e-15f, r);
    const float z = r * r;
    const float sp = fmaf(fmaf(fmaf(-1.9515295891e-4f, z, 8.3321608736e-3f), z, -1.6666654611e-1f) * z, r, r);
    const float cp = fmaf(fmaf(fmaf(2.443315711809948e-5f, z, -1.388731625493765e-3f), z, 4.166664568298827e-2f), z * z, fmaf(-0.5f, z, 1.0f));
    const int q = (int)k & 3;
    const float ss = (q & 1) ? cp : sp, cc = (q & 1) ? sp : cp;
    s = (q & 2) ? -ss : ss; c = ((q + 1) & 2) ? -cc : cc;
}
__device__ __forceinline__ void s5_disc(const Args& a, int g, int p, float dt, float& lr, float& li, float& fre, float& fim) {
    const float are = a.in[15][g * 64 + p], aim = a.in[16][g * 64 + p];
    const float mag = __expf(are * dt); float sn, cs; sincos_cw(aim * dt, sn, cs);
    lr = mag * cs; li = mag * sn;
    const float den = are * are + aim * aim, nre = lr - 1.0f, nim = li;
    fre = (nre * are + nim * aim) / den; fim = (nim * are - nre * aim) / den;
}
__device__ __forceinline__ float gelu_tanh(float x) { const float u = 0.7978845608028654f * (x + 0.044715f * x * x * x); const float t = 1.0f - 2.0f * __builtin_amdgcn_rcpf(__expf(2.0f * u) + 1.0f); return 0.5f * x * (1.0f + t); }
__device__ __forceinline__ void s5_precompute(const Args& a, int idx) {
    unsigned char* ws = a.ws;
    if (idx < 4096) {
        const int g = idx >> 6, p = idx & 63;
        const float dt = __expf(a.in[17][g]);
        float lr, li, fre, fim; s5_disc(a, g, p, dt, lr, li, fre, fim);
        float* lam = (float*)(ws + WS_S5LAM) + (size_t)idx * 2; lam[0] = lr; lam[1] = li;
        const float* br = a.in[18] + (size_t)idx * 16; const float* bi = a.in[19] + (size_t)idx * 16; const float* gm = a.in[6] + D + g * 16;
        u32x4* bb = (u32x4*)((bf16*)(ws + WS_S5BB) + ((size_t)g * 128 + 2 * p) * 16);
        float vr[16], vi[16];
#pragma unroll
        for (int c = 0; c < 16; ++c) { const float re = br[c], im = bi[c], gg = gm[c]; vr[c] = (fre * re - fim * im) * gg; vi[c] = (fre * im + fim * re) * gg; }
        bb[0] = (u32x4){pkbf(vr[0], vr[1]), pkbf(vr[2], vr[3]), pkbf(vr[4], vr[5]), pkbf(vr[6], vr[7])};
        bb[1] = (u32x4){pkbf(vr[8], vr[9]), pkbf(vr[10], vr[11]), pkbf(vr[12], vr[13]), pkbf(vr[14], vr[15])};
        bb[2] = (u32x4){pkbf(vi[0], vi[1]), pkbf(vi[2], vi[3]), pkbf(vi[4], vi[5]), pkbf(vi[6], vi[7])};
        bb[3] = (u32x4){pkbf(vi[8], vi[9]), pkbf(vi[10], vi[11]), pkbf(vi[12], vi[13]), pkbf(vi[14], vi[15])};
        unsigned* cm = (unsigned*)((bf16*)(ws + WS_S5CM) + (size_t)g * 16 * 128 + 2 * p);
#pragma unroll
        for (int c = 0; c < 16; ++c) cm[c * 64] = pkbf(a.in[20][(size_t)(g * 16 + c) * 64 + p], -a.in[21][(size_t)(g * 16 + c) * 64 + p]);
    }
    if (idx < 1024) ((float*)(ws + WS_S5DSK))[idx] = a.in[22][idx] * a.in[6][D + idx];
}
__device__ __forceinline__ void p0_transpose_item(const float* W, int K, int N, const float* gain, int gluh, bf16* WT, LAS float* scr, int item, int lane) {
    const int nblk = N / 32, kb = item / nblk, nb = item % nblk, k0 = 64 * kb, n0 = 32 * nb;
    f32x4 v[8];
#pragma unroll
    for (int i = 0; i < 8; ++i) v[i] = __builtin_nontemporal_load((const f32x4*)(W + (size_t)(k0 + 8 * i + (lane >> 3)) * N + n0 + 4 * (lane & 7)));
#pragma unroll
    for (int i = 0; i < 8; ++i) { const int kk = 8 * i + (lane >> 3); const float gk = gain ? gain[k0 + kk] : 1.0f; LAS float* s = scr + kk * 33 + 4 * (lane & 7);
        s[0] = v[i][0] * gk; s[1] = v[i][1] * gk; s[2] = v[i][2] * gk; s[3] = v[i][3] * gk; }
    LDS_FENCE();
    int r0 = n0; if (gluh > 0) r0 = (n0 < gluh) ? (n0 / 128) * 256 + (n0 % 128) : ((n0 - gluh) / 128) * 256 + 128 + ((n0 - gluh) % 128);
    const int c = lane & 7;
#pragma unroll
    for (int j = 0; j < 4; ++j) { const int n = (lane >> 3) + 8 * j; const LAS float* s = scr + (8 * c) * 33 + n;
        u32x4 o; o.x = pkbf(s[0 * 33], s[1 * 33]); o.y = pkbf(s[2 * 33], s[3 * 33]); o.z = pkbf(s[4 * 33], s[5 * 33]); o.w = pkbf(s[6 * 33], s[7 * 33]);
        *(u32x4*)(WT + (size_t)(r0 + n) * K + k0 + 8 * c) = o; }
    LDS_FENCE();
}
__device__ __forceinline__ void p0_prologue(const Args& a, ldsp lds, int gw, int ngw, int wave, int lane) {
    LAS float* scr = (LAS float*)(lds + wave * 16384);
    unsigned char* ws = a.ws;
    constexpr int I1 = (D / 64) * (DN_IN / 32), I2 = (VAL / 64) * (D / 32), I5 = (D / 64) * (2 * D / 32), I3 = (D / 64) * (2 * FFN / 32), I4 = (FFN / 64) * (D / 32);
    constexpr int NITEMS = I1 + I2 + I5 + 2 * I3 + 2 * I4;
    for (int it = gw; it < NITEMS; it += ngw) {
        int r = it;
        if (r < I1) { p0_transpose_item(a.in[9], D, DN_IN, a.in[6], 0, (bf16*)(ws + WS_W1), scr, r, lane); continue; } r -= I1;
        if (r < I2) { p0_transpose_item(a.in[14], VAL, D, nullptr, 0, (bf16*)(ws + WS_W2), scr, r, lane); continue; } r -= I2;
        if (r < I5) { p0_transpose_item(a.in[23], D, 2 * D, nullptr, D, (bf16*)(ws + WS_W5), scr, r, lane); continue; } r -= I5;
        if (r < 2 * I3) { const int l = r / I3; p0_transpose_item(a.in[24] + (size_t)l * D * 2 * FFN, D, 2 * FFN, a.in[7] + l * D, FFN, (bf16*)(ws + WS_W3) + (size_t)l * 2 * FFN * D, scr, r % I3, lane); continue; } r -= 2 * I3;
        { const int l = r / I4; p0_transpose_item(a.in[25] + (size_t)l * FFN * D, FFN, D, nullptr, 0, (bf16*)(ws + WS_W4) + (size_t)l * D * FFN, scr, r % I4, lane); }
    }
    {
        f32x4 nv[4]; int m = gw;
#define P0_XLOAD(mm) do { const bool smp_ = (mm) >= MP; const int r_ = smp_ ? (mm) - MP : (mm); const f32x4* xr_ = (const f32x4*)((smp_ ? a.in[1] : a.in[0]) + (size_t)r_ * D) + lane; \
        _Pragma("unroll") for (int j_ = 0; j_ < 4; ++j_) nv[j_] = xr_[64 * j_]; } while (0)
        if (m < MP + MS) P0_XLOAD(m);
        for (; m < MP + MS; m += ngw) {
            const bool smp = m >= MP; const int r = smp ? m - MP : m;
            f32x4 v[4]; float s = 0.f;
#pragma unroll
            for (int j = 0; j < 4; ++j) { v[j] = nv[j]; s += (v[j][0] * v[j][0] + v[j][1] * v[j][1]) + (v[j][2] * v[j][2] + v[j][3] * v[j][3]); }
            if (m + ngw < MP + MS) P0_XLOAD(m + ngw);
            s = wave_sum(s);
            u32x2* o8 = (u32x2*)((bf16*)(ws + (smp ? WS_SXB : WS_XB)) + (size_t)r * D) + lane;
#pragma unroll
            for (int j = 0; j < 4; ++j) { u32x2 w; w.x = pkbf(v[j][0], v[j][1]); w.y = pkbf(v[j][2], v[j][3]); o8[64 * j] = w; }
            float* ssr = (float*)(ws + (smp ? WS_SSS : WS_SS)) + (size_t)r * 32;
            if (lane < (smp ? 32 : 16)) ssr[lane] = (lane == 0) ? s : 0.f;
        }
#undef P0_XLOAD
    }
    if (wave == 7) s5_precompute(a, (gw >> 3) * 64 + lane);
}
constexpr int DL_K = 0, DL_V = 17408, DL_QK = 34816, DL_X = 44032, DL_SLOT = 9216, DL_ST = 99328, DL_GC = 134144, DL_BETA = 134400, DL_RED = 134656, DL_Q = 135680, DL_END = 135680 + 17408;
static_assert(DL_END <= LDSCTL_OFF, "DN LDS map");
__device__ __forceinline__ bf16x8 ldfrag(ldsp base, int row, int ld, int k) { return *(const LAS bf16x8*)(base + (row * ld + k) * 2); }
__device__ __forceinline__ void st4(ldsp base, int row, int ld, int col, const f32x4 v) { u32x2 w; w.x = pkbf(v[0], v[1]); w.y = pkbf(v[2], v[3]); *(LAS u32x2*)(base + (row * ld + col) * 2) = w; }
__device__ __forceinline__ void st1(ldsp base, int row, int ld, int col, float v) { *(LAS unsigned short*)(base + (row * ld + col) * 2) = (unsigned short)(pkbf(v, 0.f) & 0xffffu); }

typedef short s16x4 __attribute__((ext_vector_type(4)));
__device__ __forceinline__ bf16x8 ldfrag_tr(ldsp base, int k0, int ld, int c0, int fr, int fq) {
    const ldsp p = base + ((k0 + 8 * fq + (fr >> 2)) * ld + c0 + 4 * (fr & 3)) * 2;
    const s16x4 lo = __builtin_amdgcn_ds_read_tr16_b64_v4i16((LAS s16x4*)p);
    const s16x4 hi = __builtin_amdgcn_ds_read_tr16_b64_v4i16((LAS s16x4*)(p + 8 * ld));
    return (bf16x8){lo[0], lo[1], lo[2], lo[3], hi[0], hi[1], hi[2], hi[3]};
}
__device__ __forceinline__ void dn_prep(const Args& a, int gw, int ngw, int lane) {
    const bf16* PROJ = (const bf16*)(a.ws + WS_PROJ); bf16* QKVC = (bf16*)(a.ws + WS_QKVC);
    {
        const float* BETA = (const float*)(a.ws + WS_BETA); const float* GDEC = (const float*)(a.ws + WS_GDEC);
        float* GC = (float*)(a.ws + WS_GC); float* BT = (float*)(a.ws + WS_BT);
        for (int u = gw; u < NB * NH * NCHUNK; u += ngw) {
            const int c = u % NCHUNK, h = (u / NCHUNK) % NH, b = u / (NCHUNK * NH); const int row = b * SEQ + c * CHUNK + lane;
            float g = GDEC[(size_t)row * 16 + h]; const float bt = BETA[(size_t)row * 16 + h];
#pragma unroll
            for (int o = 1; o < 64; o <<= 1) { const float t = __shfl_up(g, o); if (lane >= o) g += t; }
            GC[(size_t)(b * NH + h) * SEQ + c * CHUNK + lane] = g; BT[(size_t)(b * NH + h) * SEQ + c * CHUNK + lane] = bt;
        }
    }
    for (int u = gw; u < NB * 8 * (SEQ / 32); u += ngw) {
        const int cb = u & 7, run = (u >> 3) & 63, b = u >> 9, ch0 = cb * 512 + lane * 8, t0 = run * 32, row0 = b * SEQ + t0;
        float w[4][8];
#pragma unroll
        for (int j = 0; j < 4; ++j) { const f32x4 w0 = *(const f32x4*)(a.in[10] + j * 4096 + ch0), w1 = *(const f32x4*)(a.in[10] + j * 4096 + ch0 + 4);
#pragma unroll
            for (int e = 0; e < 4; ++e) { w[j][e] = w0[e]; w[j][4 + e] = w1[e]; } }
        u32x4 xm[3];
#pragma unroll
        for (int j = 0; j < 3; ++j) { xm[j] = (u32x4){0u, 0u, 0u, 0u}; if (t0 - 3 + j >= 0) xm[j] = *(const u32x4*)(PROJ + (size_t)(row0 - 3 + j) * PROJ_LD + ch0); }
        const float scl = cb < 2 ? 0.08838834764831845f : 1.0f;
        u32x4 xr[8];
#pragma unroll
        for (int t = 0; t < 8; ++t) xr[t] = *(const u32x4*)(PROJ + (size_t)(row0 + t) * PROJ_LD + ch0);
#pragma unroll
        for (int t = 0; t < 32; ++t) {
            const u32x4 x0 = xr[t & 7];
            if (t + 8 < 32) xr[t & 7] = *(const u32x4*)(PROJ + (size_t)(row0 + t + 8) * PROJ_LD + ch0);
            float y[8];
#pragma unroll
            for (int e = 0; e < 4; ++e) {
                const unsigned a3 = xm[0][e], a2 = xm[1][e], a1 = xm[2][e], a0 = x0[e];
                y[2 * e] = w[0][2 * e] * bflo(a3) + w[1][2 * e] * bflo(a2) + w[2][2 * e] * bflo(a1) + w[3][2 * e] * bflo(a0);
                y[2 * e + 1] = w[0][2 * e + 1] * bfhi(a3) + w[1][2 * e + 1] * bfhi(a2) + w[2][2 * e + 1] * bfhi(a1) + w[3][2 * e + 1] * bfhi(a0); }
            float ssq = 0.f;
#pragma unroll
            for (int e = 0; e < 8; ++e) { y[e] = y[e] * __builtin_amdgcn_rcpf(1.0f + __expf(-y[e])); ssq += y[e] * y[e]; }
            if (cb < 4) { ssq += __shfl_xor(ssq, 1); ssq += __shfl_xor(ssq, 2); ssq += __shfl_xor(ssq, 4); ssq += __shfl_xor(ssq, 8); const float sc = rsqrtf(ssq + 1e-6f) * scl;
#pragma unroll
                for (int e = 0; e < 8; ++e) y[e] *= sc; }
            u32x4 o; o.x = pkbf(y[0], y[1]); o.y = pkbf(y[2], y[3]); o.z = pkbf(y[4], y[5]); o.w = pkbf(y[6], y[7]);
            *(u32x4*)(QKVC + (size_t)(row0 + t) * 4096 + ch0) = o;
            xm[0] = xm[1]; xm[1] = xm[2]; xm[2] = x0;
        }
    }
}

#ifndef RPA
#define RPA 1
#endif
#ifndef RPB
#define RPB 1
#endif
#ifndef RPE
#define RPE 1
#endif
#ifndef RPF
#define RPF 1
#endif
#ifndef RPO
#define RPO 1
#endif
__device__ __forceinline__ void dn_prompt(const Args& a, ldsp lds, int b, int h, int tid, int wave, int lane) {
    unsigned char* ws = a.ws;
    const bf16* PROJ = (const bf16*)(ws + WS_PROJ); const bf16* QKVC = (const bf16*)(ws + WS_QKVC); bf16* GATED = (bf16*)(ws + WS_GATED);
    const float* GC = (const float*)(ws + WS_GC) + (size_t)(b * NH + h) * SEQ; const float* BT = (const float*)(ws + WS_BT) + (size_t)(b * NH + h) * SEQ;
    const int mt = wave & 3, ch = wave >> 2, hq = h >> 1;
    LAS float* gcs = (LAS float*)(lds + DL_GC); LAS float* betas = (LAS float*)(lds + DL_BETA); LAS float* red = (LAS float*)(lds + DL_RED);
    const ldsp LK = lds + DL_K, LV = lds + DL_V, LQK = lds + DL_QK, LST = lds + DL_ST, LQ = lds + DL_Q;
#define SLOT(s) (lds + DL_X + (s) * DL_SLOT)
#define PRs(s) ((s) == 0 ? 0 : (((s) & 1) ? 2 : 4))
#define PTs(s) ((s) == 0 ? 1 : (((s) & 1) ? 3 : 5))
#define NRs(s) ((s) & 1)
    for (int i = tid; i < 128 * 136 / 2; i += NTHREADS) ((LAS unsigned*)LST)[i] = 0u;
    f32x4 S[2][4];
#pragma unroll
    for (int x = 0; x < 2; ++x)
#pragma unroll
        for (int q = 0; q < 4; ++q) S[x][q] = (f32x4){0.f, 0.f, 0.f, 0.f};
    LAS float* ngl = (LAS float*)(lds + DL_RED + 512);
    if (tid < 128) ngl[tid] = a.in[13][tid];
    u32x4 nQt[2], nKt[2], nVt[2]; float ngd = 0.f, nbt = 0.f;
#define DN_PREFETCH(cc) do { const int rowc_ = b * SEQ + (cc) * CHUNK; const bf16* krow_ = QKVC + (size_t)(rowc_ + (tid >> 3)) * 4096; \
        _Pragma("unroll") for (int p2_ = 0; p2_ < 2; ++p2_) { const int col_ = 8 * ((tid & 7) + 8 * p2_); nQt[p2_] = *(const u32x4*)(krow_ + hq * 128 + col_); nKt[p2_] = *(const u32x4*)(krow_ + 1024 + hq * 128 + col_); nVt[p2_] = *(const u32x4*)(krow_ + 2048 + h * 128 + col_); } \
        ngd = GC[(cc) * CHUNK + lane]; nbt = BT[(cc) * CHUNK + lane]; } while (0)
    DN_PREFETCH(0);
#define DN_TILES_TO_LDS() do { const int r_ = tid >> 3, pc_ = tid & 7; \
        _Pragma("unroll") for (int p2_ = 0; p2_ < 2; ++p2_) { const int col_ = 8 * (pc_ + 8 * p2_); *(LAS u32x4*)(LQ + (r_ * 136 + col_) * 2) = nQt[p2_]; *(LAS u32x4*)(LK + (r_ * 136 + col_) * 2) = nKt[p2_]; *(LAS u32x4*)(LV + (r_ * 136 + col_) * 2) = nVt[p2_]; } \
        if (wave == 0) { gcs[lane] = ngd; betas[lane] = nbt; } } while (0)
    DN_TILES_TO_LDS();
    DN_PREFETCH(NCHUNK > 1 ? 1 : 0);
    __syncthreads();
    for (int c = 0; c < NCHUNK; ++c) {
        int lane_c = lane; asm volatile("" : "+v"(lane_c));
        const int fr = lane_c & 15, fq = lane_c >> 4, i_own = 16 * mt + fr;
        const int t_own = c * CHUNK + i_own, row_own = b * SEQ + t_own;
        bf16x8 qf[4], kf[4]; u32x2 zc[4];
#pragma unroll
        for (int q = 0; q < 4; ++q) zc[q] = *(const u32x2*)(PROJ + (size_t)row_own * PROJ_LD + 4096 + h * 128 + 16 * (4 * ch + q) + 4 * fq);
#pragma unroll
        for (int kk = 0; kk < 4; ++kk) { kf[kk] = ldfrag(LK, i_own, 136, 32 * kk + 8 * fq); qf[kk] = ldfrag(LQ, i_own, 136, 32 * kk + 8 * fq); }
        for (int rpB = 0; rpB < RPB; ++rpB) {
        f32x4 Pt[2], Nt[2];
        {
            const float gi = gcs[i_own], bi = betas[i_own];
#pragma unroll
            for (int q2 = 0; q2 < 2; ++q2) { const int nt = 2 * ch + q2;
                f32x4 akk = (f32x4){0.f, 0.f, 0.f, 0.f}, aqk = akk;
#pragma unroll
                for (int kk = 0; kk < 4; ++kk) { const bf16x8 yf = ldfrag(LK, 16 * nt + fr, 136, 32 * kk + 8 * fq); MM_XROW(akk, kf[kk], yf); MM_XROW(aqk, qf[kk], yf); }
                const f32x4 gj = *(const LAS f32x4*)(gcs + 16 * nt + 4 * fq);
                f32x4 qkv, m0;
#pragma unroll
                for (int r = 0; r < 4; ++r) { const int j = 16 * nt + 4 * fq + r; const float d = (i_own >= j) ? __expf(gi - gj[r]) : 0.f; qkv[r] = aqk[r] * d; m0[r] = (i_own > j) ? -bi * akk[r] * d : 0.f; }
                st4(LQK, i_own, 72, 16 * nt + 4 * fq, qkv);
                Pt[q2] = m0; Nt[q2] = m0;
                st4(SLOT(0), i_own, 72, 16 * nt + 4 * fq, m0); }
        }
        __syncthreads();
#pragma unroll
        for (int s = 1; s <= 6; ++s) {
            f32x4 Pn[2];
            bf16x8 xn[2], xp[2];
            if (s >= 2) { xn[0] = ldfrag(SLOT(NRs(s - 2)), i_own, 72, 8 * fq); xn[1] = ldfrag(SLOT(NRs(s - 2)), i_own, 72, 32 + 8 * fq); }
            if (s <= 5) { xp[0] = ldfrag(SLOT(PRs(s - 1)), i_own, 72, 8 * fq); xp[1] = ldfrag(SLOT(PRs(s - 1)), i_own, 72, 32 + 8 * fq); }
#pragma unroll
            for (int q2 = 0; q2 < 2; ++q2) { const int nt = 2 * ch + q2;
                const bf16x8 y0 = ldfrag_tr(SLOT(PRs(s - 1)), 0, 72, 16 * nt, fr, fq), y1 = ldfrag_tr(SLOT(PRs(s - 1)), 32, 72, 16 * nt, fr, fq);
                if (s >= 2) { f32x4 acc = Nt[q2] + Pt[q2]; MM_XROW(acc, xn[0], y0); MM_XROW(acc, xn[1], y1); Nt[q2] = acc; }
                if (s <= 5) { f32x4 acc = (f32x4){0.f, 0.f, 0.f, 0.f}; MM_XROW(acc, xp[0], y0); MM_XROW(acc, xp[1], y1); Pn[q2] = acc; }
            }
#pragma unroll
            for (int q2 = 0; q2 < 2; ++q2) { const int nt = 2 * ch + q2, j0 = 16 * nt + 4 * fq;
                if (s <= 5) { Pt[q2] = Pn[q2];
                    st4(SLOT(PRs(s)), i_own, 72, j0, Pn[q2]); }
                if (s >= 2 && s <= 5) st4(SLOT(NRs(s - 1)), i_own, 72, j0, Nt[q2]);
                if (s == 6) {
                    const f32x4 gj = *(const LAS f32x4*)(gcs + j0), bj = *(const LAS f32x4*)(betas + j0); f32x4 t1, t2;
#pragma unroll
                    for (int r = 0; r < 4; ++r) { const float tv = Nt[q2][r] + ((i_own == j0 + r) ? 1.f : 0.f); t2[r] = tv * bj[r]; t1[r] = t2[r] * __expf(gj[r]); }
                    st4(SLOT(1), i_own, 72, j0, t1); st4(SLOT(3), i_own, 72, j0, t2); }
            }
            __syncthreads();
        }
        }
        f32x4 U[4]; bf16x8 ka[2][2];
        for (int rpE = 0; rpE < RPE; ++rpE) {
        {
#pragma unroll
            for (int x = 0; x < 2; ++x) { ka[x][0] = ldfrag_tr(LK, 0, 136, 16 * (2 * mt + x), fr, fq); ka[x][1] = ldfrag_tr(LK, 32, 136, 16 * (2 * mt + x), fr, fq); }
            const bf16x8 t1a = ldfrag(SLOT(1), i_own, 72, 8 * fq), t1b = ldfrag(SLOT(1), i_own, 72, 32 + 8 * fq), t2a = ldfrag(SLOT(3), i_own, 72, 8 * fq), t2b = ldfrag(SLOT(3), i_own, 72, 32 + 8 * fq);
#pragma unroll
            for (int q = 0; q < 4; ++q) { const int nt = 4 * ch + q;
                f32x4 aw = (f32x4){0.f, 0.f, 0.f, 0.f};
                MM_XROW(aw, t1a, ldfrag_tr(LK, 0, 136, 16 * nt, fr, fq)); MM_XROW(aw, t1b, ldfrag_tr(LK, 32, 136, 16 * nt, fr, fq));
                st4(SLOT(4), i_own, 136, 16 * nt + 4 * fq, -aw);
                f32x4 au = (f32x4){0.f, 0.f, 0.f, 0.f};
                MM_YROW(au, t2a, ldfrag_tr(LV, 0, 136, 16 * nt, fr, fq)); MM_YROW(au, t2b, ldfrag_tr(LV, 32, 136, 16 * nt, fr, fq));
                U[q] = au; }
        }
        __syncthreads();
        }
        f32x4 O[4];
        const float gl = gcs[63];
        for (int rpF = 0; rpF < RPF; ++rpF) {
        {
            bf16x8 wf[4];
#pragma unroll
            for (int kk = 0; kk < 4; ++kk) wf[kk] = ldfrag(SLOT(4), i_own, 136, 32 * kk + 8 * fq);
            const float ei = __expf(gcs[i_own]);
            const f32x4 gq = *(const LAS f32x4*)(gcs + 16 * mt + 4 * fq);
#pragma unroll
            for (int q = 0; q < 4; ++q) { const int nt = 4 * ch + q;
                f32x4 ao = (f32x4){0.f, 0.f, 0.f, 0.f}, av = U[q];
#pragma unroll
                for (int kk = 0; kk < 4; ++kk) { const bf16x8 sf = ldfrag(LST, 16 * nt + fr, 136, 32 * kk + 8 * fq); MM_YROW(av, wf[kk], sf); MM_XROW(ao, qf[kk], sf); }
                O[q] = ao * ei;
                st4(SLOT(0), 16 * nt + fr, 72, 16 * mt + 4 * fq, av);
                f32x4 avd;
#pragma unroll
                for (int r = 0; r < 4; ++r) avd[r] = av[r] * __expf(gl - gq[r]);
                st4(SLOT(2), 16 * nt + fr, 72, 16 * mt + 4 * fq, avd); }
        }
        __syncthreads();
        }
        {
            const bf16x8 qa = ldfrag(LQK, i_own, 72, 8 * fq), qb = ldfrag(LQK, i_own, 72, 32 + 8 * fq);
            DN_TILES_TO_LDS();
            const float el = __expf(gl);
            float ssq = 0.f;
#pragma unroll
            for (int q = 0; q < 4; ++q) { const int nt = 4 * ch + q;
                MM_XROW(O[q], qa, ldfrag(SLOT(0), 16 * nt + fr, 72, 8 * fq)); MM_XROW(O[q], qb, ldfrag(SLOT(0), 16 * nt + fr, 72, 32 + 8 * fq));
                ssq += (O[q][0] * O[q][0] + O[q][1] * O[q][1]) + (O[q][2] * O[q][2] + O[q][3] * O[q][3]);
                const bf16x8 v0 = ldfrag(SLOT(2), 16 * nt + fr, 72, 8 * fq), v1 = ldfrag(SLOT(2), 16 * nt + fr, 72, 32 + 8 * fq);
#pragma unroll
                for (int x = 0; x < 2; ++x) { f32x4 sacc = S[x][q] * el; MM_YROW(sacc, ka[x][0], v0); MM_YROW(sacc, ka[x][1], v1); S[x][q] = sacc;
                    st4(LST, 16 * nt + fr, 136, 16 * (2 * mt + x) + 4 * fq, sacc); } }
            ssq += __shfl_xor(ssq, 16); ssq += __shfl_xor(ssq, 32);
            if (fq == 0) red[i_own * 2 + ch] = ssq;
            { const int cn = (c + 2 < NCHUNK) ? c + 2 : NCHUNK - 1; DN_PREFETCH(cn); }
        }
        __syncthreads();
        for (int rpO = 0; rpO < RPO; ++rpO) {
        {
            const float rstd = rsqrtf((red[i_own * 2] + red[i_own * 2 + 1]) * (1.0f / 128.0f) + RMS_EPSF);
#pragma unroll
            for (int q = 0; q < 4; ++q) { const int dv = 16 * (4 * ch + q) + 4 * fq;
                const u32x2 z = zc[q];
                const f32x4 ngv = *(const LAS f32x4*)(ngl + dv);
                u32x2 w; w.x = pkbf(O[q][0] * rstd * ngv[0] * bflo(z.x), O[q][1] * rstd * ngv[1] * bfhi(z.x)); w.y = pkbf(O[q][2] * rstd * ngv[2] * bflo(z.y), O[q][3] * rstd * ngv[3] * bfhi(z.y));
                *(u32x2*)(GATED + (size_t)row_own * VAL + h * 128 + dv) = w; }
        }
        }
    }
    const int fr = lane & 15, fq = lane >> 4;
    float* so = a.out + O_SSMP + (size_t)(b * NH + h) * 128 * 128;
#pragma unroll
    for (int x = 0; x < 2; ++x)
#pragma unroll
        for (int q = 0; q < 4; ++q)
#pragma unroll
            for (int r = 0; r < 4; ++r) so[(size_t)(16 * (2 * mt + x) + 4 * fq + r) * 128 + 16 * (4 * ch + q) + fr] = S[x][q][r];
    for (int i = tid; i < 3 * 384; i += NTHREADS) { const int j = i / 384, cc = i % 384; if (cc < 256 && (h & 1)) continue;
        const int gch = cc < 128 ? hq * 128 + cc : (cc < 256 ? 1024 + hq * 128 + (cc - 128) : 2048 + h * 128 + (cc - 256));
        a.out[O_CONVP + (size_t)(b * 3 + j) * 4096 + gch] = bf1(PROJ[(size_t)(b * SEQ + SEQ - 3 + j) * PROJ_LD + gch]); }
    __syncthreads();
#undef SLOT
#undef DN_PREFETCH
#undef DN_TILES_TO_LDS
#undef PRs
#undef PTs
#undef NRs
}
__device__ __forceinline__ void dn_sample_all(const Args& a, ldsp lds, int ti, int nt, int tid, int wave, int lane) {
    unsigned char* ws = a.ws;
    const bf16* PROJ = (const bf16*)(ws + WS_SPROJ); bf16* GATED = (bf16*)(ws + WS_SGATED);
    const float* BETA = (const float*)(ws + WS_SBETA); const float* GDEC = (const float*)(ws + WS_SGDEC);
    LAS float* qkv = (LAS float*)lds;
    LAS float* red = qkv + 384;
    LAS float* part = qkv + 512;
    const int kg = tid >> 5, v4 = tid & 31, p = tid >> 7, c = tid & 127;
    f32x4 sn[8]; float nx3 = 0.f, nc0 = 0.f, nc1 = 0.f, nc2 = 0.f, nbeta = 0.f, ngd = 0.f; u32x2 nz = (u32x2){0u, 0u};
    float w0 = 0.f, w1 = 0.f, w2 = 0.f, w3 = 0.f; int gch_cur = -1;
#define DNS_LOAD(it_) do { const int bs_ = (it_) / NH, h_ = (it_) % NH, hq_ = h_ >> 1; \
        const float* sin_ = a.in[2] + ((size_t)(bs_ * NH + h_) * 128 + kg * 8) * 128 + 4 * v4; \
        _Pragma("unroll") for (int r_ = 0; r_ < 8; ++r_) sn[r_] = *(const f32x4*)(sin_ + r_ * 128); \
        if (tid < 384) { const int gch_ = p == 0 ? hq_ * 128 + c : (p == 1 ? 1024 + hq_ * 128 + c : 2048 + h_ * 128 + c); \
            nx3 = bf1(PROJ[(size_t)bs_ * PROJ_LD + gch_]); const float* cs_ = a.in[3] + (size_t)bs_ * 3 * 4096 + gch_; nc0 = cs_[0]; nc1 = cs_[4096]; nc2 = cs_[8192]; } \
        nbeta = BETA[(size_t)bs_ * 16 + h_]; ngd = GDEC[(size_t)bs_ * 16 + h_]; \
        if (tid < 32) nz = *(const u32x2*)(PROJ + (size_t)bs_ * PROJ_LD + 4096 + h_ * 128 + 4 * v4); } while (0)
    int it = ti;
    if (it < MS * NH) DNS_LOAD(it);
    for (; it < MS * NH; it += nt) {
        const int bs = it / NH, h = it % NH, hq = h >> 1;
        f32x4 s[8];
#pragma unroll
        for (int r = 0; r < 8; ++r) s[r] = sn[r];
        const float x3 = nx3, c0 = nc0, c1 = nc1, c2 = nc2, beta = nbeta, eg = __expf(ngd); const u32x2 z = nz;
        const int gch = p == 0 ? hq * 128 + c : (p == 1 ? 1024 + hq * 128 + c : 2048 + h * 128 + c);
        if (tid < 384 && gch != gch_cur) { const float* w = a.in[10] + gch; w0 = w[0]; w1 = w[4096]; w2 = w[8192]; w3 = w[12288]; gch_cur = gch; }
        if (it + nt < MS * NH) DNS_LOAD(it + nt);
        float sq = 0.f;
        if (tid < 384) {
            float y = c0 * w0 + c1 * w1 + c2 * w2 + x3 * w3; y = y / (1.0f + __expf(-y));
            if (p == 2 || (h & 1) == 0) { float* co = a.out + O_CONVS + (size_t)bs * 3 * 4096 + gch; co[0] = c1; co[4096] = c2; co[8192] = x3; }
            qkv[tid] = y; sq = y * y; }
        sq = wave_sum(sq);
        if (lane == 0) red[wave] = sq;
        __syncthreads();
        const float qs = rsqrtf(red[0] + red[1] + 1e-6f) * 0.08838834764831845f, ks = rsqrtf(red[2] + red[3] + 1e-6f);
        float* sout = a.out + O_SSMS + ((size_t)(bs * NH + h) * 128 + kg * 8) * 128 + 4 * v4;
        f32x4 kv = (f32x4){0.f, 0.f, 0.f, 0.f};
#pragma unroll
        for (int r = 0; r < 8; ++r) { s[r] = s[r] * eg; kv += s[r] * (qkv[128 + kg * 8 + r] * ks); }
        *(LAS f32x4*)(part + kg * 128 + 4 * v4) = kv;
        __syncthreads();
        kv = (f32x4){0.f, 0.f, 0.f, 0.f};
#pragma unroll
        for (int g = 0; g < 16; ++g) kv += *(const LAS f32x4*)(part + g * 128 + 4 * v4);
        const f32x4 vv = *(const LAS f32x4*)(qkv + 256 + 4 * v4);
        const f32x4 delta = (vv - kv) * beta;
        f32x4 op = (f32x4){0.f, 0.f, 0.f, 0.f};
#pragma unroll
        for (int r = 0; r < 8; ++r) { s[r] += delta * (qkv[128 + kg * 8 + r] * ks); *(f32x4*)(sout + r * 128) = s[r]; op += s[r] * (qkv[kg * 8 + r] * qs); }
        __syncthreads();
        *(LAS f32x4*)(part + kg * 128 + 4 * v4) = op;
        __syncthreads();
        if (tid < 32) {
            f32x4 o = (f32x4){0.f, 0.f, 0.f, 0.f};
#pragma unroll
            for (int g = 0; g < 16; ++g) o += *(const LAS f32x4*)(part + g * 128 + 4 * v4);
            float ss = (o[0] * o[0] + o[1] * o[1]) + (o[2] * o[2] + o[3] * o[3]);
#pragma unroll
            for (int m = 1; m < 32; m <<= 1) ss += __shfl_xor(ss, m);
            const float rstd = rsqrtf(ss * (1.0f / 128.0f) + RMS_EPSF);
            const f32x4 ng = *(const f32x4*)(a.in[13] + 4 * v4);
            u32x2 w; w.x = pkbf(o[0] * rstd * ng[0] * bflo(z.x), o[1] * rstd * ng[1] * bfhi(z.x)); w.y = pkbf(o[2] * rstd * ng[2] * bflo(z.y), o[3] * rstd * ng[3] * bfhi(z.y));
            *(u32x2*)(GATED + (size_t)bs * VAL + h * 128 + 4 * v4) = w;
        }
        __syncthreads();
    }
#undef DNS_LOAD
}
__device__ __forceinline__ void s5_wave(const Args& a, ldsp wl, bool sample, int b, int e0, int g, int lane) {
    unsigned char* ws = a.ws;
    const bf16* XB = (const bf16*)(ws + (sample ? WS_SXB : WS_XB)); bf16* YB = (bf16*)(ws + (sample ? WS_SYB : WS_YB)); const float* SS = (const float*)(ws + (sample ? WS_SSS : WS_SS));
    const int fr = lane & 15, fq = lane >> 4;
    LAS float* bubuf = (LAS float*)wl;
    const ldsp stbuf = wl + 16 * 132 * 4;
    const f32x2 lam = *(const f32x2*)((const float*)(ws + WS_S5LAM) + (size_t)(g * 64 + lane) * 2); const float lr = lam[0], li = lam[1];
    bf16x8 bbf[8];
#pragma unroll
    for (int nt = 0; nt < 8; ++nt) { u32x4 w = (u32x4){0u, 0u, 0u, 0u}; if (fq < 2) w = *(const u32x4*)((const bf16*)(ws + WS_S5BB) + ((size_t)g * 128 + 16 * nt + fr) * 16 + 8 * fq); bbf[nt] = __builtin_bit_cast(bf16x8, w); }
    bf16x8 cf[4];
#pragma unroll
    for (int kk = 0; kk < 4; ++kk) cf[kk] = *(const bf16x8*)((const bf16*)(ws + WS_S5CM) + ((size_t)g * 16 + fr) * 128 + 32 * kk + 8 * fq);
    const f32x4 dskv = *(const f32x4*)((const float*)(ws + WS_S5DSK) + g * 16 + 4 * fq); const float dsk[4] = {dskv[0], dskv[1], dskv[2], dskv[3]};
    float sre = 0.f, sim = 0.f;
    const int ntile = sample ? 1 : SEQ / 16;
    const int rowb0 = sample ? e0 : b * SEQ;
    u32x4 pxw[4]; f32x4 pss[4]; u32x2 puw[4];
#define S5_LOAD(k, tile) do { const int row_ = rowb0 + (tile) * 16 + fr; pxw[k] = (u32x4){0u, 0u, 0u, 0u}; if (fq < 2) pxw[k] = *(const u32x4*)(XB + (size_t)row_ * D + g * 16 + 8 * fq); \
        pss[k] = *(const f32x4*)(SS + (size_t)row_ * 32 + 4 * fq); if (sample) pss[k] += *(const f32x4*)(SS + (size_t)row_ * 32 + 16 + 4 * fq); puw[k] = *(const u32x2*)(XB + (size_t)row_ * D + g * 16 + 4 * fq); } while (0)
#pragma unroll
    for (int k = 0; k < 4; ++k) if (k < ntile) S5_LOAD(k, k);
    for (int t0 = 0; t0 < ntile; t0 += 4) {
#pragma unroll
        for (int k = 0; k < 4; ++k) {
            const int tile = t0 + k; if (tile >= ntile) break;
            const int row = rowb0 + tile * 16 + fr;
            const bf16x8 xf = __builtin_bit_cast(bf16x8, pxw[k]);
            float ssum = (pss[k][0] + pss[k][1]) + (pss[k][2] + pss[k][3]); ssum += __shfl_xor(ssum, 16); ssum += __shfl_xor(ssum, 32);
            const float rs = rsqrtf(ssum * (1.0f / 1024.0f) + RMS_EPSF);
            const u32x2 uw = puw[k];
            if (tile + 4 < ntile) S5_LOAD(k, tile + 4);
#pragma unroll
            for (int nt = 0; nt < 8; ++nt) { f32x4 acc = (f32x4){0.f, 0.f, 0.f, 0.f}; MM_XROW(acc, xf, bbf[nt]); *(LAS f32x4*)(bubuf + fr * 132 + 16 * nt + 4 * fq) = acc * rs; }
            LDS_FENCE();
            f32x2 buv[16];
#pragma unroll
            for (int t = 0; t < 16; ++t) buv[t] = *(const LAS f32x2*)(bubuf + t * 132 + 2 * lane);
            LDS_FENCE();
#pragma unroll
            for (int t = 0; t < 16; ++t) {
                const f32x2 bu = buv[t];
                if (sample) { sre = a.in[4][(size_t)(e0 + t) * 4096 + g * 64 + lane]; sim = a.in[5][(size_t)(e0 + t) * 4096 + g * 64 + lane]; }
                const float nr = fmaf(lr, sre, fmaf(-li, sim, bu[0])), ni = fmaf(lr, sim, fmaf(li, sre, bu[1]));
                sre = nr; sim = ni;
                *(LAS unsigned*)(stbuf + (t * 136 + 2 * lane) * 2) = pkbf(sre, sim);
                if (sample) { a.out[O_S5RS + (size_t)(e0 + t) * 4096 + g * 64 + lane] = sre; a.out[O_S5IS + (size_t)(e0 + t) * 4096 + g * 64 + lane] = sim; }
            }
            LDS_FENCE();
            f32x4 y = (f32x4){0.f, 0.f, 0.f, 0.f};
#pragma unroll
            for (int kk = 0; kk < 4; ++kk) MM_XROW(y, ldfrag(stbuf, fr, 136, 32 * kk + 8 * fq), cf[kk]);
            y[0] += dsk[0] * bflo(uw.x) * rs; y[1] += dsk[1] * bfhi(uw.x) * rs; y[2] += dsk[2] * bflo(uw.y) * rs; y[3] += dsk[3] * bfhi(uw.y) * rs;
            u32x2 w; w.x = pkbf(gelu_tanh(y[0]), gelu_tanh(y[1])); w.y = pkbf(gelu_tanh(y[2]), gelu_tanh(y[3]));
            *(u32x2*)(YB + (size_t)row * D + g * 16 + 4 * fq) = w;
            LDS_FENCE();
        }
    }
#undef S5_LOAD
    if (!sample) { a.out[O_S5RP + (size_t)(b * 64 + g) * 64 + lane] = sre; a.out[O_S5IP + (size_t)(b * 64 + g) * 64 + lane] = sim; }
}
__global__ void __launch_bounds__(NTHREADS, 2) hybrid_fwd(Args a) {
    extern __shared__ __attribute__((aligned(16))) unsigned char lds_raw[];
    const ldsp lds = (ldsp)lds_raw;
    const int tid = threadIdx.x, lane = tid & 63, wave = __builtin_amdgcn_readfirstlane(tid >> 6);
    const int G = gridDim.x, bx = blockIdx.x;
    const int vcu = (G % 8 == 0) ? (bx % 8) * (G / 8) + bx / 8 : bx;
    unsigned char* ws = a.ws;
    unsigned* ctl = (unsigned*)(ws + WS_CTL);
    for (int u = tid; u < (LDS_BYTES - LDSCTL_OFF) / 4; u += NTHREADS) ((LAS unsigned*)(lds + LDSCTL_OFF))[u] = 0u;
    __syncthreads();
    XcdBarrier bar = xcd_barrier_post(ctl + CW_BAR, (volatile LAS unsigned*)(lds + LDSCTL_OFF) + 8);
    const int gw = vcu * NWAVES + wave, ngw = G * NWAVES;
    bf16* XB = (bf16*)(ws + WS_XB); float* X = (float*)(ws + WS_X); float* SS = (float*)(ws + WS_SS);
    bf16* PROJ = (bf16*)(ws + WS_PROJ); bf16* GATED = (bf16*)(ws + WS_GATED); bf16* YB = (bf16*)(ws + WS_YB); bf16* HB = (bf16*)(ws + WS_H);
    const bf16* W1 = (const bf16*)(ws + WS_W1); const bf16* W2 = (const bf16*)(ws + WS_W2); const bf16* W5 = (const bf16*)(ws + WS_W5);
    const bf16* W3 = (const bf16*)(ws + WS_W3); const bf16* W4 = (const bf16*)(ws + WS_W4);
#define SINGLE_ARG(...) __VA_ARGS__
#define GEMM_PHASE(EPI, Aop, Bop, N_, K_, E_) do { pg8::Gemm g_{(const pg8::bf16_t*)(Aop), (const pg8::bf16_t*)(Bop), MP, (N_), (K_)}; pg8::StaticOrder S_; S_.init(MP, (N_), G, bx); \
        pg8::gemm_phase<EPI, pg8::StaticOrder, true, true>(lds, g_, S_, (E_)); } while (0)
#ifndef DBG_STOP
#define DBG_STOP 0
#endif
#ifndef REPG
#define REPG 0
#endif
#define DBG_DIGEST(k, SRC, NEL) do { if (DBG_STOP == (k)) { xcd_barrier(bar); const bf16* s_ = (const bf16*)(SRC); for (size_t i_ = (size_t)bx * NTHREADS + tid; i_ < (size_t)(NEL) && i_ < O_SSMP; i_ += (size_t)G * NTHREADS) a.out[i_] = bf1(s_[i_]); return; } } while (0)

#ifndef TPROBE
#define TPROBE 0
#endif
#define TP_BLK ((TPROBE) / 10000)
#define TP_S (((TPROBE) / 100) % 100)
#define TP_E ((TPROBE) % 100)
    unsigned long long tp_s = 0, tp_e = 0;
#define STAMPV(id) do { if (TPROBE && vcu == TP_BLK && tid == 0) { const unsigned long long t_ = __builtin_amdgcn_s_memrealtime(); if ((id) == TP_S && tp_s == 0) tp_s = t_; if ((id) == TP_E && tp_e == 0) tp_e = t_; } } while (0)
#define STAMP(id) do { if (TPROBE && vcu == TP_BLK && tid == 0) { const unsigned long long t_ = __builtin_amdgcn_s_memrealtime(); if ((id) == TP_S) tp_s = t_; if ((id) == TP_E) tp_e = t_; } } while (0)
    STAMP(0);
    p0_prologue(a, lds, gw, ngw, wave, lane);
    STAMP(1);
    xcd_barrier(bar);
    STAMP(2);
    { pg8::EpiProj E{(pg8::bf16_t*)PROJ, SS, 16};
      GEMM_PHASE(pg8::EpiProj, XB, W1, PROJ_LD, D, E); }
#if REPG == 1
    xcd_barrier(bar);
    { pg8::EpiProj E{(pg8::bf16_t*)PROJ, SS, 16};
      GEMM_PHASE(pg8::EpiProj, XB, W1, PROJ_LD, D, E); }
#endif
    {
        const SEpiProj Ep{nullptr, SS, 16, (float*)(ws + WS_BETA), (float*)(ws + WS_GDEC), a.in[11], a.in[12]};
        const SEpiProj Es{(bf16*)(ws + WS_SPROJ), (const float*)(ws + WS_SSS), 32, (float*)(ws + WS_SBETA), (float*)(ws + WS_SGDEC), a.in[11], a.in[12]};
        for (int u = vcu; u < 128 + 193; u += G) {
            if (u < 128) sgemm_unit<2>(lds, XB + (size_t)u * 128 * D, W1 + (size_t)6144 * D, nullptr, D, Ep, u * 128, 192, wave, lane);
            else sgemm_unit<2>(lds, (const bf16*)(ws + WS_SXB), W1 + (size_t)(u - 128) * 32 * D, nullptr, D, Es, 0, u - 128, wave, lane);
        }
    }
    DBG_DIGEST(1, PROJ, (size_t)MP * PROJ_LD);
    STAMP(3);
    xcd_barrier(bar);
    STAMP(4);
    dn_prep(a, gw, ngw, lane);
    DBG_DIGEST(2, ws + WS_QKVC, (size_t)MP * 4096);
    STAMP(5);
    xcd_barrier(bar);
    STAMP(6);
    if (vcu < NB * NH) dn_prompt(a, lds, vcu / NH, vcu % NH, tid, wave, lane);
    else {
        const int nt = G - NB * NH, ti = vcu - NB * NH;
        unsigned* tcnt = ctl + CW_TEAM; unsigned ep = 0;
        float* SX = (float*)(ws + WS_SX); bf16* SXB = (bf16*)(ws + WS_SXB); float* SSS = (float*)(ws + WS_SSS);
        bf16* SGATED = (bf16*)(ws + WS_SGATED); bf16* SH = (bf16*)(ws + WS_SH); bf16* SYB = (bf16*)(ws + WS_SYB);
#define TEAM_BAR() team_barrier(tcnt, (unsigned)nt * (++ep))
        dn_sample_all(a, lds, ti, nt, tid, wave, lane);
        STAMP(20);
        TEAM_BAR();
        STAMP(21);
        { const SEpiRes<false> E{a.in[1], SX, SXB, SSS};
          for (int u = ti; u < D / 32; u += nt) sgemm_unit<2>(lds, SGATED, W2 + (size_t)u * 32 * VAL, nullptr, VAL, E, 0, u, wave, lane); }
        STAMPV(22);
        TEAM_BAR();
        STAMPV(23);
        {
            { const SEpiSwiglu E{SH, SSS, 32};
              for (int u = ti; u < FFN / 32; u += nt) { const bf16* bg = W3 + (size_t)((u >> 2) * 256 + (u & 3) * 32) * D;
                  sgemm_unit<4>(lds, SXB, bg, bg + (size_t)128 * D, D, E, 0, u, wave, lane); } }
            STAMPV(24);
            TEAM_BAR();
            STAMPV(25);
            { const SEpiRes<false> E{SX, SX, SXB, SSS};
              for (int u = ti; u < D / 32; u += nt) sgemm_unit<2>(lds, SH, W4 + (size_t)u * 32 * FFN, nullptr, FFN, E, 0, u, wave, lane); }
            STAMPV(26);
            TEAM_BAR();
            STAMPV(27);
            {
                const ldsp wl = lds + wave * 12800;
                for (int j = ti * NWAVES + wave; j < 512; j += nt * NWAVES) s5_wave(a, wl, true, 0, (j & 7) * 16, j >> 3, lane);
                STAMPV(28);
                TEAM_BAR();
                STAMPV(29);
                { const SEpiRes<true> E{SX, SX, SXB, SSS};
                  for (int u = ti; u < D / 32; u += nt) { const bf16* bv = W5 + (size_t)((u >> 2) * 256 + (u & 3) * 32) * D;
                      sgemm_unit<4>(lds, SYB, bv, bv + (size_t)128 * D, D, E, 0, u, wave, lane); } }
            }
        }
#undef TEAM_BAR
    }
    DBG_DIGEST(3, GATED, (size_t)MP * VAL);
    STAMP(7);
    xcd_barrier(bar);
    STAMP(8);
    { pg8::EpiRes<false, 0> E{a.in[0], nullptr, (pg8::bf16_t*)XB, SS};
      GEMM_PHASE(SINGLE_ARG(pg8::EpiRes<false, 0>), GATED, W2, D, VAL, E); }
#if REPG == 2
    xcd_barrier(bar);
    { pg8::EpiRes<false, 0> E{a.in[0], nullptr, (pg8::bf16_t*)XB, SS};
      GEMM_PHASE(SINGLE_ARG(pg8::EpiRes<false, 0>), GATED, W2, D, VAL, E); }
#endif
    xcd_barrier(bar);
    { pg8::EpiSwiglu E{(pg8::bf16_t*)HB, FFN, SS, 16};
      GEMM_PHASE(pg8::EpiSwiglu, XB, W3, 2 * FFN, D, E); }
    if (bx >= 128 && bx - 128 < FFN / 32) {
        const int u = bx - 128; const SEpiSwiglu Es{(bf16*)(ws + WS_SH), (const float*)(ws + WS_SSS), 32};
        const bf16* bg = W3 + (size_t)2 * FFN * D + (size_t)((u >> 2) * 256 + (u & 3) * 32) * D;
        sgemm_unit<4>(lds, (const bf16*)(ws + WS_SXB), bg, bg + (size_t)128 * D, D, Es, 0, u, wave, lane); }
#if REPG == 3
    xcd_barrier(bar);
    { pg8::EpiSwiglu E{(pg8::bf16_t*)HB, FFN, SS, 16};
      GEMM_PHASE(pg8::EpiSwiglu, XB, W3, 2 * FFN, D, E); }
#endif
    xcd_barrier(bar);
    { pg8::EpiRes<false, 1> E{nullptr, nullptr, (pg8::bf16_t*)XB, SS};
      GEMM_PHASE(SINGLE_ARG(pg8::EpiRes<false, 1>), HB, W4, D, FFN, E); }
    xcd_barrier(bar);
    {
        const ldsp wl = lds + wave * 12800;
        STAMP(9);
        if (wave < 2) for (int it = vcu * 2 + wave; it < 512; it += G * 2) s5_wave(a, wl, false, it / 64, 0, it % 64, lane);
        STAMP(10);
    }
    xcd_barrier(bar);
    STAMP(11);
    { pg8::EpiRes<true, 1> E{nullptr, nullptr, (pg8::bf16_t*)XB, SS};
      GEMM_PHASE(SINGLE_ARG(pg8::EpiRes<true, 1>), YB, W5, 2 * D, D, E); }
    xcd_barrier(bar);
    { pg8::EpiSwiglu E{(pg8::bf16_t*)HB, FFN, SS, 32};
      GEMM_PHASE(pg8::EpiSwiglu, XB, W3 + (size_t)2 * FFN * D, 2 * FFN, D, E); }
    if (bx >= 128 && bx - 128 < D / 32) {
        const int u = bx - 128; const SEpiRes<false> Es{(const float*)(ws + WS_SX), a.out + O_YS, (bf16*)(ws + WS_SXB), (float*)(ws + WS_SSS)};
        sgemm_unit<2>(lds, (const bf16*)(ws + WS_SH), W4 + (size_t)D * FFN + (size_t)u * 32 * FFN, nullptr, FFN, Es, 0, u, wave, lane); }
    xcd_barrier(bar);
    { pg8::EpiRes<false, 2> E{nullptr, a.out + O_YP, (pg8::bf16_t*)XB, SS};
      GEMM_PHASE(SINGLE_ARG(pg8::EpiRes<false, 2>), HB, W4 + (size_t)D * FFN, D, FFN, E); }
    xcd_barrier(bar);
    for (int m = (G * NWAVES - 1 - gw); m < MS; m += ngw) {
        f32x4* xr = (f32x4*)(a.out + O_YS + (size_t)m * D) + lane;
        const float rs = pg8::row_rstd((const float*)(ws + WS_SSS), m, 32);
#pragma unroll
        for (int j = 0; j < 4; ++j) { const f32x4 gn = *((const f32x4*)a.in[8] + lane + 64 * j); xr[64 * j] = xr[64 * j] * rs * gn; }
    }
    for (int m = gw; m < MP; m += ngw) {
        f32x4* xr = (f32x4*)(a.out + O_YP + (size_t)m * D) + lane;
        const float rs = pg8::row_rstd(SS, m, 16);
#pragma unroll
        for (int j = 0; j < 4; ++j) { const f32x4 gn = *((const f32x4*)a.in[8] + lane + 64 * j); xr[64 * j] = xr[64 * j] * rs * gn; }
    }
    STAMP(12);
#if TPROBE
    xcd_barrier(bar);
    if (vcu == TP_BLK && tid == 0) { const unsigned long long t0_ = __builtin_amdgcn_s_memrealtime(), dt_ = tp_e - tp_s; while (__builtin_amdgcn_s_memrealtime() - t0_ < dt_) __builtin_amdgcn_s_sleep(8); }
#endif
#undef GEMM_PHASE
}

extern "C" void kernel_launch(void* const* d_in, const int* in_sizes, int n_in, void* d_out, int out_size, void* d_ws, size_t ws_size, hipStream_t stream) {
    static int grid = 0;
    if (grid == 0) {
        if (n_in != 26 || (size_t)out_size != O_END || ws_size < WS_END) { fprintf(stderr, "kernel_launch: unexpected shapes: n_in %d out %d ws %zu (need %zu)\n", n_in, out_size, ws_size, (size_t)WS_END); grid = -1; return; }
        int dev = 0, cus = 0, per_cu = 0;
        if (hipGetDevice(&dev) != hipSuccess || hipDeviceGetAttribute(&cus, hipDeviceAttributeMultiprocessorCount, dev) != hipSuccess) { grid = -1; return; }
        if (hipFuncSetAttribute((const void*)hybrid_fwd, hipFuncAttributeMaxDynamicSharedMemorySize, LDS_BYTES) != hipSuccess) { fprintf(stderr, "kernel_launch: hipFuncSetAttribute failed\n"); grid = -1; return; }
        if (hipOccupancyMaxActiveBlocksPerMultiprocessor(&per_cu, (const void*)hybrid_fwd, NTHREADS, LDS_BYTES) != hipSuccess || per_cu < 1) { fprintf(stderr, "kernel_launch: occupancy query says %d\n", per_cu); (void)hipGetLastError(); per_cu = 1; }
        grid = cus;
    }
    if (grid < 0) return;
    (void)hipMemsetAsync((char*)d_ws + WS_CTL, 0, CTL_ZERO_BYTES, stream);
    Args a{};
    for (int i = 0; i < 26; ++i) a.in[i] = (const float*)d_in[i];
    a.out = (float*)d_out; a.ws = (unsigned char*)d_ws;
    hipLaunchKernelGGL(hybrid_fwd, dim3(grid), dim3(NTHREADS), LDS_BYTES, stream, a);
}
```

```cpp
#define DBG_STOP 0
#define REP_DN 1
#define REP_S5 1
#define REP_P0 1
#define REPG 0
#define TPROBE 0
#define DNP_S 0
#define DNP_E 0
#define RPA 1
#define RPB 1
#define RPE 1
#define RPF 1
#define RPO 1
#include <hip/hip_runtime.h>
#include <cstdio>
#include <cstdint>
namespace pg8 {
#define PG8_LAS __attribute__((address_space(3)))
typedef unsigned short bf16_t;
typedef short bf16x8 __attribute__((ext_vector_type(8)));
typedef float f32x4 __attribute__((ext_vector_type(4)));
typedef unsigned u32x4 __attribute__((ext_vector_type(4)));
constexpr int BM = 256, BK = 64, HALF = 128, HTB = HALF * BK * 2  , STAGE_BYTES = 8 * HTB, NXCD = 8, WGM = 8;

__host__ __device__ __forceinline__ int lds_byte(int r, int c) { const int st = (r >> 4) * 2 + (c >> 5), rr = r & 15, cc = c & 31, ob = rr * 64 + cc * 2; return st * 1024 + (ob ^ (((ob >> 9) & 1) << 5)); }
__host__ __device__ __forceinline__ void stage_rc(int b, int& R, int& C) { const int st = b / 1024, sb = b % 1024, swz = sb ^ (((sb >> 9) & 1) << 5); R = (st >> 1) * 16 + swz / 64; C = (st & 1) * 32 + (swz % 64) / 2; }
__host__ __device__ __forceinline__ int perm32(int rho) { const int n = rho >> 4, i = rho & 15; return 8 * (i >> 2) + 4 * n + (i & 3); }

struct Unit { int pm, pn; };
struct Gemm { const bf16_t* A; const bf16_t* Bt; int M, N, K; };

struct StaticOrder {
    int nM, nN, nwg, G, c;
    __host__ __device__ void init(int M, int N, int G_, int c_) { nM = M / BM; nN = N / BM; nwg = nM * nN; G = G_; c = c_; }
    __host__ __device__ bool next(int i, Unit& u) const {
        const long L = (long)i * G + c; if (L >= nwg) return false;
        int wgid = (int)L; { const int q = nwg / NXCD, r = nwg % NXCD, xcd = wgid % NXCD, off = wgid / NXCD; wgid = (xcd < r ? xcd * (q + 1) : r * (q + 1) + (xcd - r) * q) + off; }
        const int nig = WGM * nN, gid = wgid / nig, fm = gid * WGM, gsz = (nM - fm) < WGM ? (nM - fm) : WGM;
        u.pm = fm + ((wgid % nig) % gsz); u.pn = (wgid % nig) / gsz; return true;
    }
    __device__ __forceinline__ void a_ready(const Unit&) const {}
    __device__ __forceinline__ void done(const Unit&) const {}
};
typedef float f32x2c __attribute__((ext_vector_type(2))); typedef __bf16 bf16x2c __attribute__((ext_vector_type(2)));
__device__ __forceinline__ unsigned cvt_pk_bf16(float lo, float hi) { const f32x2c v = {lo, hi}; return __builtin_bit_cast(unsigned, __builtin_convertvector(v, bf16x2c)); }
typedef unsigned u32x2 __attribute__((ext_vector_type(2)));
constexpr int SS_LD = 32;
constexpr float RMS_EPS = 1e-6f;
__device__ __forceinline__ float silu_f(float x) { return x * __builtin_amdgcn_rcpf(1.0f + __expf(-x)); }
__device__ __forceinline__ float sigmoid_f(float x) { return __builtin_amdgcn_rcpf(1.0f + __expf(-x)); }
__device__ __forceinline__ float row_rstd(const float* ss, int row, int nparts) {
    const f32x4* p = (const f32x4*)(ss + (size_t)row * SS_LD); float s = 0.f;
    for (int i = 0; i < nparts / 4; ++i) { const f32x4 v = p[i]; s += (v[0] + v[1]) + (v[2] + v[3]); }
    return rsqrtf(s * (1.0f / 1024.0f) + RMS_EPS);
}
__device__ __forceinline__ void rows_rstd(const float* ss, int row0, int nparts, int fq, float (&rs)[2][4]) {
    f32x4 q[2][4];
#pragma unroll
    for (int ai = 0; ai < 2; ++ai)
#pragma unroll
        for (int m = 0; m < 4; ++m) { const float* p = ss + (size_t)(row0 + ai * HALF + m * 16) * SS_LD + 4 * fq; q[ai][m] = *(const f32x4*)p; if (nparts == 32) q[ai][m] += *(const f32x4*)(p + 16); }
#pragma unroll
    for (int ai = 0; ai < 2; ++ai)
#pragma unroll
        for (int m = 0; m < 4; ++m) { float s = (q[ai][m][0] + q[ai][m][1]) + (q[ai][m][2] + q[ai][m][3]); s += __shfl_xor(s, 16); s += __shfl_xor(s, 32); rs[ai][m] = rsqrtf(s * (1.0f / 1024.0f) + RMS_EPS); }
}
struct EpiProj {
    static constexpr bool PERM = true, AFTER_DRAIN = false;
    bf16_t* O; const float* ss; int nparts;
    __device__ __forceinline__ void operator()(const f32x4 (&acc)[2][2][4][2], const Unit& u, int wr, int wc, int fr, int fq) const {
        const int row0 = u.pm * BM + wr * 64 + fr;
        float rs[2][4]; rows_rstd(ss, row0, nparts, fq, rs);
        {
            const int col0 = u.pn * BM + wc * 32 + 8 * fq; const bool act = u.pn >= 16;
#pragma unroll
            for (int ai = 0; ai < 2; ++ai)
#pragma unroll
                for (int m = 0; m < 4; ++m) { const int row = row0 + ai * HALF + m * 16; bf16_t* rowp = O + (size_t)row * 6144 + col0; const float r = rs[ai][m];
#pragma unroll
                    for (int bj = 0; bj < 2; ++bj) { f32x4 v0 = acc[ai][bj][m][0] * r, v1 = acc[ai][bj][m][1] * r;
                        if (act) {
#pragma unroll
                            for (int j = 0; j < 4; ++j) { v0[j] = silu_f(v0[j]); v1[j] = silu_f(v1[j]); } }
                        u32x4 w; w.x = cvt_pk_bf16(v0[0], v0[1]); w.y = cvt_pk_bf16(v0[2], v0[3]); w.z = cvt_pk_bf16(v1[0], v1[1]); w.w = cvt_pk_bf16(v1[2], v1[3]);
                        *(u32x4*)(rowp + bj * HALF) = w; }
                    }
        }
    }
};
struct EpiSwiglu {
    static constexpr bool PERM = true, AFTER_DRAIN = false;
    bf16_t* O; int ldo; const float* ss; int nparts;
    __device__ __forceinline__ void operator()(const f32x4 (&acc)[2][2][4][2], const Unit& u, int wr, int wc, int fr, int fq) const {
        const int row0 = u.pm * BM + wr * 64 + fr, col0 = u.pn * HALF + wc * 32 + 8 * fq;
        float rs[2][4]; rows_rstd(ss, row0, nparts, fq, rs);
#pragma unroll
        for (int ai = 0; ai < 2; ++ai)
#pragma unroll
            for (int m = 0; m < 4; ++m) { const int row = row0 + ai * HALF + m * 16; const float r = rs[ai][m];
                f32x4 h0, h1;
#pragma unroll
                for (int j = 0; j < 4; ++j) { h0[j] = silu_f(acc[ai][0][m][0][j] * r) * (acc[ai][1][m][0][j] * r); h1[j] = silu_f(acc[ai][0][m][1][j] * r) * (acc[ai][1][m][1][j] * r); }
                u32x4 w; w.x = cvt_pk_bf16(h0[0], h0[1]); w.y = cvt_pk_bf16(h0[2], h0[3]); w.z = cvt_pk_bf16(h1[0], h1[1]); w.w = cvt_pk_bf16(h1[2], h1[3]);
                *(u32x4*)(O + (size_t)row * ldo + col0) = w; }
    }
};
template <bool GLU, int MODE> struct EpiRes {
    static constexpr bool PERM = true, AFTER_DRAIN = false;
    const float* base; float* out; bf16_t* XB; float* ss;
    __device__ __forceinline__ void operator()(const f32x4 (&acc)[2][2][4][2], const Unit& u, int wr, int wc, int fr, int fq) const {
        const int col0 = (GLU ? u.pn * HALF : u.pn * BM) + wc * 32 + 8 * fq;
#pragma unroll
        for (int ai = 0; ai < 2; ++ai) {
#pragma unroll
            for (int m = 0; m < 4; ++m) { const int row = u.pm * BM + ai * HALF + wr * 64 + m * 16 + fr;
                const size_t off = (size_t)row * 1024 + col0;
                float sq = 0.f;
#pragma unroll
                for (int bj = 0; bj < (GLU ? 1 : 2); ++bj) { const int c = bj * HALF; f32x4 v0, v1;
                    if (GLU) {
#pragma unroll
                        for (int j = 0; j < 4; ++j) { v0[j] = acc[ai][0][m][0][j] * sigmoid_f(acc[ai][1][m][0][j]); v1[j] = acc[ai][0][m][1][j] * sigmoid_f(acc[ai][1][m][1][j]); }
                    } else { v0 = acc[ai][bj][m][0]; v1 = acc[ai][bj][m][1]; }
                    f32x4 b0, b1;
                    if (MODE == 0) { b0 = *(const f32x4*)(base + off + c); b1 = *(const f32x4*)(base + off + c + 4); }
                    else { const u32x4 bw = *(const u32x4*)(XB + off + c);
                        b0 = (f32x4){__builtin_bit_cast(float, bw.x << 16), __builtin_bit_cast(float, bw.x & 0xffff0000u), __builtin_bit_cast(float, bw.y << 16), __builtin_bit_cast(float, bw.y & 0xffff0000u)};
                        b1 = (f32x4){__builtin_bit_cast(float, bw.z << 16), __builtin_bit_cast(float, bw.z & 0xffff0000u), __builtin_bit_cast(float, bw.w << 16), __builtin_bit_cast(float, bw.w & 0xffff0000u)}; }
                    const f32x4 o0 = b0 + v0, o1 = b1 + v1;
                    sq += ((o0[0] * o0[0] + o0[1] * o0[1]) + (o0[2] * o0[2] + o0[3] * o0[3])) + ((o1[0] * o1[0] + o1[1] * o1[1]) + (o1[2] * o1[2] + o1[3] * o1[3]));
                    if (MODE == 2) { *(f32x4*)(out + off + c) = o0; *(f32x4*)(out + off + c + 4) = o1; }
                    else { u32x4 w; w.x = cvt_pk_bf16(o0[0], o0[1]); w.y = cvt_pk_bf16(o0[2], o0[3]); w.z = cvt_pk_bf16(o1[0], o1[1]); w.w = cvt_pk_bf16(o1[2], o1[3]); *(u32x4*)(XB + off + c) = w; } }
                sq += __shfl_xor(sq, 16); sq += __shfl_xor(sq, 32);
                if (fq == 0) ss[(size_t)row * SS_LD + u.pn * 4 + wc] = sq; }
        }
    }
};

struct EpiFinal {
    static constexpr bool PERM = false, AFTER_DRAIN = true;
    const bf16_t* XB; float* out; const float* gfin; float* xbuf; unsigned* cnt;
    __device__ __forceinline__ void fused(f32x4 (&acc)[2][2][4][2], const Unit& u, int wr, int wc, int fr, int fq, PG8_LAS unsigned char* lds, int wid, int lane) const {
        PG8_LAS float* P = (PG8_LAS float*)lds;
        PG8_LAS float* S = (PG8_LAS float*)(lds + 8192);
        const int col0 = u.pn * BM + wc * 32 + 4 * fq;
#pragma unroll
        for (int ai = 0; ai < 2; ++ai)
#pragma unroll
            for (int m = 0; m < 4; ++m) { const int rl = ai * HALF + wr * 64 + m * 16 + fr; const size_t off = (size_t)(u.pm * BM + rl) * 1024 + col0; float sq = 0.f;
#pragma unroll
                for (int bj = 0; bj < 2; ++bj)
#pragma unroll
                    for (int n = 0; n < 2; ++n) { const u32x2 bw = *(const u32x2*)(XB + off + bj * HALF + n * 16);
                        const f32x4 b = (f32x4){__builtin_bit_cast(float, bw.x << 16), __builtin_bit_cast(float, bw.x & 0xffff0000u), __builtin_bit_cast(float, bw.y << 16), __builtin_bit_cast(float, bw.y & 0xffff0000u)};
                        const f32x4 o = b + acc[ai][bj][m][n]; acc[ai][bj][m][n] = o; sq += (o[0] * o[0] + o[1] * o[1]) + (o[2] * o[2] + o[3] * o[3]); }
                sq += __shfl_xor(sq, 16); sq += __shfl_xor(sq, 32);
                if (fq == 0) P[rl * 4 + wc] = sq; }
        asm volatile("s_waitcnt lgkmcnt(0)" ::: "memory"); __builtin_amdgcn_s_barrier(); asm volatile("" ::: "memory");
        const int row = wid * 32 + (lane & 31);
        if (lane < 32) { const float t = (P[row * 4 + 0] + P[row * 4 + 1]) + (P[row * 4 + 2] + P[row * 4 + 3]);
            __hip_atomic_store(xbuf + (size_t)(u.pm * BM + row) * 4 + u.pn, t, __ATOMIC_RELAXED, __HIP_MEMORY_SCOPE_AGENT); }
        asm volatile("s_waitcnt vmcnt(0)" ::: "memory");
        if (lane == 0) __hip_atomic_fetch_add(cnt + 64 * u.pm, 1u, __ATOMIC_RELAXED, __HIP_MEMORY_SCOPE_AGENT);
        if (wid == 0) {
            const unsigned long long t0 = __builtin_amdgcn_s_memrealtime();
            while ((unsigned)__builtin_amdgcn_readfirstlane(__hip_atomic_load(cnt + 64 * u.pm, __ATOMIC_RELAXED, __HIP_MEMORY_SCOPE_AGENT)) < 32u) {
                if (__builtin_amdgcn_s_memrealtime() - t0 > 2000000ull) break;
                __builtin_amdgcn_s_sleep(2); }
            __builtin_amdgcn_fence(__ATOMIC_ACQUIRE, "agent");
        }
        asm volatile("s_waitcnt vmcnt(0) lgkmcnt(0)" ::: "memory"); __builtin_amdgcn_s_barrier(); asm volatile("" ::: "memory");
        if (lane < 32) { const float* sl = xbuf + (size_t)(u.pm * BM + row) * 4; float t = 0.f;
#pragma unroll
            for (int k = 0; k < 4; ++k) t += __hip_atomic_load(sl + k, __ATOMIC_RELAXED, __HIP_MEMORY_SCOPE_AGENT);
            S[row] = rsqrtf(t * (1.0f / 1024.0f) + RMS_EPS); }
        asm volatile("s_waitcnt lgkmcnt(0)" ::: "memory"); __builtin_amdgcn_s_barrier(); asm volatile("" ::: "memory");
#pragma unroll
        for (int ai = 0; ai < 2; ++ai)
#pragma unroll
            for (int m = 0; m < 4; ++m) { const int rl = ai * HALF + wr * 64 + m * 16 + fr; const float rs = S[rl]; const size_t off = (size_t)(u.pm * BM + rl) * 1024 + col0;
#pragma unroll
                for (int bj = 0; bj < 2; ++bj)
#pragma unroll
                    for (int n = 0; n < 2; ++n) { const int c = bj * HALF + n * 16; const f32x4 g = *(const f32x4*)(gfin + col0 + c); *(f32x4*)(out + off + c) = acc[ai][bj][m][n] * rs * g; } }
    }
};

template <class Epi, class Sched, bool ALIGN_EPI = false, bool SP2 = false>
__device__ __forceinline__ void gemm_phase(PG8_LAS unsigned char* lds, const Gemm g, const Sched& S, const Epi& E) {
    int tid_o = threadIdx.x; asm volatile("" : "+v"(tid_o));
    const int tid = tid_o, wid = __builtin_amdgcn_readfirstlane(tid >> 6), lane = tid & 63, wr = wid >> 2, wc = wid & 3, fr = lane & 15, fq = lane >> 4;
    const int K = g.K, nt = K / BK;
    unsigned voffA[2], voffB[2];
#pragma unroll
    for (int i = 0; i < 2; ++i) { int R, C; stage_rc(tid * 16 + i * 8192, R, C); const int Rb = Epi::PERM ? ((R & ~31) + perm32(R & 31)) : R;
        voffA[i] = (unsigned)(R * K + C) * 2u; voffB[i] = (unsigned)(Rb * K + C) * 2u; }
    const size_t kstep = (size_t)(BK * 2);
    const size_t hstep = (size_t)HALF * K * 2;
    const size_t tstep = 2 * hstep;
    const unsigned ldsw = (unsigned)wid * 1024u;
    const int aoff = lds_byte(wr * 64 + fr, fq * 8), boff = lds_byte(wc * 32 + fr, fq * 8);
#define PG8_SA(b, h) (((b) * 2 + (h)) * HTB)
#define PG8_SB(b, h) ((4 + (b) * 2 + (h)) * HTB)
#define PG8_STAGE(bufoff, gbase, voff) do { _Pragma("unroll") for (int _i = 0; _i < 2; ++_i) \
        __builtin_amdgcn_global_load_lds((const unsigned*)((const char*)(gbase) + (voff)[_i]), (PG8_LAS unsigned*)(lds + (bufoff) + ldsw + _i * 8192), 16, 0, 0); } while (0)
#define PG8_LDA(dst, b, h) do { _Pragma("unroll") for (int m = 0; m < 4; ++m) _Pragma("unroll") for (int k = 0; k < 2; ++k) dst[m][k] = *(const PG8_LAS bf16x8*)(lds + PG8_SA(b, h) + aoff + m * 2048 + k * 1024); } while (0)
#define PG8_LDB(dst, b, h) do { _Pragma("unroll") for (int n = 0; n < 2; ++n) _Pragma("unroll") for (int k = 0; k < 2; ++k) dst[n][k] = *(const PG8_LAS bf16x8*)(lds + PG8_SB(b, h) + boff + n * 2048 + k * 1024); } while (0)
#define PG8_MMA(ai, bj, At, Bt) do { __builtin_amdgcn_s_setprio(1); _Pragma("unroll") for (int m = 0; m < 4; ++m) _Pragma("unroll") for (int n = 0; n < 2; ++n) _Pragma("unroll") for (int k = 0; k < 2; ++k) \
        acc[ai][bj][m][n] = __builtin_amdgcn_mfma_f32_16x16x32_bf16(Bt[n][k], At[m][k], acc[ai][bj][m][n], 0, 0, 0); __builtin_amdgcn_s_setprio(0); } while (0)
#define PG8_WAIT_V(n) asm volatile("s_waitcnt vmcnt(" #n ")" ::: "memory")
#define PG8_WAIT_L(n) asm volatile("s_waitcnt lgkmcnt(" #n ")" ::: "memory")
#define PG8_BAR __builtin_amdgcn_s_barrier()
#define PG8_SCHED __builtin_amdgcn_sched_barrier(0)
    Unit cur, nxt; int ui = 0;
    if (!S.next(0, cur)) return;
    f32x4 acc[2][2][4][2];
#pragma unroll
    for (int a = 0; a < 2; ++a)
#pragma unroll
        for (int b = 0; b < 2; ++b)
#pragma unroll
            for (int m = 0; m < 4; ++m)
#pragma unroll
                for (int n = 0; n < 2; ++n) acc[a][b][m][n] = (f32x4){0.f, 0.f, 0.f, 0.f};
    bf16x8 At[4][2], B0[2][2], B1[2][2];
    const char* cA = (const char*)g.A + (size_t)cur.pm * tstep; const char* cB = (const char*)g.Bt + (size_t)cur.pn * tstep;
    S.a_ready(cur);
    if constexpr (SP2) {
        PG8_STAGE(PG8_SB(0, 0), cB, voffB); PG8_STAGE(PG8_SB(0, 1), cB + hstep, voffB); PG8_STAGE(PG8_SA(0, 0), cA, voffA); PG8_STAGE(PG8_SA(0, 1), cA + hstep, voffA);
        if (wr == 1) PG8_BAR;
        PG8_WAIT_V(2); PG8_BAR;
        PG8_STAGE(PG8_SB(1, 0), cB + kstep, voffB); PG8_STAGE(PG8_SA(1, 0), cA + kstep, voffA); PG8_STAGE(PG8_SB(1, 1), cB + hstep + kstep, voffB);
        PG8_WAIT_V(6); PG8_BAR;
    } else {
        PG8_STAGE(PG8_SB(0, 0), cB, voffB); PG8_STAGE(PG8_SA(0, 0), cA, voffA); PG8_STAGE(PG8_SB(0, 1), cB + hstep, voffB); PG8_STAGE(PG8_SA(0, 1), cA + hstep, voffA);
        if (wr == 1) PG8_BAR;
        PG8_WAIT_V(4); PG8_BAR;
        PG8_STAGE(PG8_SB(1, 0), cB + kstep, voffB); PG8_STAGE(PG8_SA(1, 0), cA + kstep, voffA); PG8_STAGE(PG8_SB(1, 1), cB + hstep + kstep, voffB);
        PG8_WAIT_V(6); PG8_BAR;
    }
    for (;;) {
        const bool has_next = S.next(ui + 1, nxt);
        const char* nA = has_next ? (const char*)g.A + (size_t)nxt.pm * tstep : cA; const char* nB = has_next ? (const char*)g.Bt + (size_t)nxt.pn * tstep : cB;
        for (int t = 0; t < nt; t += 2) {
            const bool last = (t == nt - 2);
            const char* a1 = cA + (size_t)(t + 1) * kstep;
            const char* a2 = last ? nA : cA + (size_t)(t + 2) * kstep; const char* b2 = last ? nB : cB + (size_t)(t + 2) * kstep;
            const char* a3 = a2 + kstep; const char* b3 = b2 + kstep;
            if (last && has_next) S.a_ready(nxt);
            if constexpr (SP2) {
            PG8_LDB(B0, 0, 0); PG8_LDB(B1, 0, 1); PG8_SCHED; PG8_LDA(At, 0, 0); PG8_STAGE(PG8_SA(1, 1), a1 + hstep, voffA);
            PG8_WAIT_V(8); PG8_WAIT_L(0); PG8_BAR; PG8_MMA(0, 0, At, B0); PG8_MMA(0, 1, At, B1); PG8_BAR; PG8_SCHED;
            PG8_LDA(At, 0, 1); PG8_STAGE(PG8_SB(0, 0), b2, voffB); PG8_STAGE(PG8_SB(0, 1), b2 + hstep, voffB); PG8_STAGE(PG8_SA(0, 0), a2, voffA);
            PG8_WAIT_V(8); PG8_WAIT_L(0); PG8_BAR; PG8_MMA(1, 0, At, B0); PG8_MMA(1, 1, At, B1); PG8_BAR; PG8_SCHED;
            PG8_LDB(B0, 1, 0); PG8_LDB(B1, 1, 1); PG8_SCHED; PG8_LDA(At, 1, 0); PG8_STAGE(PG8_SA(0, 1), a2 + hstep, voffA);
            PG8_WAIT_V(8); PG8_WAIT_L(0); PG8_BAR; PG8_MMA(0, 0, At, B0); PG8_MMA(0, 1, At, B1); PG8_BAR; PG8_SCHED;
            PG8_LDA(At, 1, 1); PG8_STAGE(PG8_SB(1, 0), b3, voffB); PG8_STAGE(PG8_SB(1, 1), b3 + hstep, voffB); PG8_STAGE(PG8_SA(1, 0), a3, voffA);
            PG8_WAIT_V(8); PG8_WAIT_L(0); PG8_BAR; PG8_MMA(1, 0, At, B0); PG8_MMA(1, 1, At, B1); PG8_BAR; PG8_SCHED;
            } else {
            PG8_LDB(B0, 0, 0); PG8_SCHED; PG8_LDA(At, 0, 0); PG8_STAGE(PG8_SA(1, 1), a1 + hstep, voffA);
            PG8_WAIT_L(8); PG8_BAR; PG8_WAIT_L(0); PG8_MMA(0, 0, At, B0); PG8_BAR; PG8_SCHED;
            PG8_LDB(B1, 0, 1); PG8_STAGE(PG8_SB(0, 0), b2, voffB);
            PG8_BAR; PG8_WAIT_L(0); PG8_MMA(0, 1, At, B1); PG8_BAR;
            PG8_LDA(At, 0, 1); PG8_STAGE(PG8_SA(0, 0), a2, voffA);
            PG8_BAR; PG8_WAIT_L(0); PG8_MMA(1, 0, At, B0); PG8_BAR; PG8_SCHED;
            PG8_STAGE(PG8_SB(0, 1), b2 + hstep, voffB);
            PG8_WAIT_V(6); PG8_BAR; PG8_MMA(1, 1, At, B1); PG8_BAR;
            PG8_LDB(B0, 1, 0); PG8_SCHED; PG8_LDA(At, 1, 0); PG8_STAGE(PG8_SA(0, 1), a2 + hstep, voffA);
            PG8_WAIT_L(8); PG8_BAR; PG8_WAIT_L(0); PG8_MMA(0, 0, At, B0); PG8_BAR; PG8_SCHED;
            PG8_LDB(B1, 1, 1); PG8_STAGE(PG8_SB(1, 0), b3, voffB);
            PG8_BAR; PG8_WAIT_L(0); PG8_MMA(0, 1, At, B1); PG8_BAR;
            PG8_LDA(At, 1, 1); PG8_STAGE(PG8_SA(1, 0), a3, voffA);
            PG8_BAR; PG8_WAIT_L(0); PG8_MMA(1, 0, At, B0); PG8_BAR; PG8_SCHED;
            PG8_STAGE(PG8_SB(1, 1), b3 + hstep, voffB);
            PG8_WAIT_V(6); PG8_BAR; PG8_MMA(1, 1, At, B1); PG8_BAR;
            }
        }
        if constexpr (ALIGN_EPI) { if (wr == 0) PG8_BAR; }
        if constexpr (!Epi::AFTER_DRAIN) { E(acc, cur, wr, wc, fr, fq); S.done(cur); }
        if (!has_next) break;
#pragma unroll
        for (int a = 0; a < 2; ++a)
#pragma unroll
            for (int b = 0; b < 2; ++b)
#pragma unroll
                for (int m = 0; m < 4; ++m)
#pragma unroll
                    for (int n = 0; n < 2; ++n) acc[a][b][m][n] = (f32x4){0.f, 0.f, 0.f, 0.f};
        cur = nxt; cA = nA; cB = nB; ++ui;
        if constexpr (ALIGN_EPI) { if (wr == 1) PG8_BAR; }
    }
    PG8_WAIT_V(0);
    if constexpr (!ALIGN_EPI) { if (wr == 0) PG8_BAR; }
    PG8_BAR;
    if constexpr (Epi::AFTER_DRAIN) { E.fused(acc, cur, wr, wc, fr, fq, lds, wid, lane); S.done(cur); }
#undef PG8_SA
#undef PG8_SB
#undef PG8_STAGE
#undef PG8_LDA
#undef PG8_LDB
#undef PG8_MMA
#undef PG8_WAIT_V
#undef PG8_WAIT_L
#undef PG8_BAR
#undef PG8_SCHED
}
}
constexpr int NWAVES = 8, NTHREADS = 512;
constexpr int D = 1024, SEQ = 2048, NB = 8, MP = NB * SEQ  , MS = 128  ;
constexpr int DN_IN = 6176, PROJ_LD = 6144, VAL = 2048, FFN = 2816, NH = 16, CHUNK = 64, NCHUNK = SEQ / CHUNK;
constexpr size_t MiB = 1u << 20;
constexpr size_t WS_CTL = 0, CTL_ZERO_BYTES = 64 * 1024;
constexpr size_t WS_W1 = 1 * MiB;
constexpr size_t WS_W2 = WS_W1 + (size_t)6400 * D * 2;
constexpr size_t WS_W5 = WS_W2 + (size_t)D * VAL * 2;
constexpr size_t WS_W3 = WS_W5 + (size_t)2 * D * D * 2;
constexpr size_t WS_W4 = WS_W3 + (size_t)2 * 2 * FFN * D * 2;
constexpr size_t WS_SS = WS_W4 + (size_t)2 * D * FFN * 2;
constexpr size_t WS_BETA = WS_SS + (size_t)MP * 32 * 4;
constexpr size_t WS_GDEC = WS_BETA + (size_t)MP * 16 * 4;
constexpr size_t WS_SSS = WS_GDEC + (size_t)MP * 16 * 4;
constexpr size_t WS_SBETA = WS_SSS + (size_t)MS * 32 * 4;
constexpr size_t WS_SGDEC = WS_SBETA + (size_t)MS * 16 * 4;
constexpr size_t WS_SXB = WS_SGDEC + (size_t)MS * 16 * 4;
constexpr size_t WS_SX = WS_SXB + (size_t)MS * D * 2;
constexpr size_t WS_SPROJ = WS_SX + (size_t)MS * D * 4;
constexpr size_t WS_SGATED = WS_SPROJ + (size_t)MS * PROJ_LD * 2;
constexpr size_t WS_SH = WS_SGATED + (size_t)MS * VAL * 2;
constexpr size_t WS_SYB = WS_SH + (size_t)MS * FFN * 2;
constexpr size_t WS_S5LAM = WS_SYB + (size_t)MS * D * 2;
constexpr size_t WS_S5BB = WS_S5LAM + 64 * 64 * 2 * 4;
constexpr size_t WS_S5CM = WS_S5BB + 64 * 128 * 16 * 2;
constexpr size_t WS_S5DSK = WS_S5CM + 64 * 16 * 128 * 2;
constexpr size_t WS_GC = WS_S5DSK + 1024 * 4;
constexpr size_t WS_BT = WS_GC + (size_t)MP * 16 * 4;
constexpr size_t WS_FX = WS_BT + (size_t)MP * 16 * 4;
constexpr size_t WS_XB = (WS_FX + (size_t)MP * 4 * 4 + 4095) / 4096 * 4096;
constexpr size_t WS_X = WS_XB + (size_t)MP * D * 2;
constexpr size_t WS_YB = WS_X + (size_t)MP * D * 4;
constexpr size_t WS_GATED = WS_YB + (size_t)MP * D * 2;
constexpr size_t WS_QKVC = WS_XB;
static_assert(WS_QKVC + (size_t)MP * 4096 * 2 <= WS_GATED, "QKVC overlay");
constexpr size_t WS_PROJ = WS_GATED + (size_t)MP * VAL * 2;
constexpr size_t WS_H = WS_PROJ;
constexpr size_t WS_END = WS_PROJ + (size_t)MP * PROJ_LD * 2;
constexpr int CW_BAR = 4096, CW_TEAM = 8192, CW_FIN = 8192 + 64;
constexpr size_t O_YP = 0, O_YS = O_YP + (size_t)MP * D, O_SSMP = O_YS + (size_t)MS * D, O_CONVP = O_SSMP + (size_t)NB * NH * 128 * 128, O_S5RP = O_CONVP + (size_t)NB * 3 * 4096,
                 O_S5IP = O_S5RP + (size_t)NB * 64 * 64, O_SSMS = O_S5IP + (size_t)NB * 64 * 64, O_CONVS = O_SSMS + (size_t)MS * NH * 128 * 128, O_S5RS = O_CONVS + (size_t)MS * 3 * 4096,
                 O_S5IS = O_S5RS + (size_t)MS * 64 * 64, O_END = O_S5IS + (size_t)MS * 64 * 64;
constexpr int LDS_BYTES = 163840, LDSCTL_OFF = LDS_BYTES - 256;

#define GAS __attribute__((address_space(1)))
#define LAS __attribute__((address_space(3)))
typedef unsigned short bf16;
typedef float f32x4 __attribute__((ext_vector_type(4)));
typedef float f32x2 __attribute__((ext_vector_type(2)));
typedef short bf16x8 __attribute__((ext_vector_type(8)));
typedef unsigned u32x4 __attribute__((ext_vector_type(4)));
typedef unsigned u32x2 __attribute__((ext_vector_type(2)));
typedef LAS unsigned char* ldsp;
__device__ __forceinline__ unsigned pkbf(float lo, float hi) { return pg8::cvt_pk_bf16(lo, hi); }
__device__ __forceinline__ float bflo(unsigned w) { return __builtin_bit_cast(float, w << 16); }
__device__ __forceinline__ float bfhi(unsigned w) { return __builtin_bit_cast(float, w & 0xffff0000u); }
__device__ __forceinline__ float bf1(bf16 h) { return __builtin_bit_cast(float, (unsigned)h << 16); }
__device__ __forceinline__ float wave_sum(float v) {
#pragma unroll
    for (int o = 1; o < 64; o <<= 1) v += __shfl_xor(v, o);
    return v;
}
#define MFMA16(a, b, c) __builtin_amdgcn_mfma_f32_16x16x32_bf16((a), (b), (c), 0, 0, 0)
#define MM_XROW(acc, xf, yf) (acc) = MFMA16((yf), (xf), (acc))
#define MM_YROW(acc, xf, yf) (acc) = MFMA16((xf), (yf), (acc))
#define LDS_FENCE() asm volatile("s_waitcnt lgkmcnt(0)" ::: "memory")

struct Args {
    const float* in[26]; float* out; unsigned char* ws; int pad0, pad1;
};
constexpr float RMS_EPSF = 1e-6f;
#define XB_TMO      128
#define XB_XCNT(j)  (256  + 64 * (j))
#define XB_XSUB(j)  (1280 + 64 * (j))
#define XB_XGEN(j)  (2304 + 64 * (j))
#define XB_TOP      3328
#define XB_TOPGEN   3392
#define XCD_BAR_WORDS 3456
#define XB_SPIN_CAP (1u << 18)

__device__ __forceinline__ unsigned xb_ld(unsigned* p)              { return __hip_atomic_load(p, __ATOMIC_RELAXED, __HIP_MEMORY_SCOPE_AGENT); }
__device__ __forceinline__ unsigned xb_add(unsigned* p, unsigned v) { return __hip_atomic_fetch_add(p, v, __ATOMIC_RELAXED, __HIP_MEMORY_SCOPE_AGENT); }
__device__ __forceinline__ unsigned xb_xcc_id() { return (unsigned)__builtin_amdgcn_s_getreg((3 << 11) | 20) & 0xFu; }
#define XB_SPIN(cond, bar) do { unsigned _sp = 0; while (cond) { __builtin_amdgcn_s_sleep(1); \
    if ((++_sp & 255u) == 0u) { if (xb_ld(&(bar)[XB_TMO])) break; if (_sp > XB_SPIN_CAP) { atomicAdd(&(bar)[XB_TMO], 1u); break; } } } } while (0)

struct XcdBarrier {
    unsigned* bar; unsigned x;
    volatile LAS unsigned* st;
};

__device__ __forceinline__ XcdBarrier xcd_barrier_post(unsigned* bar, volatile LAS unsigned* st) {
    XcdBarrier b; b.bar = bar; b.x = xb_xcc_id(); b.st = st;
    if (threadIdx.x == 0) (void)xb_add(&bar[XB_XCNT(b.x)], 1u);
    return b;
}
__device__ __forceinline__ void xcd_barrier_complete(unsigned* bar, unsigned x, unsigned& nloc, unsigned& nx) {
    const unsigned G = gridDim.x * gridDim.y * gridDim.z;
    unsigned sum, cnt, mine, sp = 0u;
    for (;;) {
        sum = 0u; cnt = 0u; mine = 0u;
#pragma unroll
        for (unsigned j = 0; j < 16; ++j) { const unsigned c = xb_ld(&bar[XB_XCNT(j)]); sum += c; cnt += (c > 0u) ? 1u : 0u; mine = (j == x) ? c : mine; }
        if (sum == G) break;
        __builtin_amdgcn_s_sleep(1);
        if ((++sp & 255u) == 0u) { if (xb_ld(&bar[XB_TMO])) break; if (sp > XB_SPIN_CAP) { atomicAdd(&bar[XB_TMO], 1u); break; } }
    }
    nloc = mine > 0u ? mine : 1u; nx = cnt > 0u ? cnt : 1u;
}

__device__ __forceinline__ void xcd_barrier(const XcdBarrier& b) {
    asm volatile("s_waitcnt vmcnt(0)" ::: "memory");
    __syncthreads();
    if (threadIdx.x == 0) {
        unsigned* bar = b.bar;
        __builtin_amdgcn_s_waitcnt(0);
        unsigned nloc = b.st[0], nx = b.st[1];
        if (nloc == 0u) { xcd_barrier_complete(bar, b.x, nloc, nx); b.st[0] = nloc; b.st[1] = nx; }
        const unsigned old = xb_add(&bar[XB_XSUB(b.x)], 1u);
        const unsigned gen = old / nloc;
        if (old + 1u == (gen + 1u) * nloc) {
            __builtin_amdgcn_fence(__ATOMIC_RELEASE, "agent");
            asm volatile("s_waitcnt vmcnt(0)" ::: "memory");
            const unsigned og = xb_add(&bar[XB_TOP], 1u);
            const unsigned tg = og / nx;
            if (og + 1u == (tg + 1u) * nx) xb_add(&bar[XB_TOPGEN], 1u);
            else XB_SPIN(xb_ld(&bar[XB_TOPGEN]) == tg, bar);
            __builtin_amdgcn_fence(__ATOMIC_ACQUIRE, "agent");
            xb_add(&bar[XB_XGEN(b.x)], 1u);
            asm volatile("s_waitcnt vmcnt(0)" ::: "memory");
        } else {
            XB_SPIN(xb_ld(&bar[XB_XGEN(b.x)]) == gen, bar);
            __builtin_amdgcn_fence(__ATOMIC_ACQUIRE, "agent");
            asm volatile("s_waitcnt vmcnt(0)" ::: "memory");
        }
    }
    __syncthreads();
}
__device__ __forceinline__ void sg_core(const bf16* ap, const bf16* bp, int K, int steps, f32x4 (&acc)[4][2]) {
    bf16x8 ra[4][4], rb[4][2];
    const bf16* pa[4]; const bf16* pb[2];
#pragma unroll
    for (int t = 0; t < 4; ++t) pa[t] = ap + (size_t)t * 16 * K;
    pb[0] = bp; pb[1] = bp + (size_t)16 * K;
#define SG_LOAD(slot, s) do { const int ko_ = 32 * (s); _Pragma("unroll") for (int t_ = 0; t_ < 4; ++t_) ra[slot][t_] = *(const bf16x8*)(pa[t_] + ko_); \
        rb[slot][0] = *(const bf16x8*)(pb[0] + ko_); rb[slot][1] = *(const bf16x8*)(pb[1] + ko_); } while (0)
#define SG_COMP(slot) do { _Pragma("unroll") for (int t_ = 0; t_ < 4; ++t_) { MM_XROW(acc[t_][0], ra[slot][t_], rb[slot][0]); MM_XROW(acc[t_][1], ra[slot][t_], rb[slot][1]); } } while (0)
    SG_LOAD(0, 0); SG_LOAD(1, 1); SG_LOAD(2, 2);
    int s = 0;
#pragma nounroll
    for (; s + 4 <= steps; s += 4) {
        SG_LOAD(3, s + 3);
        SG_COMP(0); if (s + 4 < steps) SG_LOAD(0, s + 4);
        SG_COMP(1); if (s + 5 < steps) SG_LOAD(1, s + 5);
        SG_COMP(2); if (s + 6 < steps) SG_LOAD(2, s + 6);
        SG_COMP(3);
    }
    const int r = steps - s;
    if (r >= 1) SG_COMP(0);
    if (r >= 2) SG_COMP(1);
    if (r >= 3) SG_COMP(2);
#undef SG_LOAD
#undef SG_COMP
}
template <int NBLK, class Epi>
__device__ __forceinline__ void sgemm_unit(ldsp lds, const bf16* A, const bf16* B0, const bf16* B1, int K, const Epi& E, int row0, int cb, int wave, int lane) {
    const int fr = lane & 15, fq = lane >> 4, rh = wave & 1, kq = wave >> 1; int steps = K / 128; asm volatile("" : "+s"(steps));
    int fro = fr; asm volatile("" : "+v"(fro));
    const bf16* ap = A + (size_t)(64 * rh + fro) * K + (size_t)kq * (K / 4) + 8 * fq;
    LAS f32x4* buf = (LAS f32x4*)lds;
#pragma unroll
    for (int pass = 0; pass < NBLK / 2; ++pass) {
        f32x4 acc[4][2];
#pragma unroll
        for (int t = 0; t < 4; ++t) { acc[t][0] = (f32x4){0.f, 0.f, 0.f, 0.f}; acc[t][1] = (f32x4){0.f, 0.f, 0.f, 0.f}; }
        sg_core(ap, (pass ? B1 : B0) + (size_t)fro * K + (size_t)kq * (K / 4) + 8 * fq, K, steps, acc);
#pragma unroll
        for (int t = 0; t < 4; ++t) { buf[(kq * 32 + (rh * 4 + t) * 4 + 2 * pass) * 64 + lane] = acc[t][0]; buf[(kq * 32 + (rh * 4 + t) * 4 + 2 * pass + 1) * 64 + lane] = acc[t][1]; }
    }
    __syncthreads();
    {
        const int rt = wave >> 1;
        f32x4 o[NBLK];
#pragma unroll
        for (int j = 0; j < NBLK; ++j) { const int slot = (rh * 4 + rt) * 4 + j; o[j] = (buf[slot * 64 + lane] + buf[(32 + slot) * 64 + lane]) + (buf[(64 + slot) * 64 + lane] + buf[(96 + slot) * 64 + lane]); }
        E(o, row0 + 64 * rh + 16 * rt + fr, cb, fq);
    }
    __syncthreads();
}
struct SEpiProj {
    bf16* O; const float* ss; int nparts; float* beta; float* gdec; const float* a_log; const float* dt_bias;
    __device__ __forceinline__ void operator()(const f32x4 (&acc)[2], int row, int cb, int fq) const {
        const float rs = pg8::row_rstd(ss, row, nparts);
        if (cb < 192) {
#pragma unroll
            for (int j = 0; j < 2; ++j) { f32x4 v = acc[j] * rs;
                if (cb >= 128) {
#pragma unroll
                    for (int r = 0; r < 4; ++r) v[r] = pg8::silu_f(v[r]); }
                u32x2 w; w.x = pkbf(v[0], v[1]); w.y = pkbf(v[2], v[3]); *(u32x2*)(O + (size_t)row * PROJ_LD + 32 * cb + 16 * j + 4 * fq) = w; }
        } else {
            f32x4 b, g;
#pragma unroll
            for (int r = 0; r < 4; ++r) { b[r] = pg8::sigmoid_f(acc[0][r] * rs); const int h = 4 * fq + r; const float xx = acc[1][r] * rs + dt_bias[h]; const float ex = __expf(xx);
                const float sp = xx > 15.f ? xx : (ex < 1e-3f ? ex * (1.0f - 0.5f * ex) : __logf(1.0f + ex)); g[r] = -__expf(a_log[h]) * sp; }
            *(f32x4*)(beta + (size_t)row * 16 + 4 * fq) = b; *(f32x4*)(gdec + (size_t)row * 16 + 4 * fq) = g;
        }
    }
};
template <bool GLU> struct SEpiRes {
    const float* base; float* out; bf16* XB; float* ss;
    __device__ __forceinline__ void operator()(const f32x4 (&acc)[GLU ? 4 : 2], int row, int cb, int fq) const {
        float sq = 0.f;
#pragma unroll
        for (int j = 0; j < 2; ++j) { f32x4 v = acc[j];
            if (GLU) {
#pragma unroll
                for (int r = 0; r < 4; ++r) v[r] = v[r] * pg8::sigmoid_f(acc[2 + j][r]); }
            const size_t off = (size_t)row * D + 32 * cb + 16 * j + 4 * fq;
            const f32x4 o = *(const f32x4*)(base + off) + v; *(f32x4*)(out + off) = o;
            sq += (o[0] * o[0] + o[1] * o[1]) + (o[2] * o[2] + o[3] * o[3]);
            u32x2 w; w.x = pkbf(o[0], o[1]); w.y = pkbf(o[2], o[3]); *(u32x2*)(XB + off) = w; }
        sq += __shfl_xor(sq, 16); sq += __shfl_xor(sq, 32);
        if (fq == 0) ss[(size_t)row * 32 + cb] = sq;
    }
};
struct SEpiSwiglu {
    bf16* H; const float* ss; int nparts;
    __device__ __forceinline__ void operator()(const f32x4 (&acc)[4], int row, int cb, int fq) const {
        const float rs = pg8::row_rstd(ss, row, nparts);
#pragma unroll
        for (int j = 0; j < 2; ++j) { f32x4 h;
#pragma unroll
            for (int r = 0; r < 4; ++r) h[r] = pg8::silu_f(acc[j][r] * rs) * (acc[2 + j][r] * rs);
            u32x2 w; w.x = pkbf(h[0], h[1]); w.y = pkbf(h[2], h[3]); *(u32x2*)(H + (size_t)row * FFN + 32 * cb + 16 * j + 4 * fq) = w; }
    }
};
__device__ __forceinline__ void team_barrier(unsigned* cnt, unsigned target) {
    asm volatile("s_waitcnt vmcnt(0)" ::: "memory");
    __syncthreads();
    if (threadIdx.x == 0) {
        __builtin_amdgcn_fence(__ATOMIC_RELEASE, "agent");
        asm volatile("s_waitcnt vmcnt(0)" ::: "memory");
        (void)__hip_atomic_fetch_add(cnt, 1u, __ATOMIC_RELAXED, __HIP_MEMORY_SCOPE_AGENT);
        unsigned sp = 0;
        while (__hip_atomic_load(cnt, __ATOMIC_RELAXED, __HIP_MEMORY_SCOPE_AGENT) < target) { __builtin_amdgcn_s_sleep(2); if (++sp > (1u << 22)) break; }
        __builtin_amdgcn_fence(__ATOMIC_ACQUIRE, "agent");
        asm volatile("s_waitcnt vmcnt(0)" ::: "memory");
    }
    __syncthreads();
}
__device__ __forceinline__ void sincos_cw(float x, float& s, float& c) {
    const float k = rintf(x * 0.636619772367581343f);
    float r = fmaf(-k, 1.57079625129699707031f, x); r = fmaf(-k, 7.54978941586159635e-08f, r); r = fmaf(-k, 5.39030285815811482e-15f, r);
    const float z = r * r;
    const float sp = fmaf(fmaf(fmaf(-1.9515295891e-4f, z, 8.3321608736e-3f), z, -1.6666654611e-1f) * z, r, r);
    const float cp = fmaf(fmaf(fmaf(2.443315711809948e-5f, z, -1.388731625493765e-3f), z, 4.166664568298827e-2f), z * z, fmaf(-0.5f, z, 1.0f));
    const int q = (int)k & 3;
    const float ss = (q & 1) ? cp : sp, cc = (q & 1) ? sp : cp;
    s = (q & 2) ? -ss : ss; c = ((q + 1) & 2) ? -cc : cc;
}
__device__ __forceinline__ void s5_disc(const Args& a, int g, int p, float dt, float& lr, float& li, float& fre, float& fim) {
    const float are = a.in[15][g * 64 + p], aim = a.in[16][g * 64 + p];
    const float mag = __expf(are * dt); float sn, cs; sincos_cw(aim * dt, sn, cs);
    lr = mag * cs; li = mag * sn;
    const float den = are * are + aim * aim, nre = lr - 1.0f, nim = li;
    fre = (nre * are + nim * aim) / den; fim = (nim * are - nre * aim) / den;
}
__device__ __forceinline__ float gelu_tanh(float x) { const float u = 0.7978845608028654f * (x + 0.044715f * x * x * x); const float t = 1.0f - 2.0f * __builtin_amdgcn_rcpf(__expf(2.0f * u) + 1.0f); return 0.5f * x * (1.0f + t); }
__device__ __forceinline__ void s5_precompute(const Args& a, int idx) {
    unsigned char* ws = a.ws;
    if (idx < 4096) {
        const int g = idx >> 6, p = idx & 63;
        const float dt = __expf(a.in[17][g]);
        float lr, li, fre, fim; s5_disc(a, g, p, dt, lr, li, fre, fim);
        float* lam = (float*)(ws + WS_S5LAM) + (size_t)idx * 2; lam[0] = lr; lam[1] = li;
        const float* br = a.in[18] + (size_t)idx * 16; const float* bi = a.in[19] + (size_t)idx * 16; const float* gm = a.in[6] + D + g * 16;
        u32x4* bb = (u32x4*)((bf16*)(ws + WS_S5BB) + ((size_t)g * 128 + 2 * p) * 16);
        float vr[16], vi[16];
#pragma unroll
        for (int c = 0; c < 16; ++c) { const float re = br[c], im = bi[c], gg = gm[c]; vr[c] = (fre * re - fim * im) * gg; vi[c] = (fre * im + fim * re) * gg; }
        bb[0] = (u32x4){pkbf(vr[0], vr[1]), pkbf(vr[2], vr[3]), pkbf(vr[4], vr[5]), pkbf(vr[6], vr[7])};
        bb[1] = (u32x4){pkbf(vr[8], vr[9]), pkbf(vr[10], vr[11]), pkbf(vr[12], vr[13]), pkbf(vr[14], vr[15])};
        bb[2] = (u32x4){pkbf(vi[0], vi[1]), pkbf(vi[2], vi[3]), pkbf(vi[4], vi[5]), pkbf(vi[6], vi[7])};
        bb[3] = (u32x4){pkbf(vi[8], vi[9]), pkbf(vi[10], vi[11]), pkbf(vi[12], vi[13]), pkbf(vi[14], vi[15])};
        unsigned* cm = (unsigned*)((bf16*)(ws + WS_S5CM) + (size_t)g * 16 * 128 + 2 * p);
#pragma unroll
        for (int c = 0; c < 16; ++c) cm[c * 64] = pkbf(a.in[20][(size_t)(g * 16 + c) * 64 + p], -a.in[21][(size_t)(g * 16 + c) * 64 + p]);
    }
    if (idx < 1024) ((float*)(ws + WS_S5DSK))[idx] = a.in[22][idx] * a.in[6][D + idx];
}
__device__ __forceinline__ void p0_transpose_item(const float* W, int K, int N, const float* gain, int gluh, bf16* WT, LAS float* scr, int item, int lane) {
    const int nblk = N / 32, kb = item / nblk, nb = item % nblk, k0 = 64 * kb, n0 = 32 * nb;
    f32x4 v[8];
#pragma unroll
    for (int i = 0; i < 8; ++i) v[i] = __builtin_nontemporal_load((const f32x4*)(W + (size_t)(k0 + 8 * i + (lane >> 3)) * N + n0 + 4 * (lane & 7)));
#pragma unroll
    for (int i = 0; i < 8; ++i) { const int kk = 8 * i + (lane >> 3); const float gk = gain ? gain[k0 + kk] : 1.0f; LAS float* s = scr + kk * 33 + 4 * (lane & 7);
        s[0] = v[i][0] * gk; s[1] = v[i][1] * gk; s[2] = v[i][2] * gk; s[3] = v[i][3] * gk; }
    LDS_FENCE();
    int r0 = n0; if (gluh > 0) r0 = (n0 < gluh) ? (n0 / 128) * 256 + (n0 % 128) : ((n0 - gluh) / 128) * 256 + 128 + ((n0 - gluh) % 128);
    const int c = lane & 7;
#pragma unroll
    for (int j = 0; j < 4; ++j) { const int n = (lane >> 3) + 8 * j; const LAS float* s = scr + (8 * c) * 33 + n;
        u32x4 o; o.x = pkbf(s[0 * 33], s[1 * 33]); o.y = pkbf(s[2 * 33], s[3 * 33]); o.z = pkbf(s[4 * 33], s[5 * 33]); o.w = pkbf(s[6 * 33], s[7 * 33]);
        *(u32x4*)(WT + (size_t)(r0 + n) * K + k0 + 8 * c) = o; }
    LDS_FENCE();
}
__device__ __forceinline__ void p0_prologue(const Args& a, ldsp lds, int gw, int ngw, int wave, int lane) {
    LAS float* scr = (LAS float*)(lds + wave * 16384);
    unsigned char* ws = a.ws;
    constexpr int I1 = (D / 64) * (DN_IN / 32), I2 = (VAL / 64) * (D / 32), I5 = (D / 64) * (2 * D / 32), I3 = (D / 64) * (2 * FFN / 32), I4 = (FFN / 64) * (D / 32);
    constexpr int NITEMS = I1 + I2 + I5 + 2 * I3 + 2 * I4;
    for (int it = gw; it < NITEMS; it += ngw) {
        int r = it;
        if (r < I1) { p0_transpose_item(a.in[9], D, DN_IN, a.in[6], 0, (bf16*)(ws + WS_W1), scr, r, lane); continue; } r -= I1;
        if (r < I2) { p0_transpose_item(a.in[14], VAL, D, nullptr, 0, (bf16*)(ws + WS_W2), scr, r, lane); continue; } r -= I2;
        if (r < I5) { p0_transpose_item(a.in[23], D, 2 * D, nullptr, D, (bf16*)(ws + WS_W5), scr, r, lane); continue; } r -= I5;
        if (r < 2 * I3) { const int l = r / I3; p0_transpose_item(a.in[24] + (size_t)l * D * 2 * FFN, D, 2 * FFN, a.in[7] + l * D, FFN, (bf16*)(ws + WS_W3) + (size_t)l * 2 * FFN * D, scr, r % I3, lane); continue; } r -= 2 * I3;
        { const int l = r / I4; p0_transpose_item(a.in[25] + (size_t)l * FFN * D, FFN, D, nullptr, 0, (bf16*)(ws + WS_W4) + (size_t)l * D * FFN, scr, r % I4, lane); }
    }
    {
        f32x4 nv[4]; int m = gw;
#define P0_XLOAD(mm) do { const bool smp_ = (mm) >= MP; const int r_ = smp_ ? (mm) - MP : (mm); const f32x4* xr_ = (const f32x4*)((smp_ ? a.in[1] : a.in[0]) + (size_t)r_ * D) + lane; \
        _Pragma("unroll") for (int j_ = 0; j_ < 4; ++j_) nv[j_] = xr_[64 * j_]; } while (0)
        if (m < MP + MS) P0_XLOAD(m);
        for (; m < MP + MS; m += ngw) {
            const bool smp = m >= MP; const int r = smp ? m - MP : m;
            f32x4 v[4]; float s = 0.f;
#pragma unroll
            for (int j = 0; j < 4; ++j) { v[j] = nv[j]; s += (v[j][0] * v[j][0] + v[j][1] * v[j][1]) + (v[j][2] * v[j][2] + v[j][3] * v[j][3]); }
            if (m + ngw < MP + MS) P0_XLOAD(m + ngw);
            s = wave_sum(s);
            u32x2* o8 = (u32x2*)((bf16*)(ws + (smp ? WS_SXB : WS_XB)) + (size_t)r * D) + lane;
#pragma unroll
            for (int j = 0; j < 4; ++j) { u32x2 w; w.x = pkbf(v[j][0], v[j][1]); w.y = pkbf(v[j][2], v[j][3]); o8[64 * j] = w; }
            float* ssr = (float*)(ws + (smp ? WS_SSS : WS_SS)) + (size_t)r * 32;
            if (lane < (smp ? 32 : 16)) ssr[lane] = (lane == 0) ? s : 0.f;
        }
#undef P0_XLOAD
    }
    if (wave == 7) s5_precompute(a, (gw >> 3) * 64 + lane);
}
constexpr int DL_K = 0, DL_V = 17408, DL_QK = 34816, DL_X = 44032, DL_SLOT = 9216, DL_ST = 99328, DL_GC = 134144, DL_BETA = 134400, DL_RED = 134656, DL_Q = 135680, DL_END = 135680 + 17408;
static_assert(DL_END <= LDSCTL_OFF, "DN LDS map");
__device__ __forceinline__ bf16x8 ldfrag(ldsp base, int row, int ld, int k) { return *(const LAS bf16x8*)(base + (row * ld + k) * 2); }
__device__ __forceinline__ void st4(ldsp base, int row, int ld, int col, const f32x4 v) { u32x2 w; w.x = pkbf(v[0], v[1]); w.y = pkbf(v[2], v[3]); *(LAS u32x2*)(base + (row * ld + col) * 2) = w; }
__device__ __forceinline__ void st1(ldsp base, int row, int ld, int col, float v) { *(LAS unsigned short*)(base + (row * ld + col) * 2) = (unsigned short)(pkbf(v, 0.f) & 0xffffu); }

typedef short s16x4 __attribute__((ext_vector_type(4)));
__device__ __forceinline__ bf16x8 ldfrag_tr(ldsp base, int k0, int ld, int c0, int fr, int fq) {
    const ldsp p = base + ((k0 + 8 * fq + (fr >> 2)) * ld + c0 + 4 * (fr & 3)) * 2;
    const s16x4 lo = __builtin_amdgcn_ds_read_tr16_b64_v4i16((LAS s16x4*)p);
    const s16x4 hi = __builtin_amdgcn_ds_read_tr16_b64_v4i16((LAS s16x4*)(p + 8 * ld));
    return (bf16x8){lo[0], lo[1], lo[2], lo[3], hi[0], hi[1], hi[2], hi[3]};
}
__device__ __forceinline__ void dn_prep(const Args& a, int gw, int ngw, int lane) {
    const bf16* PROJ = (const bf16*)(a.ws + WS_PROJ); bf16* QKVC = (bf16*)(a.ws + WS_QKVC);
    {
        const float* BETA = (const float*)(a.ws + WS_BETA); const float* GDEC = (const float*)(a.ws + WS_GDEC);
        float* GC = (float*)(a.ws + WS_GC); float* BT = (float*)(a.ws + WS_BT);
        for (int u = gw; u < NB * NH * NCHUNK; u += ngw) {
            const int c = u % NCHUNK, h = (u / NCHUNK) % NH, b = u / (NCHUNK * NH); const int row = b * SEQ + c * CHUNK + lane;
            float g = GDEC[(size_t)row * 16 + h]; const float bt = BETA[(size_t)row * 16 + h];
#pragma unroll
            for (int o = 1; o < 64; o <<= 1) { const float t = __shfl_up(g, o); if (lane >= o) g += t; }
            GC[(size_t)(b * NH + h) * SEQ + c * CHUNK + lane] = g; BT[(size_t)(b * NH + h) * SEQ + c * CHUNK + lane] = bt;
        }
    }
    for (int u = gw; u < NB * 8 * (SEQ / 32); u += ngw) {
        const int cb = u & 7, run = (u >> 3) & 63, b = u >> 9, ch0 = cb * 512 + lane * 8, t0 = run * 32, row0 = b * SEQ + t0;
        float w[4][8];
#pragma unroll
        for (int j = 0; j < 4; ++j) { const f32x4 w0 = *(const f32x4*)(a.in[10] + j * 4096 + ch0), w1 = *(const f32x4*)(a.in[10] + j * 4096 + ch0 + 4);
#pragma unroll
            for (int e = 0; e < 4; ++e) { w[j][e] = w0[e]; w[j][4 + e] = w1[e]; } }
        u32x4 xm[3];
#pragma unroll
        for (int j = 0; j < 3; ++j) { xm[j] = (u32x4){0u, 0u, 0u, 0u}; if (t0 - 3 + j >= 0) xm[j] = *(const u32x4*)(PROJ + (size_t)(row0 - 3 + j) * PROJ_LD + ch0); }
        const float scl = cb < 2 ? 0.08838834764831845f : 1.0f;
        u32x4 xr[8];
#pragma unroll
        for (int t = 0; t < 8; ++t) xr[t] = *(const u32x4*)(PROJ + (size_t)(row0 + t) * PROJ_LD + ch0);
#pragma unroll
        for (int t = 0; t < 32; ++t) {
            const u32x4 x0 = xr[t & 7];
            if (t + 8 < 32) xr[t & 7] = *(const u32x4*)(PROJ + (size_t)(row0 + t + 8) * PROJ_LD + ch0);
            float y[8];
#pragma unroll
            for (int e = 0; e < 4; ++e) {
                const unsigned a3 = xm[0][e], a2 = xm[1][e], a1 = xm[2][e], a0 = x0[e];
                y[2 * e] = w[0][2 * e] * bflo(a3) + w[1][2 * e] * bflo(a2) + w[2][2 * e] * bflo(a1) + w[3][2 * e] * bflo(a0);
                y[2 * e + 1] = w[0][2 * e + 1] * bfhi(a3) + w[1][2 * e + 1] * bfhi(a2) + w[2][2 * e + 1] * bfhi(a1) + w[3][2 * e + 1] * bfhi(a0); }
            float ssq = 0.f;
#pragma unroll
            for (int e = 0; e < 8; ++e) { y[e] = y[e] * __builtin_amdgcn_rcpf(1.0f + __expf(-y[e])); ssq += y[e] * y[e]; }
            if (cb < 4) { ssq += __shfl_xor(ssq, 1); ssq += __shfl_xor(ssq, 2); ssq += __shfl_xor(ssq, 4); ssq += __shfl_xor(ssq, 8); const float sc = rsqrtf(ssq + 1e-6f) * scl;
#pragma unroll
                for (int e = 0; e < 8; ++e) y[e] *= sc; }
            u32x4 o; o.x = pkbf(y[0], y[1]); o.y = pkbf(y[2], y[3]); o.z = pkbf(y[4], y[5]); o.w = pkbf(y[6], y[7]);
            *(u32x4*)(QKVC + (size_t)(row0 + t) * 4096 + ch0) = o;
            xm[0] = xm[1]; xm[1] = xm[2]; xm[2] = x0;
        }
    }
}

#ifndef RPA
#define RPA 1
#endif
#ifndef RPB
#define RPB 1
#endif
#ifndef RPE
#define RPE 1
#endif
#ifndef RPF
#define RPF 1
#endif
#ifndef RPO
#define RPO 1
#endif
__device__ __forceinline__ void dn_prompt(const Args& a, ldsp lds, int b, int h, int tid, int wave, int lane) {
    unsigned char* ws = a.ws;
    const bf16* PROJ = (const bf16*)(ws + WS_PROJ); const bf16* QKVC = (const bf16*)(ws + WS_QKVC); bf16* GATED = (bf16*)(ws + WS_GATED);
    const float* GC = (const float*)(ws + WS_GC) + (size_t)(b * NH + h) * SEQ; const float* BT = (const float*)(ws + WS_BT) + (size_t)(b * NH + h) * SEQ;
    const int mt = wave & 3, ch = wave >> 2, hq = h >> 1;
    LAS float* gcs = (LAS float*)(lds + DL_GC); LAS float* betas = (LAS float*)(lds + DL_BETA); LAS float* red = (LAS float*)(lds + DL_RED);
    const ldsp LK = lds + DL_K, LV = lds + DL_V, LQK = lds + DL_QK, LST = lds + DL_ST, LQ = lds + DL_Q;
#define SLOT(s) (lds + DL_X + (s) * DL_SLOT)
#define PRs(s) ((s) == 0 ? 0 : (((s) & 1) ? 2 : 4))
#define PTs(s) ((s) == 0 ? 1 : (((s) & 1) ? 3 : 5))
#define NRs(s) ((s) & 1)
    for (int i = tid; i < 128 * 136 / 2; i += NTHREADS) ((LAS unsigned*)LST)[i] = 0u;
    f32x4 S[2][4];
#pragma unroll
    for (int x = 0; x < 2; ++x)
#pragma unroll
        for (int q = 0; q < 4; ++q) S[x][q] = (f32x4){0.f, 0.f, 0.f, 0.f};
    LAS float* ngl = (LAS float*)(lds + DL_RED + 512);
    if (tid < 128) ngl[tid] = a.in[13][tid];
    u32x4 nQt[2], nKt[2], nVt[2]; float ngd = 0.f, nbt = 0.f;
#define DN_PREFETCH(cc) do { const int rowc_ = b * SEQ + (cc) * CHUNK; const bf16* krow_ = QKVC + (size_t)(rowc_ + (tid >> 3)) * 4096; \
        _Pragma("unroll") for (int p2_ = 0; p2_ < 2; ++p2_) { const int col_ = 8 * ((tid & 7) + 8 * p2_); nQt[p2_] = *(const u32x4*)(krow_ + hq * 128 + col_); nKt[p2_] = *(const u32x4*)(krow_ + 1024 + hq * 128 + col_); nVt[p2_] = *(const u32x4*)(krow_ + 2048 + h * 128 + col_); } \
        ngd = GC[(cc) * CHUNK + lane]; nbt = BT[(cc) * CHUNK + lane]; } while (0)
    DN_PREFETCH(0);
#define DN_TILES_TO_LDS() do { const int r_ = tid >> 3, pc_ = tid & 7; \
        _Pragma("unroll") for (int p2_ = 0; p2_ < 2; ++p2_) { const int col_ = 8 * (pc_ + 8 * p2_); *(LAS u32x4*)(LQ + (r_ * 136 + col_) * 2) = nQt[p2_]; *(LAS u32x4*)(LK + (r_ * 136 + col_) * 2) = nKt[p2_]; *(LAS u32x4*)(LV + (r_ * 136 + col_) * 2) = nVt[p2_]; } \
        if (wave == 0) { gcs[lane] = ngd; betas[lane] = nbt; } } while (0)
    DN_TILES_TO_LDS();
    DN_PREFETCH(NCHUNK > 1 ? 1 : 0);
    __syncthreads();
    for (int c = 0; c < NCHUNK; ++c) {
        int lane_c = lane; asm volatile("" : "+v"(lane_c));
        const int fr = lane_c & 15, fq = lane_c >> 4, i_own = 16 * mt + fr;
        const int t_own = c * CHUNK + i_own, row_own = b * SEQ + t_own;
        bf16x8 qf[4], kf[4]; u32x2 zc[4];
#pragma unroll
        for (int q = 0; q < 4; ++q) zc[q] = *(const u32x2*)(PROJ + (size_t)row_own * PROJ_LD + 4096 + h * 128 + 16 * (4 * ch + q) + 4 * fq);
#pragma unroll
        for (int kk = 0; kk < 4; ++kk) { kf[kk] = ldfrag(LK, i_own, 136, 32 * kk + 8 * fq); qf[kk] = ldfrag(LQ, i_own, 136, 32 * kk + 8 * fq); }
        for (int rpB = 0; rpB < RPB; ++rpB) {
        f32x4 Pt[2], Nt[2];
        {
            const float gi = gcs[i_own], bi = betas[i_own];
#pragma unroll
            for (int q2 = 0; q2 < 2; ++q2) { const int nt = 2 * ch + q2;
                f32x4 akk = (f32x4){0.f, 0.f, 0.f, 0.f}, aqk = akk;
#pragma unroll
                for (int kk = 0; kk < 4; ++kk) { const bf16x8 yf = ldfrag(LK, 16 * nt + fr, 136, 32 * kk + 8 * fq); MM_XROW(akk, kf[kk], yf); MM_XROW(aqk, qf[kk], yf); }
                const f32x4 gj = *(const LAS f32x4*)(gcs + 16 * nt + 4 * fq);
                f32x4 qkv, m0;
#pragma unroll
                for (int r = 0; r < 4; ++r) { const int j = 16 * nt + 4 * fq + r; const float d = (i_own >= j) ? __expf(gi - gj[r]) : 0.f; qkv[r] = aqk[r] * d; m0[r] = (i_own > j) ? -bi * akk[r] * d : 0.f; }
                st4(LQK, i_own, 72, 16 * nt + 4 * fq, qkv);
                Pt[q2] = m0; Nt[q2] = m0;
                st4(SLOT(0), i_own, 72, 16 * nt + 4 * fq, m0); }
        }
        __syncthreads();
#pragma unroll
        for (int s = 1; s <= 6; ++s) {
            f32x4 Pn[2];
            bf16x8 xn[2], xp[2];
            if (s >= 2) { xn[0] = ldfrag(SLOT(NRs(s - 2)), i_own, 72, 8 * fq); xn[1] = ldfrag(SLOT(NRs(s - 2)), i_own, 72, 32 + 8 * fq); }
            if (s <= 5) { xp[0] = ldfrag(SLOT(PRs(s - 1)), i_own, 72, 8 * fq); xp[1] = ldfrag(SLOT(PRs(s - 1)), i_own, 72, 32 + 8 * fq); }
#pragma unroll
            for (int q2 = 0; q2 < 2; ++q2) { const int nt = 2 * ch + q2;
                const bf16x8 y0 = ldfrag_tr(SLOT(PRs(s - 1)), 0, 72, 16 * nt, fr, fq), y1 = ldfrag_tr(SLOT(PRs(s - 1)), 32, 72, 16 * nt, fr, fq);
                if (s >= 2) { f32x4 acc = Nt[q2] + Pt[q2]; MM_XROW(acc, xn[0], y0); MM_XROW(acc, xn[1], y1); Nt[q2] = acc; }
                if (s <= 5) { f32x4 acc = (f32x4){0.f, 0.f, 0.f, 0.f}; MM_XROW(acc, xp[0], y0); MM_XROW(acc, xp[1], y1); Pn[q2] = acc; }
            }
#pragma unroll
            for (int q2 = 0; q2 < 2; ++q2) { const int nt = 2 * ch + q2, j0 = 16 * nt + 4 * fq;
                if (s <= 5) { Pt[q2] = Pn[q2];
                    st4(SLOT(PRs(s)), i_own, 72, j0, Pn[q2]); }
                if (s >= 2 && s <= 5) st4(SLOT(NRs(s - 1)), i_own, 72, j0, Nt[q2]);
                if (s == 6) {
                    const f32x4 gj = *(const LAS f32x4*)(gcs + j0), bj = *(const LAS f32x4*)(betas + j0); f32x4 t1, t2;
#pragma unroll
                    for (int r = 0; r < 4; ++r) { const float tv = Nt[q2][r] + ((i_own == j0 + r) ? 1.f : 0.f); t2[r] = tv * bj[r]; t1[r] = t2[r] * __expf(gj[r]); }
                    st4(SLOT(1), i_own, 72, j0, t1); st4(SLOT(3), i_own, 72, j0, t2); }
            }
            __syncthreads();
        }
        }
        f32x4 U[4]; bf16x8 ka[2][2];
        for (int rpE = 0; rpE < RPE; ++rpE) {
        {
#pragma unroll
            for (int x = 0; x < 2; ++x) { ka[x][0] = ldfrag_tr(LK, 0, 136, 16 * (2 * mt + x), fr, fq); ka[x][1] = ldfrag_tr(LK, 32, 136, 16 * (2 * mt + x), fr, fq); }
            const bf16x8 t1a = ldfrag(SLOT(1), i_own, 72, 8 * fq), t1b = ldfrag(SLOT(1), i_own, 72, 32 + 8 * fq), t2a = ldfrag(SLOT(3), i_own, 72, 8 * fq), t2b = ldfrag(SLOT(3), i_own, 72, 32 + 8 * fq);
#pragma unroll
            for (int q = 0; q < 4; ++q) { const int nt = 4 * ch + q;
                f32x4 aw = (f32x4){0.f, 0.f, 0.f, 0.f};
                MM_XROW(aw, t1a, ldfrag_tr(LK, 0, 136, 16 * nt, fr, fq)); MM_XROW(aw, t1b, ldfrag_tr(LK, 32, 136, 16 * nt, fr, fq));
                st4(SLOT(4), i_own, 136, 16 * nt + 4 * fq, -aw);
                f32x4 au = (f32x4){0.f, 0.f, 0.f, 0.f};
                MM_YROW(au, t2a, ldfrag_tr(LV, 0, 136, 16 * nt, fr, fq)); MM_YROW(au, t2b, ldfrag_tr(LV, 32, 136, 16 * nt, fr, fq));
                U[q] = au; }
        }
        __syncthreads();
        }
        f32x4 O[4];
        const float gl = gcs[63];
        for (int rpF = 0; rpF < RPF; ++rpF) {
        {
            bf16x8 wf[4];
#pragma unroll
            for (int kk = 0; kk < 4; ++kk) wf[kk] = ldfrag(SLOT(4), i_own, 136, 32 * kk + 8 * fq);
            const float ei = __expf(gcs[i_own]);
            const f32x4 gq = *(const LAS f32x4*)(gcs + 16 * mt + 4 * fq);
#pragma unroll
            for (int q = 0; q < 4; ++q) { const int nt = 4 * ch + q;
                f32x4 ao = (f32x4){0.f, 0.f, 0.f, 0.f}, av = U[q];
#pragma unroll
                for (int kk = 0; kk < 4; ++kk) { const bf16x8 sf = ldfrag(LST, 16 * nt + fr, 136, 32 * kk + 8 * fq); MM_YROW(av, wf[kk], sf); MM_XROW(ao, qf[kk], sf); }
                O[q] = ao * ei;
                st4(SLOT(0), 16 * nt + fr, 72, 16 * mt + 4 * fq, av);
                f32x4 avd;
#pragma unroll
                for (int r = 0; r < 4; ++r) avd[r] = av[r] * __expf(gl - gq[r]);
                st4(SLOT(2), 16 * nt + fr, 72, 16 * mt + 4 * fq, avd); }
        }
        __syncthreads();
        }
        {
            const bf16x8 qa = ldfrag(LQK, i_own, 72, 8 * fq), qb = ldfrag(LQK, i_own, 72, 32 + 8 * fq);
            DN_TILES_TO_LDS();
            const float el = __expf(gl);
            float ssq = 0.f;
#pragma unroll
            for (int q = 0; q < 4; ++q) { const int nt = 4 * ch + q;
                MM_XROW(O[q], qa, ldfrag(SLOT(0), 16 * nt + fr, 72, 8 * fq)); MM_XROW(O[q], qb, ldfrag(SLOT(0), 16 * nt + fr, 72, 32 + 8 * fq));
                ssq += (O[q][0] * O[q][0] + O[q][1] * O[q][1]) + (O[q][2] * O[q][2] + O[q][3] * O[q][3]);
                const bf16x8 v0 = ldfrag(SLOT(2), 16 * nt + fr, 72, 8 * fq), v1 = ldfrag(SLOT(2), 16 * nt + fr, 72, 32 + 8 * fq);
#pragma unroll
                for (int x = 0; x < 2; ++x) { f32x4 sacc = S[x][q] * el; MM_YROW(sacc, ka[x][0], v0); MM_YROW(sacc, ka[x][1], v1); S[x][q] = sacc;
                    st4(LST, 16 * nt + fr, 136, 16 * (2 * mt + x) + 4 * fq, sacc); } }
            ssq += __shfl_xor(ssq, 16); ssq += __shfl_xor(ssq, 32);
            if (fq == 0) red[i_own * 2 + ch] = ssq;
            { const int cn = (c + 2 < NCHUNK) ? c + 2 : NCHUNK - 1; DN_PREFETCH(cn); }
        }
        __syncthreads();
        for (int rpO = 0; rpO < RPO; ++rpO) {
        {
            const float rstd = rsqrtf((red[i_own * 2] + red[i_own * 2 + 1]) * (1.0f / 128.0f) + RMS_EPSF);
#pragma unroll
            for (int q = 0; q < 4; ++q) { const int dv = 16 * (4 * ch + q) + 4 * fq;
                const u32x2 z = zc[q];
                const f32x4 ngv = *(const LAS f32x4*)(ngl + dv);
                u32x2 w; w.x = pkbf(O[q][0] * rstd * ngv[0] * bflo(z.x), O[q][1] * rstd * ngv[1] * bfhi(z.x)); w.y = pkbf(O[q][2] * rstd * ngv[2] * bflo(z.y), O[q][3] * rstd * ngv[3] * bfhi(z.y));
                *(u32x2*)(GATED + (size_t)row_own * VAL + h * 128 + dv) = w; }
        }
        }
    }
    const int fr = lane & 15, fq = lane >> 4;
    float* so = a.out + O_SSMP + (size_t)(b * NH + h) * 128 * 128;
#pragma unroll
    for (int x = 0; x < 2; ++x)
#pragma unroll
        for (int q = 0; q < 4; ++q)
#pragma unroll
            for (int r = 0; r < 4; ++r) so[(size_t)(16 * (2 * mt + x) + 4 * fq + r) * 128 + 16 * (4 * ch + q) + fr] = S[x][q][r];
    for (int i = tid; i < 3 * 384; i += NTHREADS) { const int j = i / 384, cc = i % 384; if (cc < 256 && (h & 1)) continue;
        const int gch = cc < 128 ? hq * 128 + cc : (cc < 256 ? 1024 + hq * 128 + (cc - 128) : 2048 + h * 128 + (cc - 256));
        a.out[O_CONVP + (size_t)(b * 3 + j) * 4096 + gch] = bf1(PROJ[(size_t)(b * SEQ + SEQ - 3 + j) * PROJ_LD + gch]); }
    __syncthreads();
#undef SLOT
#undef DN_PREFETCH
#undef DN_TILES_TO_LDS
#undef PRs
#undef PTs
#undef NRs
}
__device__ __forceinline__ void dn_sample_all(const Args& a, ldsp lds, int ti, int nt, int tid, int wave, int lane) {
    unsigned char* ws = a.ws;
    const bf16* PROJ = (const bf16*)(ws + WS_SPROJ); bf16* GATED = (bf16*)(ws + WS_SGATED);
    const float* BETA = (const float*)(ws + WS_SBETA); const float* GDEC = (const float*)(ws + WS_SGDEC);
    LAS float* qkv = (LAS float*)lds;
    LAS float* red = qkv + 384;
    LAS float* part = qkv + 512;
    const int kg = tid >> 5, v4 = tid & 31, p = tid >> 7, c = tid & 127;
    f32x4 sn[8]; float nx3 = 0.f, nc0 = 0.f, nc1 = 0.f, nc2 = 0.f, nbeta = 0.f, ngd = 0.f; u32x2 nz = (u32x2){0u, 0u};
    float w0 = 0.f, w1 = 0.f, w2 = 0.f, w3 = 0.f; int gch_cur = -1;
#define DNS_LOAD(it_) do { const int bs_ = (it_) / NH, h_ = (it_) % NH, hq_ = h_ >> 1; \
        const float* sin_ = a.in[2] + ((size_t)(bs_ * NH + h_) * 128 + kg * 8) * 128 + 4 * v4; \
        _Pragma("unroll") for (int r_ = 0; r_ < 8; ++r_) sn[r_] = *(const f32x4*)(sin_ + r_ * 128); \
        if (tid < 384) { const int gch_ = p == 0 ? hq_ * 128 + c : (p == 1 ? 1024 + hq_ * 128 + c : 2048 + h_ * 128 + c); \
            nx3 = bf1(PROJ[(size_t)bs_ * PROJ_LD + gch_]); const float* cs_ = a.in[3] + (size_t)bs_ * 3 * 4096 + gch_; nc0 = cs_[0]; nc1 = cs_[4096]; nc2 = cs_[8192]; } \
        nbeta = BETA[(size_t)bs_ * 16 + h_]; ngd = GDEC[(size_t)bs_ * 16 + h_]; \
        if (tid < 32) nz = *(const u32x2*)(PROJ + (size_t)bs_ * PROJ_LD + 4096 + h_ * 128 + 4 * v4); } while (0)
    int it = ti;
    if (it < MS * NH) DNS_LOAD(it);
    for (; it < MS * NH; it += nt) {
        const int bs = it / NH, h = it % NH, hq = h >> 1;
        f32x4 s[8];
#pragma unroll
        for (int r = 0; r < 8; ++r) s[r] = sn[r];
        const float x3 = nx3, c0 = nc0, c1 = nc1, c2 = nc2, beta = nbeta, eg = __expf(ngd); const u32x2 z = nz;
        const int gch = p == 0 ? hq * 128 + c : (p == 1 ? 1024 + hq * 128 + c : 2048 + h * 128 + c);
        if (tid < 384 && gch != gch_cur) { const float* w = a.in[10] + gch; w0 = w[0]; w1 = w[4096]; w2 = w[8192]; w3 = w[12288]; gch_cur = gch; }
        if (it + nt < MS * NH) DNS_LOAD(it + nt);
        float sq = 0.f;
        if (tid < 384) {
            float y = c0 * w0 + c1 * w1 + c2 * w2 + x3 * w3; y = y / (1.0f + __expf(-y));
            if (p == 2 || (h & 1) == 0) { float* co = a.out + O_CONVS + (size_t)bs * 3 * 4096 + gch; co[0] = c1; co[4096] = c2; co[8192] = x3; }
            qkv[tid] = y; sq = y * y; }
        sq = wave_sum(sq);
        if (lane == 0) red[wave] = sq;
        __syncthreads();
        const float qs = rsqrtf(red[0] + red[1] + 1e-6f) * 0.08838834764831845f, ks = rsqrtf(red[2] + red[3] + 1e-6f);
        float* sout = a.out + O_SSMS + ((size_t)(bs * NH + h) * 128 + kg * 8) * 128 + 4 * v4;
        f32x4 kv = (f32x4){0.f, 0.f, 0.f, 0.f};
#pragma unroll
        for (int r = 0; r < 8; ++r) { s[r] = s[r] * eg; kv += s[r] * (qkv[128 + kg * 8 + r] * ks); }
        *(LAS f32x4*)(part + kg * 128 + 4 * v4) = kv;
        __syncthreads();
        kv = (f32x4){0.f, 0.f, 0.f, 0.f};
#pragma unroll
        for (int g = 0; g < 16; ++g) kv += *(const LAS f32x4*)(part + g * 128 + 4 * v4);
        const f32x4 vv = *(const LAS f32x4*)(qkv + 256 + 4 * v4);
        const f32x4 delta = (vv - kv) * beta;
        f32x4 op = (f32x4){0.f, 0.f, 0.f, 0.f};
#pragma unroll
        for (int r = 0; r < 8; ++r) { s[r] += delta * (qkv[128 + kg * 8 + r] * ks); *(f32x4*)(sout + r * 128) = s[r]; op += s[r] * (qkv[kg * 8 + r] * qs); }
        __syncthreads();
        *(LAS f32x4*)(part + kg * 128 + 4 * v4) = op;
        __syncthreads();
        if (tid < 32) {
            f32x4 o = (f32x4){0.f, 0.f, 0.f, 0.f};
#pragma unroll
            for (int g = 0; g < 16; ++g) o += *(const LAS f32x4*)(part + g * 128 + 4 * v4);
            float ss = (o[0] * o[0] + o[1] * o[1]) + (o[2] * o[2] + o[3] * o[3]);
#pragma unroll
            for (int m = 1; m < 32; m <<= 1) ss += __shfl_xor(ss, m);
            const float rstd = rsqrtf(ss * (1.0f / 128.0f) + RMS_EPSF);
            const f32x4 ng = *(const f32x4*)(a.in[13] + 4 * v4);
            u32x2 w; w.x = pkbf(o[0] * rstd * ng[0] * bflo(z.x), o[1] * rstd * ng[1] * bfhi(z.x)); w.y = pkbf(o[2] * rstd * ng[2] * bflo(z.y), o[3] * rstd * ng[3] * bfhi(z.y));
            *(u32x2*)(GATED + (size_t)bs * VAL + h * 128 + 4 * v4) = w;
        }
        __syncthreads();
    }
#undef DNS_LOAD
}
__device__ __forceinline__ void s5_wave(const Args& a, ldsp wl, bool sample, int b, int e0, int g, int lane) {
    unsigned char* ws = a.ws;
    const bf16* XB = (const bf16*)(ws + (sample ? WS_SXB : WS_XB)); bf16* YB = (bf16*)(ws + (sample ? WS_SYB : WS_YB)); const float* SS = (const float*)(ws + (sample ? WS_SSS : WS_SS));
    const int fr = lane & 15, fq = lane >> 4;
    LAS float* bubuf = (LAS float*)wl;
    const ldsp stbuf = wl + 16 * 132 * 4;
    const f32x2 lam = *(const f32x2*)((const float*)(ws + WS_S5LAM) + (size_t)(g * 64 + lane) * 2); const float lr = lam[0], li = lam[1];
    bf16x8 bbf[8];
#pragma unroll
    for (int nt = 0; nt < 8; ++nt) { u32x4 w = (u32x4){0u, 0u, 0u, 0u}; if (fq < 2) w = *(const u32x4*)((const bf16*)(ws + WS_S5BB) + ((size_t)g * 128 + 16 * nt + fr) * 16 + 8 * fq); bbf[nt] = __builtin_bit_cast(bf16x8, w); }
    bf16x8 cf[4];
#pragma unroll
    for (int kk = 0; kk < 4; ++kk) cf[kk] = *(const bf16x8*)((const bf16*)(ws + WS_S5CM) + ((size_t)g * 16 + fr) * 128 + 32 * kk + 8 * fq);
    const f32x4 dskv = *(const f32x4*)((const float*)(ws + WS_S5DSK) + g * 16 + 4 * fq); const float dsk[4] = {dskv[0], dskv[1], dskv[2], dskv[3]};
    float sre = 0.f, sim = 0.f;
    const int ntile = sample ? 1 : SEQ / 16;
    const int rowb0 = sample ? e0 : b * SEQ;
    u32x4 pxw[4]; f32x4 pss[4]; u32x2 puw[4];
#define S5_LOAD(k, tile) do { const int row_ = rowb0 + (tile) * 16 + fr; pxw[k] = (u32x4){0u, 0u, 0u, 0u}; if (fq < 2) pxw[k] = *(const u32x4*)(XB + (size_t)row_ * D + g * 16 + 8 * fq); \
        pss[k] = *(const f32x4*)(SS + (size_t)row_ * 32 + 4 * fq); if (sample) pss[k] += *(const f32x4*)(SS + (size_t)row_ * 32 + 16 + 4 * fq); puw[k] = *(const u32x2*)(XB + (size_t)row_ * D + g * 16 + 4 * fq); } while (0)
#pragma unroll
    for (int k = 0; k < 4; ++k) if (k < ntile) S5_LOAD(k, k);
    for (int t0 = 0; t0 < ntile; t0 += 4) {
#pragma unroll
        for (int k = 0; k < 4; ++k) {
            const int tile = t0 + k; if (tile >= ntile) break;
            const int row = rowb0 + tile * 16 + fr;
            const bf16x8 xf = __builtin_bit_cast(bf16x8, pxw[k]);
            float ssum = (pss[k][0] + pss[k][1]) + (pss[k][2] + pss[k][3]); ssum += __shfl_xor(ssum, 16); ssum += __shfl_xor(ssum, 32);
            const float rs = rsqrtf(ssum * (1.0f / 1024.0f) + RMS_EPSF);
            const u32x2 uw = puw[k];
            if (tile + 4 < ntile) S5_LOAD(k, tile + 4);
#pragma unroll
            for (int nt = 0; nt < 8; ++nt) { f32x4 acc = (f32x4){0.f, 0.f, 0.f, 0.f}; MM_XROW(acc, xf, bbf[nt]); *(LAS f32x4*)(bubuf + fr * 132 + 16 * nt + 4 * fq) = acc * rs; }
            LDS_FENCE();
            f32x2 buv[16];
#pragma unroll
            for (int t = 0; t < 16; ++t) buv[t] = *(const LAS f32x2*)(bubuf + t * 132 + 2 * lane);
            LDS_FENCE();
#pragma unroll
            for (int t = 0; t < 16; ++t) {
                const f32x2 bu = buv[t];
                if (sample) { sre = a.in[4][(size_t)(e0 + t) * 4096 + g * 64 + lane]; sim = a.in[5][(size_t)(e0 + t) * 4096 + g * 64 + lane]; }
                const float nr = fmaf(lr, sre, fmaf(-li, sim, bu[0])), ni = fmaf(lr, sim, fmaf(li, sre, bu[1]));
                sre = nr; sim = ni;
                *(LAS unsigned*)(stbuf + (t * 136 + 2 * lane) * 2) = pkbf(sre, sim);
                if (sample) { a.out[O_S5RS + (size_t)(e0 + t) * 4096 + g * 64 + lane] = sre; a.out[O_S5IS + (size_t)(e0 + t) * 4096 + g * 64 + lane] = sim; }
            }
            LDS_FENCE();
            f32x4 y = (f32x4){0.f, 0.f, 0.f, 0.f};
#pragma unroll
            for (int kk = 0; kk < 4; ++kk) MM_XROW(y, ldfrag(stbuf, fr, 136, 32 * kk + 8 * fq), cf[kk]);
            y[0] += dsk[0] * bflo(uw.x) * rs; y[1] += dsk[1] * bfhi(uw.x) * rs; y[2] += dsk[2] * bflo(uw.y) * rs; y[3] += dsk[3] * bfhi(uw.y) * rs;
            u32x2 w; w.x = pkbf(gelu_tanh(y[0]), gelu_tanh(y[1])); w.y = pkbf(gelu_tanh(y[2]), gelu_tanh(y[3]));
            *(u32x2*)(YB + (size_t)row * D + g * 16 + 4 * fq) = w;
            LDS_FENCE();
        }
    }
#undef S5_LOAD
    if (!sample) { a.out[O_S5RP + (size_t)(b * 64 + g) * 64 + lane] = sre; a.out[O_S5IP + (size_t)(b * 64 + g) * 64 + lane] = sim; }
}
template <bool EMIT>
__device__ __forceinline__ void s5_tiles(const bf16* XB, bf16* YB, const float* SS, ldsp wl, int rowb0, int ntile, int g, int lane, float lr, float li,
                                         const bf16x8 (&bbf)[8], const bf16x8 (&cf)[4], const float (&dsk)[4], float& sre, float& sim) {
    const int fr = lane & 15, fq = lane >> 4;
    LAS float* bubuf = (LAS float*)wl; const ldsp stbuf = wl + 16 * 132 * 4;
    u32x4 pxw[4]; f32x4 pss[4]; u32x2 puw[4];
#define S5_LOAD(k, tile) do { const int row_ = rowb0 + (tile) * 16 + fr; pxw[k] = (u32x4){0u, 0u, 0u, 0u}; if (fq < 2) pxw[k] = *(const u32x4*)(XB + (size_t)row_ * D + g * 16 + 8 * fq); \
        pss[k] = *(const f32x4*)(SS + (size_t)row_ * 32 + 4 * fq); if (EMIT) puw[k] = *(const u32x2*)(XB + (size_t)row_ * D + g * 16 + 4 * fq); } while (0)
#pragma unroll
    for (int k = 0; k < 4; ++k) if (k < ntile) S5_LOAD(k, k);
    for (int t0 = 0; t0 < ntile; t0 += 4) {
#pragma unroll
        for (int k = 0; k < 4; ++k) {
            const int tile = t0 + k; if (tile >= ntile) break;
            const int row = rowb0 + tile * 16 + fr;
            const bf16x8 xf = __builtin_bit_cast(bf16x8, pxw[k]);
            float ssum = (pss[k][0] + pss[k][1]) + (pss[k][2] + pss[k][3]); ssum += __shfl_xor(ssum, 16); ssum += __shfl_xor(ssum, 32);
            const float rs = rsqrtf(ssum * (1.0f / 1024.0f) + RMS_EPSF);
            u32x2 uw = (u32x2){0u, 0u}; if (EMIT) uw = puw[k];
            if (tile + 4 < ntile) S5_LOAD(k, tile + 4);
#pragma unroll
            for (int nt = 0; nt < 8; ++nt) { f32x4 acc = (f32x4){0.f, 0.f, 0.f, 0.f}; MM_XROW(acc, xf, bbf[nt]); *(LAS f32x4*)(bubuf + fr * 132 + 16 * nt + 4 * fq) = acc * rs; }
            LDS_FENCE();
            f32x2 buv[16];
#pragma unroll
            for (int t = 0; t < 16; ++t) buv[t] = *(const LAS f32x2*)(bubuf + t * 132 + 2 * lane);
            LDS_FENCE();
#pragma unroll
            for (int t = 0; t < 16; ++t) {
                const float nr = fmaf(lr, sre, fmaf(-li, sim, buv[t][0])), ni = fmaf(lr, sim, fmaf(li, sre, buv[t][1]));
                sre = nr; sim = ni;
                if (EMIT) *(LAS unsigned*)(stbuf + (t * 136 + 2 * lane) * 2) = pkbf(sre, sim);
            }
            if (EMIT) {
                LDS_FENCE();
                f32x4 y = (f32x4){0.f, 0.f, 0.f, 0.f};
#pragma unroll
                for (int kk = 0; kk < 4; ++kk) MM_XROW(y, ldfrag(stbuf, fr, 136, 32 * kk + 8 * fq), cf[kk]);
                y[0] += dsk[0] * bflo(uw.x) * rs; y[1] += dsk[1] * bfhi(uw.x) * rs; y[2] += dsk[2] * bflo(uw.y) * rs; y[3] += dsk[3] * bfhi(uw.y) * rs;
                u32x2 w; w.x = pkbf(gelu_tanh(y[0]), gelu_tanh(y[1])); w.y = pkbf(gelu_tanh(y[2]), gelu_tanh(y[3]));
                *(u32x2*)(YB + (size_t)row * D + g * 16 + 4 * fq) = w;
            }
            LDS_FENCE();
        }
    }
#undef S5_LOAD
}
__device__ __forceinline__ void s5_prompt_wg(const Args& a, ldsp lds, int vcu, int G, int wave, int lane) {
    unsigned char* ws = a.ws;
    const bf16* XB = (const bf16*)(ws + WS_XB); bf16* YB = (bf16*)(ws + WS_YB); const float* SS = (const float*)(ws + WS_SS);
    const int fr = lane & 15, fq = lane >> 4, p = wave >> 2, seg = wave & 3;
    const ldsp wl = lds + wave * 12800;
    LAS f32x2* exch = (LAS f32x2*)(lds + 8 * 12800);
    const int nrounds = (256 + G - 1) / G;
    for (int k = 0; k < nrounds; ++k) {
        const bool valid = vcu + k * G < 256;
        const int it = valid ? (vcu + k * G) * 2 + p : 0, b = it >> 6, g = it & 63;
        const f32x2 lam = *(const f32x2*)((const float*)(ws + WS_S5LAM) + (size_t)(g * 64 + lane) * 2); const float lr = lam[0], li = lam[1];
        bf16x8 bbf[8];
#pragma unroll
        for (int nt = 0; nt < 8; ++nt) { u32x4 w = (u32x4){0u, 0u, 0u, 0u}; if (fq < 2) w = *(const u32x4*)((const bf16*)(ws + WS_S5BB) + ((size_t)g * 128 + 16 * nt + fr) * 16 + 8 * fq); bbf[nt] = __builtin_bit_cast(bf16x8, w); }
        bf16x8 cf[4];
#pragma unroll
        for (int kk = 0; kk < 4; ++kk) cf[kk] = *(const bf16x8*)((const bf16*)(ws + WS_S5CM) + ((size_t)g * 16 + fr) * 128 + 32 * kk + 8 * fq);
        const f32x4 dskv = *(const f32x4*)((const float*)(ws + WS_S5DSK) + g * 16 + 4 * fq); const float dsk[4] = {dskv[0], dskv[1], dskv[2], dskv[3]};
        const int rowb0 = b * SEQ + seg * 512;
        float sre = 0.f, sim = 0.f;
        if (valid && seg < 3) s5_tiles<false>(XB, YB, SS, wl, rowb0, 32, g, lane, lr, li, bbf, cf, dsk, sre, sim);
        exch[(p * 4 + seg) * 64 + lane] = (f32x2){sre, sim};
        __syncthreads();
        if (valid) {
            float Lr = lr, Li = li;
#pragma unroll
            for (int q = 0; q < 9; ++q) { const float r2 = Lr * Lr - Li * Li, i2 = 2.0f * Lr * Li; Lr = r2; Li = i2; }
            float cr = 0.f, ci = 0.f;
            for (int j = 0; j < seg; ++j) { const f32x2 e = exch[(p * 4 + j) * 64 + lane]; const float nr = Lr * cr - Li * ci + e[0], ni = Lr * ci + Li * cr + e[1]; cr = nr; ci = ni; }
            sre = cr; sim = ci;
            s5_tiles<true>(XB, YB, SS, wl, rowb0, 32, g, lane, lr, li, bbf, cf, dsk, sre, sim);
            if (seg == 3) { a.out[O_S5RP + (size_t)(b * 64 + g) * 64 + lane] = sre; a.out[O_S5IP + (size_t)(b * 64 + g) * 64 + lane] = sim; }
        }
        __syncthreads();
    }
}
__global__ void __launch_bounds__(NTHREADS, 2) hybrid_fwd(Args a) {
    extern __shared__ __attribute__((aligned(16))) unsigned char lds_raw[];
    const ldsp lds = (ldsp)lds_raw;
    const int tid = threadIdx.x, lane = tid & 63, wave = __builtin_amdgcn_readfirstlane(tid >> 6);
    const int G = gridDim.x, bx = blockIdx.x;
    const int vcu = (G % 8 == 0) ? (bx % 8) * (G / 8) + bx / 8 : bx;
    unsigned char* ws = a.ws;
    unsigned* ctl = (unsigned*)(ws + WS_CTL);
    for (int u = tid; u < (LDS_BYTES - LDSCTL_OFF) / 4; u += NTHREADS) ((LAS unsigned*)(lds + LDSCTL_OFF))[u] = 0u;
    __syncthreads();
    XcdBarrier bar = xcd_barrier_post(ctl + CW_BAR, (volatile LAS unsigned*)(lds + LDSCTL_OFF) + 8);
    const int gw = vcu * NWAVES + wave, ngw = G * NWAVES;
    bf16* XB = (bf16*)(ws + WS_XB); float* X = (float*)(ws + WS_X); float* SS = (float*)(ws + WS_SS);
    bf16* PROJ = (bf16*)(ws + WS_PROJ); bf16* GATED = (bf16*)(ws + WS_GATED); bf16* YB = (bf16*)(ws + WS_YB); bf16* HB = (bf16*)(ws + WS_H);
    const bf16* W1 = (const bf16*)(ws + WS_W1); const bf16* W2 = (const bf16*)(ws + WS_W2); const bf16* W5 = (const bf16*)(ws + WS_W5);
    const bf16* W3 = (const bf16*)(ws + WS_W3); const bf16* W4 = (const bf16*)(ws + WS_W4);
#define SINGLE_ARG(...) __VA_ARGS__
#define GEMM_PHASE(EPI, Aop, Bop, N_, K_, E_) do { pg8::Gemm g_{(const pg8::bf16_t*)(Aop), (const pg8::bf16_t*)(Bop), MP, (N_), (K_)}; pg8::StaticOrder S_; S_.init(MP, (N_), G, bx); \
        pg8::gemm_phase<EPI, pg8::StaticOrder, true, true>(lds, g_, S_, (E_)); } while (0)
#ifndef DBG_STOP
#define DBG_STOP 0
#endif
#ifndef REPG
#define REPG 0
#endif
#define DBG_DIGEST(k, SRC, NEL) do { if (DBG_STOP == (k)) { xcd_barrier(bar); const bf16* s_ = (const bf16*)(SRC); for (size_t i_ = (size_t)bx * NTHREADS + tid; i_ < (size_t)(NEL) && i_ < O_SSMP; i_ += (size_t)G * NTHREADS) a.out[i_] = bf1(s_[i_]); return; } } while (0)

#ifndef TPROBE
#define TPROBE 0
#endif
#define TP_BLK ((TPROBE) / 10000)
#define TP_S (((TPROBE) / 100) % 100)
#define TP_E ((TPROBE) % 100)
    unsigned long long tp_s = 0, tp_e = 0;
#define STAMPV(id) do { if (TPROBE && vcu == TP_BLK && tid == 0) { const unsigned long long t_ = __builtin_amdgcn_s_memrealtime(); if ((id) == TP_S && tp_s == 0) tp_s = t_; if ((id) == TP_E && tp_e == 0) tp_e = t_; } } while (0)
#define STAMP(id) do { if (TPROBE && vcu == TP_BLK && tid == 0) { const unsigned long long t_ = __builtin_amdgcn_s_memrealtime(); if ((id) == TP_S) tp_s = t_; if ((id) == TP_E) tp_e = t_; } } while (0)
    STAMP(0);
    p0_prologue(a, lds, gw, ngw, wave, lane);
    STAMP(1);
    xcd_barrier(bar);
    STAMP(2);
    { pg8::EpiProj E{(pg8::bf16_t*)PROJ, SS, 16};
      GEMM_PHASE(pg8::EpiProj, XB, W1, PROJ_LD, D, E); }
#if REPG == 1
    xcd_barrier(bar);
    { pg8::EpiProj E{(pg8::bf16_t*)PROJ, SS, 16};
      GEMM_PHASE(pg8::EpiProj, XB, W1, PROJ_LD, D, E); }
#endif
    {
        const SEpiProj Ep{nullptr, SS, 16, (float*)(ws + WS_BETA), (float*)(ws + WS_GDEC), a.in[11], a.in[12]};
        const SEpiProj Es{(bf16*)(ws + WS_SPROJ), (const float*)(ws + WS_SSS), 32, (float*)(ws + WS_SBETA), (float*)(ws + WS_SGDEC), a.in[11], a.in[12]};
        for (int u = vcu; u < 128 + 193; u += G) {
            if (u < 128) sgemm_unit<2>(lds, XB + (size_t)u * 128 * D, W1 + (size_t)6144 * D, nullptr, D, Ep, u * 128, 192, wave, lane);
            else sgemm_unit<2>(lds, (const bf16*)(ws + WS_SXB), W1 + (size_t)(u - 128) * 32 * D, nullptr, D, Es, 0, u - 128, wave, lane);
        }
    }
    DBG_DIGEST(1, PROJ, (size_t)MP * PROJ_LD);
    STAMP(3);
    xcd_barrier(bar);
    STAMP(4);
    dn_prep(a, gw, ngw, lane);
    DBG_DIGEST(2, ws + WS_QKVC, (size_t)MP * 4096);
    STAMP(5);
    xcd_barrier(bar);
    STAMP(6);
    if (vcu < NB * NH) dn_prompt(a, lds, vcu / NH, vcu % NH, tid, wave, lane);
    else {
        const int nt = G - NB * NH, ti = vcu - NB * NH;
        unsigned* tcnt = ctl + CW_TEAM; unsigned ep = 0;
        float* SX = (float*)(ws + WS_SX); bf16* SXB = (bf16*)(ws + WS_SXB); float* SSS = (float*)(ws + WS_SSS);
        bf16* SGATED = (bf16*)(ws + WS_SGATED); bf16* SH = (bf16*)(ws + WS_SH); bf16* SYB = (bf16*)(ws + WS_SYB);
#define TEAM_BAR() team_barrier(tcnt, (unsigned)nt * (++ep))
        dn_sample_all(a, lds, ti, nt, tid, wave, lane);
        STAMP(20);
        TEAM_BAR();
        STAMP(21);
        { const SEpiRes<false> E{a.in[1], SX, SXB, SSS};
          for (int u = ti; u < D / 32; u += nt) sgemm_unit<2>(lds, SGATED, W2 + (size_t)u * 32 * VAL, nullptr, VAL, E, 0, u, wave, lane); }
        STAMPV(22);
        TEAM_BAR();
        STAMPV(23);
        {
            { const SEpiSwiglu E{SH, SSS, 32};
              for (int u = ti; u < FFN / 32; u += nt) { const bf16* bg = W3 + (size_t)((u >> 2) * 256 + (u & 3) * 32) * D;
                  sgemm_unit<4>(lds, SXB, bg, bg + (size_t)128 * D, D, E, 0, u, wave, lane); } }
            STAMPV(24);
            TEAM_BAR();
            STAMPV(25);
            { const SEpiRes<false> E{SX, SX, SXB, SSS};
              for (int u = ti; u < D / 32; u += nt) sgemm_unit<2>(lds, SH, W4 + (size_t)u * 32 * FFN, nullptr, FFN, E, 0, u, wave, lane); }
            STAMPV(26);
            TEAM_BAR();
            STAMPV(27);
            {
                const ldsp wl = lds + wave * 12800;
                for (int j = ti * NWAVES + wave; j < 512; j += nt * NWAVES) s5_wave(a, wl, true, 0, (j & 7) * 16, j >> 3, lane);
                STAMPV(28);
                TEAM_BAR();
                STAMPV(29);
                { const SEpiRes<true> E{SX, SX, SXB, SSS};
                  for (int u = ti; u < D / 32; u += nt) { const bf16* bv = W5 + (size_t)((u >> 2) * 256 + (u & 3) * 32) * D;
                      sgemm_unit<4>(lds, SYB, bv, bv + (size_t)128 * D, D, E, 0, u, wave, lane); } }
            }
        }
#undef TEAM_BAR
    }
    DBG_DIGEST(3, GATED, (size_t)MP * VAL);
    STAMP(7);
    xcd_barrier(bar);
    STAMP(8);
    { pg8::EpiRes<false, 0> E{a.in[0], nullptr, (pg8::bf16_t*)XB, SS};
      GEMM_PHASE(SINGLE_ARG(pg8::EpiRes<false, 0>), GATED, W2, D, VAL, E); }
#if REPG == 2
    xcd_barrier(bar);
    { pg8::EpiRes<false, 0> E{a.in[0], nullptr, (pg8::bf16_t*)XB, SS};
      GEMM_PHASE(SINGLE_ARG(pg8::EpiRes<false, 0>), GATED, W2, D, VAL, E); }
#endif
    xcd_barrier(bar);
    { pg8::EpiSwiglu E{(pg8::bf16_t*)HB, FFN, SS, 16};
      GEMM_PHASE(pg8::EpiSwiglu, XB, W3, 2 * FFN, D, E); }
    if (bx >= 128 && bx - 128 < FFN / 32) {
        const int u = bx - 128; const SEpiSwiglu Es{(bf16*)(ws + WS_SH), (const float*)(ws + WS_SSS), 32};
        const bf16* bg = W3 + (size_t)2 * FFN * D + (size_t)((u >> 2) * 256 + (u & 3) * 32) * D;
        sgemm_unit<4>(lds, (const bf16*)(ws + WS_SXB), bg, bg + (size_t)128 * D, D, Es, 0, u, wave, lane); }
#if REPG == 3
    xcd_barrier(bar);
    { pg8::EpiSwiglu E{(pg8::bf16_t*)HB, FFN, SS, 16};
      GEMM_PHASE(pg8::EpiSwiglu, XB, W3, 2 * FFN, D, E); }
#endif
    xcd_barrier(bar);
    { pg8::EpiRes<false, 1> E{nullptr, nullptr, (pg8::bf16_t*)XB, SS};
      GEMM_PHASE(SINGLE_ARG(pg8::EpiRes<false, 1>), HB, W4, D, FFN, E); }
    xcd_barrier(bar);
    {
        const ldsp wl = lds + wave * 12800;
        STAMP(9);
        (void)wl; s5_prompt_wg(a, lds, vcu, G, wave, lane);
        STAMP(10);
    }
    xcd_barrier(bar);
    STAMP(11);
    { pg8::EpiRes<true, 1> E{nullptr, nullptr, (pg8::bf16_t*)XB, SS};
      GEMM_PHASE(SINGLE_ARG(pg8::EpiRes<true, 1>), YB, W5, 2 * D, D, E); }
    xcd_barrier(bar);
    { pg8::EpiSwiglu E{(pg8::bf16_t*)HB, FFN, SS, 32};
      GEMM_PHASE(pg8::EpiSwiglu, XB, W3 + (size_t)2 * FFN * D, 2 * FFN, D, E); }
    if (bx >= 128 && bx - 128 < D / 32) {
        const int u = bx - 128; const SEpiRes<false> Es{(const float*)(ws + WS_SX), a.out + O_YS, (bf16*)(ws + WS_SXB), (float*)(ws + WS_SSS)};
        sgemm_unit<2>(lds, (const bf16*)(ws + WS_SH), W4 + (size_t)D * FFN + (size_t)u * 32 * FFN, nullptr, FFN, Es, 0, u, wave, lane); }
    xcd_barrier(bar);
    { pg8::EpiRes<false, 2> E{nullptr, a.out + O_YP, (pg8::bf16_t*)XB, SS};
      GEMM_PHASE(SINGLE_ARG(pg8::EpiRes<false, 2>), HB, W4 + (size_t)D * FFN, D, FFN, E); }
    xcd_barrier(bar);
    for (int m = (G * NWAVES - 1 - gw); m < MS; m += ngw) {
        f32x4* xr = (f32x4*)(a.out + O_YS + (size_t)m * D) + lane;
        const float rs = pg8::row_rstd((const float*)(ws + WS_SSS), m, 32);
#pragma unroll
        for (int j = 0; j < 4; ++j) { const f32x4 gn = *((const f32x4*)a.in[8] + lane + 64 * j); xr[64 * j] = xr[64 * j] * rs * gn; }
    }
    for (int m = gw; m < MP; m += ngw) {
        f32x4* xr = (f32x4*)(a.out + O_YP + (size_t)m * D) + lane;
        const float rs = pg8::row_rstd(SS, m, 16);
#pragma unroll
        for (int j = 0; j < 4; ++j) { const f32x4 gn = *((const f32x4*)a.in[8] + lane + 64 * j); xr[64 * j] = xr[64 * j] * rs * gn; }
    }
    STAMP(12);
#if TPROBE
    xcd_barrier(bar);
    if (vcu == TP_BLK && tid == 0) { const unsigned long long t0_ = __builtin_amdgcn_s_memrealtime(), dt_ = tp_e - tp_s; while (__builtin_amdgcn_s_memrealtime() - t0_ < dt_) __builtin_amdgcn_s_sleep(8); }
#endif
#undef GEMM_PHASE
}

extern "C" void kernel_launch(void* const* d_in, const int* in_sizes, int n_in, void* d_out, int out_size, void* d_ws, size_t ws_size, hipStream_t stream) {
    static int grid = 0;
    if (grid == 0) {
        if (n_in != 26 || (size_t)out_size != O_END || ws_size < WS_END) { fprintf(stderr, "kernel_launch: unexpected shapes: n_in %d out %d ws %zu (need %zu)\n", n_in, out_size, ws_size, (size_t)WS_END); grid = -1; return; }
        int dev = 0, cus = 0, per_cu = 0;
        if (hipGetDevice(&dev) != hipSuccess || hipDeviceGetAttribute(&cus, hipDeviceAttributeMultiprocessorCount, dev) != hipSuccess) { grid = -1; return; }
        if (hipFuncSetAttribute((const void*)hybrid_fwd, hipFuncAttributeMaxDynamicSharedMemorySize, LDS_BYTES) != hipSuccess) { fprintf(stderr, "kernel_launch: hipFuncSetAttribute failed\n"); grid = -1; return; }
        if (hipOccupancyMaxActiveBlocksPerMultiprocessor(&per_cu, (const void*)hybrid_fwd, NTHREADS, LDS_BYTES) != hipSuccess || per_cu < 1) { fprintf(stderr, "kernel_launch: occupancy query says %d\n", per_cu); (void)hipGetLastError(); per_cu = 1; }
        grid = cus;
    }
    if (grid < 0) return;
    (void)hipMemsetAsync((char*)d_ws + WS_CTL, 0, CTL_ZERO_BYTES, stream);
    Args a{};
    for (int i = 0; i < 26; ++i) a.in[i] = (const float*)d_in[i];
    a.out = (float*)d_out; a.ws = (unsigned char*)d_ws;
    hipLaunchKernelGGL(hybrid_fwd, dim3(grid), dim3(NTHREADS), LDS_BYTES, stream, a);
}
```

```cpp
#define DBG_STOP 0
#define REP_DN 1
#define REP_S5 1
#define REP_P0 1
#define REPG 0
#define TPROBE 0
#define S5_GEMM 1
#define S5REP 1
#define DNP_S 0
#define DNP_E 0
#define RPA 1
#define RPB 1
#define RPE 1
#define RPF 1
#define RPO 1
#include <hip/hip_runtime.h>
#include <cstdio>
#include <cstdint>
namespace pg8 {
#define PG8_LAS __attribute__((address_space(3)))
typedef unsigned short bf16_t;
typedef short bf16x8 __attribute__((ext_vector_type(8)));
typedef float f32x4 __attribute__((ext_vector_type(4)));
typedef unsigned u32x4 __attribute__((ext_vector_type(4)));
constexpr int BM = 256, BK = 64, HALF = 128, HTB = HALF * BK * 2  , STAGE_BYTES = 8 * HTB, NXCD = 8, WGM = 8;

__host__ __device__ __forceinline__ int lds_byte(int r, int c) { const int st = (r >> 4) * 2 + (c >> 5), rr = r & 15, cc = c & 31, ob = rr * 64 + cc * 2; return st * 1024 + (ob ^ (((ob >> 9) & 1) << 5)); }
__host__ __device__ __forceinline__ void stage_rc(int b, int& R, int& C) { const int st = b / 1024, sb = b % 1024, swz = sb ^ (((sb >> 9) & 1) << 5); R = (st >> 1) * 16 + swz / 64; C = (st & 1) * 32 + (swz % 64) / 2; }
__host__ __device__ __forceinline__ int perm32(int rho) { const int n = rho >> 4, i = rho & 15; return 8 * (i >> 2) + 4 * n + (i & 3); }

struct Unit { int pm, pn; };
struct Gemm { const bf16_t* A; const bf16_t* Bt; int M, N, K; };

struct StaticOrder {
    int nM, nN, nwg, G, c;
    __host__ __device__ void init(int M, int N, int G_, int c_) { nM = M / BM; nN = N / BM; nwg = nM * nN; G = G_; c = c_; }
    __host__ __device__ bool next(int i, Unit& u) const {
        const long L = (long)i * G + c; if (L >= nwg) return false;
        int wgid = (int)L; { const int q = nwg / NXCD, r = nwg % NXCD, xcd = wgid % NXCD, off = wgid / NXCD; wgid = (xcd < r ? xcd * (q + 1) : r * (q + 1) + (xcd - r) * q) + off; }
        const int nig = WGM * nN, gid = wgid / nig, fm = gid * WGM, gsz = (nM - fm) < WGM ? (nM - fm) : WGM;
        u.pm = fm + ((wgid % nig) % gsz); u.pn = (wgid % nig) / gsz; return true;
    }
    __device__ __forceinline__ void a_ready(const Unit&) const {}
    __device__ __forceinline__ void done(const Unit&) const {}
};
typedef float f32x2c __attribute__((ext_vector_type(2))); typedef __bf16 bf16x2c __attribute__((ext_vector_type(2)));
__device__ __forceinline__ unsigned cvt_pk_bf16(float lo, float hi) { const f32x2c v = {lo, hi}; return __builtin_bit_cast(unsigned, __builtin_convertvector(v, bf16x2c)); }
typedef unsigned u32x2 __attribute__((ext_vector_type(2)));
constexpr int SS_LD = 32;
constexpr float RMS_EPS = 1e-6f;
__device__ __forceinline__ float silu_f(float x) { return x * __builtin_amdgcn_rcpf(1.0f + __expf(-x)); }
__device__ __forceinline__ float sigmoid_f(float x) { return __builtin_amdgcn_rcpf(1.0f + __expf(-x)); }
__device__ __forceinline__ float row_rstd(const float* ss, int row, int nparts) {
    const f32x4* p = (const f32x4*)(ss + (size_t)row * SS_LD); float s = 0.f;
    for (int i = 0; i < nparts / 4; ++i) { const f32x4 v = p[i]; s += (v[0] + v[1]) + (v[2] + v[3]); }
    return rsqrtf(s * (1.0f / 1024.0f) + RMS_EPS);
}
__device__ __forceinline__ void rows_rstd(const float* ss, int row0, int nparts, int fq, float (&rs)[2][4]) {
    f32x4 q[2][4];
#pragma unroll
    for (int ai = 0; ai < 2; ++ai)
#pragma unroll
        for (int m = 0; m < 4; ++m) { const float* p = ss + (size_t)(row0 + ai * HALF + m * 16) * SS_LD + 4 * fq; q[ai][m] = *(const f32x4*)p; if (nparts == 32) q[ai][m] += *(const f32x4*)(p + 16); }
#pragma unroll
    for (int ai = 0; ai < 2; ++ai)
#pragma unroll
        for (int m = 0; m < 4; ++m) { float s = (q[ai][m][0] + q[ai][m][1]) + (q[ai][m][2] + q[ai][m][3]); s += __shfl_xor(s, 16); s += __shfl_xor(s, 32); rs[ai][m] = rsqrtf(s * (1.0f / 1024.0f) + RMS_EPS); }
}
struct EpiProj {
    static constexpr bool PERM = true, AFTER_DRAIN = false;
    bf16_t* O; const float* ss; int nparts;
    __device__ __forceinline__ void operator()(const f32x4 (&acc)[2][2][4][2], const Unit& u, int wr, int wc, int fr, int fq) const {
        const int row0 = u.pm * BM + wr * 64 + fr;
        float rs[2][4]; rows_rstd(ss, row0, nparts, fq, rs);
        {
            const int col0 = u.pn * BM + wc * 32 + 8 * fq; const bool act = u.pn >= 16;
#pragma unroll
            for (int ai = 0; ai < 2; ++ai)
#pragma unroll
                for (int m = 0; m < 4; ++m) { const int row = row0 + ai * HALF + m * 16; bf16_t* rowp = O + (size_t)row * 6144 + col0; const float r = rs[ai][m];
#pragma unroll
                    for (int bj = 0; bj < 2; ++bj) { f32x4 v0 = acc[ai][bj][m][0] * r, v1 = acc[ai][bj][m][1] * r;
                        if (act) {
#pragma unroll
                            for (int j = 0; j < 4; ++j) { v0[j] = silu_f(v0[j]); v1[j] = silu_f(v1[j]); } }
                        u32x4 w; w.x = cvt_pk_bf16(v0[0], v0[1]); w.y = cvt_pk_bf16(v0[2], v0[3]); w.z = cvt_pk_bf16(v1[0], v1[1]); w.w = cvt_pk_bf16(v1[2], v1[3]);
                        *(u32x4*)(rowp + bj * HALF) = w; }
                    }
        }
    }
};
struct EpiSwiglu {
    static constexpr bool PERM = true, AFTER_DRAIN = false;
    bf16_t* O; int ldo; const float* ss; int nparts;
    __device__ __forceinline__ void operator()(const f32x4 (&acc)[2][2][4][2], const Unit& u, int wr, int wc, int fr, int fq) const {
        const int row0 = u.pm * BM + wr * 64 + fr, col0 = u.pn * HALF + wc * 32 + 8 * fq;
        float rs[2][4]; rows_rstd(ss, row0, nparts, fq, rs);
#pragma unroll
        for (int ai = 0; ai < 2; ++ai)
#pragma unroll
            for (int m = 0; m < 4; ++m) { const int row = row0 + ai * HALF + m * 16; const float r = rs[ai][m];
                f32x4 h0, h1;
#pragma unroll
                for (int j = 0; j < 4; ++j) { h0[j] = silu_f(acc[ai][0][m][0][j] * r) * (acc[ai][1][m][0][j] * r); h1[j] = silu_f(acc[ai][0][m][1][j] * r) * (acc[ai][1][m][1][j] * r); }
                u32x4 w; w.x = cvt_pk_bf16(h0[0], h0[1]); w.y = cvt_pk_bf16(h0[2], h0[3]); w.z = cvt_pk_bf16(h1[0], h1[1]); w.w = cvt_pk_bf16(h1[2], h1[3]);
                *(u32x4*)(O + (size_t)row * ldo + col0) = w; }
    }
};
template <bool GLU, int MODE> struct EpiRes {
    static constexpr bool PERM = true, AFTER_DRAIN = false;
    const float* base; float* out; bf16_t* XB; float* ss;
    __device__ __forceinline__ void operator()(const f32x4 (&acc)[2][2][4][2], const Unit& u, int wr, int wc, int fr, int fq) const {
        const int col0 = (GLU ? u.pn * HALF : u.pn * BM) + wc * 32 + 8 * fq;
#pragma unroll
        for (int ai = 0; ai < 2; ++ai) {
#pragma unroll
            for (int m = 0; m < 4; ++m) { const int row = u.pm * BM + ai * HALF + wr * 64 + m * 16 + fr;
                const size_t off = (size_t)row * 1024 + col0;
                float sq = 0.f;
#pragma unroll
                for (int bj = 0; bj < (GLU ? 1 : 2); ++bj) { const int c = bj * HALF; f32x4 v0, v1;
                    if (GLU) {
#pragma unroll
                        for (int j = 0; j < 4; ++j) { v0[j] = acc[ai][0][m][0][j] * sigmoid_f(acc[ai][1][m][0][j]); v1[j] = acc[ai][0][m][1][j] * sigmoid_f(acc[ai][1][m][1][j]); }
                    } else { v0 = acc[ai][bj][m][0]; v1 = acc[ai][bj][m][1]; }
                    f32x4 b0, b1;
                    if (MODE == 0) { b0 = *(const f32x4*)(base + off + c); b1 = *(const f32x4*)(base + off + c + 4); }
                    else { const u32x4 bw = *(const u32x4*)(XB + off + c);
                        b0 = (f32x4){__builtin_bit_cast(float, bw.x << 16), __builtin_bit_cast(float, bw.x & 0xffff0000u), __builtin_bit_cast(float, bw.y << 16), __builtin_bit_cast(float, bw.y & 0xffff0000u)};
                        b1 = (f32x4){__builtin_bit_cast(float, bw.z << 16), __builtin_bit_cast(float, bw.z & 0xffff0000u), __builtin_bit_cast(float, bw.w << 16), __builtin_bit_cast(float, bw.w & 0xffff0000u)}; }
                    const f32x4 o0 = b0 + v0, o1 = b1 + v1;
                    sq += ((o0[0] * o0[0] + o0[1] * o0[1]) + (o0[2] * o0[2] + o0[3] * o0[3])) + ((o1[0] * o1[0] + o1[1] * o1[1]) + (o1[2] * o1[2] + o1[3] * o1[3]));
                    if (MODE == 2) { *(f32x4*)(out + off + c) = o0; *(f32x4*)(out + off + c + 4) = o1; }
                    else { u32x4 w; w.x = cvt_pk_bf16(o0[0], o0[1]); w.y = cvt_pk_bf16(o0[2], o0[3]); w.z = cvt_pk_bf16(o1[0], o1[1]); w.w = cvt_pk_bf16(o1[2], o1[3]); *(u32x4*)(XB + off + c) = w; } }
                sq += __shfl_xor(sq, 16); sq += __shfl_xor(sq, 32);
                if (fq == 0) ss[(size_t)row * SS_LD + u.pn * 4 + wc] = sq; }
        }
    }
};

struct EpiFinal {
    static constexpr bool PERM = false, AFTER_DRAIN = true;
    const bf16_t* XB; float* out; const float* gfin; float* xbuf; unsigned* cnt;
    __device__ __forceinline__ void fused(f32x4 (&acc)[2][2][4][2], const Unit& u, int wr, int wc, int fr, int fq, PG8_LAS unsigned char* lds, int wid, int lane) const {
        PG8_LAS float* P = (PG8_LAS float*)lds;
        PG8_LAS float* S = (PG8_LAS float*)(lds + 8192);
        const int col0 = u.pn * BM + wc * 32 + 4 * fq;
#pragma unroll
        for (int ai = 0; ai < 2; ++ai)
#pragma unroll
            for (int m = 0; m < 4; ++m) { const int rl = ai * HALF + wr * 64 + m * 16 + fr; const size_t off = (size_t)(u.pm * BM + rl) * 1024 + col0; float sq = 0.f;
#pragma unroll
                for (int bj = 0; bj < 2; ++bj)
#pragma unroll
                    for (int n = 0; n < 2; ++n) { const u32x2 bw = *(const u32x2*)(XB + off + bj * HALF + n * 16);
                        const f32x4 b = (f32x4){__builtin_bit_cast(float, bw.x << 16), __builtin_bit_cast(float, bw.x & 0xffff0000u), __builtin_bit_cast(float, bw.y << 16), __builtin_bit_cast(float, bw.y & 0xffff0000u)};
                        const f32x4 o = b + acc[ai][bj][m][n]; acc[ai][bj][m][n] = o; sq += (o[0] * o[0] + o[1] * o[1]) + (o[2] * o[2] + o[3] * o[3]); }
                sq += __shfl_xor(sq, 16); sq += __shfl_xor(sq, 32);
                if (fq == 0) P[rl * 4 + wc] = sq; }
        asm volatile("s_waitcnt lgkmcnt(0)" ::: "memory"); __builtin_amdgcn_s_barrier(); asm volatile("" ::: "memory");
        const int row = wid * 32 + (lane & 31);
        if (lane < 32) { const float t = (P[row * 4 + 0] + P[row * 4 + 1]) + (P[row * 4 + 2] + P[row * 4 + 3]);
            __hip_atomic_store(xbuf + (size_t)(u.pm * BM + row) * 4 + u.pn, t, __ATOMIC_RELAXED, __HIP_MEMORY_SCOPE_AGENT); }
        asm volatile("s_waitcnt vmcnt(0)" ::: "memory");
        if (lane == 0) __hip_atomic_fetch_add(cnt + 64 * u.pm, 1u, __ATOMIC_RELAXED, __HIP_MEMORY_SCOPE_AGENT);
        if (wid == 0) {
            const unsigned long long t0 = __builtin_amdgcn_s_memrealtime();
            while ((unsigned)__builtin_amdgcn_readfirstlane(__hip_atomic_load(cnt + 64 * u.pm, __ATOMIC_RELAXED, __HIP_MEMORY_SCOPE_AGENT)) < 32u) {
                if (__builtin_amdgcn_s_memrealtime() - t0 > 2000000ull) break;
                __builtin_amdgcn_s_sleep(2); }
            __builtin_amdgcn_fence(__ATOMIC_ACQUIRE, "agent");
        }
        asm volatile("s_waitcnt vmcnt(0) lgkmcnt(0)" ::: "memory"); __builtin_amdgcn_s_barrier(); asm volatile("" ::: "memory");
        if (lane < 32) { const float* sl = xbuf + (size_t)(u.pm * BM + row) * 4; float t = 0.f;
#pragma unroll
            for (int k = 0; k < 4; ++k) t += __hip_atomic_load(sl + k, __ATOMIC_RELAXED, __HIP_MEMORY_SCOPE_AGENT);
            S[row] = rsqrtf(t * (1.0f / 1024.0f) + RMS_EPS); }
        asm volatile("s_waitcnt lgkmcnt(0)" ::: "memory"); __builtin_amdgcn_s_barrier(); asm volatile("" ::: "memory");
#pragma unroll
        for (int ai = 0; ai < 2; ++ai)
#pragma unroll
            for (int m = 0; m < 4; ++m) { const int rl = ai * HALF + wr * 64 + m * 16 + fr; const float rs = S[rl]; const size_t off = (size_t)(u.pm * BM + rl) * 1024 + col0;
#pragma unroll
                for (int bj = 0; bj < 2; ++bj)
#pragma unroll
                    for (int n = 0; n < 2; ++n) { const int c = bj * HALF + n * 16; const f32x4 g = *(const f32x4*)(gfin + col0 + c); *(f32x4*)(out + off + c) = acc[ai][bj][m][n] * rs * g; } }
    }
};

template <class Epi, class Sched, bool ALIGN_EPI = false, bool SP2 = false>
__device__ __forceinline__ void gemm_phase(PG8_LAS unsigned char* lds, const Gemm g, const Sched& S, const Epi& E) {
    int tid_o = threadIdx.x; asm volatile("" : "+v"(tid_o));
    const int tid = tid_o, wid = __builtin_amdgcn_readfirstlane(tid >> 6), lane = tid & 63, wr = wid >> 2, wc = wid & 3, fr = lane & 15, fq = lane >> 4;
    const int K = g.K, nt = K / BK;
    unsigned voffA[2], voffB[2];
#pragma unroll
    for (int i = 0; i < 2; ++i) { int R, C; stage_rc(tid * 16 + i * 8192, R, C); const int Rb = Epi::PERM ? ((R & ~31) + perm32(R & 31)) : R;
        voffA[i] = (unsigned)(R * K + C) * 2u; voffB[i] = (unsigned)(Rb * K + C) * 2u; }
    const size_t kstep = (size_t)(BK * 2);
    const size_t hstep = (size_t)HALF * K * 2;
    const size_t tstep = 2 * hstep;
    const unsigned ldsw = (unsigned)wid * 1024u;
    const int aoff = lds_byte(wr * 64 + fr, fq * 8), boff = lds_byte(wc * 32 + fr, fq * 8);
#define PG8_SA(b, h) (((b) * 2 + (h)) * HTB)
#define PG8_SB(b, h) ((4 + (b) * 2 + (h)) * HTB)
#define PG8_STAGE(bufoff, gbase, voff) do { _Pragma("unroll") for (int _i = 0; _i < 2; ++_i) \
        __builtin_amdgcn_global_load_lds((const unsigned*)((const char*)(gbase) + (voff)[_i]), (PG8_LAS unsigned*)(lds + (bufoff) + ldsw + _i * 8192), 16, 0, 0); } while (0)
#define PG8_LDA(dst, b, h) do { _Pragma("unroll") for (int m = 0; m < 4; ++m) _Pragma("unroll") for (int k = 0; k < 2; ++k) dst[m][k] = *(const PG8_LAS bf16x8*)(lds + PG8_SA(b, h) + aoff + m * 2048 + k * 1024); } while (0)
#define PG8_LDB(dst, b, h) do { _Pragma("unroll") for (int n = 0; n < 2; ++n) _Pragma("unroll") for (int k = 0; k < 2; ++k) dst[n][k] = *(const PG8_LAS bf16x8*)(lds + PG8_SB(b, h) + boff + n * 2048 + k * 1024); } while (0)
#define PG8_MMA(ai, bj, At, Bt) do { __builtin_amdgcn_s_setprio(1); _Pragma("unroll") for (int m = 0; m < 4; ++m) _Pragma("unroll") for (int n = 0; n < 2; ++n) _Pragma("unroll") for (int k = 0; k < 2; ++k) \
        acc[ai][bj][m][n] = __builtin_amdgcn_mfma_f32_16x16x32_bf16(Bt[n][k], At[m][k], acc[ai][bj][m][n], 0, 0, 0); __builtin_amdgcn_s_setprio(0); } while (0)
#define PG8_WAIT_V(n) asm volatile("s_waitcnt vmcnt(" #n ")" ::: "memory")
#define PG8_WAIT_L(n) asm volatile("s_waitcnt lgkmcnt(" #n ")" ::: "memory")
#define PG8_BAR __builtin_amdgcn_s_barrier()
#define PG8_SCHED __builtin_amdgcn_sched_barrier(0)
    Unit cur, nxt; int ui = 0;
    if (!S.next(0, cur)) return;
    f32x4 acc[2][2][4][2];
#pragma unroll
    for (int a = 0; a < 2; ++a)
#pragma unroll
        for (int b = 0; b < 2; ++b)
#pragma unroll
            for (int m = 0; m < 4; ++m)
#pragma unroll
                for (int n = 0; n < 2; ++n) acc[a][b][m][n] = (f32x4){0.f, 0.f, 0.f, 0.f};
    bf16x8 At[4][2], B0[2][2], B1[2][2];
    const char* cA = (const char*)g.A + (size_t)cur.pm * tstep; const char* cB = (const char*)g.Bt + (size_t)cur.pn * tstep;
    S.a_ready(cur);
    if constexpr (SP2) {
        PG8_STAGE(PG8_SB(0, 0), cB, voffB); PG8_STAGE(PG8_SB(0, 1), cB + hstep, voffB); PG8_STAGE(PG8_SA(0, 0), cA, voffA); PG8_STAGE(PG8_SA(0, 1), cA + hstep, voffA);
        if (wr == 1) PG8_BAR;
        PG8_WAIT_V(2); PG8_BAR;
        PG8_STAGE(PG8_SB(1, 0), cB + kstep, voffB); PG8_STAGE(PG8_SA(1, 0), cA + kstep, voffA); PG8_STAGE(PG8_SB(1, 1), cB + hstep + kstep, voffB);
        PG8_WAIT_V(6); PG8_BAR;
    } else {
        PG8_STAGE(PG8_SB(0, 0), cB, voffB); PG8_STAGE(PG8_SA(0, 0), cA, voffA); PG8_STAGE(PG8_SB(0, 1), cB + hstep, voffB); PG8_STAGE(PG8_SA(0, 1), cA + hstep, voffA);
        if (wr == 1) PG8_BAR;
        PG8_WAIT_V(4); PG8_BAR;
        PG8_STAGE(PG8_SB(1, 0), cB + kstep, voffB); PG8_STAGE(PG8_SA(1, 0), cA + kstep, voffA); PG8_STAGE(PG8_SB(1, 1), cB + hstep + kstep, voffB);
        PG8_WAIT_V(6); PG8_BAR;
    }
    for (;;) {
        const bool has_next = S.next(ui + 1, nxt);
        const char* nA = has_next ? (const char*)g.A + (size_t)nxt.pm * tstep : cA; const char* nB = has_next ? (const char*)g.Bt + (size_t)nxt.pn * tstep : cB;
        for (int t = 0; t < nt; t += 2) {
            const bool last = (t == nt - 2);
            const char* a1 = cA + (size_t)(t + 1) * kstep;
            const char* a2 = last ? nA : cA + (size_t)(t + 2) * kstep; const char* b2 = last ? nB : cB + (size_t)(t + 2) * kstep;
            const char* a3 = a2 + kstep; const char* b3 = b2 + kstep;
            if (last && has_next) S.a_ready(nxt);
            if constexpr (SP2) {
            PG8_LDB(B0, 0, 0); PG8_LDB(B1, 0, 1); PG8_SCHED; PG8_LDA(At, 0, 0); PG8_STAGE(PG8_SA(1, 1), a1 + hstep, voffA);
            PG8_WAIT_V(8); PG8_WAIT_L(0); PG8_BAR; PG8_MMA(0, 0, At, B0); PG8_MMA(0, 1, At, B1); PG8_BAR; PG8_SCHED;
            PG8_LDA(At, 0, 1); PG8_STAGE(PG8_SB(0, 0), b2, voffB); PG8_STAGE(PG8_SB(0, 1), b2 + hstep, voffB); PG8_STAGE(PG8_SA(0, 0), a2, voffA);
            PG8_WAIT_V(8); PG8_WAIT_L(0); PG8_BAR; PG8_MMA(1, 0, At, B0); PG8_MMA(1, 1, At, B1); PG8_BAR; PG8_SCHED;
            PG8_LDB(B0, 1, 0); PG8_LDB(B1, 1, 1); PG8_SCHED; PG8_LDA(At, 1, 0); PG8_STAGE(PG8_SA(0, 1), a2 + hstep, voffA);
            PG8_WAIT_V(8); PG8_WAIT_L(0); PG8_BAR; PG8_MMA(0, 0, At, B0); PG8_MMA(0, 1, At, B1); PG8_BAR; PG8_SCHED;
            PG8_LDA(At, 1, 1); PG8_STAGE(PG8_SB(1, 0), b3, voffB); PG8_STAGE(PG8_SB(1, 1), b3 + hstep, voffB); PG8_STAGE(PG8_SA(1, 0), a3, voffA);
            PG8_WAIT_V(8); PG8_WAIT_L(0); PG8_BAR; PG8_MMA(1, 0, At, B0); PG8_MMA(1, 1, At, B1); PG8_BAR; PG8_SCHED;
            } else {
            PG8_LDB(B0, 0, 0); PG8_SCHED; PG8_LDA(At, 0, 0); PG8_STAGE(PG8_SA(1, 1), a1 + hstep, voffA);
            PG8_WAIT_L(8); PG8_BAR; PG8_WAIT_L(0); PG8_MMA(0, 0, At, B0); PG8_BAR; PG8_SCHED;
            PG8_LDB(B1, 0, 1); PG8_STAGE(PG8_SB(0, 0), b2, voffB);
            PG8_BAR; PG8_WAIT_L(0); PG8_MMA(0, 1, At, B1); PG8_BAR;
            PG8_LDA(At, 0, 1); PG8_STAGE(PG8_SA(0, 0), a2, voffA);
            PG8_BAR; PG8_WAIT_L(0); PG8_MMA(1, 0, At, B0); PG8_BAR; PG8_SCHED;
            PG8_STAGE(PG8_SB(0, 1), b2 + hstep, voffB);
            PG8_WAIT_V(6); PG8_BAR; PG8_MMA(1, 1, At, B1); PG8_BAR;
            PG8_LDB(B0, 1, 0); PG8_SCHED; PG8_LDA(At, 1, 0); PG8_STAGE(PG8_SA(0, 1), a2 + hstep, voffA);
            PG8_WAIT_L(8); PG8_BAR; PG8_WAIT_L(0); PG8_MMA(0, 0, At, B0); PG8_BAR; PG8_SCHED;
            PG8_LDB(B1, 1, 1); PG8_STAGE(PG8_SB(1, 0), b3, voffB);
            PG8_BAR; PG8_WAIT_L(0); PG8_MMA(0, 1, At, B1); PG8_BAR;
            PG8_LDA(At, 1, 1); PG8_STAGE(PG8_SA(1, 0), a3, voffA);
            PG8_BAR; PG8_WAIT_L(0); PG8_MMA(1, 0, At, B0); PG8_BAR; PG8_SCHED;
            PG8_STAGE(PG8_SB(1, 1), b3 + hstep, voffB);
            PG8_WAIT_V(6); PG8_BAR; PG8_MMA(1, 1, At, B1); PG8_BAR;
            }
        }
        if constexpr (ALIGN_EPI) { if (wr == 0) PG8_BAR; }
        if constexpr (!Epi::AFTER_DRAIN) { E(acc, cur, wr, wc, fr, fq); S.done(cur); }
        if (!has_next) break;
#pragma unroll
        for (int a = 0; a < 2; ++a)
#pragma unroll
            for (int b = 0; b < 2; ++b)
#pragma unroll
                for (int m = 0; m < 4; ++m)
#pragma unroll
                    for (int n = 0; n < 2; ++n) acc[a][b][m][n] = (f32x4){0.f, 0.f, 0.f, 0.f};
        cur = nxt; cA = nA; cB = nB; ++ui;
        if constexpr (ALIGN_EPI) { if (wr == 1) PG8_BAR; }
    }
    PG8_WAIT_V(0);
    if constexpr (!ALIGN_EPI) { if (wr == 0) PG8_BAR; }
    PG8_BAR;
    if constexpr (Epi::AFTER_DRAIN) { E.fused(acc, cur, wr, wc, fr, fq, lds, wid, lane); S.done(cur); }
#undef PG8_SA
#undef PG8_SB
#undef PG8_STAGE
#undef PG8_LDA
#undef PG8_LDB
#undef PG8_MMA
#undef PG8_WAIT_V
#undef PG8_WAIT_L
#undef PG8_BAR
#undef PG8_SCHED
}
}
constexpr int NWAVES = 8, NTHREADS = 512;
constexpr int D = 1024, SEQ = 2048, NB = 8, MP = NB * SEQ  , MS = 128  ;
constexpr int DN_IN = 6176, PROJ_LD = 6144, VAL = 2048, FFN = 2816, NH = 16, CHUNK = 64, NCHUNK = SEQ / CHUNK;
constexpr size_t MiB = 1u << 20;
constexpr size_t WS_CTL = 0, CTL_ZERO_BYTES = 64 * 1024;
constexpr size_t WS_W1 = 1 * MiB;
constexpr size_t WS_W2 = WS_W1 + (size_t)6400 * D * 2;
constexpr size_t WS_W5 = WS_W2 + (size_t)D * VAL * 2;
constexpr size_t WS_W3 = WS_W5 + (size_t)2 * D * D * 2;
constexpr size_t WS_W4 = WS_W3 + (size_t)2 * 2 * FFN * D * 2;
constexpr size_t WS_SS = WS_W4 + (size_t)2 * D * FFN * 2;
constexpr size_t WS_BETA = WS_SS + (size_t)MP * 32 * 4;
constexpr size_t WS_GDEC = WS_BETA + (size_t)MP * 16 * 4;
constexpr size_t WS_SSS = WS_GDEC + (size_t)MP * 16 * 4;
constexpr size_t WS_SBETA = WS_SSS + (size_t)MS * 32 * 4;
constexpr size_t WS_SGDEC = WS_SBETA + (size_t)MS * 16 * 4;
constexpr size_t WS_SXB = WS_SGDEC + (size_t)MS * 16 * 4;
constexpr size_t WS_SX = WS_SXB + (size_t)MS * D * 2;
constexpr size_t WS_SPROJ = WS_SX + (size_t)MS * D * 4;
constexpr size_t WS_SGATED = WS_SPROJ + (size_t)MS * PROJ_LD * 2;
constexpr size_t WS_SH = WS_SGATED + (size_t)MS * VAL * 2;
constexpr size_t WS_SYB = WS_SH + (size_t)MS * FFN * 2;
constexpr size_t WS_S5LAM = WS_SYB + (size_t)MS * D * 2;
constexpr size_t WS_S5BB = WS_S5LAM + 64 * 64 * 2 * 4;
constexpr size_t WS_S5CM = WS_S5BB + 64 * 128 * 16 * 2;
constexpr size_t WS_S5DSK = WS_S5CM + 64 * 16 * 128 * 2;
constexpr size_t WS_GC = WS_S5DSK + 1024 * 4;
constexpr size_t WS_BT = WS_GC + (size_t)MP * 16 * 4;
constexpr size_t WS_POW = WS_BT + (size_t)MP * 16 * 4;
constexpr size_t WS_BBF = WS_POW + 64 * 64 * 17 * 2 * 4;
constexpr size_t WS_KT = WS_BBF + 64 * 64 * 2 * 16 * 4;
constexpr size_t WS_FX = WS_KT + 64 * 16 * 16 * 16 * 4;
constexpr size_t WS_XB = (WS_FX + (size_t)MP * 4 * 4 + 4095) / 4096 * 4096;
constexpr size_t WS_X = WS_XB + (size_t)MP * D * 2;
constexpr size_t WS_YB = WS_X + (size_t)MP * D * 4;
constexpr size_t WS_GATED = WS_YB + (size_t)MP * D * 2;
constexpr size_t WS_QKVC = WS_XB;
static_assert(WS_QKVC + (size_t)MP * 4096 * 2 <= WS_GATED, "QKVC overlay");
constexpr size_t WS_PROJ = WS_GATED + (size_t)MP * VAL * 2;
constexpr size_t WS_H = WS_PROJ;
constexpr size_t WS_END = WS_PROJ + (size_t)MP * PROJ_LD * 2;
constexpr int CW_BAR = 4096, CW_TEAM = 8192, CW_FIN = 8192 + 64;
constexpr size_t O_YP = 0, O_YS = O_YP + (size_t)MP * D, O_SSMP = O_YS + (size_t)MS * D, O_CONVP = O_SSMP + (size_t)NB * NH * 128 * 128, O_S5RP = O_CONVP + (size_t)NB * 3 * 4096,
                 O_S5IP = O_S5RP + (size_t)NB * 64 * 64, O_SSMS = O_S5IP + (size_t)NB * 64 * 64, O_CONVS = O_SSMS + (size_t)MS * NH * 128 * 128, O_S5RS = O_CONVS + (size_t)MS * 3 * 4096,
                 O_S5IS = O_S5RS + (size_t)MS * 64 * 64, O_END = O_S5IS + (size_t)MS * 64 * 64;
constexpr int LDS_BYTES = 163840, LDSCTL_OFF = LDS_BYTES - 256;

#define GAS __attribute__((address_space(1)))
#define LAS __attribute__((address_space(3)))
typedef unsigned short bf16;
typedef float f32x4 __attribute__((ext_vector_type(4)));
typedef float f32x2 __attribute__((ext_vector_type(2)));
typedef short bf16x8 __attribute__((ext_vector_type(8)));
typedef unsigned u32x4 __attribute__((ext_vector_type(4)));
typedef unsigned u32x2 __attribute__((ext_vector_type(2)));
typedef LAS unsigned char* ldsp;
__device__ __forceinline__ unsigned pkbf(float lo, float hi) { return pg8::cvt_pk_bf16(lo, hi); }
__device__ __forceinline__ float bflo(unsigned w) { return __builtin_bit_cast(float, w << 16); }
__device__ __forceinline__ float bfhi(unsigned w) { return __builtin_bit_cast(float, w & 0xffff0000u); }
__device__ __forceinline__ float bf1(bf16 h) { return __builtin_bit_cast(float, (unsigned)h << 16); }
__device__ __forceinline__ float wave_sum(float v) {
#pragma unroll
    for (int o = 1; o < 64; o <<= 1) v += __shfl_xor(v, o);
    return v;
}
#define MFMA16(a, b, c) __builtin_amdgcn_mfma_f32_16x16x32_bf16((a), (b), (c), 0, 0, 0)
#define MM_XROW(acc, xf, yf) (acc) = MFMA16((yf), (xf), (acc))
#define MM_YROW(acc, xf, yf) (acc) = MFMA16((xf), (yf), (acc))
#define LDS_FENCE() asm volatile("s_waitcnt lgkmcnt(0)" ::: "memory")

struct Args {
    const float* in[26]; float* out; unsigned char* ws; int pad0, pad1;
};
constexpr float RMS_EPSF = 1e-6f;
#define XB_TMO      128
#define XB_XCNT(j)  (256  + 64 * (j))
#define XB_XSUB(j)  (1280 + 64 * (j))
#define XB_XGEN(j)  (2304 + 64 * (j))
#define XB_TOP      3328
#define XB_TOPGEN   3392
#define XCD_BAR_WORDS 3456
#define XB_SPIN_CAP (1u << 18)

__device__ __forceinline__ unsigned xb_ld(unsigned* p)              { return __hip_atomic_load(p, __ATOMIC_RELAXED, __HIP_MEMORY_SCOPE_AGENT); }
__device__ __forceinline__ unsigned xb_add(unsigned* p, unsigned v) { return __hip_atomic_fetch_add(p, v, __ATOMIC_RELAXED, __HIP_MEMORY_SCOPE_AGENT); }
__device__ __forceinline__ unsigned xb_xcc_id() { return (unsigned)__builtin_amdgcn_s_getreg((3 << 11) | 20) & 0xFu; }
#define XB_SPIN(cond, bar) do { unsigned _sp = 0; while (cond) { __builtin_amdgcn_s_sleep(1); \
    if ((++_sp & 255u) == 0u) { if (xb_ld(&(bar)[XB_TMO])) break; if (_sp > XB_SPIN_CAP) { atomicAdd(&(bar)[XB_TMO], 1u); break; } } } } while (0)

struct XcdBarrier {
    unsigned* bar; unsigned x;
    volatile LAS unsigned* st;
};

__device__ __forceinline__ XcdBarrier xcd_barrier_post(unsigned* bar, volatile LAS unsigned* st) {
    XcdBarrier b; b.bar = bar; b.x = xb_xcc_id(); b.st = st;
    if (threadIdx.x == 0) (void)xb_add(&bar[XB_XCNT(b.x)], 1u);
    return b;
}
__device__ __forceinline__ void xcd_barrier_complete(unsigned* bar, unsigned x, unsigned& nloc, unsigned& nx) {
    const unsigned G = gridDim.x * gridDim.y * gridDim.z;
    unsigned sum, cnt, mine, sp = 0u;
    for (;;) {
        sum = 0u; cnt = 0u; mine = 0u;
#pragma unroll
        for (unsigned j = 0; j < 16; ++j) { const unsigned c = xb_ld(&bar[XB_XCNT(j)]); sum += c; cnt += (c > 0u) ? 1u : 0u; mine = (j == x) ? c : mine; }
        if (sum == G) break;
        __builtin_amdgcn_s_sleep(1);
        if ((++sp & 255u) == 0u) { if (xb_ld(&bar[XB_TMO])) break; if (sp > XB_SPIN_CAP) { atomicAdd(&bar[XB_TMO], 1u); break; } }
    }
    nloc = mine > 0u ? mine : 1u; nx = cnt > 0u ? cnt : 1u;
}

__device__ __forceinline__ void xcd_barrier(const XcdBarrier& b) {
    asm volatile("s_waitcnt vmcnt(0)" ::: "memory");
    __syncthreads();
    if (threadIdx.x == 0) {
        unsigned* bar = b.bar;
        __builtin_amdgcn_s_waitcnt(0);
        unsigned nloc = b.st[0], nx = b.st[1];
        if (nloc == 0u) { xcd_barrier_complete(bar, b.x, nloc, nx); b.st[0] = nloc; b.st[1] = nx; }
        const unsigned old = xb_add(&bar[XB_XSUB(b.x)], 1u);
        const unsigned gen = old / nloc;
        if (old + 1u == (gen + 1u) * nloc) {
            __builtin_amdgcn_fence(__ATOMIC_RELEASE, "agent");
            asm volatile("s_waitcnt vmcnt(0)" ::: "memory");
            const unsigned og = xb_add(&bar[XB_TOP], 1u);
            const unsigned tg = og / nx;
            if (og + 1u == (tg + 1u) * nx) xb_add(&bar[XB_TOPGEN], 1u);
            else XB_SPIN(xb_ld(&bar[XB_TOPGEN]) == tg, bar);
            __builtin_amdgcn_fence(__ATOMIC_ACQUIRE, "agent");
            xb_add(&bar[XB_XGEN(b.x)], 1u);
            asm volatile("s_waitcnt vmcnt(0)" ::: "memory");
        } else {
            XB_SPIN(xb_ld(&bar[XB_XGEN(b.x)]) == gen, bar);
            __builtin_amdgcn_fence(__ATOMIC_ACQUIRE, "agent");
            asm volatile("s_waitcnt vmcnt(0)" ::: "memory");
        }
    }
    __syncthreads();
}
__device__ __forceinline__ void sg_core(const bf16* ap, const bf16* bp, int K, int steps, f32x4 (&acc)[4][2]) {
    bf16x8 ra[4][4], rb[4][2];
    const bf16* pa[4]; const bf16* pb[2];
#pragma unroll
    for (int t = 0; t < 4; ++t) pa[t] = ap + (size_t)t * 16 * K;
    pb[0] = bp; pb[1] = bp + (size_t)16 * K;
#define SG_LOAD(slot, s) do { const int ko_ = 32 * (s); _Pragma("unroll") for (int t_ = 0; t_ < 4; ++t_) ra[slot][t_] = *(const bf16x8*)(pa[t_] + ko_); \
        rb[slot][0] = *(const bf16x8*)(pb[0] + ko_); rb[slot][1] = *(const bf16x8*)(pb[1] + ko_); } while (0)
#define SG_COMP(slot) do { _Pragma("unroll") for (int t_ = 0; t_ < 4; ++t_) { MM_XROW(acc[t_][0], ra[slot][t_], rb[slot][0]); MM_XROW(acc[t_][1], ra[slot][t_], rb[slot][1]); } } while (0)
    SG_LOAD(0, 0); SG_LOAD(1, 1); SG_LOAD(2, 2);
    int s = 0;
#pragma nounroll
    for (; s + 4 <= steps; s += 4) {
        SG_LOAD(3, s + 3);
        SG_COMP(0); if (s + 4 < steps) SG_LOAD(0, s + 4);
        SG_COMP(1); if (s + 5 < steps) SG_LOAD(1, s + 5);
        SG_COMP(2); if (s + 6 < steps) SG_LOAD(2, s + 6);
        SG_COMP(3);
    }
    const int r = steps - s;
    if (r >= 1) SG_COMP(0);
    if (r >= 2) SG_COMP(1);
    if (r >= 3) SG_COMP(2);
#undef SG_LOAD
#undef SG_COMP
}
template <int NBLK, class Epi>
__device__ __forceinline__ void sgemm_unit(ldsp lds, const bf16* A, const bf16* B0, const bf16* B1, int K, const Epi& E, int row0, int cb, int wave, int lane) {
    const int fr = lane & 15, fq = lane >> 4, rh = wave & 1, kq = wave >> 1; int steps = K / 128; asm volatile("" : "+s"(steps));
    int fro = fr; asm volatile("" : "+v"(fro));
    const bf16* ap = A + (size_t)(64 * rh + fro) * K + (size_t)kq * (K / 4) + 8 * fq;
    LAS f32x4* buf = (LAS f32x4*)lds;
#pragma unroll
    for (int pass = 0; pass < NBLK / 2; ++pass) {
        f32x4 acc[4][2];
#pragma unroll
        for (int t = 0; t < 4; ++t) { acc[t][0] = (f32x4){0.f, 0.f, 0.f, 0.f}; acc[t][1] = (f32x4){0.f, 0.f, 0.f, 0.f}; }
        sg_core(ap, (pass ? B1 : B0) + (size_t)fro * K + (size_t)kq * (K / 4) + 8 * fq, K, steps, acc);
#pragma unroll
        for (int t = 0; t < 4; ++t) { buf[(kq * 32 + (rh * 4 + t) * 4 + 2 * pass) * 64 + lane] = acc[t][0]; buf[(kq * 32 + (rh * 4 + t) * 4 + 2 * pass + 1) * 64 + lane] = acc[t][1]; }
    }
    __syncthreads();
    {
        const int rt = wave >> 1;
        f32x4 o[NBLK];
#pragma unroll
        for (int j = 0; j < NBLK; ++j) { const int slot = (rh * 4 + rt) * 4 + j; o[j] = (buf[slot * 64 + lane] + buf[(32 + slot) * 64 + lane]) + (buf[(64 + slot) * 64 + lane] + buf[(96 + slot) * 64 + lane]); }
        E(o, row0 + 64 * rh + 16 * rt + fr, cb, fq);
    }
    __syncthreads();
}
struct SEpiProj {
    bf16* O; const float* ss; int nparts; float* beta; float* gdec; const float* a_log; const float* dt_bias;
    __device__ __forceinline__ void operator()(const f32x4 (&acc)[2], int row, int cb, int fq) const {
        const float rs = pg8::row_rstd(ss, row, nparts);
        if (cb < 192) {
#pragma unroll
            for (int j = 0; j < 2; ++j) { f32x4 v = acc[j] * rs;
                if (cb >= 128) {
#pragma unroll
                    for (int r = 0; r < 4; ++r) v[r] = pg8::silu_f(v[r]); }
                u32x2 w; w.x = pkbf(v[0], v[1]); w.y = pkbf(v[2], v[3]); *(u32x2*)(O + (size_t)row * PROJ_LD + 32 * cb + 16 * j + 4 * fq) = w; }
        } else {
            f32x4 b, g;
#pragma unroll
            for (int r = 0; r < 4; ++r) { b[r] = pg8::sigmoid_f(acc[0][r] * rs); const int h = 4 * fq + r; const float xx = acc[1][r] * rs + dt_bias[h]; const float ex = __expf(xx);
                const float sp = xx > 15.f ? xx : (ex < 1e-3f ? ex * (1.0f - 0.5f * ex) : __logf(1.0f + ex)); g[r] = -__expf(a_log[h]) * sp; }
            *(f32x4*)(beta + (size_t)row * 16 + 4 * fq) = b; *(f32x4*)(gdec + (size_t)row * 16 + 4 * fq) = g;
        }
    }
};
template <bool GLU> struct SEpiRes {
    const float* base; float* out; bf16* XB; float* ss;
    __device__ __forceinline__ void operator()(const f32x4 (&acc)[GLU ? 4 : 2], int row, int cb, int fq) const {
        float sq = 0.f;
#pragma unroll
        for (int j = 0; j < 2; ++j) { f32x4 v = acc[j];
            if (GLU) {
#pragma unroll
                for (int r = 0; r < 4; ++r) v[r] = v[r] * pg8::sigmoid_f(acc[2 + j][r]); }
            const size_t off = (size_t)row * D + 32 * cb + 16 * j + 4 * fq;
            const f32x4 o = *(const f32x4*)(base + off) + v; *(f32x4*)(out + off) = o;
            sq += (o[0] * o[0] + o[1] * o[1]) + (o[2] * o[2] + o[3] * o[3]);
            u32x2 w; w.x = pkbf(o[0], o[1]); w.y = pkbf(o[2], o[3]); *(u32x2*)(XB + off) = w; }
        sq += __shfl_xor(sq, 16); sq += __shfl_xor(sq, 32);
        if (fq == 0) ss[(size_t)row * 32 + cb] = sq;
    }
};
struct SEpiSwiglu {
    bf16* H; const float* ss; int nparts;
    __device__ __forceinline__ void operator()(const f32x4 (&acc)[4], int row, int cb, int fq) const {
        const float rs = pg8::row_rstd(ss, row, nparts);
#pragma unroll
        for (int j = 0; j < 2; ++j) { f32x4 h;
#pragma unroll
            for (int r = 0; r < 4; ++r) h[r] = pg8::silu_f(acc[j][r] * rs) * (acc[2 + j][r] * rs);
            u32x2 w; w.x = pkbf(h[0], h[1]); w.y = pkbf(h[2], h[3]); *(u32x2*)(H + (size_t)row * FFN + 32 * cb + 16 * j + 4 * fq) = w; }
    }
};
__device__ __forceinline__ void team_barrier(unsigned* cnt, unsigned target) {
    asm volatile("s_waitcnt vmcnt(0)" ::: "memory");
    __syncthreads();
    if (threadIdx.x == 0) {
        __builtin_amdgcn_fence(__ATOMIC_RELEASE, "agent");
        asm volatile("s_waitcnt vmcnt(0)" ::: "memory");
        (void)__hip_atomic_fetch_add(cnt, 1u, __ATOMIC_RELAXED, __HIP_MEMORY_SCOPE_AGENT);
        unsigned sp = 0;
        while (__hip_atomic_load(cnt, __ATOMIC_RELAXED, __HIP_MEMORY_SCOPE_AGENT) < target) { __builtin_amdgcn_s_sleep(2); if (++sp > (1u << 22)) break; }
        __builtin_amdgcn_fence(__ATOMIC_ACQUIRE, "agent");
        asm volatile("s_waitcnt vmcnt(0)" ::: "memory");
    }
    __syncthreads();
}
__device__ __forceinline__ void sincos_cw(float x, float& s, float& c) {
    const float k = rintf(x * 0.636619772367581343f);
    float r = fmaf(-k, 1.57079625129699707031f, x); r = fmaf(-k, 7.54978941586159635e-08f, r); r = fmaf(-k, 5.39030285815811482e-15f, r);
    const float z = r * r;
    const float sp = fmaf(fmaf(fmaf(-1.9515295891e-4f, z, 8.3321608736e-3f), z, -1.6666654611e-1f) * z, r, r);
    const float cp = fmaf(fmaf(fmaf(2.443315711809948e-5f, z, -1.388731625493765e-3f), z, 4.166664568298827e-2f), z * z, fmaf(-0.5f, z, 1.0f));
    const int q = (int)k & 3;
    const float ss = (q & 1) ? cp : sp, cc = (q & 1) ? sp : cp;
    s = (q & 2) ? -ss : ss; c = ((q + 1) & 2) ? -cc : cc;
}
__device__ __forceinline__ void s5_disc(const Args& a, int g, int p, float dt, float& lr, float& li, float& fre, float& fim) {
    const float are = a.in[15][g * 64 + p], aim = a.in[16][g * 64 + p];
    const float mag = __expf(are * dt); float sn, cs; sincos_cw(aim * dt, sn, cs);
    lr = mag * cs; li = mag * sn;
    const float den = are * are + aim * aim, nre = lr - 1.0f, nim = li;
    fre = (nre * are + nim * aim) / den; fim = (nim * are - nre * aim) / den;
}
__device__ __forceinline__ float gelu_tanh(float x) { const float u = 0.7978845608028654f * (x + 0.044715f * x * x * x); const float t = 1.0f - 2.0f * __builtin_amdgcn_rcpf(__expf(2.0f * u) + 1.0f); return 0.5f * x * (1.0f + t); }
__device__ __forceinline__ void s5_precompute(const Args& a, int idx) {
    unsigned char* ws = a.ws;
    if (idx < 4096) {
        const int g = idx >> 6, p = idx & 63;
        const float dt = __expf(a.in[17][g]);
        float lr, li, fre, fim; s5_disc(a, g, p, dt, lr, li, fre, fim);
        float* lam = (float*)(ws + WS_S5LAM) + (size_t)idx * 2; lam[0] = lr; lam[1] = li;
        const float* br = a.in[18] + (size_t)idx * 16; const float* bi = a.in[19] + (size_t)idx * 16; const float* gm = a.in[6] + D + g * 16;
        u32x4* bb = (u32x4*)((bf16*)(ws + WS_S5BB) + ((size_t)g * 128 + 2 * p) * 16);
        float vr[16], vi[16];
#pragma unroll
        for (int c = 0; c < 16; ++c) { const float re = br[c], im = bi[c], gg = gm[c]; vr[c] = (fre * re - fim * im) * gg; vi[c] = (fre * im + fim * re) * gg; }
        bb[0] = (u32x4){pkbf(vr[0], vr[1]), pkbf(vr[2], vr[3]), pkbf(vr[4], vr[5]), pkbf(vr[6], vr[7])};
        bb[1] = (u32x4){pkbf(vr[8], vr[9]), pkbf(vr[10], vr[11]), pkbf(vr[12], vr[13]), pkbf(vr[14], vr[15])};
        bb[2] = (u32x4){pkbf(vi[0], vi[1]), pkbf(vi[2], vi[3]), pkbf(vi[4], vi[5]), pkbf(vi[6], vi[7])};
        bb[3] = (u32x4){pkbf(vi[8], vi[9]), pkbf(vi[10], vi[11]), pkbf(vi[12], vi[13]), pkbf(vi[14], vi[15])};
        {
            f32x4* bf = (f32x4*)((float*)(ws + WS_BBF) + (size_t)idx * 32);
#pragma unroll
            for (int q = 0; q < 4; ++q) { bf[q] = (f32x4){vr[4 * q], vr[4 * q + 1], vr[4 * q + 2], vr[4 * q + 3]}; bf[4 + q] = (f32x4){vi[4 * q], vi[4 * q + 1], vi[4 * q + 2], vi[4 * q + 3]}; }
            const float are = a.in[15][idx], aim = a.in[16][idx];
            float* pw = (float*)(ws + WS_POW) + (size_t)idx * 34;
            for (int dd = 0; dd <= 16; ++dd) { const float mg = __expf(are * dt * (float)dd); float sn, cs; sincos_cw(aim * dt * (float)dd, sn, cs); pw[2 * dd] = mg * cs; pw[2 * dd + 1] = mg * sn; }
        }
        unsigned* cm = (unsigned*)((bf16*)(ws + WS_S5CM) + (size_t)g * 16 * 128 + 2 * p);
#pragma unroll
        for (int c = 0; c < 16; ++c) cm[c * 64] = pkbf(a.in[20][(size_t)(g * 16 + c) * 64 + p], -a.in[21][(size_t)(g * 16 + c) * 64 + p]);
    }
    if (idx < 1024) ((float*)(ws + WS_S5DSK))[idx] = a.in[22][idx] * a.in[6][D + idx];
}
__device__ __forceinline__ void s5_ktable(const Args& a, int t) {
    if (t >= 65536) return;
    unsigned char* ws = a.ws;
    const int g = t >> 10, dd = (t >> 6) & 15, c = (t >> 2) & 15, cq = t & 3;
    const float* pw = (const float*)(ws + WS_POW) + (size_t)g * 64 * 34 + 2 * dd; const float* bf = (const float*)(ws + WS_BBF) + (size_t)g * 64 * 32 + 4 * cq;
    const float* cre = a.in[20] + (size_t)(g * 16 + c) * 64; const float* cim = a.in[21] + (size_t)(g * 16 + c) * 64;
    f32x4 acc = (f32x4){0.f, 0.f, 0.f, 0.f};
    for (int p = 0; p < 64; ++p) {
        const float lr = pw[p * 34], li = pw[p * 34 + 1], cr = cre[p], ci = cim[p];
        const float zr = cr * lr - ci * li, zi = cr * li + ci * lr;
        const f32x4 br = *(const f32x4*)(bf + p * 32), bi = *(const f32x4*)(bf + p * 32 + 16);
        acc += br * zr - bi * zi;
    }
    if (dd == 0 && (c >> 2) == cq) acc[c & 3] += ((const float*)(ws + WS_S5DSK))[g * 16 + c];
    *(f32x4*)((float*)(ws + WS_KT) + ((size_t)(g * 16 + dd) * 16 + c) * 16 + 4 * cq) = acc;
}
__device__ __forceinline__ void p0_transpose_item(const float* W, int K, int N, const float* gain, int gluh, bf16* WT, LAS float* scr, int item, int lane) {
    const int nblk = N / 32, kb = item / nblk, nb = item % nblk, k0 = 64 * kb, n0 = 32 * nb;
    f32x4 v[8];
#pragma unroll
    for (int i = 0; i < 8; ++i) v[i] = __builtin_nontemporal_load((const f32x4*)(W + (size_t)(k0 + 8 * i + (lane >> 3)) * N + n0 + 4 * (lane & 7)));
#pragma unroll
    for (int i = 0; i < 8; ++i) { const int kk = 8 * i + (lane >> 3); const float gk = gain ? gain[k0 + kk] : 1.0f; LAS float* s = scr + kk * 33 + 4 * (lane & 7);
        s[0] = v[i][0] * gk; s[1] = v[i][1] * gk; s[2] = v[i][2] * gk; s[3] = v[i][3] * gk; }
    LDS_FENCE();
    int r0 = n0; if (gluh > 0) r0 = (n0 < gluh) ? (n0 / 128) * 256 + (n0 % 128) : ((n0 - gluh) / 128) * 256 + 128 + ((n0 - gluh) % 128);
    const int c = lane & 7;
#pragma unroll
    for (int j = 0; j < 4; ++j) { const int n = (lane >> 3) + 8 * j; const LAS float* s = scr + (8 * c) * 33 + n;
        u32x4 o; o.x = pkbf(s[0 * 33], s[1 * 33]); o.y = pkbf(s[2 * 33], s[3 * 33]); o.z = pkbf(s[4 * 33], s[5 * 33]); o.w = pkbf(s[6 * 33], s[7 * 33]);
        *(u32x4*)(WT + (size_t)(r0 + n) * K + k0 + 8 * c) = o; }
    LDS_FENCE();
}
__device__ __forceinline__ void p0_prologue(const Args& a, ldsp lds, int gw, int ngw, int wave, int lane) {
    LAS float* scr = (LAS float*)(lds + wave * 16384);
    unsigned char* ws = a.ws;
    constexpr int I1 = (D / 64) * (DN_IN / 32), I2 = (VAL / 64) * (D / 32), I5 = (D / 64) * (2 * D / 32), I3 = (D / 64) * (2 * FFN / 32), I4 = (FFN / 64) * (D / 32);
    constexpr int NITEMS = I1 + I2 + I5 + 2 * I3 + 2 * I4;
    for (int it = gw; it < NITEMS; it += ngw) {
        int r = it;
        if (r < I1) { p0_transpose_item(a.in[9], D, DN_IN, a.in[6], 0, (bf16*)(ws + WS_W1), scr, r, lane); continue; } r -= I1;
        if (r < I2) { p0_transpose_item(a.in[14], VAL, D, nullptr, 0, (bf16*)(ws + WS_W2), scr, r, lane); continue; } r -= I2;
        if (r < I5) { p0_transpose_item(a.in[23], D, 2 * D, nullptr, D, (bf16*)(ws + WS_W5), scr, r, lane); continue; } r -= I5;
        if (r < 2 * I3) { const int l = r / I3; p0_transpose_item(a.in[24] + (size_t)l * D * 2 * FFN, D, 2 * FFN, a.in[7] + l * D, FFN, (bf16*)(ws + WS_W3) + (size_t)l * 2 * FFN * D, scr, r % I3, lane); continue; } r -= 2 * I3;
        { const int l = r / I4; p0_transpose_item(a.in[25] + (size_t)l * FFN * D, FFN, D, nullptr, 0, (bf16*)(ws + WS_W4) + (size_t)l * D * FFN, scr, r % I4, lane); }
    }
    {
        f32x4 nv[4]; int m = gw;
#define P0_XLOAD(mm) do { const bool smp_ = (mm) >= MP; const int r_ = smp_ ? (mm) - MP : (mm); const f32x4* xr_ = (const f32x4*)((smp_ ? a.in[1] : a.in[0]) + (size_t)r_ * D) + lane; \
        _Pragma("unroll") for (int j_ = 0; j_ < 4; ++j_) nv[j_] = xr_[64 * j_]; } while (0)
        if (m < MP + MS) P0_XLOAD(m);
        for (; m < MP + MS; m += ngw) {
            const bool smp = m >= MP; const int r = smp ? m - MP : m;
            f32x4 v[4]; float s = 0.f;
#pragma unroll
            for (int j = 0; j < 4; ++j) { v[j] = nv[j]; s += (v[j][0] * v[j][0] + v[j][1] * v[j][1]) + (v[j][2] * v[j][2] + v[j][3] * v[j][3]); }
            if (m + ngw < MP + MS) P0_XLOAD(m + ngw);
            s = wave_sum(s);
            u32x2* o8 = (u32x2*)((bf16*)(ws + (smp ? WS_SXB : WS_XB)) + (size_t)r * D) + lane;
#pragma unroll
            for (int j = 0; j < 4; ++j) { u32x2 w; w.x = pkbf(v[j][0], v[j][1]); w.y = pkbf(v[j][2], v[j][3]); o8[64 * j] = w; }
            float* ssr = (float*)(ws + (smp ? WS_SSS : WS_SS)) + (size_t)r * 32;
            if (lane < (smp ? 32 : 16)) ssr[lane] = (lane == 0) ? s : 0.f;
        }
#undef P0_XLOAD
    }
    if (wave == 7) s5_precompute(a, (gw >> 3) * 64 + lane);
}
constexpr int DL_K = 0, DL_V = 17408, DL_QK = 34816, DL_X = 44032, DL_SLOT = 9216, DL_ST = 99328, DL_GC = 134144, DL_BETA = 134400, DL_RED = 134656, DL_Q = 135680, DL_END = 135680 + 17408;
static_assert(DL_END <= LDSCTL_OFF, "DN LDS map");
__device__ __forceinline__ bf16x8 ldfrag(ldsp base, int row, int ld, int k) { return *(const LAS bf16x8*)(base + (row * ld + k) * 2); }
__device__ __forceinline__ void st4(ldsp base, int row, int ld, int col, const f32x4 v) { u32x2 w; w.x = pkbf(v[0], v[1]); w.y = pkbf(v[2], v[3]); *(LAS u32x2*)(base + (row * ld + col) * 2) = w; }
__device__ __forceinline__ void st1(ldsp base, int row, int ld, int col, float v) { *(LAS unsigned short*)(base + (row * ld + col) * 2) = (unsigned short)(pkbf(v, 0.f) & 0xffffu); }

typedef short s16x4 __attribute__((ext_vector_type(4)));
__device__ __forceinline__ bf16x8 ldfrag_tr(ldsp base, int k0, int ld, int c0, int fr, int fq) {
    const ldsp p = base + ((k0 + 8 * fq + (fr >> 2)) * ld + c0 + 4 * (fr & 3)) * 2;
    const s16x4 lo = __builtin_amdgcn_ds_read_tr16_b64_v4i16((LAS s16x4*)p);
    const s16x4 hi = __builtin_amdgcn_ds_read_tr16_b64_v4i16((LAS s16x4*)(p + 8 * ld));
    return (bf16x8){lo[0], lo[1], lo[2], lo[3], hi[0], hi[1], hi[2], hi[3]};
}
__device__ __forceinline__ void dn_prep(const Args& a, int gw, int ngw, int lane) {
    const bf16* PROJ = (const bf16*)(a.ws + WS_PROJ); bf16* QKVC = (bf16*)(a.ws + WS_QKVC);
    {
        const float* BETA = (const float*)(a.ws + WS_BETA); const float* GDEC = (const float*)(a.ws + WS_GDEC);
        float* GC = (float*)(a.ws + WS_GC); float* BT = (float*)(a.ws + WS_BT);
        for (int u = gw; u < NB * NH * NCHUNK; u += ngw) {
            const int c = u % NCHUNK, h = (u / NCHUNK) % NH, b = u / (NCHUNK * NH); const int row = b * SEQ + c * CHUNK + lane;
            float g = GDEC[(size_t)row * 16 + h]; const float bt = BETA[(size_t)row * 16 + h];
#pragma unroll
            for (int o = 1; o < 64; o <<= 1) { const float t = __shfl_up(g, o); if (lane >= o) g += t; }
            GC[(size_t)(b * NH + h) * SEQ + c * CHUNK + lane] = g; BT[(size_t)(b * NH + h) * SEQ + c * CHUNK + lane] = bt;
        }
    }
    for (int u = gw; u < NB * 8 * (SEQ / 32); u += ngw) {
        const int cb = u & 7, run = (u >> 3) & 63, b = u >> 9, ch0 = cb * 512 + lane * 8, t0 = run * 32, row0 = b * SEQ + t0;
        float w[4][8];
#pragma unroll
        for (int j = 0; j < 4; ++j) { const f32x4 w0 = *(const f32x4*)(a.in[10] + j * 4096 + ch0), w1 = *(const f32x4*)(a.in[10] + j * 4096 + ch0 + 4);
#pragma unroll
            for (int e = 0; e < 4; ++e) { w[j][e] = w0[e]; w[j][4 + e] = w1[e]; } }
        u32x4 xm[3];
#pragma unroll
        for (int j = 0; j < 3; ++j) { xm[j] = (u32x4){0u, 0u, 0u, 0u}; if (t0 - 3 + j >= 0) xm[j] = *(const u32x4*)(PROJ + (size_t)(row0 - 3 + j) * PROJ_LD + ch0); }
        const float scl = cb < 2 ? 0.08838834764831845f : 1.0f;
        u32x4 xr[8];
#pragma unroll
        for (int t = 0; t < 8; ++t) xr[t] = *(const u32x4*)(PROJ + (size_t)(row0 + t) * PROJ_LD + ch0);
#pragma unroll
        for (int t = 0; t < 32; ++t) {
            const u32x4 x0 = xr[t & 7];
            if (t + 8 < 32) xr[t & 7] = *(const u32x4*)(PROJ + (size_t)(row0 + t + 8) * PROJ_LD + ch0);
            float y[8];
#pragma unroll
            for (int e = 0; e < 4; ++e) {
                const unsigned a3 = xm[0][e], a2 = xm[1][e], a1 = xm[2][e], a0 = x0[e];
                y[2 * e] = w[0][2 * e] * bflo(a3) + w[1][2 * e] * bflo(a2) + w[2][2 * e] * bflo(a1) + w[3][2 * e] * bflo(a0);
                y[2 * e + 1] = w[0][2 * e + 1] * bfhi(a3) + w[1][2 * e + 1] * bfhi(a2) + w[2][2 * e + 1] * bfhi(a1) + w[3][2 * e + 1] * bfhi(a0); }
            float ssq = 0.f;
#pragma unroll
            for (int e = 0; e < 8; ++e) { y[e] = y[e] * __builtin_amdgcn_rcpf(1.0f + __expf(-y[e])); ssq += y[e] * y[e]; }
            if (cb < 4) { ssq += __shfl_xor(ssq, 1); ssq += __shfl_xor(ssq, 2); ssq += __shfl_xor(ssq, 4); ssq += __shfl_xor(ssq, 8); const float sc = rsqrtf(ssq + 1e-6f) * scl;
#pragma unroll
                for (int e = 0; e < 8; ++e) y[e] *= sc; }
            u32x4 o; o.x = pkbf(y[0], y[1]); o.y = pkbf(y[2], y[3]); o.z = pkbf(y[4], y[5]); o.w = pkbf(y[6], y[7]);
            *(u32x4*)(QKVC + (size_t)(row0 + t) * 4096 + ch0) = o;
            xm[0] = xm[1]; xm[1] = xm[2]; xm[2] = x0;
        }
    }
}

#ifndef RPA
#define RPA 1
#endif
#ifndef RPB
#define RPB 1
#endif
#ifndef RPE
#define RPE 1
#endif
#ifndef RPF
#define RPF 1
#endif
#ifndef RPO
#define RPO 1
#endif
__device__ __forceinline__ void dn_prompt(const Args& a, ldsp lds, int b, int h, int tid, int wave, int lane) {
    unsigned char* ws = a.ws;
    const bf16* PROJ = (const bf16*)(ws + WS_PROJ); const bf16* QKVC = (const bf16*)(ws + WS_QKVC); bf16* GATED = (bf16*)(ws + WS_GATED);
    const float* GC = (const float*)(ws + WS_GC) + (size_t)(b * NH + h) * SEQ; const float* BT = (const float*)(ws + WS_BT) + (size_t)(b * NH + h) * SEQ;
    const int mt = wave & 3, ch = wave >> 2, hq = h >> 1;
    LAS float* gcs = (LAS float*)(lds + DL_GC); LAS float* betas = (LAS float*)(lds + DL_BETA); LAS float* red = (LAS float*)(lds + DL_RED);
    const ldsp LK = lds + DL_K, LV = lds + DL_V, LQK = lds + DL_QK, LST = lds + DL_ST, LQ = lds + DL_Q;
#define SLOT(s) (lds + DL_X + (s) * DL_SLOT)
#define PRs(s) ((s) == 0 ? 0 : (((s) & 1) ? 2 : 4))
#define PTs(s) ((s) == 0 ? 1 : (((s) & 1) ? 3 : 5))
#define NRs(s) ((s) & 1)
    for (int i = tid; i < 128 * 136 / 2; i += NTHREADS) ((LAS unsigned*)LST)[i] = 0u;
    f32x4 S[2][4];
#pragma unroll
    for (int x = 0; x < 2; ++x)
#pragma unroll
        for (int q = 0; q < 4; ++q) S[x][q] = (f32x4){0.f, 0.f, 0.f, 0.f};
    LAS float* ngl = (LAS float*)(lds + DL_RED + 512);
    if (tid < 128) ngl[tid] = a.in[13][tid];
    u32x4 nQt[2], nKt[2], nVt[2]; float ngd = 0.f, nbt = 0.f;
#define DN_PREFETCH(cc) do { const int rowc_ = b * SEQ + (cc) * CHUNK; const bf16* krow_ = QKVC + (size_t)(rowc_ + (tid >> 3)) * 4096; \
        _Pragma("unroll") for (int p2_ = 0; p2_ < 2; ++p2_) { const int col_ = 8 * ((tid & 7) + 8 * p2_); nQt[p2_] = *(const u32x4*)(krow_ + hq * 128 + col_); nKt[p2_] = *(const u32x4*)(krow_ + 1024 + hq * 128 + col_); nVt[p2_] = *(const u32x4*)(krow_ + 2048 + h * 128 + col_); } \
        ngd = GC[(cc) * CHUNK + lane]; nbt = BT[(cc) * CHUNK + lane]; } while (0)
    DN_PREFETCH(0);
#define DN_TILES_TO_LDS() do { const int r_ = tid >> 3, pc_ = tid & 7; \
        _Pragma("unroll") for (int p2_ = 0; p2_ < 2; ++p2_) { const int col_ = 8 * (pc_ + 8 * p2_); *(LAS u32x4*)(LQ + (r_ * 136 + col_) * 2) = nQt[p2_]; *(LAS u32x4*)(LK + (r_ * 136 + col_) * 2) = nKt[p2_]; *(LAS u32x4*)(LV + (r_ * 136 + col_) * 2) = nVt[p2_]; } \
        if (wave == 0) { gcs[lane] = ngd; betas[lane] = nbt; } } while (0)
    DN_TILES_TO_LDS();
    DN_PREFETCH(NCHUNK > 1 ? 1 : 0);
    __syncthreads();
    for (int c = 0; c < NCHUNK; ++c) {
        int lane_c = lane; asm volatile("" : "+v"(lane_c));
        const int fr = lane_c & 15, fq = lane_c >> 4, i_own = 16 * mt + fr;
        const int t_own = c * CHUNK + i_own, row_own = b * SEQ + t_own;
        bf16x8 qf[4], kf[4]; u32x2 zc[4];
#pragma unroll
        for (int q = 0; q < 4; ++q) zc[q] = *(const u32x2*)(PROJ + (size_t)row_own * PROJ_LD + 4096 + h * 128 + 16 * (4 * ch + q) + 4 * fq);
#pragma unroll
        for (int kk = 0; kk < 4; ++kk) { kf[kk] = ldfrag(LK, i_own, 136, 32 * kk + 8 * fq); qf[kk] = ldfrag(LQ, i_own, 136, 32 * kk + 8 * fq); }
        for (int rpB = 0; rpB < RPB; ++rpB) {
        f32x4 Pt[2], Nt[2];
        {
            const float gi = gcs[i_own], bi = betas[i_own];
#pragma unroll
            for (int q2 = 0; q2 < 2; ++q2) { const int nt = 2 * ch + q2;
                f32x4 akk = (f32x4){0.f, 0.f, 0.f, 0.f}, aqk = akk;
#pragma unroll
                for (int kk = 0; kk < 4; ++kk) { const bf16x8 yf = ldfrag(LK, 16 * nt + fr, 136, 32 * kk + 8 * fq); MM_XROW(akk, kf[kk], yf); MM_XROW(aqk, qf[kk], yf); }
                const f32x4 gj = *(const LAS f32x4*)(gcs + 16 * nt + 4 * fq);
                f32x4 qkv, m0;
#pragma unroll
                for (int r = 0; r < 4; ++r) { const int j = 16 * nt + 4 * fq + r; const float d = (i_own >= j) ? __expf(gi - gj[r]) : 0.f; qkv[r] = aqk[r] * d; m0[r] = (i_own > j) ? -bi * akk[r] * d : 0.f; }
                st4(LQK, i_own, 72, 16 * nt + 4 * fq, qkv);
                Pt[q2] = m0; Nt[q2] = m0;
                st4(SLOT(0), i_own, 72, 16 * nt + 4 * fq, m0); }
        }
        __syncthreads();
#pragma unroll
        for (int s = 1; s <= 6; ++s) {
            f32x4 Pn[2];
            bf16x8 xn[2], xp[2];
            if (s >= 2) { xn[0] = ldfrag(SLOT(NRs(s - 2)), i_own, 72, 8 * fq); xn[1] = ldfrag(SLOT(NRs(s - 2)), i_own, 72, 32 + 8 * fq); }
            if (s <= 5) { xp[0] = ldfrag(SLOT(PRs(s - 1)), i_own, 72, 8 * fq); xp[1] = ldfrag(SLOT(PRs(s - 1)), i_own, 72, 32 + 8 * fq); }
#pragma unroll
            for (int q2 = 0; q2 < 2; ++q2) { const int nt = 2 * ch + q2;
                const bf16x8 y0 = ldfrag_tr(SLOT(PRs(s - 1)), 0, 72, 16 * nt, fr, fq), y1 = ldfrag_tr(SLOT(PRs(s - 1)), 32, 72, 16 * nt, fr, fq);
                if (s >= 2) { f32x4 acc = Nt[q2] + Pt[q2]; MM_XROW(acc, xn[0], y0); MM_XROW(acc, xn[1], y1); Nt[q2] = acc; }
                if (s <= 5) { f32x4 acc = (f32x4){0.f, 0.f, 0.f, 0.f}; MM_XROW(acc, xp[0], y0); MM_XROW(acc, xp[1], y1); Pn[q2] = acc; }
            }
#pragma unroll
            for (int q2 = 0; q2 < 2; ++q2) { const int nt = 2 * ch + q2, j0 = 16 * nt + 4 * fq;
                if (s <= 5) { Pt[q2] = Pn[q2];
                    st4(SLOT(PRs(s)), i_own, 72, j0, Pn[q2]); }
                if (s >= 2 && s <= 5) st4(SLOT(NRs(s - 1)), i_own, 72, j0, Nt[q2]);
                if (s == 6) {
                    const f32x4 gj = *(const LAS f32x4*)(gcs + j0), bj = *(const LAS f32x4*)(betas + j0); f32x4 t1, t2;
#pragma unroll
                    for (int r = 0; r < 4; ++r) { const float tv = Nt[q2][r] + ((i_own == j0 + r) ? 1.f : 0.f); t2[r] = tv * bj[r]; t1[r] = t2[r] * __expf(gj[r]); }
                    st4(SLOT(1), i_own, 72, j0, t1); st4(SLOT(3), i_own, 72, j0, t2); }
            }
            __syncthreads();
        }
        }
        f32x4 U[4]; bf16x8 ka[2][2];
        for (int rpE = 0; rpE < RPE; ++rpE) {
        {
#pragma unroll
            for (int x = 0; x < 2; ++x) { ka[x][0] = ldfrag_tr(LK, 0, 136, 16 * (2 * mt + x), fr, fq); ka[x][1] = ldfrag_tr(LK, 32, 136, 16 * (2 * mt + x), fr, fq); }
            const bf16x8 t1a = ldfrag(SLOT(1), i_own, 72, 8 * fq), t1b = ldfrag(SLOT(1), i_own, 72, 32 + 8 * fq), t2a = ldfrag(SLOT(3), i_own, 72, 8 * fq), t2b = ldfrag(SLOT(3), i_own, 72, 32 + 8 * fq);
#pragma unroll
            for (int q = 0; q < 4; ++q) { const int nt = 4 * ch + q;
                f32x4 aw = (f32x4){0.f, 0.f, 0.f, 0.f};
                MM_XROW(aw, t1a, ldfrag_tr(LK, 0, 136, 16 * nt, fr, fq)); MM_XROW(aw, t1b, ldfrag_tr(LK, 32, 136, 16 * nt, fr, fq));
                st4(SLOT(4), i_own, 136, 16 * nt + 4 * fq, -aw);
                f32x4 au = (f32x4){0.f, 0.f, 0.f, 0.f};
                MM_YROW(au, t2a, ldfrag_tr(LV, 0, 136, 16 * nt, fr, fq)); MM_YROW(au, t2b, ldfrag_tr(LV, 32, 136, 16 * nt, fr, fq));
                U[q] = au; }
        }
        __syncthreads();
        }
        f32x4 O[4];
        const float gl = gcs[63];
        for (int rpF = 0; rpF < RPF; ++rpF) {
        {
            bf16x8 wf[4];
#pragma unroll
            for (int kk = 0; kk < 4; ++kk) wf[kk] = ldfrag(SLOT(4), i_own, 136, 32 * kk + 8 * fq);
            const float ei = __expf(gcs[i_own]);
            const f32x4 gq = *(const LAS f32x4*)(gcs + 16 * mt + 4 * fq);
#pragma unroll
            for (int q = 0; q < 4; ++q) { const int nt = 4 * ch + q;
                f32x4 ao = (f32x4){0.f, 0.f, 0.f, 0.f}, av = U[q];
#pragma unroll
                for (int kk = 0; kk < 4; ++kk) { const bf16x8 sf = ldfrag(LST, 16 * nt + fr, 136, 32 * kk + 8 * fq); MM_YROW(av, wf[kk], sf); MM_XROW(ao, qf[kk], sf); }
                O[q] = ao * ei;
                st4(SLOT(0), 16 * nt + fr, 72, 16 * mt + 4 * fq, av);
                f32x4 avd;
#pragma unroll
                for (int r = 0; r < 4; ++r) avd[r] = av[r] * __expf(gl - gq[r]);
                st4(SLOT(2), 16 * nt + fr, 72, 16 * mt + 4 * fq, avd); }
        }
        __syncthreads();
        }
        {
            const bf16x8 qa = ldfrag(LQK, i_own, 72, 8 * fq), qb = ldfrag(LQK, i_own, 72, 32 + 8 * fq);
            DN_TILES_TO_LDS();
            const float el = __expf(gl);
            float ssq = 0.f;
#pragma unroll
            for (int q = 0; q < 4; ++q) { const int nt = 4 * ch + q;
                MM_XROW(O[q], qa, ldfrag(SLOT(0), 16 * nt + fr, 72, 8 * fq)); MM_XROW(O[q], qb, ldfrag(SLOT(0), 16 * nt + fr, 72, 32 + 8 * fq));
                ssq += (O[q][0] * O[q][0] + O[q][1] * O[q][1]) + (O[q][2] * O[q][2] + O[q][3] * O[q][3]);
                const bf16x8 v0 = ldfrag(SLOT(2), 16 * nt + fr, 72, 8 * fq), v1 = ldfrag(SLOT(2), 16 * nt + fr, 72, 32 + 8 * fq);
#pragma unroll
                for (int x = 0; x < 2; ++x) { f32x4 sacc = S[x][q] * el; MM_YROW(sacc, ka[x][0], v0); MM_YROW(sacc, ka[x][1], v1); S[x][q] = sacc;
                    st4(LST, 16 * nt + fr, 136, 16 * (2 * mt + x) + 4 * fq, sacc); } }
            ssq += __shfl_xor(ssq, 16); ssq += __shfl_xor(ssq, 32);
            if (fq == 0) red[i_own * 2 + ch] = ssq;
            { const int cn = (c + 2 < NCHUNK) ? c + 2 : NCHUNK - 1; DN_PREFETCH(cn); }
        }
        __syncthreads();
        for (int rpO = 0; rpO < RPO; ++rpO) {
        {
            const float rstd = rsqrtf((red[i_own * 2] + red[i_own * 2 + 1]) * (1.0f / 128.0f) + RMS_EPSF);
#pragma unroll
            for (int q = 0; q < 4; ++q) { const int dv = 16 * (4 * ch + q) + 4 * fq;
                const u32x2 z = zc[q];
                const f32x4 ngv = *(const LAS f32x4*)(ngl + dv);
                u32x2 w; w.x = pkbf(O[q][0] * rstd * ngv[0] * bflo(z.x), O[q][1] * rstd * ngv[1] * bfhi(z.x)); w.y = pkbf(O[q][2] * rstd * ngv[2] * bflo(z.y), O[q][3] * rstd * ngv[3] * bfhi(z.y));
                *(u32x2*)(GATED + (size_t)row_own * VAL + h * 128 + dv) = w; }
        }
        }
    }
    const int fr = lane & 15, fq = lane >> 4;
    float* so = a.out + O_SSMP + (size_t)(b * NH + h) * 128 * 128;
#pragma unroll
    for (int x = 0; x < 2; ++x)
#pragma unroll
        for (int q = 0; q < 4; ++q)
#pragma unroll
            for (int r = 0; r < 4; ++r) so[(size_t)(16 * (2 * mt + x) + 4 * fq + r) * 128 + 16 * (4 * ch + q) + fr] = S[x][q][r];
    for (int i = tid; i < 3 * 384; i += NTHREADS) { const int j = i / 384, cc = i % 384; if (cc < 256 && (h & 1)) continue;
        const int gch = cc < 128 ? hq * 128 + cc : (cc < 256 ? 1024 + hq * 128 + (cc - 128) : 2048 + h * 128 + (cc - 256));
        a.out[O_CONVP + (size_t)(b * 3 + j) * 4096 + gch] = bf1(PROJ[(size_t)(b * SEQ + SEQ - 3 + j) * PROJ_LD + gch]); }
    __syncthreads();
#undef SLOT
#undef DN_PREFETCH
#undef DN_TILES_TO_LDS
#undef PRs
#undef PTs
#undef NRs
}
__device__ __forceinline__ void dn_sample_all(const Args& a, ldsp lds, int ti, int nt, int tid, int wave, int lane) {
    unsigned char* ws = a.ws;
    const bf16* PROJ = (const bf16*)(ws + WS_SPROJ); bf16* GATED = (bf16*)(ws + WS_SGATED);
    const float* BETA = (const float*)(ws + WS_SBETA); const float* GDEC = (const float*)(ws + WS_SGDEC);
    LAS float* qkv = (LAS float*)lds;
    LAS float* red = qkv + 384;
    LAS float* part = qkv + 512;
    const int kg = tid >> 5, v4 = tid & 31, p = tid >> 7, c = tid & 127;
    f32x4 sn[8]; float nx3 = 0.f, nc0 = 0.f, nc1 = 0.f, nc2 = 0.f, nbeta = 0.f, ngd = 0.f; u32x2 nz = (u32x2){0u, 0u};
    float w0 = 0.f, w1 = 0.f, w2 = 0.f, w3 = 0.f; int gch_cur = -1;
#define DNS_LOAD(it_) do { const int bs_ = (it_) / NH, h_ = (it_) % NH, hq_ = h_ >> 1; \
        const float* sin_ = a.in[2] + ((size_t)(bs_ * NH + h_) * 128 + kg * 8) * 128 + 4 * v4; \
        _Pragma("unroll") for (int r_ = 0; r_ < 8; ++r_) sn[r_] = *(const f32x4*)(sin_ + r_ * 128); \
        if (tid < 384) { const int gch_ = p == 0 ? hq_ * 128 + c : (p == 1 ? 1024 + hq_ * 128 + c : 2048 + h_ * 128 + c); \
            nx3 = bf1(PROJ[(size_t)bs_ * PROJ_LD + gch_]); const float* cs_ = a.in[3] + (size_t)bs_ * 3 * 4096 + gch_; nc0 = cs_[0]; nc1 = cs_[4096]; nc2 = cs_[8192]; } \
        nbeta = BETA[(size_t)bs_ * 16 + h_]; ngd = GDEC[(size_t)bs_ * 16 + h_]; \
        if (tid < 32) nz = *(const u32x2*)(PROJ + (size_t)bs_ * PROJ_LD + 4096 + h_ * 128 + 4 * v4); } while (0)
    int it = ti;
    if (it < MS * NH) DNS_LOAD(it);
    for (; it < MS * NH; it += nt) {
        const int bs = it / NH, h = it % NH, hq = h >> 1;
        f32x4 s[8];
#pragma unroll
        for (int r = 0; r < 8; ++r) s[r] = sn[r];
        const float x3 = nx3, c0 = nc0, c1 = nc1, c2 = nc2, beta = nbeta, eg = __expf(ngd); const u32x2 z = nz;
        const int gch = p == 0 ? hq * 128 + c : (p == 1 ? 1024 + hq * 128 + c : 2048 + h * 128 + c);
        if (tid < 384 && gch != gch_cur) { const float* w = a.in[10] + gch; w0 = w[0]; w1 = w[4096]; w2 = w[8192]; w3 = w[12288]; gch_cur = gch; }
        if (it + nt < MS * NH) DNS_LOAD(it + nt);
        float sq = 0.f;
        if (tid < 384) {
            float y = c0 * w0 + c1 * w1 + c2 * w2 + x3 * w3; y = y / (1.0f + __expf(-y));
            if (p == 2 || (h & 1) == 0) { float* co = a.out + O_CONVS + (size_t)bs * 3 * 4096 + gch; co[0] = c1; co[4096] = c2; co[8192] = x3; }
            qkv[tid] = y; sq = y * y; }
        sq = wave_sum(sq);
        if (lane == 0) red[wave] = sq;
        __syncthreads();
        const float qs = rsqrtf(red[0] + red[1] + 1e-6f) * 0.08838834764831845f, ks = rsqrtf(red[2] + red[3] + 1e-6f);
        float* sout = a.out + O_SSMS + ((size_t)(bs * NH + h) * 128 + kg * 8) * 128 + 4 * v4;
        f32x4 kv = (f32x4){0.f, 0.f, 0.f, 0.f};
#pragma unroll
        for (int r = 0; r < 8; ++r) { s[r] = s[r] * eg; kv += s[r] * (qkv[128 + kg * 8 + r] * ks); }
        *(LAS f32x4*)(part + kg * 128 + 4 * v4) = kv;
        __syncthreads();
        kv = (f32x4){0.f, 0.f, 0.f, 0.f};
#pragma unroll
        for (int g = 0; g < 16; ++g) kv += *(const LAS f32x4*)(part + g * 128 + 4 * v4);
        const f32x4 vv = *(const LAS f32x4*)(qkv + 256 + 4 * v4);
        const f32x4 delta = (vv - kv) * beta;
        f32x4 op = (f32x4){0.f, 0.f, 0.f, 0.f};
#pragma unroll
        for (int r = 0; r < 8; ++r) { s[r] += delta * (qkv[128 + kg * 8 + r] * ks); *(f32x4*)(sout + r * 128) = s[r]; op += s[r] * (qkv[kg * 8 + r] * qs); }
        __syncthreads();
        *(LAS f32x4*)(part + kg * 128 + 4 * v4) = op;
        __syncthreads();
        if (tid < 32) {
            f32x4 o = (f32x4){0.f, 0.f, 0.f, 0.f};
#pragma unroll
            for (int g = 0; g < 16; ++g) o += *(const LAS f32x4*)(part + g * 128 + 4 * v4);
            float ss = (o[0] * o[0] + o[1] * o[1]) + (o[2] * o[2] + o[3] * o[3]);
#pragma unroll
            for (int m = 1; m < 32; m <<= 1) ss += __shfl_xor(ss, m);
            const float rstd = rsqrtf(ss * (1.0f / 128.0f) + RMS_EPSF);
            const f32x4 ng = *(const f32x4*)(a.in[13] + 4 * v4);
            u32x2 w; w.x = pkbf(o[0] * rstd * ng[0] * bflo(z.x), o[1] * rstd * ng[1] * bfhi(z.x)); w.y = pkbf(o[2] * rstd * ng[2] * bflo(z.y), o[3] * rstd * ng[3] * bfhi(z.y));
            *(u32x2*)(GATED + (size_t)bs * VAL + h * 128 + 4 * v4) = w;
        }
        __syncthreads();
    }
#undef DNS_LOAD
}
__device__ __forceinline__ void s5_wave(const Args& a, ldsp wl, bool sample, int b, int e0, int g, int lane) {
    unsigned char* ws = a.ws;
    const bf16* XB = (const bf16*)(ws + (sample ? WS_SXB : WS_XB)); bf16* YB = (bf16*)(ws + (sample ? WS_SYB : WS_YB)); const float* SS = (const float*)(ws + (sample ? WS_SSS : WS_SS));
    const int fr = lane & 15, fq = lane >> 4;
    LAS float* bubuf = (LAS float*)wl;
    const ldsp stbuf = wl + 16 * 132 * 4;
    const f32x2 lam = *(const f32x2*)((const float*)(ws + WS_S5LAM) + (size_t)(g * 64 + lane) * 2); const float lr = lam[0], li = lam[1];
    bf16x8 bbf[8];
#pragma unroll
    for (int nt = 0; nt < 8; ++nt) { u32x4 w = (u32x4){0u, 0u, 0u, 0u}; if (fq < 2) w = *(const u32x4*)((const bf16*)(ws + WS_S5BB) + ((size_t)g * 128 + 16 * nt + fr) * 16 + 8 * fq); bbf[nt] = __builtin_bit_cast(bf16x8, w); }
    bf16x8 cf[4];
#pragma unroll
    for (int kk = 0; kk < 4; ++kk) cf[kk] = *(const bf16x8*)((const bf16*)(ws + WS_S5CM) + ((size_t)g * 16 + fr) * 128 + 32 * kk + 8 * fq);
    const f32x4 dskv = *(const f32x4*)((const float*)(ws + WS_S5DSK) + g * 16 + 4 * fq); const float dsk[4] = {dskv[0], dskv[1], dskv[2], dskv[3]};
    float sre = 0.f, sim = 0.f;
    const int ntile = sample ? 1 : SEQ / 16;
    const int rowb0 = sample ? e0 : b * SEQ;
    u32x4 pxw[4]; f32x4 pss[4]; u32x2 puw[4];
#define S5_LOAD(k, tile) do { const int row_ = rowb0 + (tile) * 16 + fr; pxw[k] = (u32x4){0u, 0u, 0u, 0u}; if (fq < 2) pxw[k] = *(const u32x4*)(XB + (size_t)row_ * D + g * 16 + 8 * fq); \
        pss[k] = *(const f32x4*)(SS + (size_t)row_ * 32 + 4 * fq); if (sample) pss[k] += *(const f32x4*)(SS + (size_t)row_ * 32 + 16 + 4 * fq); puw[k] = *(const u32x2*)(XB + (size_t)row_ * D + g * 16 + 4 * fq); } while (0)
#pragma unroll
    for (int k = 0; k < 4; ++k) if (k < ntile) S5_LOAD(k, k);
    for (int t0 = 0; t0 < ntile; t0 += 4) {
#pragma unroll
        for (int k = 0; k < 4; ++k) {
            const int tile = t0 + k; if (tile >= ntile) break;
            const int row = rowb0 + tile * 16 + fr;
            const bf16x8 xf = __builtin_bit_cast(bf16x8, pxw[k]);
            float ssum = (pss[k][0] + pss[k][1]) + (pss[k][2] + pss[k][3]); ssum += __shfl_xor(ssum, 16); ssum += __shfl_xor(ssum, 32);
            const float rs = rsqrtf(ssum * (1.0f / 1024.0f) + RMS_EPSF);
            const u32x2 uw = puw[k];
            if (tile + 4 < ntile) S5_LOAD(k, tile + 4);
#pragma unroll
            for (int nt = 0; nt < 8; ++nt) { f32x4 acc = (f32x4){0.f, 0.f, 0.f, 0.f}; MM_XROW(acc, xf, bbf[nt]); *(LAS f32x4*)(bubuf + fr * 132 + 16 * nt + 4 * fq) = acc * rs; }
            LDS_FENCE();
            f32x2 buv[16];
#pragma unroll
            for (int t = 0; t < 16; ++t) buv[t] = *(const LAS f32x2*)(bubuf + t * 132 + 2 * lane);
            LDS_FENCE();
#pragma unroll
            for (int t = 0; t < 16; ++t) {
                const f32x2 bu = buv[t];
                if (sample) { sre = a.in[4][(size_t)(e0 + t) * 4096 + g * 64 + lane]; sim = a.in[5][(size_t)(e0 + t) * 4096 + g * 64 + lane]; }
                const float nr = fmaf(lr, sre, fmaf(-li, sim, bu[0])), ni = fmaf(lr, sim, fmaf(li, sre, bu[1]));
                sre = nr; sim = ni;
                *(LAS unsigned*)(stbuf + (t * 136 + 2 * lane) * 2) = pkbf(sre, sim);
                if (sample) { a.out[O_S5RS + (size_t)(e0 + t) * 4096 + g * 64 + lane] = sre; a.out[O_S5IS + (size_t)(e0 + t) * 4096 + g * 64 + lane] = sim; }
            }
            LDS_FENCE();
            f32x4 y = (f32x4){0.f, 0.f, 0.f, 0.f};
#pragma unroll
            for (int kk = 0; kk < 4; ++kk) MM_XROW(y, ldfrag(stbuf, fr, 136, 32 * kk + 8 * fq), cf[kk]);
            y[0] += dsk[0] * bflo(uw.x) * rs; y[1] += dsk[1] * bfhi(uw.x) * rs; y[2] += dsk[2] * bflo(uw.y) * rs; y[3] += dsk[3] * bfhi(uw.y) * rs;
            u32x2 w; w.x = pkbf(gelu_tanh(y[0]), gelu_tanh(y[1])); w.y = pkbf(gelu_tanh(y[2]), gelu_tanh(y[3]));
            *(u32x2*)(YB + (size_t)row * D + g * 16 + 4 * fq) = w;
            LDS_FENCE();
        }
    }
#undef S5_LOAD
    if (!sample) { a.out[O_S5RP + (size_t)(b * 64 + g) * 64 + lane] = sre; a.out[O_S5IP + (size_t)(b * 64 + g) * 64 + lane] = sim; }
}
template <bool EMIT>
__device__ __forceinline__ void s5_tiles(const bf16* XB, bf16* YB, const float* SS, ldsp wl, int rowb0, int ntile, int g, int lane, float lr, float li,
                                         const bf16x8 (&bbf)[8], const bf16x8 (&cf)[4], const float (&dsk)[4], float& sre, float& sim) {
    const int fr = lane & 15, fq = lane >> 4;
    LAS float* bubuf = (LAS float*)wl; const ldsp stbuf = wl + 16 * 132 * 4;
    u32x4 pxw[4]; f32x4 pss[4]; u32x2 puw[4];
#define S5_LOAD(k, tile) do { const int row_ = rowb0 + (tile) * 16 + fr; pxw[k] = (u32x4){0u, 0u, 0u, 0u}; if (fq < 2) pxw[k] = *(const u32x4*)(XB + (size_t)row_ * D + g * 16 + 8 * fq); \
        pss[k] = *(const f32x4*)(SS + (size_t)row_ * 32 + 4 * fq); if (EMIT) puw[k] = *(const u32x2*)(XB + (size_t)row_ * D + g * 16 + 4 * fq); } while (0)
#pragma unroll
    for (int k = 0; k < 4; ++k) if (k < ntile) S5_LOAD(k, k);
    for (int t0 = 0; t0 < ntile; t0 += 4) {
#pragma unroll
        for (int k = 0; k < 4; ++k) {
            const int tile = t0 + k; if (tile >= ntile) break;
            const int row = rowb0 + tile * 16 + fr;
            const bf16x8 xf = __builtin_bit_cast(bf16x8, pxw[k]);
            float ssum = (pss[k][0] + pss[k][1]) + (pss[k][2] + pss[k][3]); ssum += __shfl_xor(ssum, 16); ssum += __shfl_xor(ssum, 32);
            const float rs = rsqrtf(ssum * (1.0f / 1024.0f) + RMS_EPSF);
            u32x2 uw = (u32x2){0u, 0u}; if (EMIT) uw = puw[k];
            if (tile + 4 < ntile) S5_LOAD(k, tile + 4);
#pragma unroll
            for (int nt = 0; nt < 8; ++nt) { f32x4 acc = (f32x4){0.f, 0.f, 0.f, 0.f}; MM_XROW(acc, xf, bbf[nt]); *(LAS f32x4*)(bubuf + fr * 132 + 16 * nt + 4 * fq) = acc * rs; }
            LDS_FENCE();
            f32x2 buv[16];
#pragma unroll
            for (int t = 0; t < 16; ++t) buv[t] = *(const LAS f32x2*)(bubuf + t * 132 + 2 * lane);
            LDS_FENCE();
#pragma unroll
            for (int t = 0; t < 16; ++t) {
                const float nr = fmaf(lr, sre, fmaf(-li, sim, buv[t][0])), ni = fmaf(lr, sim, fmaf(li, sre, buv[t][1]));
                sre = nr; sim = ni;
                if (EMIT) *(LAS unsigned*)(stbuf + (t * 136 + 2 * lane) * 2) = pkbf(sre, sim);
            }
            if (EMIT) {
                LDS_FENCE();
                f32x4 y = (f32x4){0.f, 0.f, 0.f, 0.f};
#pragma unroll
                for (int kk = 0; kk < 4; ++kk) MM_XROW(y, ldfrag(stbuf, fr, 136, 32 * kk + 8 * fq), cf[kk]);
                y[0] += dsk[0] * bflo(uw.x) * rs; y[1] += dsk[1] * bfhi(uw.x) * rs; y[2] += dsk[2] * bflo(uw.y) * rs; y[3] += dsk[3] * bfhi(uw.y) * rs;
                u32x2 w; w.x = pkbf(gelu_tanh(y[0]), gelu_tanh(y[1])); w.y = pkbf(gelu_tanh(y[2]), gelu_tanh(y[3]));
                *(u32x2*)(YB + (size_t)row * D + g * 16 + 4 * fq) = w;
            }
            LDS_FENCE();
        }
    }
#undef S5_LOAD
}
__device__ __forceinline__ void s5_prompt_wg(const Args& a, ldsp lds, int vcu, int G, int wave, int lane) {
    unsigned char* ws = a.ws;
    const bf16* XB = (const bf16*)(ws + WS_XB); bf16* YB = (bf16*)(ws + WS_YB); const float* SS = (const float*)(ws + WS_SS);
    const int fr = lane & 15, fq = lane >> 4, p = wave >> 2, seg = wave & 3;
    const ldsp wl = lds + wave * 12800;
    LAS f32x2* exch = (LAS f32x2*)(lds + 8 * 12800);
    const int nrounds = (256 + G - 1) / G;
    for (int k = 0; k < nrounds; ++k) {
        const bool valid = vcu + k * G < 256;
        const int it = valid ? (vcu + k * G) * 2 + p : 0, b = it >> 6, g = it & 63;
        const f32x2 lam = *(const f32x2*)((const float*)(ws + WS_S5LAM) + (size_t)(g * 64 + lane) * 2); const float lr = lam[0], li = lam[1];
        bf16x8 bbf[8];
#pragma unroll
        for (int nt = 0; nt < 8; ++nt) { u32x4 w = (u32x4){0u, 0u, 0u, 0u}; if (fq < 2) w = *(const u32x4*)((const bf16*)(ws + WS_S5BB) + ((size_t)g * 128 + 16 * nt + fr) * 16 + 8 * fq); bbf[nt] = __builtin_bit_cast(bf16x8, w); }
        bf16x8 cf[4];
#pragma unroll
        for (int kk = 0; kk < 4; ++kk) cf[kk] = *(const bf16x8*)((const bf16*)(ws + WS_S5CM) + ((size_t)g * 16 + fr) * 128 + 32 * kk + 8 * fq);
        const f32x4 dskv = *(const f32x4*)((const float*)(ws + WS_S5DSK) + g * 16 + 4 * fq); const float dsk[4] = {dskv[0], dskv[1], dskv[2], dskv[3]};
        const int rowb0 = b * SEQ + seg * 512;
        float sre = 0.f, sim = 0.f;
        if (valid && seg < 3) s5_tiles<false>(XB, YB, SS, wl, rowb0, 32, g, lane, lr, li, bbf, cf, dsk, sre, sim);
        exch[(p * 4 + seg) * 64 + lane] = (f32x2){sre, sim};
        __syncthreads();
        if (valid) {
            float Lr = lr, Li = li;
#pragma unroll
            for (int q = 0; q < 9; ++q) { const float r2 = Lr * Lr - Li * Li, i2 = 2.0f * Lr * Li; Lr = r2; Li = i2; }
            float cr = 0.f, ci = 0.f;
            for (int j = 0; j < seg; ++j) { const f32x2 e = exch[(p * 4 + j) * 64 + lane]; const float nr = Lr * cr - Li * ci + e[0], ni = Lr * ci + Li * cr + e[1]; cr = nr; ci = ni; }
            sre = cr; sim = ci;
            s5_tiles<true>(XB, YB, SS, wl, rowb0, 32, g, lane, lr, li, bbf, cf, dsk, sre, sim);
            if (seg == 3) { a.out[O_S5RP + (size_t)(b * 64 + g) * 64 + lane] = sre; a.out[O_S5IP + (size_t)(b * 64 + g) * 64 + lane] = sim; }
        }
        __syncthreads();
    }
}
template <int KK, bool SCAN>
__device__ __forceinline__ void s5_gemm_role(const Args& a, ldsp lds, int g, int bp, int tid, int wave, int lane) {
    unsigned char* ws = a.ws;
    const bf16* XB = (const bf16*)(ws + WS_XB); bf16* YB = (bf16*)(ws + WS_YB); const float* SS = (const float*)(ws + WS_SS);
    asm volatile("" : "+v"(lane), "+s"(wave), "+v"(tid));
    const int fr = lane & 15, fq = lane >> 4;
    const ldsp UT = lds, SIN = lds + 3 * 8448;
    const float* kt = (const float*)(ws + WS_KT) + (size_t)g * 4096;
    const float* pw = (const float*)(ws + WS_POW) + (size_t)g * 64 * 34;
    const float* bfp = (const float*)(ws + WS_BBF) + (size_t)g * 64 * 32;
    const float* cre = a.in[20] + (size_t)g * 16 * 64; const float* cim = a.in[21] + (size_t)g * 16 * 64;
    bf16x8 vf[2][4], Fw[2][KK];
#pragma unroll
    for (int x = 0; x < 2; ++x) { const int tau = 2 * wave + x;
#pragma unroll
        for (int kk = 0; kk < 4; ++kk) { const int p0 = 16 * kk + 4 * fq; const f32x4 cr4 = *(const f32x4*)(cre + fr * 64 + p0), ci4 = *(const f32x4*)(cim + fr * 64 + p0); float v[8];
#pragma unroll
            for (int q = 0; q < 4; ++q) { const float lr = pw[(p0 + q) * 34 + 2 * (tau + 1)], li = pw[(p0 + q) * 34 + 2 * (tau + 1) + 1]; v[2 * q] = cr4[q] * lr - ci4[q] * li; v[2 * q + 1] = -(cr4[q] * li + ci4[q] * lr); }
            u32x4 w; w.x = pkbf(v[0], v[1]); w.y = pkbf(v[2], v[3]); w.z = pkbf(v[4], v[5]); w.w = pkbf(v[6], v[7]); vf[x][kk] = __builtin_bit_cast(bf16x8, w); }
#pragma unroll
        for (int kk = 0; kk < KK; ++kk) { const int lag = tau - 2 * kk - (fq >> 1); u32x4 w = (u32x4){0u, 0u, 0u, 0u};
            if (lag >= 0) { const float* kp = kt + ((size_t)lag * 16 + fr) * 16 + 8 * (fq & 1); const f32x4 k0 = *(const f32x4*)kp, k1 = *(const f32x4*)(kp + 4);
                w.x = pkbf(k0[0], k0[1]); w.y = pkbf(k0[2], k0[3]); w.z = pkbf(k1[0], k1[1]); w.w = pkbf(k1[2], k1[3]); }
            Fw[x][kk] = __builtin_bit_cast(bf16x8, w); } }
    float l1r = 0.f, l1i = 0.f, l4r = 0.f, l4i = 0.f;
    bf16x8 wr[SCAN ? 8 : 1], wi[SCAN ? 8 : 1];
    const int ps = 16 * (wave & 3) + fr;
    if (SCAN) {
#pragma unroll
        for (int kk = 0; kk < 8; ++kk) { const int j = 2 * kk + (fq >> 1); const float lr = pw[ps * 34 + 2 * (15 - j)], li = pw[ps * 34 + 2 * (15 - j) + 1];
            const float* bp_ = bfp + ps * 32 + 8 * (fq & 1); const f32x4 r0 = *(const f32x4*)bp_, r1 = *(const f32x4*)(bp_ + 4), i0 = *(const f32x4*)(bp_ + 16), i1 = *(const f32x4*)(bp_ + 20);
            u32x4 wa, wb;
            wa.x = pkbf(lr * r0[0] - li * i0[0], lr * r0[1] - li * i0[1]); wa.y = pkbf(lr * r0[2] - li * i0[2], lr * r0[3] - li * i0[3]); wa.z = pkbf(lr * r1[0] - li * i1[0], lr * r1[1] - li * i1[1]); wa.w = pkbf(lr * r1[2] - li * i1[2], lr * r1[3] - li * i1[3]);
            wb.x = pkbf(lr * i0[0] + li * r0[0], lr * i0[1] + li * r0[1]); wb.y = pkbf(lr * i0[2] + li * r0[2], lr * i0[3] + li * r0[3]); wb.z = pkbf(lr * i1[0] + li * r1[0], lr * i1[1] + li * r1[1]); wb.w = pkbf(lr * i1[2] + li * r1[2], lr * i1[3] + li * r1[3]);
            wr[kk] = __builtin_bit_cast(bf16x8, wa); wi[kk] = __builtin_bit_cast(bf16x8, wb); }
        l1r = pw[ps * 34 + 32]; l1i = pw[ps * 34 + 33];
        const float l2r = l1r * l1r - l1i * l1i, l2i = 2.0f * l1r * l1i; l4r = l2r * l2r - l2i * l2i; l4i = 2.0f * l2r * l2i;
    }
    const int token = tid >> 1, half = tid & 1;
    u32x4 pxwA, pxwB; f32x4 psaA, psbA, psaB, psbB;
#define S5G_ULOAD(SET, ct_) do { const int c__ = (ct_) < 16 ? (ct_) : 15; const size_t row_ = (size_t)(2 * bp + (c__ >> 3)) * SEQ + 256 * (c__ & 7) + token; pxw##SET = *(const u32x4*)(XB + row_ * D + g * 16 + 8 * half); \
        psa##SET = *(const f32x4*)(SS + row_ * 32 + 8 * half); psb##SET = *(const f32x4*)(SS + row_ * 32 + 8 * half + 4); } while (0)
#define S5G_USTORE(SET, ct_) do { float s_ = ((psa##SET[0] + psa##SET[1]) + (psa##SET[2] + psa##SET[3])) + ((psb##SET[0] + psb##SET[1]) + (psb##SET[2] + psb##SET[3])); s_ += __shfl_xor(s_, 1); const float rs_ = rsqrtf(s_ * (1.0f / 1024.0f) + RMS_EPSF); \
        u32x4 w_; w_.x = pkbf(bflo(pxw##SET.x) * rs_, bfhi(pxw##SET.x) * rs_); w_.y = pkbf(bflo(pxw##SET.y) * rs_, bfhi(pxw##SET.y) * rs_); w_.z = pkbf(bflo(pxw##SET.z) * rs_, bfhi(pxw##SET.z) * rs_); w_.w = pkbf(bflo(pxw##SET.w) * rs_, bfhi(pxw##SET.w) * rs_); \
        *(LAS u32x4*)(UT + ((ct_) % 3) * 8448 + ((token >> 4) * 264 + (token & 15) * 16 + 8 * half) * 2) = w_; } while (0)
    float car = 0.f, cai = 0.f;
#define S5G_SCAN(cs) do { if (SCAN) { const ldsp ut_ = UT + ((cs) % 3) * 8448; const ldsp sin_ = SIN + ((cs) & 1) * 4352; \
            if (((cs) & 7) == 0) { car = 0.f; cai = 0.f; } \
            f32x4 er = (f32x4){0.f, 0.f, 0.f, 0.f}, ei = er; \
            _Pragma("unroll") for (int kk = 0; kk < 8; ++kk) { const bf16x8 u_ = ldfrag(ut_, fr, 264, 32 * kk + 8 * fq); MM_XROW(er, wr[kk], u_); MM_XROW(ei, wi[kk], u_); } \
            float br = er[0], bi = ei[0]; \
            _Pragma("unroll") for (int r = 1; r < 4; ++r) { const float nr = l1r * br - l1i * bi + er[r], ni = l1r * bi + l1i * br + ei[r]; br = nr; bi = ni; } \
            float s0r = car, s0i = cai, cr_ = car, ci_ = cai; \
            _Pragma("unroll") for (int k = 0; k < 4; ++k) { const float qr = __shfl(br, fr + 16 * k), qi = __shfl(bi, fr + 16 * k); \
                const float nr = l4r * cr_ - l4i * ci_ + qr, ni = l4r * ci_ + l4i * cr_ + qi; cr_ = nr; ci_ = ni; if (k < fq) { s0r = nr; s0i = ni; } } \
            car = cr_; cai = ci_; \
            float sr = s0r, si = s0i; \
            _Pragma("unroll") for (int r = 0; r < 4; ++r) { *(LAS unsigned*)(sin_ + ((4 * fq + r) * 136 + 2 * ps) * 2) = pkbf(sr, si); \
                const float nr = l1r * sr - l1i * si + er[r], ni = l1r * si + l1i * sr + ei[r]; sr = nr; si = ni; } \
            if (((cs) & 7) == 7 && fq == 0) { const int b_ = 2 * bp + ((cs) >> 3); a.out[O_S5RP + (size_t)(b_ * 64 + g) * 64 + ps] = car; a.out[O_S5IP + (size_t)(b_ * 64 + g) * 64 + ps] = cai; } } } while (0)
#define S5G_Y(ct_) do { const ldsp ut_ = UT + ((ct_) % 3) * 8448; const ldsp sin_ = SIN + ((ct_) & 1) * 4352; bf16x8 uf[KK], sf[4]; \
        _Pragma("unroll") for (int kk = 0; kk < KK; ++kk) uf[kk] = ldfrag(ut_, fr, 264, 32 * kk + 8 * fq); \
        _Pragma("unroll") for (int kk = 0; kk < 4; ++kk) sf[kk] = ldfrag(sin_, fr, 136, 32 * kk + 8 * fq); \
        _Pragma("unroll") for (int x = 0; x < 2; ++x) { const int tau = 2 * wave + x; f32x4 acc = (f32x4){0.f, 0.f, 0.f, 0.f}; \
            _Pragma("unroll") for (int kk = 0; kk < KK; ++kk) if (2 * kk <= tau) MM_YROW(acc, Fw[x][kk], uf[kk]); \
            _Pragma("unroll") for (int kk = 0; kk < 4; ++kk) MM_YROW(acc, vf[x][kk], sf[kk]); \
            const size_t row = (size_t)(2 * bp + ((ct_) >> 3)) * SEQ + 256 * ((ct_) & 7) + 16 * fr + tau; \
            u32x2 w; w.x = pkbf(gelu_tanh(acc[0]), gelu_tanh(acc[1])); w.y = pkbf(gelu_tanh(acc[2]), gelu_tanh(acc[3])); \
            *(u32x2*)(YB + row * D + g * 16 + 4 * fq) = w; } } while (0)
#ifndef S5REP
#define S5REP 1
#endif
    for (int rep_ = 0; rep_ < S5REP; ++rep_) {
    S5G_ULOAD(A, 0); S5G_ULOAD(B, 1); S5G_USTORE(A, 0); S5G_USTORE(B, 1);
    S5G_ULOAD(A, 2); S5G_ULOAD(B, 3);
    __syncthreads();
    S5G_SCAN(0);
    __syncthreads();
    for (int ct = 0; ct < 16; ct += 2) {
        S5G_USTORE(A, ct + 2); S5G_ULOAD(A, ct + 4);
        S5G_SCAN(ct + 1);
        S5G_Y(ct);
        __syncthreads();
        S5G_USTORE(B, ct + 3); S5G_ULOAD(B, ct + 5);
        if (ct + 2 < 16) S5G_SCAN(ct + 2);
        S5G_Y(ct + 1);
        __syncthreads();
    }
    }
#undef S5G_ULOAD
#undef S5G_USTORE
#undef S5G_SCAN
#undef S5G_Y
}
__device__ __forceinline__ void s5_gemm_wg(const Args& a, ldsp lds, int vcu, int G, int tid, int wave, int lane) {
    for (int it = vcu; it < 256; it += G) {
        if (wave < 4) s5_gemm_role<4, true>(a, lds, it >> 2, it & 3, tid, wave, lane);
        else s5_gemm_role<8, false>(a, lds, it >> 2, it & 3, tid, wave, lane);
    }
}
__global__ void __launch_bounds__(NTHREADS, 2) hybrid_fwd(Args a) {
    extern __shared__ __attribute__((aligned(16))) unsigned char lds_raw[];
    const ldsp lds = (ldsp)lds_raw;
    const int tid = threadIdx.x, lane = tid & 63, wave = __builtin_amdgcn_readfirstlane(tid >> 6);
    const int G = gridDim.x, bx = blockIdx.x;
    const int vcu = (G % 8 == 0) ? (bx % 8) * (G / 8) + bx / 8 : bx;
    unsigned char* ws = a.ws;
    unsigned* ctl = (unsigned*)(ws + WS_CTL);
    for (int u = tid; u < (LDS_BYTES - LDSCTL_OFF) / 4; u += NTHREADS) ((LAS unsigned*)(lds + LDSCTL_OFF))[u] = 0u;
    __syncthreads();
    XcdBarrier bar = xcd_barrier_post(ctl + CW_BAR, (volatile LAS unsigned*)(lds + LDSCTL_OFF) + 8);
    const int gw = vcu * NWAVES + wave, ngw = G * NWAVES;
    bf16* XB = (bf16*)(ws + WS_XB); float* X = (float*)(ws + WS_X); float* SS = (float*)(ws + WS_SS);
    bf16* PROJ = (bf16*)(ws + WS_PROJ); bf16* GATED = (bf16*)(ws + WS_GATED); bf16* YB = (bf16*)(ws + WS_YB); bf16* HB = (bf16*)(ws + WS_H);
    const bf16* W1 = (const bf16*)(ws + WS_W1); const bf16* W2 = (const bf16*)(ws + WS_W2); const bf16* W5 = (const bf16*)(ws + WS_W5);
    const bf16* W3 = (const bf16*)(ws + WS_W3); const bf16* W4 = (const bf16*)(ws + WS_W4);
#define SINGLE_ARG(...) __VA_ARGS__
#define GEMM_PHASE(EPI, Aop, Bop, N_, K_, E_) do { pg8::Gemm g_{(const pg8::bf16_t*)(Aop), (const pg8::bf16_t*)(Bop), MP, (N_), (K_)}; pg8::StaticOrder S_; S_.init(MP, (N_), G, bx); \
        pg8::gemm_phase<EPI, pg8::StaticOrder, true, true>(lds, g_, S_, (E_)); } while (0)
#ifndef DBG_STOP
#define DBG_STOP 0
#endif
#ifndef REPG
#define REPG 0
#endif
#define DBG_DIGEST(k, SRC, NEL) do { if (DBG_STOP == (k)) { xcd_barrier(bar); const bf16* s_ = (const bf16*)(SRC); for (size_t i_ = (size_t)bx * NTHREADS + tid; i_ < (size_t)(NEL) && i_ < O_SSMP; i_ += (size_t)G * NTHREADS) a.out[i_] = bf1(s_[i_]); return; } } while (0)

#ifndef TPROBE
#define TPROBE 0
#endif
#define TP_BLK ((TPROBE) / 10000)
#define TP_S (((TPROBE) / 100) % 100)
#define TP_E ((TPROBE) % 100)
    unsigned long long tp_s = 0, tp_e = 0;
#define STAMPV(id) do { if (TPROBE && vcu == TP_BLK && tid == 0) { const unsigned long long t_ = __builtin_amdgcn_s_memrealtime(); if ((id) == TP_S && tp_s == 0) tp_s = t_; if ((id) == TP_E && tp_e == 0) tp_e = t_; } } while (0)
#define STAMP(id) do { if (TPROBE && vcu == TP_BLK && tid == 0) { const unsigned long long t_ = __builtin_amdgcn_s_memrealtime(); if ((id) == TP_S) tp_s = t_; if ((id) == TP_E) tp_e = t_; } } while (0)
    STAMP(0);
    p0_prologue(a, lds, gw, ngw, wave, lane);
    STAMP(1);
    xcd_barrier(bar);
    STAMP(2);
    { pg8::EpiProj E{(pg8::bf16_t*)PROJ, SS, 16};
      GEMM_PHASE(pg8::EpiProj, XB, W1, PROJ_LD, D, E); }
#if REPG == 1
    xcd_barrier(bar);
    { pg8::EpiProj E{(pg8::bf16_t*)PROJ, SS, 16};
      GEMM_PHASE(pg8::EpiProj, XB, W1, PROJ_LD, D, E); }
#endif
    {
        const SEpiProj Ep{nullptr, SS, 16, (float*)(ws + WS_BETA), (float*)(ws + WS_GDEC), a.in[11], a.in[12]};
        for (int u = vcu; u < 128; u += G) sgemm_unit<2>(lds, XB + (size_t)u * 128 * D, W1 + (size_t)6144 * D, nullptr, D, Ep, u * 128, 192, wave, lane);
    }
    DBG_DIGEST(1, PROJ, (size_t)MP * PROJ_LD);
    STAMP(3);
    xcd_barrier(bar);
    STAMP(4);
    {
        const SEpiProj Es{(bf16*)(ws + WS_SPROJ), (const float*)(ws + WS_SSS), 32, (float*)(ws + WS_SBETA), (float*)(ws + WS_SGDEC), a.in[11], a.in[12]};
        for (int u = G - 1 - vcu; u < 193; u += G) sgemm_unit<2>(lds, (const bf16*)(ws + WS_SXB), W1 + (size_t)u * 32 * D, nullptr, D, Es, 0, u, wave, lane);
    }
    for (int t = (ngw - 1 - gw) * 64 + lane; t < 65536; t += ngw * 64) s5_ktable(a, t);
    dn_prep(a, gw, ngw, lane);
    DBG_DIGEST(2, ws + WS_QKVC, (size_t)MP * 4096);
    STAMP(5);
    xcd_barrier(bar);
    STAMP(6);
    if (vcu < NB * NH) dn_prompt(a, lds, vcu / NH, vcu % NH, tid, wave, lane);
    else {
        const int nt = G - NB * NH, ti = vcu - NB * NH;
        unsigned* tcnt = ctl + CW_TEAM; unsigned ep = 0;
        float* SX = (float*)(ws + WS_SX); bf16* SXB = (bf16*)(ws + WS_SXB); float* SSS = (float*)(ws + WS_SSS);
        bf16* SGATED = (bf16*)(ws + WS_SGATED); bf16* SH = (bf16*)(ws + WS_SH); bf16* SYB = (bf16*)(ws + WS_SYB);
#define TEAM_BAR() team_barrier(tcnt, (unsigned)nt * (++ep))
        dn_sample_all(a, lds, ti, nt, tid, wave, lane);
        STAMP(20);
        TEAM_BAR();
        STAMP(21);
        { const SEpiRes<false> E{a.in[1], SX, SXB, SSS};
          for (int u = ti; u < D / 32; u += nt) sgemm_unit<2>(lds, SGATED, W2 + (size_t)u * 32 * VAL, nullptr, VAL, E, 0, u, wave, lane); }
        STAMPV(22);
        TEAM_BAR();
        STAMPV(23);
        {
            { const SEpiSwiglu E{SH, SSS, 32};
              for (int u = ti; u < FFN / 32; u += nt) { const bf16* bg = W3 + (size_t)((u >> 2) * 256 + (u & 3) * 32) * D;
                  sgemm_unit<4>(lds, SXB, bg, bg + (size_t)128 * D, D, E, 0, u, wave, lane); } }
            STAMPV(24);
            TEAM_BAR();
            STAMPV(25);
            { const SEpiRes<false> E{SX, SX, SXB, SSS};
              for (int u = ti; u < D / 32; u += nt) sgemm_unit<2>(lds, SH, W4 + (size_t)u * 32 * FFN, nullptr, FFN, E, 0, u, wave, lane); }
            STAMPV(26);
            TEAM_BAR();
            STAMPV(27);
            {
                const ldsp wl = lds + wave * 12800;
                for (int j = ti * NWAVES + wave; j < 512; j += nt * NWAVES) s5_wave(a, wl, true, 0, (j & 7) * 16, j >> 3, lane);
                STAMPV(28);
                TEAM_BAR();
                STAMPV(29);
                { const SEpiRes<true> E{SX, SX, SXB, SSS};
                  for (int u = ti; u < D / 32; u += nt) { const bf16* bv = W5 + (size_t)((u >> 2) * 256 + (u & 3) * 32) * D;
                      sgemm_unit<4>(lds, SYB, bv, bv + (size_t)128 * D, D, E, 0, u, wave, lane); } }
            }
        }
#undef TEAM_BAR
    }
    DBG_DIGEST(3, GATED, (size_t)MP * VAL);
    STAMP(7);
    xcd_barrier(bar);
    STAMP(8);
    { pg8::EpiRes<false, 0> E{a.in[0], nullptr, (pg8::bf16_t*)XB, SS};
      GEMM_PHASE(SINGLE_ARG(pg8::EpiRes<false, 0>), GATED, W2, D, VAL, E); }
#if REPG == 2
    xcd_barrier(bar);
    { pg8::EpiRes<false, 0> E{a.in[0], nullptr, (pg8::bf16_t*)XB, SS};
      GEMM_PHASE(SINGLE_ARG(pg8::EpiRes<false, 0>), GATED, W2, D, VAL, E); }
#endif
    xcd_barrier(bar);
    STAMP(30);
    { pg8::EpiSwiglu E{(pg8::bf16_t*)HB, FFN, SS, 16};
      GEMM_PHASE(pg8::EpiSwiglu, XB, W3, 2 * FFN, D, E); }
    if (bx >= 128 && bx - 128 < FFN / 32) {
        const int u = bx - 128; const SEpiSwiglu Es{(bf16*)(ws + WS_SH), (const float*)(ws + WS_SSS), 32};
        const bf16* bg = W3 + (size_t)2 * FFN * D + (size_t)((u >> 2) * 256 + (u & 3) * 32) * D;
        sgemm_unit<4>(lds, (const bf16*)(ws + WS_SXB), bg, bg + (size_t)128 * D, D, Es, 0, u, wave, lane); }
#if REPG == 3
    xcd_barrier(bar);
    { pg8::EpiSwiglu E{(pg8::bf16_t*)HB, FFN, SS, 16};
      GEMM_PHASE(pg8::EpiSwiglu, XB, W3, 2 * FFN, D, E); }
#endif
    xcd_barrier(bar);
    STAMP(31);
    { pg8::EpiRes<false, 1> E{nullptr, nullptr, (pg8::bf16_t*)XB, SS};
      GEMM_PHASE(SINGLE_ARG(pg8::EpiRes<false, 1>), HB, W4, D, FFN, E); }
    xcd_barrier(bar);
    STAMP(32);
    {
        const ldsp wl = lds + wave * 12800;
        STAMP(9);
        (void)wl;
#if S5_GEMM
        s5_gemm_wg(a, lds, vcu, G, tid, wave, lane);
#else
        s5_prompt_wg(a, lds, vcu, G, wave, lane);
#endif
        STAMP(10);
    }
    xcd_barrier(bar);
    STAMP(11);
    { pg8::EpiRes<true, 1> E{nullptr, nullptr, (pg8::bf16_t*)XB, SS};
      GEMM_PHASE(SINGLE_ARG(pg8::EpiRes<true, 1>), YB, W5, 2 * D, D, E); }
    xcd_barrier(bar);
    STAMP(33);
    { pg8::EpiSwiglu E{(pg8::bf16_t*)HB, FFN, SS, 32};
      GEMM_PHASE(pg8::EpiSwiglu, XB, W3 + (size_t)2 * FFN * D, 2 * FFN, D, E); }
    if (bx >= 128 && bx - 128 < D / 32) {
        const int u = bx - 128; const SEpiRes<false> Es{(const float*)(ws + WS_SX), a.out + O_YS, (bf16*)(ws + WS_SXB), (float*)(ws + WS_SSS)};
        sgemm_unit<2>(lds, (const bf16*)(ws + WS_SH), W4 + (size_t)D * FFN + (size_t)u * 32 * FFN, nullptr, FFN, Es, 0, u, wave, lane); }
    xcd_barrier(bar);
    STAMP(34);
    { pg8::EpiRes<false, 2> E{nullptr, a.out + O_YP, (pg8::bf16_t*)XB, SS};
      GEMM_PHASE(SINGLE_ARG(pg8::EpiRes<false, 2>), HB, W4 + (size_t)D * FFN, D, FFN, E); }
    xcd_barrier(bar);
    STAMP(35);
    for (int m = (G * NWAVES - 1 - gw); m < MS; m += ngw) {
        f32x4* xr = (f32x4*)(a.out + O_YS + (size_t)m * D) + lane;
        const float rs = pg8::row_rstd((const float*)(ws + WS_SSS), m, 32);
#pragma unroll
        for (int j = 0; j < 4; ++j) { const f32x4 gn = *((const f32x4*)a.in[8] + lane + 64 * j); xr[64 * j] = xr[64 * j] * rs * gn; }
    }
    for (int m = gw; m < MP; m += ngw) {
        f32x4* xr = (f32x4*)(a.out + O_YP + (size_t)m * D) + lane;
        const float rs = pg8::row_rstd(SS, m, 16);
#pragma unroll
        for (int j = 0; j < 4; ++j) { const f32x4 gn = *((const f32x4*)a.in[8] + lane + 64 * j); xr[64 * j] = xr[64 * j] * rs * gn; }
    }
    STAMP(12);
#if TPROBE
    xcd_barrier(bar);
    if (vcu == TP_BLK && tid == 0) { const unsigned long long t0_ = __builtin_amdgcn_s_memrealtime(), dt_ = tp_e - tp_s; while (__builtin_amdgcn_s_memrealtime() - t0_ < dt_) __builtin_amdgcn_s_sleep(8); }
#endif
#undef GEMM_PHASE
}

extern "C" void kernel_launch(void* const* d_in, const int* in_sizes, int n_in, void* d_out, int out_size, void* d_ws, size_t ws_size, hipStream_t stream) {
    static int grid = 0;
    if (grid == 0) {
        if (n_in != 26 || (size_t)out_size != O_END || ws_size < WS_END) { fprintf(stderr, "kernel_launch: unexpected shapes: n_in %d out %d ws %zu (need %zu)\n", n_in, out_size, ws_size, (size_t)WS_END); grid = -1; return; }
        int dev = 0, cus = 0, per_cu = 0;
        if (hipGetDevice(&dev) != hipSuccess || hipDeviceGetAttribute(&cus, hipDeviceAttributeMultiprocessorCount, dev) != hipSuccess) { grid = -1; return; }
        if (hipFuncSetAttribute((const void*)hybrid_fwd, hipFuncAttributeMaxDynamicSharedMemorySize, LDS_BYTES) != hipSuccess) { fprintf(stderr, "kernel_launch: hipFuncSetAttribute failed\n"); grid = -1; return; }
        if (hipOccupancyMaxActiveBlocksPerMultiprocessor(&per_cu, (const void*)hybrid_fwd, NTHREADS, LDS_BYTES) != hipSuccess || per_cu < 1) { fprintf(stderr, "kernel_launch: occupancy query says %d\n", per_cu); (void)hipGetLastError(); per_cu = 1; }
        grid = cus;
    }
    if (grid < 0) return;
    (void)hipMemsetAsync((char*)d_ws + WS_CTL, 0, CTL_ZERO_BYTES, stream);
    Args a{};
    for (int i = 0; i < 26; ++i) a.in[i] = (const float*)d_in[i];
    a.out = (float*)d_out; a.ws = (unsigned char*)d_ws;
    hipLaunchKernelGGL(hybrid_fwd, dim3(grid), dim3(NTHREADS), LDS_BYTES, stream, a);
}
```

```cpp
#define DBG_STOP 0
#define REP_DN 1
#define REP_S5 1
#define REP_P0 1
#define REPG 0
#define TPROBE 0
#define S5_GEMM 1
#define S5REP 1
#define DNP_S 0
#define DNP_E 0
#define RPA 1
#define RPB 1
#define RPE 1
#define RPF 1
#define RPO 1
#include <hip/hip_runtime.h>
#include <cstdio>
#include <cstdint>
namespace pg8 {
#define PG8_LAS __attribute__((address_space(3)))
typedef unsigned short bf16_t;
typedef short bf16x8 __attribute__((ext_vector_type(8)));
typedef float f32x4 __attribute__((ext_vector_type(4)));
typedef unsigned u32x4 __attribute__((ext_vector_type(4)));
constexpr int BM = 256, BK = 64, HALF = 128, HTB = HALF * BK * 2  , STAGE_BYTES = 8 * HTB, NXCD = 8, WGM = 8;

__host__ __device__ __forceinline__ int lds_byte(int r, int c) { const int st = (r >> 4) * 2 + (c >> 5), rr = r & 15, cc = c & 31, ob = rr * 64 + cc * 2; return st * 1024 + (ob ^ (((ob >> 9) & 1) << 5)); }
__host__ __device__ __forceinline__ void stage_rc(int b, int& R, int& C) { const int st = b / 1024, sb = b % 1024, swz = sb ^ (((sb >> 9) & 1) << 5); R = (st >> 1) * 16 + swz / 64; C = (st & 1) * 32 + (swz % 64) / 2; }
__host__ __device__ __forceinline__ int perm32(int rho) { const int n = rho >> 4, i = rho & 15; return 8 * (i >> 2) + 4 * n + (i & 3); }

struct Unit { int pm, pn; };
struct Gemm { const bf16_t* A; const bf16_t* Bt; int M, N, K; };

struct StaticOrder {
    int nM, nN, nwg, G, c;
    __host__ __device__ void init(int M, int N, int G_, int c_) { nM = M / BM; nN = N / BM; nwg = nM * nN; G = G_; c = c_; }
    __host__ __device__ bool next(int i, Unit& u) const {
        const long L = (long)i * G + c; if (L >= nwg) return false;
        int wgid = (int)L; { const int q = nwg / NXCD, r = nwg % NXCD, xcd = wgid % NXCD, off = wgid / NXCD; wgid = (xcd < r ? xcd * (q + 1) : r * (q + 1) + (xcd - r) * q) + off; }
        const int nig = WGM * nN, gid = wgid / nig, fm = gid * WGM, gsz = (nM - fm) < WGM ? (nM - fm) : WGM;
        u.pm = fm + ((wgid % nig) % gsz); u.pn = (wgid % nig) / gsz; return true;
    }
    __device__ __forceinline__ void a_ready(const Unit&) const {}
    __device__ __forceinline__ void done(const Unit&) const {}
};
typedef float f32x2c __attribute__((ext_vector_type(2))); typedef __bf16 bf16x2c __attribute__((ext_vector_type(2)));
__device__ __forceinline__ unsigned cvt_pk_bf16(float lo, float hi) { const f32x2c v = {lo, hi}; return __builtin_bit_cast(unsigned, __builtin_convertvector(v, bf16x2c)); }
typedef unsigned u32x2 __attribute__((ext_vector_type(2)));
constexpr int SS_LD = 32;
constexpr float RMS_EPS = 1e-6f;
__device__ __forceinline__ float silu_f(float x) { return x * __builtin_amdgcn_rcpf(1.0f + __expf(-x)); }
__device__ __forceinline__ float sigmoid_f(float x) { return __builtin_amdgcn_rcpf(1.0f + __expf(-x)); }
__device__ __forceinline__ float row_rstd(const float* ss, int row, int nparts) {
    const f32x4* p = (const f32x4*)(ss + (size_t)row * SS_LD); float s = 0.f;
    for (int i = 0; i < nparts / 4; ++i) { const f32x4 v = p[i]; s += (v[0] + v[1]) + (v[2] + v[3]); }
    return rsqrtf(s * (1.0f / 1024.0f) + RMS_EPS);
}
__device__ __forceinline__ void rows_rstd(const float* ss, int row0, int nparts, int fq, float (&rs)[2][4]) {
    f32x4 q[2][4];
#pragma unroll
    for (int ai = 0; ai < 2; ++ai)
#pragma unroll
        for (int m = 0; m < 4; ++m) { const float* p = ss + (size_t)(row0 + ai * HALF + m * 16) * SS_LD + 4 * fq; q[ai][m] = *(const f32x4*)p; if (nparts == 32) q[ai][m] += *(const f32x4*)(p + 16); }
#pragma unroll
    for (int ai = 0; ai < 2; ++ai)
#pragma unroll
        for (int m = 0; m < 4; ++m) { float s = (q[ai][m][0] + q[ai][m][1]) + (q[ai][m][2] + q[ai][m][3]); s += __shfl_xor(s, 16); s += __shfl_xor(s, 32); rs[ai][m] = rsqrtf(s * (1.0f / 1024.0f) + RMS_EPS); }
}
struct EpiProj {
    static constexpr bool PERM = true, AFTER_DRAIN = false;
    bf16_t* O; const float* ss; int nparts;
    __device__ __forceinline__ void operator()(const f32x4 (&acc)[2][2][4][2], const Unit& u, int wr, int wc, int fr, int fq) const {
        const int row0 = u.pm * BM + wr * 64 + fr;
        float rs[2][4]; rows_rstd(ss, row0, nparts, fq, rs);
        {
            const int col0 = u.pn * BM + wc * 32 + 8 * fq; const bool act = u.pn >= 16;
#pragma unroll
            for (int ai = 0; ai < 2; ++ai)
#pragma unroll
                for (int m = 0; m < 4; ++m) { const int row = row0 + ai * HALF + m * 16; bf16_t* rowp = O + (size_t)row * 6144 + col0; const float r = rs[ai][m];
#pragma unroll
                    for (int bj = 0; bj < 2; ++bj) { f32x4 v0 = acc[ai][bj][m][0] * r, v1 = acc[ai][bj][m][1] * r;
                        if (act) {
#pragma unroll
                            for (int j = 0; j < 4; ++j) { v0[j] = silu_f(v0[j]); v1[j] = silu_f(v1[j]); } }
                        u32x4 w; w.x = cvt_pk_bf16(v0[0], v0[1]); w.y = cvt_pk_bf16(v0[2], v0[3]); w.z = cvt_pk_bf16(v1[0], v1[1]); w.w = cvt_pk_bf16(v1[2], v1[3]);
                        *(u32x4*)(rowp + bj * HALF) = w; }
                    }
        }
    }
};
struct EpiSwiglu {
    static constexpr bool PERM = true, AFTER_DRAIN = false;
    bf16_t* O; int ldo; const float* ss; int nparts;
    __device__ __forceinline__ void operator()(const f32x4 (&acc)[2][2][4][2], const Unit& u, int wr, int wc, int fr, int fq) const {
        const int row0 = u.pm * BM + wr * 64 + fr, col0 = u.pn * HALF + wc * 32 + 8 * fq;
        float rs[2][4]; rows_rstd(ss, row0, nparts, fq, rs);
#pragma unroll
        for (int ai = 0; ai < 2; ++ai)
#pragma unroll
            for (int m = 0; m < 4; ++m) { const int row = row0 + ai * HALF + m * 16; const float r = rs[ai][m];
                f32x4 h0, h1;
#pragma unroll
                for (int j = 0; j < 4; ++j) { h0[j] = silu_f(acc[ai][0][m][0][j] * r) * (acc[ai][1][m][0][j] * r); h1[j] = silu_f(acc[ai][0][m][1][j] * r) * (acc[ai][1][m][1][j] * r); }
                u32x4 w; w.x = cvt_pk_bf16(h0[0], h0[1]); w.y = cvt_pk_bf16(h0[2], h0[3]); w.z = cvt_pk_bf16(h1[0], h1[1]); w.w = cvt_pk_bf16(h1[2], h1[3]);
                *(u32x4*)(O + (size_t)row * ldo + col0) = w; }
    }
};
template <bool GLU, int MODE> struct EpiRes {
    static constexpr bool PERM = true, AFTER_DRAIN = false;
    const float* base; float* out; bf16_t* XB; float* ss;
    __device__ __forceinline__ void operator()(const f32x4 (&acc)[2][2][4][2], const Unit& u, int wr, int wc, int fr, int fq) const {
        const int col0 = (GLU ? u.pn * HALF : u.pn * BM) + wc * 32 + 8 * fq;
#pragma unroll
        for (int ai = 0; ai < 2; ++ai) {
#pragma unroll
            for (int m = 0; m < 4; ++m) { const int row = u.pm * BM + ai * HALF + wr * 64 + m * 16 + fr;
                const size_t off = (size_t)row * 1024 + col0;
                float sq = 0.f;
#pragma unroll
                for (int bj = 0; bj < (GLU ? 1 : 2); ++bj) { const int c = bj * HALF; f32x4 v0, v1;
                    if (GLU) {
#pragma unroll
                        for (int j = 0; j < 4; ++j) { v0[j] = acc[ai][0][m][0][j] * sigmoid_f(acc[ai][1][m][0][j]); v1[j] = acc[ai][0][m][1][j] * sigmoid_f(acc[ai][1][m][1][j]); }
                    } else { v0 = acc[ai][bj][m][0]; v1 = acc[ai][bj][m][1]; }
                    f32x4 b0, b1;
                    if (MODE == 0) { b0 = *(const f32x4*)(base + off + c); b1 = *(const f32x4*)(base + off + c + 4); }
                    else { const u32x4 bw = *(const u32x4*)(XB + off + c);
                        b0 = (f32x4){__builtin_bit_cast(float, bw.x << 16), __builtin_bit_cast(float, bw.x & 0xffff0000u), __builtin_bit_cast(float, bw.y << 16), __builtin_bit_cast(float, bw.y & 0xffff0000u)};
                        b1 = (f32x4){__builtin_bit_cast(float, bw.z << 16), __builtin_bit_cast(float, bw.z & 0xffff0000u), __builtin_bit_cast(float, bw.w << 16), __builtin_bit_cast(float, bw.w & 0xffff0000u)}; }
                    const f32x4 o0 = b0 + v0, o1 = b1 + v1;
                    sq += ((o0[0] * o0[0] + o0[1] * o0[1]) + (o0[2] * o0[2] + o0[3] * o0[3])) + ((o1[0] * o1[0] + o1[1] * o1[1]) + (o1[2] * o1[2] + o1[3] * o1[3]));
                    if (MODE == 2) { *(f32x4*)(out + off + c) = o0; *(f32x4*)(out + off + c + 4) = o1; }
                    else { u32x4 w; w.x = cvt_pk_bf16(o0[0], o0[1]); w.y = cvt_pk_bf16(o0[2], o0[3]); w.z = cvt_pk_bf16(o1[0], o1[1]); w.w = cvt_pk_bf16(o1[2], o1[3]); *(u32x4*)(XB + off + c) = w; } }
                sq += __shfl_xor(sq, 16); sq += __shfl_xor(sq, 32);
                if (fq == 0) ss[(size_t)row * SS_LD + u.pn * 4 + wc] = sq; }
        }
    }
};

struct EpiFinal {
    static constexpr bool PERM = false, AFTER_DRAIN = true;
    const bf16_t* XB; float* out; const float* gfin; float* xbuf; unsigned* cnt;
    __device__ __forceinline__ void fused(f32x4 (&acc)[2][2][4][2], const Unit& u, int wr, int wc, int fr, int fq, PG8_LAS unsigned char* lds, int wid, int lane) const {
        PG8_LAS float* P = (PG8_LAS float*)lds;
        PG8_LAS float* S = (PG8_LAS float*)(lds + 8192);
        const int col0 = u.pn * BM + wc * 32 + 4 * fq;
#pragma unroll
        for (int ai = 0; ai < 2; ++ai)
#pragma unroll
            for (int m = 0; m < 4; ++m) { const int rl = ai * HALF + wr * 64 + m * 16 + fr; const size_t off = (size_t)(u.pm * BM + rl) * 1024 + col0; float sq = 0.f;
#pragma unroll
                for (int bj = 0; bj < 2; ++bj)
#pragma unroll
                    for (int n = 0; n < 2; ++n) { const u32x2 bw = *(const u32x2*)(XB + off + bj * HALF + n * 16);
                        const f32x4 b = (f32x4){__builtin_bit_cast(float, bw.x << 16), __builtin_bit_cast(float, bw.x & 0xffff0000u), __builtin_bit_cast(float, bw.y << 16), __builtin_bit_cast(float, bw.y & 0xffff0000u)};
                        const f32x4 o = b + acc[ai][bj][m][n]; acc[ai][bj][m][n] = o; sq += (o[0] * o[0] + o[1] * o[1]) + (o[2] * o[2] + o[3] * o[3]); }
                sq += __shfl_xor(sq, 16); sq += __shfl_xor(sq, 32);
                if (fq == 0) P[rl * 4 + wc] = sq; }
        asm volatile("s_waitcnt lgkmcnt(0)" ::: "memory"); __builtin_amdgcn_s_barrier(); asm volatile("" ::: "memory");
        const int row = wid * 32 + (lane & 31);
        if (lane < 32) { const float t = (P[row * 4 + 0] + P[row * 4 + 1]) + (P[row * 4 + 2] + P[row * 4 + 3]);
            __hip_atomic_store(xbuf + (size_t)(u.pm * BM + row) * 4 + u.pn, t, __ATOMIC_RELAXED, __HIP_MEMORY_SCOPE_AGENT); }
        asm volatile("s_waitcnt vmcnt(0)" ::: "memory");
        if (lane == 0) __hip_atomic_fetch_add(cnt + 64 * u.pm, 1u, __ATOMIC_RELAXED, __HIP_MEMORY_SCOPE_AGENT);
        if (wid == 0) {
            const unsigned long long t0 = __builtin_amdgcn_s_memrealtime();
            while ((unsigned)__builtin_amdgcn_readfirstlane(__hip_atomic_load(cnt + 64 * u.pm, __ATOMIC_RELAXED, __HIP_MEMORY_SCOPE_AGENT)) < 32u) {
                if (__builtin_amdgcn_s_memrealtime() - t0 > 2000000ull) break;
                __builtin_amdgcn_s_sleep(2); }
            __builtin_amdgcn_fence(__ATOMIC_ACQUIRE, "agent");
        }
        asm volatile("s_waitcnt vmcnt(0) lgkmcnt(0)" ::: "memory"); __builtin_amdgcn_s_barrier(); asm volatile("" ::: "memory");
        if (lane < 32) { const float* sl = xbuf + (size_t)(u.pm * BM + row) * 4; float t = 0.f;
#pragma unroll
            for (int k = 0; k < 4; ++k) t += __hip_atomic_load(sl + k, __ATOMIC_RELAXED, __HIP_MEMORY_SCOPE_AGENT);
            S[row] = rsqrtf(t * (1.0f / 1024.0f) + RMS_EPS); }
        asm volatile("s_waitcnt lgkmcnt(0)" ::: "memory"); __builtin_amdgcn_s_barrier(); asm volatile("" ::: "memory");
#pragma unroll
        for (int ai = 0; ai < 2; ++ai)
#pragma unroll
            for (int m = 0; m < 4; ++m) { const int rl = ai * HALF + wr * 64 + m * 16 + fr; const float rs = S[rl]; const size_t off = (size_t)(u.pm * BM + rl) * 1024 + col0;
#pragma unroll
                for (int bj = 0; bj < 2; ++bj)
#pragma unroll
                    for (int n = 0; n < 2; ++n) { const int c = bj * HALF + n * 16; const f32x4 g = *(const f32x4*)(gfin + col0 + c); *(f32x4*)(out + off + c) = acc[ai][bj][m][n] * rs * g; } }
    }
};

template <class Epi, class Sched, bool ALIGN_EPI = false, bool SP2 = false>
__device__ __forceinline__ void gemm_phase(PG8_LAS unsigned char* lds, const Gemm g, const Sched& S, const Epi& E) {
    int tid_o = threadIdx.x; asm volatile("" : "+v"(tid_o));
    const int tid = tid_o, wid = __builtin_amdgcn_readfirstlane(tid >> 6), lane = tid & 63, wr = wid >> 2, wc = wid & 3, fr = lane & 15, fq = lane >> 4;
    const int K = g.K, nt = K / BK;
    unsigned voffA[2], voffB[2];
#pragma unroll
    for (int i = 0; i < 2; ++i) { int R, C; stage_rc(tid * 16 + i * 8192, R, C); const int Rb = Epi::PERM ? ((R & ~31) + perm32(R & 31)) : R;
        voffA[i] = (unsigned)(R * K + C) * 2u; voffB[i] = (unsigned)(Rb * K + C) * 2u; }
    const size_t kstep = (size_t)(BK * 2);
    const size_t hstep = (size_t)HALF * K * 2;
    const size_t tstep = 2 * hstep;
    const unsigned ldsw = (unsigned)wid * 1024u;
    const int aoff = lds_byte(wr * 64 + fr, fq * 8), boff = lds_byte(wc * 32 + fr, fq * 8);
#define PG8_SA(b, h) (((b) * 2 + (h)) * HTB)
#define PG8_SB(b, h) ((4 + (b) * 2 + (h)) * HTB)
#define PG8_STAGE(bufoff, gbase, voff) do { _Pragma("unroll") for (int _i = 0; _i < 2; ++_i) \
        __builtin_amdgcn_global_load_lds((const unsigned*)((const char*)(gbase) + (voff)[_i]), (PG8_LAS unsigned*)(lds + (bufoff) + ldsw + _i * 8192), 16, 0, 0); } while (0)
#define PG8_LDA(dst, b, h) do { _Pragma("unroll") for (int m = 0; m < 4; ++m) _Pragma("unroll") for (int k = 0; k < 2; ++k) dst[m][k] = *(const PG8_LAS bf16x8*)(lds + PG8_SA(b, h) + aoff + m * 2048 + k * 1024); } while (0)
#define PG8_LDB(dst, b, h) do { _Pragma("unroll") for (int n = 0; n < 2; ++n) _Pragma("unroll") for (int k = 0; k < 2; ++k) dst[n][k] = *(const PG8_LAS bf16x8*)(lds + PG8_SB(b, h) + boff + n * 2048 + k * 1024); } while (0)
#define PG8_MMA(ai, bj, At, Bt) do { __builtin_amdgcn_s_setprio(1); _Pragma("unroll") for (int m = 0; m < 4; ++m) _Pragma("unroll") for (int n = 0; n < 2; ++n) _Pragma("unroll") for (int k = 0; k < 2; ++k) \
        acc[ai][bj][m][n] = __builtin_amdgcn_mfma_f32_16x16x32_bf16(Bt[n][k], At[m][k], acc[ai][bj][m][n], 0, 0, 0); __builtin_amdgcn_s_setprio(0); } while (0)
#define PG8_WAIT_V(n) asm volatile("s_waitcnt vmcnt(" #n ")" ::: "memory")
#define PG8_WAIT_L(n) asm volatile("s_waitcnt lgkmcnt(" #n ")" ::: "memory")
#define PG8_BAR __builtin_amdgcn_s_barrier()
#define PG8_SCHED __builtin_amdgcn_sched_barrier(0)
    Unit cur, nxt; int ui = 0;
    if (!S.next(0, cur)) return;
    f32x4 acc[2][2][4][2];
#pragma unroll
    for (int a = 0; a < 2; ++a)
#pragma unroll
        for (int b = 0; b < 2; ++b)
#pragma unroll
            for (int m = 0; m < 4; ++m)
#pragma unroll
                for (int n = 0; n < 2; ++n) acc[a][b][m][n] = (f32x4){0.f, 0.f, 0.f, 0.f};
    bf16x8 At[4][2], B0[2][2], B1[2][2];
    const char* cA = (const char*)g.A + (size_t)cur.pm * tstep; const char* cB = (const char*)g.Bt + (size_t)cur.pn * tstep;
    S.a_ready(cur);
    if constexpr (SP2) {
        PG8_STAGE(PG8_SB(0, 0), cB, voffB); PG8_STAGE(PG8_SB(0, 1), cB + hstep, voffB); PG8_STAGE(PG8_SA(0, 0), cA, voffA); PG8_STAGE(PG8_SA(0, 1), cA + hstep, voffA);
        if (wr == 1) PG8_BAR;
        PG8_WAIT_V(2); PG8_BAR;
        PG8_STAGE(PG8_SB(1, 0), cB + kstep, voffB); PG8_STAGE(PG8_SA(1, 0), cA + kstep, voffA); PG8_STAGE(PG8_SB(1, 1), cB + hstep + kstep, voffB);
        PG8_WAIT_V(6); PG8_BAR;
    } else {
        PG8_STAGE(PG8_SB(0, 0), cB, voffB); PG8_STAGE(PG8_SA(0, 0), cA, voffA); PG8_STAGE(PG8_SB(0, 1), cB + hstep, voffB); PG8_STAGE(PG8_SA(0, 1), cA + hstep, voffA);
        if (wr == 1) PG8_BAR;
        PG8_WAIT_V(4); PG8_BAR;
        PG8_STAGE(PG8_SB(1, 0), cB + kstep, voffB); PG8_STAGE(PG8_SA(1, 0), cA + kstep, voffA); PG8_STAGE(PG8_SB(1, 1), cB + hstep + kstep, voffB);
        PG8_WAIT_V(6); PG8_BAR;
    }
    for (;;) {
        const bool has_next = S.next(ui + 1, nxt);
        const char* nA = has_next ? (const char*)g.A + (size_t)nxt.pm * tstep : cA; const char* nB = has_next ? (const char*)g.Bt + (size_t)nxt.pn * tstep : cB;
        for (int t = 0; t < nt; t += 2) {
            const bool last = (t == nt - 2);
            const char* a1 = cA + (size_t)(t + 1) * kstep;
            const char* a2 = last ? nA : cA + (size_t)(t + 2) * kstep; const char* b2 = last ? nB : cB + (size_t)(t + 2) * kstep;
            const char* a3 = a2 + kstep; const char* b3 = b2 + kstep;
            if (last && has_next) S.a_ready(nxt);
            if constexpr (SP2) {
            PG8_LDB(B0, 0, 0); PG8_LDB(B1, 0, 1); PG8_SCHED; PG8_LDA(At, 0, 0); PG8_STAGE(PG8_SA(1, 1), a1 + hstep, voffA);
            PG8_WAIT_V(8); PG8_WAIT_L(0); PG8_BAR; PG8_MMA(0, 0, At, B0); PG8_MMA(0, 1, At, B1); PG8_BAR; PG8_SCHED;
            PG8_LDA(At, 0, 1); PG8_STAGE(PG8_SB(0, 0), b2, voffB); PG8_STAGE(PG8_SB(0, 1), b2 + hstep, voffB); PG8_STAGE(PG8_SA(0, 0), a2, voffA);
            PG8_WAIT_V(8); PG8_WAIT_L(0); PG8_BAR; PG8_MMA(1, 0, At, B0); PG8_MMA(1, 1, At, B1); PG8_BAR; PG8_SCHED;
            PG8_LDB(B0, 1, 0); PG8_LDB(B1, 1, 1); PG8_SCHED; PG8_LDA(At, 1, 0); PG8_STAGE(PG8_SA(0, 1), a2 + hstep, voffA);
            PG8_WAIT_V(8); PG8_WAIT_L(0); PG8_BAR; PG8_MMA(0, 0, At, B0); PG8_MMA(0, 1, At, B1); PG8_BAR; PG8_SCHED;
            PG8_LDA(At, 1, 1); PG8_STAGE(PG8_SB(1, 0), b3, voffB); PG8_STAGE(PG8_SB(1, 1), b3 + hstep, voffB); PG8_STAGE(PG8_SA(1, 0), a3, voffA);
            PG8_WAIT_V(8); PG8_WAIT_L(0); PG8_BAR; PG8_MMA(1, 0, At, B0); PG8_MMA(1, 1, At, B1); PG8_BAR; PG8_SCHED;
            } else {
            PG8_LDB(B0, 0, 0); PG8_SCHED; PG8_LDA(At, 0, 0); PG8_STAGE(PG8_SA(1, 1), a1 + hstep, voffA);
            PG8_WAIT_L(8); PG8_BAR; PG8_WAIT_L(0); PG8_MMA(0, 0, At, B0); PG8_BAR; PG8_SCHED;
            PG8_LDB(B1, 0, 1); PG8_STAGE(PG8_SB(0, 0), b2, voffB);
            PG8_BAR; PG8_WAIT_L(0); PG8_MMA(0, 1, At, B1); PG8_BAR;
            PG8_LDA(At, 0, 1); PG8_STAGE(PG8_SA(0, 0), a2, voffA);
            PG8_BAR; PG8_WAIT_L(0); PG8_MMA(1, 0, At, B0); PG8_BAR; PG8_SCHED;
            PG8_STAGE(PG8_SB(0, 1), b2 + hstep, voffB);
            PG8_WAIT_V(6); PG8_BAR; PG8_MMA(1, 1, At, B1); PG8_BAR;
            PG8_LDB(B0, 1, 0); PG8_SCHED; PG8_LDA(At, 1, 0); PG8_STAGE(PG8_SA(0, 1), a2 + hstep, voffA);
            PG8_WAIT_L(8); PG8_BAR; PG8_WAIT_L(0); PG8_MMA(0, 0, At, B0); PG8_BAR; PG8_SCHED;
            PG8_LDB(B1, 1, 1); PG8_STAGE(PG8_SB(1, 0), b3, voffB);
            PG8_BAR; PG8_WAIT_L(0); PG8_MMA(0, 1, At, B1); PG8_BAR;
            PG8_LDA(At, 1, 1); PG8_STAGE(PG8_SA(1, 0), a3, voffA);
            PG8_BAR; PG8_WAIT_L(0); PG8_MMA(1, 0, At, B0); PG8_BAR; PG8_SCHED;
            PG8_STAGE(PG8_SB(1, 1), b3 + hstep, voffB);
            PG8_WAIT_V(6); PG8_BAR; PG8_MMA(1, 1, At, B1); PG8_BAR;
            }
        }
        if constexpr (ALIGN_EPI) { if (wr == 0) PG8_BAR; }
        if constexpr (!Epi::AFTER_DRAIN) { E(acc, cur, wr, wc, fr, fq); S.done(cur); }
        if (!has_next) break;
#pragma unroll
        for (int a = 0; a < 2; ++a)
#pragma unroll
            for (int b = 0; b < 2; ++b)
#pragma unroll
                for (int m = 0; m < 4; ++m)
#pragma unroll
                    for (int n = 0; n < 2; ++n) acc[a][b][m][n] = (f32x4){0.f, 0.f, 0.f, 0.f};
        cur = nxt; cA = nA; cB = nB; ++ui;
        if constexpr (ALIGN_EPI) { if (wr == 1) PG8_BAR; }
    }
    PG8_WAIT_V(0);
    if constexpr (!ALIGN_EPI) { if (wr == 0) PG8_BAR; }
    PG8_BAR;
    if constexpr (Epi::AFTER_DRAIN) { E.fused(acc, cur, wr, wc, fr, fq, lds, wid, lane); S.done(cur); }
#undef PG8_SA
#undef PG8_SB
#undef PG8_STAGE
#undef PG8_LDA
#undef PG8_LDB
#undef PG8_MMA
#undef PG8_WAIT_V
#undef PG8_WAIT_L
#undef PG8_BAR
#undef PG8_SCHED
}
}
constexpr int NWAVES = 8, NTHREADS = 512;
constexpr int D = 1024, SEQ = 2048, NB = 8, MP = NB * SEQ  , MS = 128  ;
constexpr int DN_IN = 6176, PROJ_LD = 6144, VAL = 2048, FFN = 2816, NH = 16, CHUNK = 64, NCHUNK = SEQ / CHUNK;
constexpr size_t MiB = 1u << 20;
constexpr size_t WS_CTL = 0, CTL_ZERO_BYTES = 64 * 1024;
constexpr size_t WS_W1 = 1 * MiB;
constexpr size_t WS_W2 = WS_W1 + (size_t)6400 * D * 2;
constexpr size_t WS_W5 = WS_W2 + (size_t)D * VAL * 2;
constexpr size_t WS_W3 = WS_W5 + (size_t)2 * D * D * 2;
constexpr size_t WS_W4 = WS_W3 + (size_t)2 * 2 * FFN * D * 2;
constexpr size_t WS_SS = WS_W4 + (size_t)2 * D * FFN * 2;
constexpr size_t WS_BETA = WS_SS + (size_t)MP * 32 * 4;
constexpr size_t WS_GDEC = WS_BETA + (size_t)MP * 16 * 4;
constexpr size_t WS_SSS = WS_GDEC + (size_t)MP * 16 * 4;
constexpr size_t WS_SBETA = WS_SSS + (size_t)MS * 32 * 4;
constexpr size_t WS_SGDEC = WS_SBETA + (size_t)MS * 16 * 4;
constexpr size_t WS_SXB = WS_SGDEC + (size_t)MS * 16 * 4;
constexpr size_t WS_SX = WS_SXB + (size_t)MS * D * 2;
constexpr size_t WS_SPROJ = WS_SX + (size_t)MS * D * 4;
constexpr size_t WS_SGATED = WS_SPROJ + (size_t)MS * PROJ_LD * 2;
constexpr size_t WS_SH = WS_SGATED + (size_t)MS * VAL * 2;
constexpr size_t WS_SYB = WS_SH + (size_t)MS * FFN * 2;
constexpr size_t WS_S5LAM = WS_SYB + (size_t)MS * D * 2;
constexpr size_t WS_S5BB = WS_S5LAM + 64 * 64 * 2 * 4;
constexpr size_t WS_S5CM = WS_S5BB + 64 * 128 * 16 * 2;
constexpr size_t WS_S5DSK = WS_S5CM + 64 * 16 * 128 * 2;
constexpr size_t WS_GC = WS_S5DSK + 1024 * 4;
constexpr size_t WS_BT = WS_GC + (size_t)MP * 16 * 4;
constexpr size_t WS_POW = WS_BT + (size_t)MP * 16 * 4;
constexpr size_t WS_BBF = WS_POW + 64 * 64 * 17 * 2 * 4;
constexpr size_t WS_KT = WS_BBF + 64 * 64 * 2 * 16 * 4;
constexpr size_t WS_FX = WS_KT + 64 * 16 * 16 * 16 * 4;
constexpr size_t WS_XB = (WS_FX + (size_t)MP * 4 * 4 + 4095) / 4096 * 4096;
constexpr size_t WS_X = WS_XB + (size_t)MP * D * 2;
constexpr size_t WS_YB = WS_X + (size_t)MP * D * 4;
constexpr size_t WS_GATED = WS_YB + (size_t)MP * D * 2;
constexpr size_t WS_QKVC = WS_XB;
static_assert(WS_QKVC + (size_t)MP * 4096 * 2 <= WS_GATED, "QKVC overlay");
constexpr size_t WS_PROJ = WS_GATED + (size_t)MP * VAL * 2;
constexpr size_t WS_H = WS_PROJ;
constexpr size_t WS_END = WS_PROJ + (size_t)MP * PROJ_LD * 2;
constexpr int CW_BAR = 4096, CW_TEAM = 8192, CW_FIN = 8192 + 64;
constexpr size_t O_YP = 0, O_YS = O_YP + (size_t)MP * D, O_SSMP = O_YS + (size_t)MS * D, O_CONVP = O_SSMP + (size_t)NB * NH * 128 * 128, O_S5RP = O_CONVP + (size_t)NB * 3 * 4096,
                 O_S5IP = O_S5RP + (size_t)NB * 64 * 64, O_SSMS = O_S5IP + (size_t)NB * 64 * 64, O_CONVS = O_SSMS + (size_t)MS * NH * 128 * 128, O_S5RS = O_CONVS + (size_t)MS * 3 * 4096,
                 O_S5IS = O_S5RS + (size_t)MS * 64 * 64, O_END = O_S5IS + (size_t)MS * 64 * 64;
constexpr int LDS_BYTES = 163840, LDSCTL_OFF = LDS_BYTES - 256;

#define GAS __attribute__((address_space(1)))
#define LAS __attribute__((address_space(3)))
typedef unsigned short bf16;
typedef float f32x4 __attribute__((ext_vector_type(4)));
typedef float f32x2 __attribute__((ext_vector_type(2)));
typedef short bf16x8 __attribute__((ext_vector_type(8)));
typedef unsigned u32x4 __attribute__((ext_vector_type(4)));
typedef unsigned u32x2 __attribute__((ext_vector_type(2)));
typedef LAS unsigned char* ldsp;
__device__ __forceinline__ unsigned pkbf(float lo, float hi) { return pg8::cvt_pk_bf16(lo, hi); }
__device__ __forceinline__ float bflo(unsigned w) { return __builtin_bit_cast(float, w << 16); }
__device__ __forceinline__ float bfhi(unsigned w) { return __builtin_bit_cast(float, w & 0xffff0000u); }
__device__ __forceinline__ float bf1(bf16 h) { return __builtin_bit_cast(float, (unsigned)h << 16); }
__device__ __forceinline__ float wave_sum(float v) {
#pragma unroll
    for (int o = 1; o < 64; o <<= 1) v += __shfl_xor(v, o);
    return v;
}
#define MFMA16(a, b, c) __builtin_amdgcn_mfma_f32_16x16x32_bf16((a), (b), (c), 0, 0, 0)
#define MM_XROW(acc, xf, yf) (acc) = MFMA16((yf), (xf), (acc))
#define MM_YROW(acc, xf, yf) (acc) = MFMA16((xf), (yf), (acc))
#define LDS_FENCE() asm volatile("s_waitcnt lgkmcnt(0)" ::: "memory")

struct Args {
    const float* in[26]; float* out; unsigned char* ws; int pad0, pad1;
};
constexpr float RMS_EPSF = 1e-6f;
#define XB_TMO      128
#define XB_XCNT(j)  (256  + 64 * (j))
#define XB_XSUB(j)  (1280 + 64 * (j))
#define XB_XGEN(j)  (2304 + 64 * (j))
#define XB_TOP      3328
#define XB_TOPGEN   3392
#define XCD_BAR_WORDS 3456
#define XB_SPIN_CAP (1u << 18)

__device__ __forceinline__ unsigned xb_ld(unsigned* p)              { return __hip_atomic_load(p, __ATOMIC_RELAXED, __HIP_MEMORY_SCOPE_AGENT); }
__device__ __forceinline__ unsigned xb_add(unsigned* p, unsigned v) { return __hip_atomic_fetch_add(p, v, __ATOMIC_RELAXED, __HIP_MEMORY_SCOPE_AGENT); }
__device__ __forceinline__ unsigned xb_xcc_id() { return (unsigned)__builtin_amdgcn_s_getreg((3 << 11) | 20) & 0xFu; }
#define XB_SPIN(cond, bar) do { unsigned _sp = 0; while (cond) { __builtin_amdgcn_s_sleep(1); \
    if ((++_sp & 255u) == 0u) { if (xb_ld(&(bar)[XB_TMO])) break; if (_sp > XB_SPIN_CAP) { atomicAdd(&(bar)[XB_TMO], 1u); break; } } } } while (0)

struct XcdBarrier {
    unsigned* bar; unsigned x;
    volatile LAS unsigned* st;
};

__device__ __forceinline__ XcdBarrier xcd_barrier_post(unsigned* bar, volatile LAS unsigned* st) {
    XcdBarrier b; b.bar = bar; b.x = xb_xcc_id(); b.st = st;
    if (threadIdx.x == 0) (void)xb_add(&bar[XB_XCNT(b.x)], 1u);
    return b;
}
__device__ __forceinline__ void xcd_barrier_complete(unsigned* bar, unsigned x, unsigned& nloc, unsigned& nx) {
    const unsigned G = gridDim.x * gridDim.y * gridDim.z;
    unsigned sum, cnt, mine, sp = 0u;
    for (;;) {
        sum = 0u; cnt = 0u; mine = 0u;
#pragma unroll
        for (unsigned j = 0; j < 16; ++j) { const unsigned c = xb_ld(&bar[XB_XCNT(j)]); sum += c; cnt += (c > 0u) ? 1u : 0u; mine = (j == x) ? c : mine; }
        if (sum == G) break;
        __builtin_amdgcn_s_sleep(1);
        if ((++sp & 255u) == 0u) { if (xb_ld(&bar[XB_TMO])) break; if (sp > XB_SPIN_CAP) { atomicAdd(&bar[XB_TMO], 1u); break; } }
    }
    nloc = mine > 0u ? mine : 1u; nx = cnt > 0u ? cnt : 1u;
}

__device__ __forceinline__ void xcd_barrier(const XcdBarrier& b) {
    asm volatile("s_waitcnt vmcnt(0)" ::: "memory");
    __syncthreads();
    if (threadIdx.x == 0) {
        unsigned* bar = b.bar;
        __builtin_amdgcn_s_waitcnt(0);
        unsigned nloc = b.st[0], nx = b.st[1];
        if (nloc == 0u) { xcd_barrier_complete(bar, b.x, nloc, nx); b.st[0] = nloc; b.st[1] = nx; }
        const unsigned old = xb_add(&bar[XB_XSUB(b.x)], 1u);
        const unsigned gen = old / nloc;
        if (old + 1u == (gen + 1u) * nloc) {
            __builtin_amdgcn_fence(__ATOMIC_RELEASE, "agent");
            asm volatile("s_waitcnt vmcnt(0)" ::: "memory");
            const unsigned og = xb_add(&bar[XB_TOP], 1u);
            const unsigned tg = og / nx;
            if (og + 1u == (tg + 1u) * nx) xb_add(&bar[XB_TOPGEN], 1u);
            else XB_SPIN(xb_ld(&bar[XB_TOPGEN]) == tg, bar);
            __builtin_amdgcn_fence(__ATOMIC_ACQUIRE, "agent");
            xb_add(&bar[XB_XGEN(b.x)], 1u);
            asm volatile("s_waitcnt vmcnt(0)" ::: "memory");
        } else {
            XB_SPIN(xb_ld(&bar[XB_XGEN(b.x)]) == gen, bar);
            __builtin_amdgcn_fence(__ATOMIC_ACQUIRE, "agent");
            asm volatile("s_waitcnt vmcnt(0)" ::: "memory");
        }
    }
    __syncthreads();
}
__device__ __forceinline__ void sg_core(const bf16* ap, const bf16* bp, int K, int steps, f32x4 (&acc)[4][2]) {
    bf16x8 ra[4][4], rb[4][2];
    const bf16* pa[4]; const bf16* pb[2];
#pragma unroll
    for (int t = 0; t < 4; ++t) pa[t] = ap + (size_t)t * 16 * K;
    pb[0] = bp; pb[1] = bp + (size_t)16 * K;
#define SG_LOAD(slot, s) do { const int ko_ = 32 * (s); _Pragma("unroll") for (int t_ = 0; t_ < 4; ++t_) ra[slot][t_] = *(const bf16x8*)(pa[t_] + ko_); \
        rb[slot][0] = *(const bf16x8*)(pb[0] + ko_); rb[slot][1] = *(const bf16x8*)(pb[1] + ko_); } while (0)
#define SG_COMP(slot) do { _Pragma("unroll") for (int t_ = 0; t_ < 4; ++t_) { MM_XROW(acc[t_][0], ra[slot][t_], rb[slot][0]); MM_XROW(acc[t_][1], ra[slot][t_], rb[slot][1]); } } while (0)
    SG_LOAD(0, 0); SG_LOAD(1, 1); SG_LOAD(2, 2);
    int s = 0;
#pragma nounroll
    for (; s + 4 <= steps; s += 4) {
        SG_LOAD(3, s + 3);
        SG_COMP(0); if (s + 4 < steps) SG_LOAD(0, s + 4);
        SG_COMP(1); if (s + 5 < steps) SG_LOAD(1, s + 5);
        SG_COMP(2); if (s + 6 < steps) SG_LOAD(2, s + 6);
        SG_COMP(3);
    }
    const int r = steps - s;
    if (r >= 1) SG_COMP(0);
    if (r >= 2) SG_COMP(1);
    if (r >= 3) SG_COMP(2);
#undef SG_LOAD
#undef SG_COMP
}
template <int NBLK, class Epi>
__device__ __forceinline__ void sgemm_unit(ldsp lds, const bf16* A, const bf16* B0, const bf16* B1, int K, const Epi& E, int row0, int cb, int wave, int lane) {
    const int fr = lane & 15, fq = lane >> 4, rh = wave & 1, kq = wave >> 1; int steps = K / 128; asm volatile("" : "+s"(steps));
    int fro = fr; asm volatile("" : "+v"(fro));
    const bf16* ap = A + (size_t)(64 * rh + fro) * K + (size_t)kq * (K / 4) + 8 * fq;
    LAS f32x4* buf = (LAS f32x4*)lds;
#pragma unroll
    for (int pass = 0; pass < NBLK / 2; ++pass) {
        f32x4 acc[4][2];
#pragma unroll
        for (int t = 0; t < 4; ++t) { acc[t][0] = (f32x4){0.f, 0.f, 0.f, 0.f}; acc[t][1] = (f32x4){0.f, 0.f, 0.f, 0.f}; }
        sg_core(ap, (pass ? B1 : B0) + (size_t)fro * K + (size_t)kq * (K / 4) + 8 * fq, K, steps, acc);
#pragma unroll
        for (int t = 0; t < 4; ++t) { buf[(kq * 32 + (rh * 4 + t) * 4 + 2 * pass) * 64 + lane] = acc[t][0]; buf[(kq * 32 + (rh * 4 + t) * 4 + 2 * pass + 1) * 64 + lane] = acc[t][1]; }
    }
    __syncthreads();
    {
        const int rt = wave >> 1;
        f32x4 o[NBLK];
#pragma unroll
        for (int j = 0; j < NBLK; ++j) { const int slot = (rh * 4 + rt) * 4 + j; o[j] = (buf[slot * 64 + lane] + buf[(32 + slot) * 64 + lane]) + (buf[(64 + slot) * 64 + lane] + buf[(96 + slot) * 64 + lane]); }
        E(o, row0 + 64 * rh + 16 * rt + fr, cb, fq);
    }
    __syncthreads();
}
struct SEpiProj {
    bf16* O; const float* ss; int nparts; float* beta; float* gdec; const float* a_log; const float* dt_bias;
    __device__ __forceinline__ void operator()(const f32x4 (&acc)[2], int row, int cb, int fq) const {
        const float rs = pg8::row_rstd(ss, row, nparts);
        if (cb < 192) {
#pragma unroll
            for (int j = 0; j < 2; ++j) { f32x4 v = acc[j] * rs;
                if (cb >= 128) {
#pragma unroll
                    for (int r = 0; r < 4; ++r) v[r] = pg8::silu_f(v[r]); }
                u32x2 w; w.x = pkbf(v[0], v[1]); w.y = pkbf(v[2], v[3]); *(u32x2*)(O + (size_t)row * PROJ_LD + 32 * cb + 16 * j + 4 * fq) = w; }
        } else {
            f32x4 b, g;
#pragma unroll
            for (int r = 0; r < 4; ++r) { b[r] = pg8::sigmoid_f(acc[0][r] * rs); const int h = 4 * fq + r; const float xx = acc[1][r] * rs + dt_bias[h]; const float ex = __expf(xx);
                const float sp = xx > 15.f ? xx : (ex < 1e-3f ? ex * (1.0f - 0.5f * ex) : __logf(1.0f + ex)); g[r] = -__expf(a_log[h]) * sp; }
            *(f32x4*)(beta + (size_t)row * 16 + 4 * fq) = b; *(f32x4*)(gdec + (size_t)row * 16 + 4 * fq) = g;
        }
    }
};
template <bool GLU> struct SEpiRes {
    const float* base; float* out; bf16* XB; float* ss;
    __device__ __forceinline__ void operator()(const f32x4 (&acc)[GLU ? 4 : 2], int row, int cb, int fq) const {
        float sq = 0.f;
#pragma unroll
        for (int j = 0; j < 2; ++j) { f32x4 v = acc[j];
            if (GLU) {
#pragma unroll
                for (int r = 0; r < 4; ++r) v[r] = v[r] * pg8::sigmoid_f(acc[2 + j][r]); }
            const size_t off = (size_t)row * D + 32 * cb + 16 * j + 4 * fq;
            const f32x4 o = *(const f32x4*)(base + off) + v; *(f32x4*)(out + off) = o;
            sq += (o[0] * o[0] + o[1] * o[1]) + (o[2] * o[2] + o[3] * o[3]);
            u32x2 w; w.x = pkbf(o[0], o[1]); w.y = pkbf(o[2], o[3]); *(u32x2*)(XB + off) = w; }
        sq += __shfl_xor(sq, 16); sq += __shfl_xor(sq, 32);
        if (fq == 0) ss[(size_t)row * 32 + cb] = sq;
    }
};
struct SEpiSwiglu {
    bf16* H; const float* ss; int nparts;
    __device__ __forceinline__ void operator()(const f32x4 (&acc)[4], int row, int cb, int fq) const {
        const float rs = pg8::row_rstd(ss, row, nparts);
#pragma unroll
        for (int j = 0; j < 2; ++j) { f32x4 h;
#pragma unroll
            for (int r = 0; r < 4; ++r) h[r] = pg8::silu_f(acc[j][r] * rs) * (acc[2 + j][r] * rs);
            u32x2 w; w.x = pkbf(h[0], h[1]); w.y = pkbf(h[2], h[3]); *(u32x2*)(H + (size_t)row * FFN + 32 * cb + 16 * j + 4 * fq) = w; }
    }
};
__device__ __forceinline__ void team_barrier(unsigned* cnt, unsigned target) {
    asm volatile("s_waitcnt vmcnt(0)" ::: "memory");
    __syncthreads();
    if (threadIdx.x == 0) {
        __builtin_amdgcn_fence(__ATOMIC_RELEASE, "agent");
        asm volatile("s_waitcnt vmcnt(0)" ::: "memory");
        (void)__hip_atomic_fetch_add(cnt, 1u, __ATOMIC_RELAXED, __HIP_MEMORY_SCOPE_AGENT);
        unsigned sp = 0;
        while (__hip_atomic_load(cnt, __ATOMIC_RELAXED, __HIP_MEMORY_SCOPE_AGENT) < target) { __builtin_amdgcn_s_sleep(2); if (++sp > (1u << 22)) break; }
        __builtin_amdgcn_fence(__ATOMIC_ACQUIRE, "agent");
        asm volatile("s_waitcnt vmcnt(0)" ::: "memory");
    }
    __syncthreads();
}
__device__ __forceinline__ void sincos_cw(float x, float& s, float& c) {
    const float k = rintf(x * 0.636619772367581343f);
    float r = fmaf(-k, 1.57079625129699707031f, x); r = fmaf(-k, 7.54978941586159635e-08f, r); r = fmaf(-k, 5.39030285815811482e-15f, r);
    const float z = r * r;
    const float sp = fmaf(fmaf(fmaf(-1.9515295891e-4f, z, 8.3321608736e-3f), z, -1.6666654611e-1f) * z, r, r);
    const float cp = fmaf(fmaf(fmaf(2.443315711809948e-5f, z, -1.388731625493765e-3f), z, 4.166664568298827e-2f), z * z, fmaf(-0.5f, z, 1.0f));
    const int q = (int)k & 3;
    const float ss = (q & 1) ? cp : sp, cc = (q & 1) ? sp : cp;
    s = (q & 2) ? -ss : ss; c = ((q + 1) & 2) ? -cc : cc;
}
__device__ __forceinline__ void s5_disc(const Args& a, int g, int p, float dt, float& lr, float& li, float& fre, float& fim) {
    const float are = a.in[15][g * 64 + p], aim = a.in[16][g * 64 + p];
    const float mag = __expf(are * dt); float sn, cs; sincos_cw(aim * dt, sn, cs);
    lr = mag * cs; li = mag * sn;
    const float den = are * are + aim * aim, nre = lr - 1.0f, nim = li;
    fre = (nre * are + nim * aim) / den; fim = (nim * are - nre * aim) / den;
}
__device__ __forceinline__ float gelu_tanh(float x) { const float u = 0.7978845608028654f * (x + 0.044715f * x * x * x); const float t = 1.0f - 2.0f * __builtin_amdgcn_rcpf(__expf(2.0f * u) + 1.0f); return 0.5f * x * (1.0f + t); }
__device__ __forceinline__ void s5_precompute(const Args& a, int idx) {
    unsigned char* ws = a.ws;
    if (idx < 4096) {
        const int g = idx >> 6, p = idx & 63;
        const float dt = __expf(a.in[17][g]);
        float lr, li, fre, fim; s5_disc(a, g, p, dt, lr, li, fre, fim);
        float* lam = (float*)(ws + WS_S5LAM) + (size_t)idx * 2; lam[0] = lr; lam[1] = li;
        const float* br = a.in[18] + (size_t)idx * 16; const float* bi = a.in[19] + (size_t)idx * 16; const float* gm = a.in[6] + D + g * 16;
        u32x4* bb = (u32x4*)((bf16*)(ws + WS_S5BB) + ((size_t)g * 128 + 2 * p) * 16);
        float vr[16], vi[16];
#pragma unroll
        for (int c = 0; c < 16; ++c) { const float re = br[c], im = bi[c], gg = gm[c]; vr[c] = (fre * re - fim * im) * gg; vi[c] = (fre * im + fim * re) * gg; }
        bb[0] = (u32x4){pkbf(vr[0], vr[1]), pkbf(vr[2], vr[3]), pkbf(vr[4], vr[5]), pkbf(vr[6], vr[7])};
        bb[1] = (u32x4){pkbf(vr[8], vr[9]), pkbf(vr[10], vr[11]), pkbf(vr[12], vr[13]), pkbf(vr[14], vr[15])};
        bb[2] = (u32x4){pkbf(vi[0], vi[1]), pkbf(vi[2], vi[3]), pkbf(vi[4], vi[5]), pkbf(vi[6], vi[7])};
        bb[3] = (u32x4){pkbf(vi[8], vi[9]), pkbf(vi[10], vi[11]), pkbf(vi[12], vi[13]), pkbf(vi[14], vi[15])};
        {
            f32x4* bf = (f32x4*)((float*)(ws + WS_BBF) + (size_t)idx * 32);
#pragma unroll
            for (int q = 0; q < 4; ++q) { bf[q] = (f32x4){vr[4 * q], vr[4 * q + 1], vr[4 * q + 2], vr[4 * q + 3]}; bf[4 + q] = (f32x4){vi[4 * q], vi[4 * q + 1], vi[4 * q + 2], vi[4 * q + 3]}; }
            const float are = a.in[15][idx], aim = a.in[16][idx];
            float* pw = (float*)(ws + WS_POW) + (size_t)idx * 34;
            for (int dd = 0; dd <= 16; ++dd) { const float mg = __expf(are * dt * (float)dd); float sn, cs; sincos_cw(aim * dt * (float)dd, sn, cs); pw[2 * dd] = mg * cs; pw[2 * dd + 1] = mg * sn; }
        }
        unsigned* cm = (unsigned*)((bf16*)(ws + WS_S5CM) + (size_t)g * 16 * 128 + 2 * p);
#pragma unroll
        for (int c = 0; c < 16; ++c) cm[c * 64] = pkbf(a.in[20][(size_t)(g * 16 + c) * 64 + p], -a.in[21][(size_t)(g * 16 + c) * 64 + p]);
    }
    if (idx < 1024) ((float*)(ws + WS_S5DSK))[idx] = a.in[22][idx] * a.in[6][D + idx];
}
__device__ __forceinline__ void s5_ktable(const Args& a, int t) {
    if (t >= 65536) return;
    unsigned char* ws = a.ws;
    const int g = t >> 10, dd = (t >> 6) & 15, c = (t >> 2) & 15, cq = t & 3;
    const float* pw = (const float*)(ws + WS_POW) + (size_t)g * 64 * 34 + 2 * dd; const float* bf = (const float*)(ws + WS_BBF) + (size_t)g * 64 * 32 + 4 * cq;
    const float* cre = a.in[20] + (size_t)(g * 16 + c) * 64; const float* cim = a.in[21] + (size_t)(g * 16 + c) * 64;
    f32x4 acc = (f32x4){0.f, 0.f, 0.f, 0.f};
    for (int p = 0; p < 64; ++p) {
        const float lr = pw[p * 34], li = pw[p * 34 + 1], cr = cre[p], ci = cim[p];
        const float zr = cr * lr - ci * li, zi = cr * li + ci * lr;
        const f32x4 br = *(const f32x4*)(bf + p * 32), bi = *(const f32x4*)(bf + p * 32 + 16);
        acc += br * zr - bi * zi;
    }
    if (dd == 0 && (c >> 2) == cq) acc[c & 3] += ((const float*)(ws + WS_S5DSK))[g * 16 + c];
    *(f32x4*)((float*)(ws + WS_KT) + ((size_t)(g * 16 + dd) * 16 + c) * 16 + 4 * cq) = acc;
}
__device__ __forceinline__ void p0_transpose_item(const float* W, int K, int N, const float* gain, int gluh, bf16* WT, LAS float* scr, int item, int lane) {
    const int nblk = N / 32, kb = item / nblk, nb = item % nblk, k0 = 64 * kb, n0 = 32 * nb;
    f32x4 v[8];
#pragma unroll
    for (int i = 0; i < 8; ++i) v[i] = __builtin_nontemporal_load((const f32x4*)(W + (size_t)(k0 + 8 * i + (lane >> 3)) * N + n0 + 4 * (lane & 7)));
#pragma unroll
    for (int i = 0; i < 8; ++i) { const int kk = 8 * i + (lane >> 3); const float gk = gain ? gain[k0 + kk] : 1.0f; LAS float* s = scr + kk * 33 + 4 * (lane & 7);
        s[0] = v[i][0] * gk; s[1] = v[i][1] * gk; s[2] = v[i][2] * gk; s[3] = v[i][3] * gk; }
    LDS_FENCE();
    int r0 = n0; if (gluh > 0) r0 = (n0 < gluh) ? (n0 / 128) * 256 + (n0 % 128) : ((n0 - gluh) / 128) * 256 + 128 + ((n0 - gluh) % 128);
    const int c = lane & 7;
#pragma unroll
    for (int j = 0; j < 4; ++j) { const int n = (lane >> 3) + 8 * j; const LAS float* s = scr + (8 * c) * 33 + n;
        u32x4 o; o.x = pkbf(s[0 * 33], s[1 * 33]); o.y = pkbf(s[2 * 33], s[3 * 33]); o.z = pkbf(s[4 * 33], s[5 * 33]); o.w = pkbf(s[6 * 33], s[7 * 33]);
        *(u32x4*)(WT + (size_t)(r0 + n) * K + k0 + 8 * c) = o; }
    LDS_FENCE();
}
__device__ __forceinline__ void p0_prologue(const Args& a, ldsp lds, int gw, int ngw, int wave, int lane) {
    LAS float* scr = (LAS float*)(lds + wave * 16384);
    unsigned char* ws = a.ws;
    constexpr int I1 = (D / 64) * (DN_IN / 32), I2 = (VAL / 64) * (D / 32), I5 = (D / 64) * (2 * D / 32), I3 = (D / 64) * (2 * FFN / 32), I4 = (FFN / 64) * (D / 32);
    constexpr int NITEMS = I1 + I2 + I5 + 2 * I3 + 2 * I4;
    for (int it = gw; it < NITEMS; it += ngw) {
        int r = it;
        if (r < I1) { p0_transpose_item(a.in[9], D, DN_IN, a.in[6], 0, (bf16*)(ws + WS_W1), scr, r, lane); continue; } r -= I1;
        if (r < I2) { p0_transpose_item(a.in[14], VAL, D, nullptr, 0, (bf16*)(ws + WS_W2), scr, r, lane); continue; } r -= I2;
        if (r < I5) { p0_transpose_item(a.in[23], D, 2 * D, nullptr, D, (bf16*)(ws + WS_W5), scr, r, lane); continue; } r -= I5;
        if (r < 2 * I3) { const int l = r / I3; p0_transpose_item(a.in[24] + (size_t)l * D * 2 * FFN, D, 2 * FFN, a.in[7] + l * D, FFN, (bf16*)(ws + WS_W3) + (size_t)l * 2 * FFN * D, scr, r % I3, lane); continue; } r -= 2 * I3;
        { const int l = r / I4; p0_transpose_item(a.in[25] + (size_t)l * FFN * D, FFN, D, nullptr, 0, (bf16*)(ws + WS_W4) + (size_t)l * D * FFN, scr, r % I4, lane); }
    }
    {
        f32x4 nv[4]; int m = gw;
#define P0_XLOAD(mm) do { const bool smp_ = (mm) >= MP; const int r_ = smp_ ? (mm) - MP : (mm); const f32x4* xr_ = (const f32x4*)((smp_ ? a.in[1] : a.in[0]) + (size_t)r_ * D) + lane; \
        _Pragma("unroll") for (int j_ = 0; j_ < 4; ++j_) nv[j_] = xr_[64 * j_]; } while (0)
        if (m < MP + MS) P0_XLOAD(m);
        for (; m < MP + MS; m += ngw) {
            const bool smp = m >= MP; const int r = smp ? m - MP : m;
            f32x4 v[4]; float s = 0.f;
#pragma unroll
            for (int j = 0; j < 4; ++j) { v[j] = nv[j]; s += (v[j][0] * v[j][0] + v[j][1] * v[j][1]) + (v[j][2] * v[j][2] + v[j][3] * v[j][3]); }
            if (m + ngw < MP + MS) P0_XLOAD(m + ngw);
            s = wave_sum(s);
            u32x2* o8 = (u32x2*)((bf16*)(ws + (smp ? WS_SXB : WS_XB)) + (size_t)r * D) + lane;
#pragma unroll
            for (int j = 0; j < 4; ++j) { u32x2 w; w.x = pkbf(v[j][0], v[j][1]); w.y = pkbf(v[j][2], v[j][3]); o8[64 * j] = w; }
            float* ssr = (float*)(ws + (smp ? WS_SSS : WS_SS)) + (size_t)r * 32;
            if (lane < (smp ? 32 : 16)) ssr[lane] = (lane == 0) ? s : 0.f;
        }
#undef P0_XLOAD
    }
    if (wave == 7) s5_precompute(a, (gw >> 3) * 64 + lane);
}
constexpr int DL_K = 0, DL_V = 17408, DL_QK = 34816, DL_X = 44032, DL_SLOT = 9216, DL_ST = 99328, DL_GC = 134144, DL_BETA = 134400, DL_RED = 134656, DL_Q = 135680, DL_END = 135680 + 17408;
static_assert(DL_END <= LDSCTL_OFF, "DN LDS map");
__device__ __forceinline__ bf16x8 ldfrag(ldsp base, int row, int ld, int k) { return *(const LAS bf16x8*)(base + (row * ld + k) * 2); }
__device__ __forceinline__ void st4(ldsp base, int row, int ld, int col, const f32x4 v) { u32x2 w; w.x = pkbf(v[0], v[1]); w.y = pkbf(v[2], v[3]); *(LAS u32x2*)(base + (row * ld + col) * 2) = w; }
__device__ __forceinline__ void st1(ldsp base, int row, int ld, int col, float v) { *(LAS unsigned short*)(base + (row * ld + col) * 2) = (unsigned short)(pkbf(v, 0.f) & 0xffffu); }

typedef short s16x4 __attribute__((ext_vector_type(4)));
__device__ __forceinline__ bf16x8 ldfrag_tr(ldsp base, int k0, int ld, int c0, int fr, int fq) {
    const ldsp p = base + ((k0 + 8 * fq + (fr >> 2)) * ld + c0 + 4 * (fr & 3)) * 2;
    const s16x4 lo = __builtin_amdgcn_ds_read_tr16_b64_v4i16((LAS s16x4*)p);
    const s16x4 hi = __builtin_amdgcn_ds_read_tr16_b64_v4i16((LAS s16x4*)(p + 8 * ld));
    return (bf16x8){lo[0], lo[1], lo[2], lo[3], hi[0], hi[1], hi[2], hi[3]};
}
__device__ __forceinline__ void dn_prep(const Args& a, int gw, int ngw, int lane) {
    const bf16* PROJ = (const bf16*)(a.ws + WS_PROJ); bf16* QKVC = (bf16*)(a.ws + WS_QKVC);
    {
        const float* BETA = (const float*)(a.ws + WS_BETA); const float* GDEC = (const float*)(a.ws + WS_GDEC);
        float* GC = (float*)(a.ws + WS_GC); float* BT = (float*)(a.ws + WS_BT);
        for (int u = gw; u < NB * NH * NCHUNK; u += ngw) {
            const int c = u % NCHUNK, h = (u / NCHUNK) % NH, b = u / (NCHUNK * NH); const int row = b * SEQ + c * CHUNK + lane;
            float g = GDEC[(size_t)row * 16 + h]; const float bt = BETA[(size_t)row * 16 + h];
#pragma unroll
            for (int o = 1; o < 64; o <<= 1) { const float t = __shfl_up(g, o); if (lane >= o) g += t; }
            GC[(size_t)(b * NH + h) * SEQ + c * CHUNK + lane] = g; BT[(size_t)(b * NH + h) * SEQ + c * CHUNK + lane] = bt;
        }
    }
    for (int u = gw; u < NB * 8 * (SEQ / 32); u += ngw) {
        const int cb = u & 7, run = (u >> 3) & 63, b = u >> 9, ch0 = cb * 512 + lane * 8, t0 = run * 32, row0 = b * SEQ + t0;
        float w[4][8];
#pragma unroll
        for (int j = 0; j < 4; ++j) { const f32x4 w0 = *(const f32x4*)(a.in[10] + j * 4096 + ch0), w1 = *(const f32x4*)(a.in[10] + j * 4096 + ch0 + 4);
#pragma unroll
            for (int e = 0; e < 4; ++e) { w[j][e] = w0[e]; w[j][4 + e] = w1[e]; } }
        u32x4 xm[3];
#pragma unroll
        for (int j = 0; j < 3; ++j) { xm[j] = (u32x4){0u, 0u, 0u, 0u}; if (t0 - 3 + j >= 0) xm[j] = *(const u32x4*)(PROJ + (size_t)(row0 - 3 + j) * PROJ_LD + ch0); }
        const float scl = cb < 2 ? 0.08838834764831845f : 1.0f;
        u32x4 xr[8];
#pragma unroll
        for (int t = 0; t < 8; ++t) xr[t] = *(const u32x4*)(PROJ + (size_t)(row0 + t) * PROJ_LD + ch0);
#pragma unroll
        for (int t = 0; t < 32; ++t) {
            const u32x4 x0 = xr[t & 7];
            if (t + 8 < 32) xr[t & 7] = *(const u32x4*)(PROJ + (size_t)(row0 + t + 8) * PROJ_LD + ch0);
            float y[8];
#pragma unroll
            for (int e = 0; e < 4; ++e) {
                const unsigned a3 = xm[0][e], a2 = xm[1][e], a1 = xm[2][e], a0 = x0[e];
                y[2 * e] = w[0][2 * e] * bflo(a3) + w[1][2 * e] * bflo(a2) + w[2][2 * e] * bflo(a1) + w[3][2 * e] * bflo(a0);
                y[2 * e + 1] = w[0][2 * e + 1] * bfhi(a3) + w[1][2 * e + 1] * bfhi(a2) + w[2][2 * e + 1] * bfhi(a1) + w[3][2 * e + 1] * bfhi(a0); }
            float ssq = 0.f;
#pragma unroll
            for (int e = 0; e < 8; ++e) { y[e] = y[e] * __builtin_amdgcn_rcpf(1.0f + __expf(-y[e])); ssq += y[e] * y[e]; }
            if (cb < 4) { ssq += __shfl_xor(ssq, 1); ssq += __shfl_xor(ssq, 2); ssq += __shfl_xor(ssq, 4); ssq += __shfl_xor(ssq, 8); const float sc = rsqrtf(ssq + 1e-6f) * scl;
#pragma unroll
                for (int e = 0; e < 8; ++e) y[e] *= sc; }
            u32x4 o; o.x = pkbf(y[0], y[1]); o.y = pkbf(y[2], y[3]); o.z = pkbf(y[4], y[5]); o.w = pkbf(y[6], y[7]);
            *(u32x4*)(QKVC + (size_t)(row0 + t) * 4096 + ch0) = o;
            xm[0] = xm[1]; xm[1] = xm[2]; xm[2] = x0;
        }
    }
}

#ifndef RPA
#define RPA 1
#endif
#ifndef RPB
#define RPB 1
#endif
#ifndef RPE
#define RPE 1
#endif
#ifndef RPF
#define RPF 1
#endif
#ifndef RPO
#define RPO 1
#endif
__device__ __forceinline__ void dn_prompt(const Args& a, ldsp lds, int b, int h, int tid, int wave, int lane) {
    unsigned char* ws = a.ws;
    const bf16* PROJ = (const bf16*)(ws + WS_PROJ); const bf16* QKVC = (const bf16*)(ws + WS_QKVC); bf16* GATED = (bf16*)(ws + WS_GATED);
    const float* GC = (const float*)(ws + WS_GC) + (size_t)(b * NH + h) * SEQ; const float* BT = (const float*)(ws + WS_BT) + (size_t)(b * NH + h) * SEQ;
    const int mt = wave & 3, ch = wave >> 2, hq = h >> 1;
    LAS float* gcs = (LAS float*)(lds + DL_GC); LAS float* betas = (LAS float*)(lds + DL_BETA); LAS float* red = (LAS float*)(lds + DL_RED);
    const ldsp LK = lds + DL_K, LV = lds + DL_V, LQK = lds + DL_QK, LST = lds + DL_ST, LQ = lds + DL_Q;
#define SLOT(s) (lds + DL_X + (s) * DL_SLOT)
#define PRs(s) ((s) == 0 ? 0 : (((s) & 1) ? 2 : 4))
#define PTs(s) ((s) == 0 ? 1 : (((s) & 1) ? 3 : 5))
#define NRs(s) ((s) & 1)
    for (int i = tid; i < 128 * 136 / 2; i += NTHREADS) ((LAS unsigned*)LST)[i] = 0u;
    f32x4 S[2][4];
#pragma unroll
    for (int x = 0; x < 2; ++x)
#pragma unroll
        for (int q = 0; q < 4; ++q) S[x][q] = (f32x4){0.f, 0.f, 0.f, 0.f};
    LAS float* ngl = (LAS float*)(lds + DL_RED + 512);
    if (tid < 128) ngl[tid] = a.in[13][tid];
    u32x4 nQt[2], nKt[2], nVt[2]; float ngd = 0.f, nbt = 0.f;
#define DN_PREFETCH(cc) do { const int rowc_ = b * SEQ + (cc) * CHUNK; const bf16* krow_ = QKVC + (size_t)(rowc_ + (tid >> 3)) * 4096; \
        _Pragma("unroll") for (int p2_ = 0; p2_ < 2; ++p2_) { const int col_ = 8 * ((tid & 7) + 8 * p2_); nQt[p2_] = *(const u32x4*)(krow_ + hq * 128 + col_); nKt[p2_] = *(const u32x4*)(krow_ + 1024 + hq * 128 + col_); nVt[p2_] = *(const u32x4*)(krow_ + 2048 + h * 128 + col_); } \
        ngd = GC[(cc) * CHUNK + lane]; nbt = BT[(cc) * CHUNK + lane]; } while (0)
    DN_PREFETCH(0);
#define DN_TILES_TO_LDS() do { const int r_ = tid >> 3, pc_ = tid & 7; \
        _Pragma("unroll") for (int p2_ = 0; p2_ < 2; ++p2_) { const int col_ = 8 * (pc_ + 8 * p2_); *(LAS u32x4*)(LQ + (r_ * 136 + col_) * 2) = nQt[p2_]; *(LAS u32x4*)(LK + (r_ * 136 + col_) * 2) = nKt[p2_]; *(LAS u32x4*)(LV + (r_ * 136 + col_) * 2) = nVt[p2_]; } \
        if (wave == 0) { gcs[lane] = ngd; betas[lane] = nbt; } } while (0)
    DN_TILES_TO_LDS();
    DN_PREFETCH(NCHUNK > 1 ? 1 : 0);
    __syncthreads();
    for (int c = 0; c < NCHUNK; ++c) {
        int lane_c = lane; asm volatile("" : "+v"(lane_c));
        const int fr = lane_c & 15, fq = lane_c >> 4, i_own = 16 * mt + fr;
        const int t_own = c * CHUNK + i_own, row_own = b * SEQ + t_own;
        bf16x8 qf[4], kf[4]; u32x2 zc[4];
#pragma unroll
        for (int q = 0; q < 4; ++q) zc[q] = *(const u32x2*)(PROJ + (size_t)row_own * PROJ_LD + 4096 + h * 128 + 16 * (4 * ch + q) + 4 * fq);
#pragma unroll
        for (int kk = 0; kk < 4; ++kk) { kf[kk] = ldfrag(LK, i_own, 136, 32 * kk + 8 * fq); qf[kk] = ldfrag(LQ, i_own, 136, 32 * kk + 8 * fq); }
        for (int rpB = 0; rpB < RPB; ++rpB) {
        f32x4 Pt[2], Nt[2];
        {
            const float gi = gcs[i_own], bi = betas[i_own];
#pragma unroll
            for (int q2 = 0; q2 < 2; ++q2) { const int nt = 2 * ch + q2;
                f32x4 akk = (f32x4){0.f, 0.f, 0.f, 0.f}, aqk = akk;
#pragma unroll
                for (int kk = 0; kk < 4; ++kk) { const bf16x8 yf = ldfrag(LK, 16 * nt + fr, 136, 32 * kk + 8 * fq); MM_XROW(akk, kf[kk], yf); MM_XROW(aqk, qf[kk], yf); }
                const f32x4 gj = *(const LAS f32x4*)(gcs + 16 * nt + 4 * fq);
                f32x4 qkv, m0;
#pragma unroll
                for (int r = 0; r < 4; ++r) { const int j = 16 * nt + 4 * fq + r; const float d = (i_own >= j) ? __expf(gi - gj[r]) : 0.f; qkv[r] = aqk[r] * d; m0[r] = (i_own > j) ? -bi * akk[r] * d : 0.f; }
                st4(LQK, i_own, 72, 16 * nt + 4 * fq, qkv);
                Pt[q2] = m0; Nt[q2] = m0;
                st4(SLOT(0), i_own, 72, 16 * nt + 4 * fq, m0); }
        }
        __syncthreads();
#pragma unroll
        for (int s = 1; s <= 6; ++s) {
            f32x4 Pn[2];
            bf16x8 xn[2], xp[2];
            if (s >= 2) { xn[0] = ldfrag(SLOT(NRs(s - 2)), i_own, 72, 8 * fq); xn[1] = ldfrag(SLOT(NRs(s - 2)), i_own, 72, 32 + 8 * fq); }
            if (s <= 5) { xp[0] = ldfrag(SLOT(PRs(s - 1)), i_own, 72, 8 * fq); xp[1] = ldfrag(SLOT(PRs(s - 1)), i_own, 72, 32 + 8 * fq); }
#pragma unroll
            for (int q2 = 0; q2 < 2; ++q2) { const int nt = 2 * ch + q2;
                const bf16x8 y0 = ldfrag_tr(SLOT(PRs(s - 1)), 0, 72, 16 * nt, fr, fq), y1 = ldfrag_tr(SLOT(PRs(s - 1)), 32, 72, 16 * nt, fr, fq);
                if (s >= 2) { f32x4 acc = Nt[q2] + Pt[q2]; MM_XROW(acc, xn[0], y0); MM_XROW(acc, xn[1], y1); Nt[q2] = acc; }
                if (s <= 5) { f32x4 acc = (f32x4){0.f, 0.f, 0.f, 0.f}; MM_XROW(acc, xp[0], y0); MM_XROW(acc, xp[1], y1); Pn[q2] = acc; }
            }
#pragma unroll
            for (int q2 = 0; q2 < 2; ++q2) { const int nt = 2 * ch + q2, j0 = 16 * nt + 4 * fq;
                if (s <= 5) { Pt[q2] = Pn[q2];
                    st4(SLOT(PRs(s)), i_own, 72, j0, Pn[q2]); }
                if (s >= 2 && s <= 5) st4(SLOT(NRs(s - 1)), i_own, 72, j0, Nt[q2]);
                if (s == 6) {
                    const f32x4 gj = *(const LAS f32x4*)(gcs + j0), bj = *(const LAS f32x4*)(betas + j0); f32x4 t1, t2;
#pragma unroll
                    for (int r = 0; r < 4; ++r) { const float tv = Nt[q2][r] + ((i_own == j0 + r) ? 1.f : 0.f); t2[r] = tv * bj[r]; t1[r] = t2[r] * __expf(gj[r]); }
                    st4(SLOT(1), i_own, 72, j0, t1); st4(SLOT(3), i_own, 72, j0, t2); }
            }
            __syncthreads();
        }
        }
        f32x4 U[4]; bf16x8 ka[2][2];
        for (int rpE = 0; rpE < RPE; ++rpE) {
        {
#pragma unroll
            for (int x = 0; x < 2; ++x) { ka[x][0] = ldfrag_tr(LK, 0, 136, 16 * (2 * mt + x), fr, fq); ka[x][1] = ldfrag_tr(LK, 32, 136, 16 * (2 * mt + x), fr, fq); }
            const bf16x8 t1a = ldfrag(SLOT(1), i_own, 72, 8 * fq), t1b = ldfrag(SLOT(1), i_own, 72, 32 + 8 * fq), t2a = ldfrag(SLOT(3), i_own, 72, 8 * fq), t2b = ldfrag(SLOT(3), i_own, 72, 32 + 8 * fq);
#pragma unroll
            for (int q = 0; q < 4; ++q) { const int nt = 4 * ch + q;
                f32x4 aw = (f32x4){0.f, 0.f, 0.f, 0.f};
                MM_XROW(aw, t1a, ldfrag_tr(LK, 0, 136, 16 * nt, fr, fq)); MM_XROW(aw, t1b, ldfrag_tr(LK, 32, 136, 16 * nt, fr, fq));
                st4(SLOT(4), i_own, 136, 16 * nt + 4 * fq, -aw);
                f32x4 au = (f32x4){0.f, 0.f, 0.f, 0.f};
                MM_YROW(au, t2a, ldfrag_tr(LV, 0, 136, 16 * nt, fr, fq)); MM_YROW(au, t2b, ldfrag_tr(LV, 32, 136, 16 * nt, fr, fq));
                U[q] = au; }
        }
        __syncthreads();
        }
        f32x4 O[4];
        const float gl = gcs[63];
        for (int rpF = 0; rpF < RPF; ++rpF) {
        {
            bf16x8 wf[4];
#pragma unroll
            for (int kk = 0; kk < 4; ++kk) wf[kk] = ldfrag(SLOT(4), i_own, 136, 32 * kk + 8 * fq);
            const float ei = __expf(gcs[i_own]);
            const f32x4 gq = *(const LAS f32x4*)(gcs + 16 * mt + 4 * fq);
#pragma unroll
            for (int q = 0; q < 4; ++q) { const int nt = 4 * ch + q;
                f32x4 ao = (f32x4){0.f, 0.f, 0.f, 0.f}, av = U[q];
#pragma unroll
                for (int kk = 0; kk < 4; ++kk) { const bf16x8 sf = ldfrag(LST, 16 * nt + fr, 136, 32 * kk + 8 * fq); MM_YROW(av, wf[kk], sf); MM_XROW(ao, qf[kk], sf); }
                O[q] = ao * ei;
                st4(SLOT(0), 16 * nt + fr, 72, 16 * mt + 4 * fq, av);
                f32x4 avd;
#pragma unroll
                for (int r = 0; r < 4; ++r) avd[r] = av[r] * __expf(gl - gq[r]);
                st4(SLOT(2), 16 * nt + fr, 72, 16 * mt + 4 * fq, avd); }
        }
        __syncthreads();
        }
        {
            const bf16x8 qa = ldfrag(LQK, i_own, 72, 8 * fq), qb = ldfrag(LQK, i_own, 72, 32 + 8 * fq);
            DN_TILES_TO_LDS();
            const float el = __expf(gl);
            float ssq = 0.f;
#pragma unroll
            for (int q = 0; q < 4; ++q) { const int nt = 4 * ch + q;
                MM_XROW(O[q], qa, ldfrag(SLOT(0), 16 * nt + fr, 72, 8 * fq)); MM_XROW(O[q], qb, ldfrag(SLOT(0), 16 * nt + fr, 72, 32 + 8 * fq));
                ssq += (O[q][0] * O[q][0] + O[q][1] * O[q][1]) + (O[q][2] * O[q][2] + O[q][3] * O[q][3]);
                const bf16x8 v0 = ldfrag(SLOT(2), 16 * nt + fr, 72, 8 * fq), v1 = ldfrag(SLOT(2), 16 * nt + fr, 72, 32 + 8 * fq);
#pragma unroll
                for (int x = 0; x < 2; ++x) { f32x4 sacc = S[x][q] * el; MM_YROW(sacc, ka[x][0], v0); MM_YROW(sacc, ka[x][1], v1); S[x][q] = sacc;
                    st4(LST, 16 * nt + fr, 136, 16 * (2 * mt + x) + 4 * fq, sacc); } }
            ssq += __shfl_xor(ssq, 16); ssq += __shfl_xor(ssq, 32);
            if (fq == 0) red[i_own * 2 + ch] = ssq;
            { const int cn = (c + 2 < NCHUNK) ? c + 2 : NCHUNK - 1; DN_PREFETCH(cn); }
        }
        __syncthreads();
        for (int rpO = 0; rpO < RPO; ++rpO) {
        {
            const float rstd = rsqrtf((red[i_own * 2] + red[i_own * 2 + 1]) * (1.0f / 128.0f) + RMS_EPSF);
#pragma unroll
            for (int q = 0; q < 4; ++q) { const int dv = 16 * (4 * ch + q) + 4 * fq;
                const u32x2 z = zc[q];
                const f32x4 ngv = *(const LAS f32x4*)(ngl + dv);
                u32x2 w; w.x = pkbf(O[q][0] * rstd * ngv[0] * bflo(z.x), O[q][1] * rstd * ngv[1] * bfhi(z.x)); w.y = pkbf(O[q][2] * rstd * ngv[2] * bflo(z.y), O[q][3] * rstd * ngv[3] * bfhi(z.y));
                *(u32x2*)(GATED + (size_t)row_own * VAL + h * 128 + dv) = w; }
        }
        }
    }
    const int fr = lane & 15, fq = lane >> 4;
    float* so = a.out + O_SSMP + (size_t)(b * NH + h) * 128 * 128;
#pragma unroll
    for (int x = 0; x < 2; ++x)
#pragma unroll
        for (int q = 0; q < 4; ++q)
#pragma unroll
            for (int r = 0; r < 4; ++r) so[(size_t)(16 * (2 * mt + x) + 4 * fq + r) * 128 + 16 * (4 * ch + q) + fr] = S[x][q][r];
    for (int i = tid; i < 3 * 384; i += NTHREADS) { const int j = i / 384, cc = i % 384; if (cc < 256 && (h & 1)) continue;
        const int gch = cc < 128 ? hq * 128 + cc : (cc < 256 ? 1024 + hq * 128 + (cc - 128) : 2048 + h * 128 + (cc - 256));
        a.out[O_CONVP + (size_t)(b * 3 + j) * 4096 + gch] = bf1(PROJ[(size_t)(b * SEQ + SEQ - 3 + j) * PROJ_LD + gch]); }
    __syncthreads();
#undef SLOT
#undef DN_PREFETCH
#undef DN_TILES_TO_LDS
#undef PRs
#undef PTs
#undef NRs
}
__device__ __forceinline__ void dn_sample_all(const Args& a, ldsp lds, int ti, int nt, int tid, int wave, int lane) {
    unsigned char* ws = a.ws;
    const bf16* PROJ = (const bf16*)(ws + WS_SPROJ); bf16* GATED = (bf16*)(ws + WS_SGATED);
    const float* BETA = (const float*)(ws + WS_SBETA); const float* GDEC = (const float*)(ws + WS_SGDEC);
    LAS float* qkv = (LAS float*)lds;
    LAS float* red = qkv + 384;
    LAS float* part = qkv + 512;
    const int kg = tid >> 5, v4 = tid & 31, p = tid >> 7, c = tid & 127;
    f32x4 sn[8]; float nx3 = 0.f, nc0 = 0.f, nc1 = 0.f, nc2 = 0.f, nbeta = 0.f, ngd = 0.f; u32x2 nz = (u32x2){0u, 0u};
    float w0 = 0.f, w1 = 0.f, w2 = 0.f, w3 = 0.f; int gch_cur = -1;
#define DNS_LOAD(it_) do { const int bs_ = (it_) / NH, h_ = (it_) % NH, hq_ = h_ >> 1; \
        const float* sin_ = a.in[2] + ((size_t)(bs_ * NH + h_) * 128 + kg * 8) * 128 + 4 * v4; \
        _Pragma("unroll") for (int r_ = 0; r_ < 8; ++r_) sn[r_] = *(const f32x4*)(sin_ + r_ * 128); \
        if (tid < 384) { const int gch_ = p == 0 ? hq_ * 128 + c : (p == 1 ? 1024 + hq_ * 128 + c : 2048 + h_ * 128 + c); \
            nx3 = bf1(PROJ[(size_t)bs_ * PROJ_LD + gch_]); const float* cs_ = a.in[3] + (size_t)bs_ * 3 * 4096 + gch_; nc0 = cs_[0]; nc1 = cs_[4096]; nc2 = cs_[8192]; } \
        nbeta = BETA[(size_t)bs_ * 16 + h_]; ngd = GDEC[(size_t)bs_ * 16 + h_]; \
        if (tid < 32) nz = *(const u32x2*)(PROJ + (size_t)bs_ * PROJ_LD + 4096 + h_ * 128 + 4 * v4); } while (0)
    int it = ti;
    if (it < MS * NH) DNS_LOAD(it);
    for (; it < MS * NH; it += nt) {
        const int bs = it / NH, h = it % NH, hq = h >> 1;
        f32x4 s[8];
#pragma unroll
        for (int r = 0; r < 8; ++r) s[r] = sn[r];
        const float x3 = nx3, c0 = nc0, c1 = nc1, c2 = nc2, beta = nbeta, eg = __expf(ngd); const u32x2 z = nz;
        const int gch = p == 0 ? hq * 128 + c : (p == 1 ? 1024 + hq * 128 + c : 2048 + h * 128 + c);
        if (tid < 384 && gch != gch_cur) { const float* w = a.in[10] + gch; w0 = w[0]; w1 = w[4096]; w2 = w[8192]; w3 = w[12288]; gch_cur = gch; }
        if (it + nt < MS * NH) DNS_LOAD(it + nt);
        float sq = 0.f;
        if (tid < 384) {
            float y = c0 * w0 + c1 * w1 + c2 * w2 + x3 * w3; y = y / (1.0f + __expf(-y));
            if (p == 2 || (h & 1) == 0) { float* co = a.out + O_CONVS + (size_t)bs * 3 * 4096 + gch; co[0] = c1; co[4096] = c2; co[8192] = x3; }
            qkv[tid] = y; sq = y * y; }
        sq = wave_sum(sq);
        if (lane == 0) red[wave] = sq;
        __syncthreads();
        const float qs = rsqrtf(red[0] + red[1] + 1e-6f) * 0.08838834764831845f, ks = rsqrtf(red[2] + red[3] + 1e-6f);
        float* sout = a.out + O_SSMS + ((size_t)(bs * NH + h) * 128 + kg * 8) * 128 + 4 * v4;
        f32x4 kv = (f32x4){0.f, 0.f, 0.f, 0.f};
#pragma unroll
        for (int r = 0; r < 8; ++r) { s[r] = s[r] * eg; kv += s[r] * (qkv[128 + kg * 8 + r] * ks); }
        *(LAS f32x4*)(part + kg * 128 + 4 * v4) = kv;
        __syncthreads();
        kv = (f32x4){0.f, 0.f, 0.f, 0.f};
#pragma unroll
        for (int g = 0; g < 16; ++g) kv += *(const LAS f32x4*)(part + g * 128 + 4 * v4);
        const f32x4 vv = *(const LAS f32x4*)(qkv + 256 + 4 * v4);
        const f32x4 delta = (vv - kv) * beta;
        f32x4 op = (f32x4){0.f, 0.f, 0.f, 0.f};
#pragma unroll
        for (int r = 0; r < 8; ++r) { s[r] += delta * (qkv[128 + kg * 8 + r] * ks); *(f32x4*)(sout + r * 128) = s[r]; op += s[r] * (qkv[kg * 8 + r] * qs); }
        __syncthreads();
        *(LAS f32x4*)(part + kg * 128 + 4 * v4) = op;
        __syncthreads();
        if (tid < 32) {
            f32x4 o = (f32x4){0.f, 0.f, 0.f, 0.f};
#pragma unroll
            for (int g = 0; g < 16; ++g) o += *(const LAS f32x4*)(part + g * 128 + 4 * v4);
            float ss = (o[0] * o[0] + o[1] * o[1]) + (o[2] * o[2] + o[3] * o[3]);
#pragma unroll
            for (int m = 1; m < 32; m <<= 1) ss += __shfl_xor(ss, m);
            const float rstd = rsqrtf(ss * (1.0f / 128.0f) + RMS_EPSF);
            const f32x4 ng = *(const f32x4*)(a.in[13] + 4 * v4);
            u32x2 w; w.x = pkbf(o[0] * rstd * ng[0] * bflo(z.x), o[1] * rstd * ng[1] * bfhi(z.x)); w.y = pkbf(o[2] * rstd * ng[2] * bflo(z.y), o[3] * rstd * ng[3] * bfhi(z.y));
            *(u32x2*)(GATED + (size_t)bs * VAL + h * 128 + 4 * v4) = w;
        }
        __syncthreads();
    }
#undef DNS_LOAD
}
__device__ __forceinline__ void s5_wave(const Args& a, ldsp wl, bool sample, int b, int e0, int g, int lane) {
    unsigned char* ws = a.ws;
    const bf16* XB = (const bf16*)(ws + (sample ? WS_SXB : WS_XB)); bf16* YB = (bf16*)(ws + (sample ? WS_SYB : WS_YB)); const float* SS = (const float*)(ws + (sample ? WS_SSS : WS_SS));
    const int fr = lane & 15, fq = lane >> 4;
    LAS float* bubuf = (LAS float*)wl;
    const ldsp stbuf = wl + 16 * 132 * 4;
    const f32x2 lam = *(const f32x2*)((const float*)(ws + WS_S5LAM) + (size_t)(g * 64 + lane) * 2); const float lr = lam[0], li = lam[1];
    bf16x8 bbf[8];
#pragma unroll
    for (int nt = 0; nt < 8; ++nt) { u32x4 w = (u32x4){0u, 0u, 0u, 0u}; if (fq < 2) w = *(const u32x4*)((const bf16*)(ws + WS_S5BB) + ((size_t)g * 128 + 16 * nt + fr) * 16 + 8 * fq); bbf[nt] = __builtin_bit_cast(bf16x8, w); }
    bf16x8 cf[4];
#pragma unroll
    for (int kk = 0; kk < 4; ++kk) cf[kk] = *(const bf16x8*)((const bf16*)(ws + WS_S5CM) + ((size_t)g * 16 + fr) * 128 + 32 * kk + 8 * fq);
    const f32x4 dskv = *(const f32x4*)((const float*)(ws + WS_S5DSK) + g * 16 + 4 * fq); const float dsk[4] = {dskv[0], dskv[1], dskv[2], dskv[3]};
    float sre = 0.f, sim = 0.f;
    const int ntile = sample ? 1 : SEQ / 16;
    const int rowb0 = sample ? e0 : b * SEQ;
    u32x4 pxw[4]; f32x4 pss[4]; u32x2 puw[4];
#define S5_LOAD(k, tile) do { const int row_ = rowb0 + (tile) * 16 + fr; pxw[k] = (u32x4){0u, 0u, 0u, 0u}; if (fq < 2) pxw[k] = *(const u32x4*)(XB + (size_t)row_ * D + g * 16 + 8 * fq); \
        pss[k] = *(const f32x4*)(SS + (size_t)row_ * 32 + 4 * fq); if (sample) pss[k] += *(const f32x4*)(SS + (size_t)row_ * 32 + 16 + 4 * fq); puw[k] = *(const u32x2*)(XB + (size_t)row_ * D + g * 16 + 4 * fq); } while (0)
#pragma unroll
    for (int k = 0; k < 4; ++k) if (k < ntile) S5_LOAD(k, k);
    for (int t0 = 0; t0 < ntile; t0 += 4) {
#pragma unroll
        for (int k = 0; k < 4; ++k) {
            const int tile = t0 + k; if (tile >= ntile) break;
            const int row = rowb0 + tile * 16 + fr;
            const bf16x8 xf = __builtin_bit_cast(bf16x8, pxw[k]);
            float ssum = (pss[k][0] + pss[k][1]) + (pss[k][2] + pss[k][3]); ssum += __shfl_xor(ssum, 16); ssum += __shfl_xor(ssum, 32);
            const float rs = rsqrtf(ssum * (1.0f / 1024.0f) + RMS_EPSF);
            const u32x2 uw = puw[k];
            if (tile + 4 < ntile) S5_LOAD(k, tile + 4);
#pragma unroll
            for (int nt = 0; nt < 8; ++nt) { f32x4 acc = (f32x4){0.f, 0.f, 0.f, 0.f}; MM_XROW(acc, xf, bbf[nt]); *(LAS f32x4*)(bubuf + fr * 132 + 16 * nt + 4 * fq) = acc * rs; }
            LDS_FENCE();
            f32x2 buv[16];
#pragma unroll
            for (int t = 0; t < 16; ++t) buv[t] = *(const LAS f32x2*)(bubuf + t * 132 + 2 * lane);
            LDS_FENCE();
#pragma unroll
            for (int t = 0; t < 16; ++t) {
                const f32x2 bu = buv[t];
                if (sample) { sre = a.in[4][(size_t)(e0 + t) * 4096 + g * 64 + lane]; sim = a.in[5][(size_t)(e0 + t) * 4096 + g * 64 + lane]; }
                const float nr = fmaf(lr, sre, fmaf(-li, sim, bu[0])), ni = fmaf(lr, sim, fmaf(li, sre, bu[1]));
                sre = nr; sim = ni;
                *(LAS unsigned*)(stbuf + (t * 136 + 2 * lane) * 2) = pkbf(sre, sim);
                if (sample) { a.out[O_S5RS + (size_t)(e0 + t) * 4096 + g * 64 + lane] = sre; a.out[O_S5IS + (size_t)(e0 + t) * 4096 + g * 64 + lane] = sim; }
            }
            LDS_FENCE();
            f32x4 y = (f32x4){0.f, 0.f, 0.f, 0.f};
#pragma unroll
            for (int kk = 0; kk < 4; ++kk) MM_XROW(y, ldfrag(stbuf, fr, 136, 32 * kk + 8 * fq), cf[kk]);
            y[0] += dsk[0] * bflo(uw.x) * rs; y[1] += dsk[1] * bfhi(uw.x) * rs; y[2] += dsk[2] * bflo(uw.y) * rs; y[3] += dsk[3] * bfhi(uw.y) * rs;
            u32x2 w; w.x = pkbf(gelu_tanh(y[0]), gelu_tanh(y[1])); w.y = pkbf(gelu_tanh(y[2]), gelu_tanh(y[3]));
            *(u32x2*)(YB + (size_t)row * D + g * 16 + 4 * fq) = w;
            LDS_FENCE();
        }
    }
#undef S5_LOAD
    if (!sample) { a.out[O_S5RP + (size_t)(b * 64 + g) * 64 + lane] = sre; a.out[O_S5IP + (size_t)(b * 64 + g) * 64 + lane] = sim; }
}
template <bool EMIT>
__device__ __forceinline__ void s5_tiles(const bf16* XB, bf16* YB, const float* SS, ldsp wl, int rowb0, int ntile, int g, int lane, float lr, float li,
                                         const bf16x8 (&bbf)[8], const bf16x8 (&cf)[4], const float (&dsk)[4], float& sre, float& sim) {
    const int fr = lane & 15, fq = lane >> 4;
    LAS float* bubuf = (LAS float*)wl; const ldsp stbuf = wl + 16 * 132 * 4;
    u32x4 pxw[4]; f32x4 pss[4]; u32x2 puw[4];
#define S5_LOAD(k, tile) do { const int row_ = rowb0 + (tile) * 16 + fr; pxw[k] = (u32x4){0u, 0u, 0u, 0u}; if (fq < 2) pxw[k] = *(const u32x4*)(XB + (size_t)row_ * D + g * 16 + 8 * fq); \
        pss[k] = *(const f32x4*)(SS + (size_t)row_ * 32 + 4 * fq); if (EMIT) puw[k] = *(const u32x2*)(XB + (size_t)row_ * D + g * 16 + 4 * fq); } while (0)
#pragma unroll
    for (int k = 0; k < 4; ++k) if (k < ntile) S5_LOAD(k, k);
    for (int t0 = 0; t0 < ntile; t0 += 4) {
#pragma unroll
        for (int k = 0; k < 4; ++k) {
            const int tile = t0 + k; if (tile >= ntile) break;
            const int row = rowb0 + tile * 16 + fr;
            const bf16x8 xf = __builtin_bit_cast(bf16x8, pxw[k]);
            float ssum = (pss[k][0] + pss[k][1]) + (pss[k][2] + pss[k][3]); ssum += __shfl_xor(ssum, 16); ssum += __shfl_xor(ssum, 32);
            const float rs = rsqrtf(ssum * (1.0f / 1024.0f) + RMS_EPSF);
            u32x2 uw = (u32x2){0u, 0u}; if (EMIT) uw = puw[k];
            if (tile + 4 < ntile) S5_LOAD(k, tile + 4);
#pragma unroll
            for (int nt = 0; nt < 8; ++nt) { f32x4 acc = (f32x4){0.f, 0.f, 0.f, 0.f}; MM_XROW(acc, xf, bbf[nt]); *(LAS f32x4*)(bubuf + fr * 132 + 16 * nt + 4 * fq) = acc * rs; }
            LDS_FENCE();
            f32x2 buv[16];
#pragma unroll
            for (int t = 0; t < 16; ++t) buv[t] = *(const LAS f32x2*)(bubuf + t * 132 + 2 * lane);
            LDS_FENCE();
#pragma unroll
            for (int t = 0; t < 16; ++t) {
                const float nr = fmaf(lr, sre, fmaf(-li, sim, buv[t][0])), ni = fmaf(lr, sim, fmaf(li, sre, buv[t][1]));
                sre = nr; sim = ni;
                if (EMIT) *(LAS unsigned*)(stbuf + (t * 136 + 2 * lane) * 2) = pkbf(sre, sim);
            }
            if (EMIT) {
                LDS_FENCE();
                f32x4 y = (f32x4){0.f, 0.f, 0.f, 0.f};
#pragma unroll
                for (int kk = 0; kk < 4; ++kk) MM_XROW(y, ldfrag(stbuf, fr, 136, 32 * kk + 8 * fq), cf[kk]);
                y[0] += dsk[0] * bflo(uw.x) * rs; y[1] += dsk[1] * bfhi(uw.x) * rs; y[2] += dsk[2] * bflo(uw.y) * rs; y[3] += dsk[3] * bfhi(uw.y) * rs;
                u32x2 w; w.x = pkbf(gelu_tanh(y[0]), gelu_tanh(y[1])); w.y = pkbf(gelu_tanh(y[2]), gelu_tanh(y[3]));
                *(u32x2*)(YB + (size_t)row * D + g * 16 + 4 * fq) = w;
            }
            LDS_FENCE();
        }
    }
#undef S5_LOAD
}
__device__ __forceinline__ void s5_prompt_wg(const Args& a, ldsp lds, int vcu, int G, int wave, int lane) {
    unsigned char* ws = a.ws;
    const bf16* XB = (const bf16*)(ws + WS_XB); bf16* YB = (bf16*)(ws + WS_YB); const float* SS = (const float*)(ws + WS_SS);
    const int fr = lane & 15, fq = lane >> 4, p = wave >> 2, seg = wave & 3;
    const ldsp wl = lds + wave * 12800;
    LAS f32x2* exch = (LAS f32x2*)(lds + 8 * 12800);
    const int nrounds = (256 + G - 1) / G;
    for (int k = 0; k < nrounds; ++k) {
        const bool valid = vcu + k * G < 256;
        const int it = valid ? (vcu + k * G) * 2 + p : 0, b = it >> 6, g = it & 63;
        const f32x2 lam = *(const f32x2*)((const float*)(ws + WS_S5LAM) + (size_t)(g * 64 + lane) * 2); const float lr = lam[0], li = lam[1];
        bf16x8 bbf[8];
#pragma unroll
        for (int nt = 0; nt < 8; ++nt) { u32x4 w = (u32x4){0u, 0u, 0u, 0u}; if (fq < 2) w = *(const u32x4*)((const bf16*)(ws + WS_S5BB) + ((size_t)g * 128 + 16 * nt + fr) * 16 + 8 * fq); bbf[nt] = __builtin_bit_cast(bf16x8, w); }
        bf16x8 cf[4];
#pragma unroll
        for (int kk = 0; kk < 4; ++kk) cf[kk] = *(const bf16x8*)((const bf16*)(ws + WS_S5CM) + ((size_t)g * 16 + fr) * 128 + 32 * kk + 8 * fq);
        const f32x4 dskv = *(const f32x4*)((const float*)(ws + WS_S5DSK) + g * 16 + 4 * fq); const float dsk[4] = {dskv[0], dskv[1], dskv[2], dskv[3]};
        const int rowb0 = b * SEQ + seg * 512;
        float sre = 0.f, sim = 0.f;
        if (valid && seg < 3) s5_tiles<false>(XB, YB, SS, wl, rowb0, 32, g, lane, lr, li, bbf, cf, dsk, sre, sim);
        exch[(p * 4 + seg) * 64 + lane] = (f32x2){sre, sim};
        __syncthreads();
        if (valid) {
            float Lr = lr, Li = li;
#pragma unroll
            for (int q = 0; q < 9; ++q) { const float r2 = Lr * Lr - Li * Li, i2 = 2.0f * Lr * Li; Lr = r2; Li = i2; }
            float cr = 0.f, ci = 0.f;
            for (int j = 0; j < seg; ++j) { const f32x2 e = exch[(p * 4 + j) * 64 + lane]; const float nr = Lr * cr - Li * ci + e[0], ni = Lr * ci + Li * cr + e[1]; cr = nr; ci = ni; }
            sre = cr; sim = ci;
            s5_tiles<true>(XB, YB, SS, wl, rowb0, 32, g, lane, lr, li, bbf, cf, dsk, sre, sim);
            if (seg == 3) { a.out[O_S5RP + (size_t)(b * 64 + g) * 64 + lane] = sre; a.out[O_S5IP + (size_t)(b * 64 + g) * 64 + lane] = sim; }
        }
        __syncthreads();
    }
}
template <int KK, bool SCAN>
__device__ __forceinline__ void s5_gemm_role(const Args& a, ldsp lds, int g, int bp, int tid, int wave, int lane) {
    unsigned char* ws = a.ws;
    const bf16* XB = (const bf16*)(ws + WS_XB); bf16* YB = (bf16*)(ws + WS_YB); const float* SS = (const float*)(ws + WS_SS);
    asm volatile("" : "+v"(lane), "+s"(wave), "+v"(tid));
    const int fr = lane & 15, fq = lane >> 4;
    const ldsp UT = lds, SIN = lds + 3 * 8448;
    const float* kt = (const float*)(ws + WS_KT) + (size_t)g * 4096;
    const float* pw = (const float*)(ws + WS_POW) + (size_t)g * 64 * 34;
    const float* bfp = (const float*)(ws + WS_BBF) + (size_t)g * 64 * 32;
    const float* cre = a.in[20] + (size_t)g * 16 * 64; const float* cim = a.in[21] + (size_t)g * 16 * 64;
    bf16x8 vf[2][4], Fw[2][KK];
#pragma unroll
    for (int x = 0; x < 2; ++x) { const int tau = 2 * wave + x;
#pragma unroll
        for (int kk = 0; kk < 4; ++kk) { const int p0 = 16 * kk + 4 * fq; const f32x4 cr4 = *(const f32x4*)(cre + fr * 64 + p0), ci4 = *(const f32x4*)(cim + fr * 64 + p0); float v[8];
#pragma unroll
            for (int q = 0; q < 4; ++q) { const float lr = pw[(p0 + q) * 34 + 2 * (tau + 1)], li = pw[(p0 + q) * 34 + 2 * (tau + 1) + 1]; v[2 * q] = cr4[q] * lr - ci4[q] * li; v[2 * q + 1] = -(cr4[q] * li + ci4[q] * lr); }
            u32x4 w; w.x = pkbf(v[0], v[1]); w.y = pkbf(v[2], v[3]); w.z = pkbf(v[4], v[5]); w.w = pkbf(v[6], v[7]); vf[x][kk] = __builtin_bit_cast(bf16x8, w); }
#pragma unroll
        for (int kk = 0; kk < KK; ++kk) { const int lag = tau - 2 * kk - (fq >> 1); u32x4 w = (u32x4){0u, 0u, 0u, 0u};
            if (lag >= 0) { const float* kp = kt + ((size_t)lag * 16 + fr) * 16 + 8 * (fq & 1); const f32x4 k0 = *(const f32x4*)kp, k1 = *(const f32x4*)(kp + 4);
                w.x = pkbf(k0[0], k0[1]); w.y = pkbf(k0[2], k0[3]); w.z = pkbf(k1[0], k1[1]); w.w = pkbf(k1[2], k1[3]); }
            Fw[x][kk] = __builtin_bit_cast(bf16x8, w); } }
    float l1r = 0.f, l1i = 0.f, l4r = 0.f, l4i = 0.f;
    bf16x8 wr[SCAN ? 8 : 1], wi[SCAN ? 8 : 1];
    const int ps = 16 * (wave & 3) + fr;
    if (SCAN) {
#pragma unroll
        for (int kk = 0; kk < 8; ++kk) { const int j = 2 * kk + (fq >> 1); const float lr = pw[ps * 34 + 2 * (15 - j)], li = pw[ps * 34 + 2 * (15 - j) + 1];
            const float* bp_ = bfp + ps * 32 + 8 * (fq & 1); const f32x4 r0 = *(const f32x4*)bp_, r1 = *(const f32x4*)(bp_ + 4), i0 = *(const f32x4*)(bp_ + 16), i1 = *(const f32x4*)(bp_ + 20);
            u32x4 wa, wb;
            wa.x = pkbf(lr * r0[0] - li * i0[0], lr * r0[1] - li * i0[1]); wa.y = pkbf(lr * r0[2] - li * i0[2], lr * r0[3] - li * i0[3]); wa.z = pkbf(lr * r1[0] - li * i1[0], lr * r1[1] - li * i1[1]); wa.w = pkbf(lr * r1[2] - li * i1[2], lr * r1[3] - li * i1[3]);
            wb.x = pkbf(lr * i0[0] + li * r0[0], lr * i0[1] + li * r0[1]); wb.y = pkbf(lr * i0[2] + li * r0[2], lr * i0[3] + li * r0[3]); wb.z = pkbf(lr * i1[0] + li * r1[0], lr * i1[1] + li * r1[1]); wb.w = pkbf(lr * i1[2] + li * r1[2], lr * i1[3] + li * r1[3]);
            wr[kk] = __builtin_bit_cast(bf16x8, wa); wi[kk] = __builtin_bit_cast(bf16x8, wb); }
        l1r = pw[ps * 34 + 32]; l1i = pw[ps * 34 + 33];
        const float l2r = l1r * l1r - l1i * l1i, l2i = 2.0f * l1r * l1i; l4r = l2r * l2r - l2i * l2i; l4i = 2.0f * l2r * l2i;
    }
    const int token = tid >> 1, half = tid & 1;
    u32x4 pxwA, pxwB; f32x4 psaA, psbA, psaB, psbB;
#define S5G_ULOAD(SET, ct_) do { const int c__ = (ct_) < 16 ? (ct_) : 15; const size_t row_ = (size_t)(2 * bp + (c__ >> 3)) * SEQ + 256 * (c__ & 7) + token; pxw##SET = *(const u32x4*)(XB + row_ * D + g * 16 + 8 * half); \
        psa##SET = *(const f32x4*)(SS + row_ * 32 + 8 * half); psb##SET = *(const f32x4*)(SS + row_ * 32 + 8 * half + 4); } while (0)
#define S5G_USTORE(SET, ct_) do { float s_ = ((psa##SET[0] + psa##SET[1]) + (psa##SET[2] + psa##SET[3])) + ((psb##SET[0] + psb##SET[1]) + (psb##SET[2] + psb##SET[3])); s_ += __shfl_xor(s_, 1); const float rs_ = rsqrtf(s_ * (1.0f / 1024.0f) + RMS_EPSF); \
        u32x4 w_; w_.x = pkbf(bflo(pxw##SET.x) * rs_, bfhi(pxw##SET.x) * rs_); w_.y = pkbf(bflo(pxw##SET.y) * rs_, bfhi(pxw##SET.y) * rs_); w_.z = pkbf(bflo(pxw##SET.z) * rs_, bfhi(pxw##SET.z) * rs_); w_.w = pkbf(bflo(pxw##SET.w) * rs_, bfhi(pxw##SET.w) * rs_); \
        *(LAS u32x4*)(UT + ((ct_) % 3) * 8448 + ((token >> 4) * 264 + (token & 15) * 16 + 8 * half) * 2) = w_; } while (0)
    float car = 0.f, cai = 0.f;
#define S5G_SCAN(cs) do { if (SCAN) { const ldsp ut_ = UT + ((cs) % 3) * 8448; const ldsp sin_ = SIN + ((cs) & 1) * 4352; \
            if (((cs) & 7) == 0) { car = 0.f; cai = 0.f; } \
            f32x4 er = (f32x4){0.f, 0.f, 0.f, 0.f}, ei = er; \
            _Pragma("unroll") for (int kk = 0; kk < 8; ++kk) { const bf16x8 u_ = ldfrag(ut_, fr, 264, 32 * kk + 8 * fq); MM_XROW(er, wr[kk], u_); MM_XROW(ei, wi[kk], u_); } \
            float br = er[0], bi = ei[0]; \
            _Pragma("unroll") for (int r = 1; r < 4; ++r) { const float nr = l1r * br - l1i * bi + er[r], ni = l1r * bi + l1i * br + ei[r]; br = nr; bi = ni; } \
            float s0r = car, s0i = cai, cr_ = car, ci_ = cai; \
            _Pragma("unroll") for (int k = 0; k < 4; ++k) { const float qr = __shfl(br, fr + 16 * k), qi = __shfl(bi, fr + 16 * k); \
                const float nr = l4r * cr_ - l4i * ci_ + qr, ni = l4r * ci_ + l4i * cr_ + qi; cr_ = nr; ci_ = ni; if (k < fq) { s0r = nr; s0i = ni; } } \
            car = cr_; cai = ci_; \
            float sr = s0r, si = s0i; \
            _Pragma("unroll") for (int r = 0; r < 4; ++r) { *(LAS unsigned*)(sin_ + ((4 * fq + r) * 136 + 2 * ps) * 2) = pkbf(sr, si); \
                const float nr = l1r * sr - l1i * si + er[r], ni = l1r * si + l1i * sr + ei[r]; sr = nr; si = ni; } \
            if (((cs) & 7) == 7 && fq == 0) { const int b_ = 2 * bp + ((cs) >> 3); a.out[O_S5RP + (size_t)(b_ * 64 + g) * 64 + ps] = car; a.out[O_S5IP + (size_t)(b_ * 64 + g) * 64 + ps] = cai; } } } while (0)
#define S5G_Y(ct_) do { const ldsp ut_ = UT + ((ct_) % 3) * 8448; const ldsp sin_ = SIN + ((ct_) & 1) * 4352; bf16x8 uf[KK], sf[4]; \
        _Pragma("unroll") for (int kk = 0; kk < KK; ++kk) uf[kk] = ldfrag(ut_, fr, 264, 32 * kk + 8 * fq); \
        _Pragma("unroll") for (int kk = 0; kk < 4; ++kk) sf[kk] = ldfrag(sin_, fr, 136, 32 * kk + 8 * fq); \
        _Pragma("unroll") for (int x = 0; x < 2; ++x) { const int tau = 2 * wave + x; f32x4 acc = (f32x4){0.f, 0.f, 0.f, 0.f}; \
            _Pragma("unroll") for (int kk = 0; kk < KK; ++kk) MM_YROW(acc, Fw[x][kk], uf[kk]);     \
            _Pragma("unroll") for (int kk = 0; kk < 4; ++kk) MM_YROW(acc, vf[x][kk], sf[kk]); \
            const size_t row = (size_t)(2 * bp + ((ct_) >> 3)) * SEQ + 256 * ((ct_) & 7) + 16 * fr + tau; \
            u32x2 w; w.x = pkbf(gelu_tanh(acc[0]), gelu_tanh(acc[1])); w.y = pkbf(gelu_tanh(acc[2]), gelu_tanh(acc[3])); \
            *(u32x2*)(YB + row * D + g * 16 + 4 * fq) = w; } } while (0)
#ifndef S5REP
#define S5REP 1
#endif
    for (int rep_ = 0; rep_ < S5REP; ++rep_) {
    S5G_ULOAD(A, 0); S5G_ULOAD(B, 1); S5G_USTORE(A, 0); S5G_USTORE(B, 1);
    S5G_ULOAD(A, 2); S5G_ULOAD(B, 3);
    __syncthreads();
    S5G_SCAN(0);
    __syncthreads();
    for (int ct = 0; ct < 16; ct += 2) {
        S5G_USTORE(A, ct + 2); S5G_ULOAD(A, ct + 4);
        S5G_SCAN(ct + 1);
        S5G_Y(ct);
        __syncthreads();
        S5G_USTORE(B, ct + 3); S5G_ULOAD(B, ct + 5);
        if (ct + 2 < 16) S5G_SCAN(ct + 2);
        S5G_Y(ct + 1);
        __syncthreads();
    }
    }
#undef S5G_ULOAD
#undef S5G_USTORE
#undef S5G_SCAN
#undef S5G_Y
}
__device__ __forceinline__ void s5_gemm_wg(const Args& a, ldsp lds, int vcu, int G, int tid, int wave, int lane) {
    for (int it = vcu; it < 256; it += G) {
        if (wave < 4) s5_gemm_role<4, true>(a, lds, it >> 2, it & 3, tid, wave, lane);
        else s5_gemm_role<8, false>(a, lds, it >> 2, it & 3, tid, wave, lane);
    }
}
__global__ void __launch_bounds__(NTHREADS, 2) hybrid_fwd(Args a) {
    extern __shared__ __attribute__((aligned(16))) unsigned char lds_raw[];
    const ldsp lds = (ldsp)lds_raw;
    const int tid = threadIdx.x, lane = tid & 63, wave = __builtin_amdgcn_readfirstlane(tid >> 6);
    const int G = gridDim.x, bx = blockIdx.x;
    const int vcu = (G % 8 == 0) ? (bx % 8) * (G / 8) + bx / 8 : bx;
    unsigned char* ws = a.ws;
    unsigned* ctl = (unsigned*)(ws + WS_CTL);
    for (int u = tid; u < (LDS_BYTES - LDSCTL_OFF) / 4; u += NTHREADS) ((LAS unsigned*)(lds + LDSCTL_OFF))[u] = 0u;
    __syncthreads();
    XcdBarrier bar = xcd_barrier_post(ctl + CW_BAR, (volatile LAS unsigned*)(lds + LDSCTL_OFF) + 8);
    const int gw = vcu * NWAVES + wave, ngw = G * NWAVES;
    bf16* XB = (bf16*)(ws + WS_XB); float* X = (float*)(ws + WS_X); float* SS = (float*)(ws + WS_SS);
    bf16* PROJ = (bf16*)(ws + WS_PROJ); bf16* GATED = (bf16*)(ws + WS_GATED); bf16* YB = (bf16*)(ws + WS_YB); bf16* HB = (bf16*)(ws + WS_H);
    const bf16* W1 = (const bf16*)(ws + WS_W1); const bf16* W2 = (const bf16*)(ws + WS_W2); const bf16* W5 = (const bf16*)(ws + WS_W5);
    const bf16* W3 = (const bf16*)(ws + WS_W3); const bf16* W4 = (const bf16*)(ws + WS_W4);
#define SINGLE_ARG(...) __VA_ARGS__
#define GEMM_PHASE(EPI, Aop, Bop, N_, K_, E_) do { pg8::Gemm g_{(const pg8::bf16_t*)(Aop), (const pg8::bf16_t*)(Bop), MP, (N_), (K_)}; pg8::StaticOrder S_; S_.init(MP, (N_), G, bx); \
        pg8::gemm_phase<EPI, pg8::StaticOrder, true, true>(lds, g_, S_, (E_)); } while (0)
#ifndef DBG_STOP
#define DBG_STOP 0
#endif
#ifndef REPG
#define REPG 0
#endif
#define DBG_DIGEST(k, SRC, NEL) do { if (DBG_STOP == (k)) { xcd_barrier(bar); const bf16* s_ = (const bf16*)(SRC); for (size_t i_ = (size_t)bx * NTHREADS + tid; i_ < (size_t)(NEL) && i_ < O_SSMP; i_ += (size_t)G * NTHREADS) a.out[i_] = bf1(s_[i_]); return; } } while (0)

#ifndef TPROBE
#define TPROBE 0
#endif
#define TP_BLK ((TPROBE) / 10000)
#define TP_S (((TPROBE) / 100) % 100)
#define TP_E ((TPROBE) % 100)
    unsigned long long tp_s = 0, tp_e = 0;
#define STAMPV(id) do { if (TPROBE && vcu == TP_BLK && tid == 0) { const unsigned long long t_ = __builtin_amdgcn_s_memrealtime(); if ((id) == TP_S && tp_s == 0) tp_s = t_; if ((id) == TP_E && tp_e == 0) tp_e = t_; } } while (0)
#define STAMP(id) do { if (TPROBE && vcu == TP_BLK && tid == 0) { const unsigned long long t_ = __builtin_amdgcn_s_memrealtime(); if ((id) == TP_S) tp_s = t_; if ((id) == TP_E) tp_e = t_; } } while (0)
    STAMP(0);
    p0_prologue(a, lds, gw, ngw, wave, lane);
    STAMP(1);
    xcd_barrier(bar);
    STAMP(2);
    { pg8::EpiProj E{(pg8::bf16_t*)PROJ, SS, 16};
      GEMM_PHASE(pg8::EpiProj, XB, W1, PROJ_LD, D, E); }
#if REPG == 1
    xcd_barrier(bar);
    { pg8::EpiProj E{(pg8::bf16_t*)PROJ, SS, 16};
      GEMM_PHASE(pg8::EpiProj, XB, W1, PROJ_LD, D, E); }
#endif
    {
        const SEpiProj Ep{nullptr, SS, 16, (float*)(ws + WS_BETA), (float*)(ws + WS_GDEC), a.in[11], a.in[12]};
        for (int u = vcu; u < 128; u += G) sgemm_unit<2>(lds, XB + (size_t)u * 128 * D, W1 + (size_t)6144 * D, nullptr, D, Ep, u * 128, 192, wave, lane);
    }
    DBG_DIGEST(1, PROJ, (size_t)MP * PROJ_LD);
    STAMP(3);
    xcd_barrier(bar);
    STAMP(4);
    {
        const SEpiProj Es{(bf16*)(ws + WS_SPROJ), (const float*)(ws + WS_SSS), 32, (float*)(ws + WS_SBETA), (float*)(ws + WS_SGDEC), a.in[11], a.in[12]};
        for (int u = G - 1 - vcu; u < 193; u += G) sgemm_unit<2>(lds, (const bf16*)(ws + WS_SXB), W1 + (size_t)u * 32 * D, nullptr, D, Es, 0, u, wave, lane);
    }
    for (int t = (ngw - 1 - gw) * 64 + lane; t < 65536; t += ngw * 64) s5_ktable(a, t);
    dn_prep(a, gw, ngw, lane);
    DBG_DIGEST(2, ws + WS_QKVC, (size_t)MP * 4096);
    STAMP(5);
    xcd_barrier(bar);
    STAMP(6);
    if (vcu < NB * NH) dn_prompt(a, lds, vcu / NH, vcu % NH, tid, wave, lane);
    else {
        const int nt = G - NB * NH, ti = vcu - NB * NH;
        unsigned* tcnt = ctl + CW_TEAM; unsigned ep = 0;
        float* SX = (float*)(ws + WS_SX); bf16* SXB = (bf16*)(ws + WS_SXB); float* SSS = (float*)(ws + WS_SSS);
        bf16* SGATED = (bf16*)(ws + WS_SGATED); bf16* SH = (bf16*)(ws + WS_SH); bf16* SYB = (bf16*)(ws + WS_SYB);
#define TEAM_BAR() team_barrier(tcnt, (unsigned)nt * (++ep))
        dn_sample_all(a, lds, ti, nt, tid, wave, lane);
        STAMP(20);
        TEAM_BAR();
        STAMP(21);
        { const SEpiRes<false> E{a.in[1], SX, SXB, SSS};
          for (int u = ti; u < D / 32; u += nt) sgemm_unit<2>(lds, SGATED, W2 + (size_t)u * 32 * VAL, nullptr, VAL, E, 0, u, wave, lane); }
        STAMPV(22);
        TEAM_BAR();
        STAMPV(23);
        {
            { const SEpiSwiglu E{SH, SSS, 32};
              for (int u = ti; u < FFN / 32; u += nt) { const bf16* bg = W3 + (size_t)((u >> 2) * 256 + (u & 3) * 32) * D;
                  sgemm_unit<4>(lds, SXB, bg, bg + (size_t)128 * D, D, E, 0, u, wave, lane); } }
            STAMPV(24);
            TEAM_BAR();
            STAMPV(25);
            { const SEpiRes<false> E{SX, SX, SXB, SSS};
              for (int u = ti; u < D / 32; u += nt) sgemm_unit<2>(lds, SH, W4 + (size_t)u * 32 * FFN, nullptr, FFN, E, 0, u, wave, lane); }
            STAMPV(26);
            TEAM_BAR();
            STAMPV(27);
            {
                const ldsp wl = lds + wave * 12800;
                for (int j = ti * NWAVES + wave; j < 512; j += nt * NWAVES) s5_wave(a, wl, true, 0, (j & 7) * 16, j >> 3, lane);
                STAMPV(28);
                TEAM_BAR();
                STAMPV(29);
                { const SEpiRes<true> E{SX, SX, SXB, SSS};
                  for (int u = ti; u < D / 32; u += nt) { const bf16* bv = W5 + (size_t)((u >> 2) * 256 + (u & 3) * 32) * D;
                      sgemm_unit<4>(lds, SYB, bv, bv + (size_t)128 * D, D, E, 0, u, wave, lane); } }
            }
        }
#undef TEAM_BAR
    }
    DBG_DIGEST(3, GATED, (size_t)MP * VAL);
    STAMP(7);
    xcd_barrier(bar);
    STAMP(8);
    { pg8::EpiRes<false, 0> E{a.in[0], nullptr, (pg8::bf16_t*)XB, SS};
      GEMM_PHASE(SINGLE_ARG(pg8::EpiRes<false, 0>), GATED, W2, D, VAL, E); }
#if REPG == 2
    xcd_barrier(bar);
    { pg8::EpiRes<false, 0> E{a.in[0], nullptr, (pg8::bf16_t*)XB, SS};
      GEMM_PHASE(SINGLE_ARG(pg8::EpiRes<false, 0>), GATED, W2, D, VAL, E); }
#endif
    xcd_barrier(bar);
    STAMP(30);
    { pg8::EpiSwiglu E{(pg8::bf16_t*)HB, FFN, SS, 16};
      GEMM_PHASE(pg8::EpiSwiglu, XB, W3, 2 * FFN, D, E); }
    if (bx >= 128 && bx - 128 < FFN / 32) {
        const int u = bx - 128; const SEpiSwiglu Es{(bf16*)(ws + WS_SH), (const float*)(ws + WS_SSS), 32};
        const bf16* bg = W3 + (size_t)2 * FFN * D + (size_t)((u >> 2) * 256 + (u & 3) * 32) * D;
        sgemm_unit<4>(lds, (const bf16*)(ws + WS_SXB), bg, bg + (size_t)128 * D, D, Es, 0, u, wave, lane); }
#if REPG == 3
    xcd_barrier(bar);
    { pg8::EpiSwiglu E{(pg8::bf16_t*)HB, FFN, SS, 16};
      GEMM_PHASE(pg8::EpiSwiglu, XB, W3, 2 * FFN, D, E); }
#endif
    xcd_barrier(bar);
    STAMP(31);
    { pg8::EpiRes<false, 1> E{nullptr, nullptr, (pg8::bf16_t*)XB, SS};
      GEMM_PHASE(SINGLE_ARG(pg8::EpiRes<false, 1>), HB, W4, D, FFN, E); }
    xcd_barrier(bar);
    STAMP(32);
    {
        const ldsp wl = lds + wave * 12800;
        STAMP(9);
        (void)wl;
#if S5_GEMM
        s5_gemm_wg(a, lds, vcu, G, tid, wave, lane);
#else
        s5_prompt_wg(a, lds, vcu, G, wave, lane);
#endif
        STAMP(10);
    }
    xcd_barrier(bar);
    STAMP(11);
    { pg8::EpiRes<true, 1> E{nullptr, nullptr, (pg8::bf16_t*)XB, SS};
      GEMM_PHASE(SINGLE_ARG(pg8::EpiRes<true, 1>), YB, W5, 2 * D, D, E); }
    xcd_barrier(bar);
    STAMP(33);
    { pg8::EpiSwiglu E{(pg8::bf16_t*)HB, FFN, SS, 32};
      GEMM_PHASE(pg8::EpiSwiglu, XB, W3 + (size_t)2 * FFN * D, 2 * FFN, D, E); }
    if (bx >= 128 && bx - 128 < D / 32) {
        const int u = bx - 128; const SEpiRes<false> Es{(const float*)(ws + WS_SX), a.out + O_YS, (bf16*)(ws + WS_SXB), (float*)(ws + WS_SSS)};
        sgemm_unit<2>(lds, (const bf16*)(ws + WS_SH), W4 + (size_t)D * FFN + (size_t)u * 32 * FFN, nullptr, FFN, Es, 0, u, wave, lane); }
    xcd_barrier(bar);
    STAMP(34);
    { pg8::EpiRes<false, 2> E{nullptr, a.out + O_YP, (pg8::bf16_t*)XB, SS};
      GEMM_PHASE(SINGLE_ARG(pg8::EpiRes<false, 2>), HB, W4 + (size_t)D * FFN, D, FFN, E); }
    xcd_barrier(bar);
    STAMP(35);
    for (int m = (G * NWAVES - 1 - gw); m < MS; m += ngw) {
        f32x4* xr = (f32x4*)(a.out + O_YS + (size_t)m * D) + lane;
        const float rs = pg8::row_rstd((const float*)(ws + WS_SSS), m, 32);
#pragma unroll
        for (int j = 0; j < 4; ++j) { const f32x4 gn = *((const f32x4*)a.in[8] + lane + 64 * j); xr[64 * j] = xr[64 * j] * rs * gn; }
    }
    for (int m = gw; m < MP; m += ngw) {
        f32x4* xr = (f32x4*)(a.out + O_YP + (size_t)m * D) + lane;
        const float rs = pg8::row_rstd(SS, m, 16);
#pragma unroll
        for (int j = 0; j < 4; ++j) { const f32x4 gn = *((const f32x4*)a.in[8] + lane + 64 * j); xr[64 * j] = xr[64 * j] * rs * gn; }
    }
    STAMP(12);
#if TPROBE
    xcd_barrier(bar);
    if (vcu == TP_BLK && tid == 0) { const unsigned long long t0_ = __builtin_amdgcn_s_memrealtime(), dt_ = tp_e - tp_s; while (__builtin_amdgcn_s_memrealtime() - t0_ < dt_) __builtin_amdgcn_s_sleep(8); }
#endif
#undef GEMM_PHASE
}

extern "C" void kernel_launch(void* const* d_in, const int* in_sizes, int n_in, void* d_out, int out_size, void* d_ws, size_t ws_size, hipStream_t stream) {
    static int grid = 0;
    if (grid == 0) {
        if (n_in != 26 || (size_t)out_size != O_END || ws_size < WS_END) { fprintf(stderr, "kernel_launch: unexpected shapes: n_in %d out %d ws %zu (need %zu)\n", n_in, out_size, ws_size, (size_t)WS_END); grid = -1; return; }
        int dev = 0, cus = 0, per_cu = 0;
        if (hipGetDevice(&dev) != hipSuccess || hipDeviceGetAttribute(&cus, hipDeviceAttributeMultiprocessorCount, dev) != hipSuccess) { grid = -1; return; }
        if (hipFuncSetAttribute((const void*)hybrid_fwd, hipFuncAttributeMaxDynamicSharedMemorySize, LDS_BYTES) != hipSuccess) { fprintf(stderr, "kernel_launch: hipFuncSetAttribute failed\n"); grid = -1; return; }
        if (hipOccupancyMaxActiveBlocksPerMultiprocessor(&per_cu, (const void*)hybrid_fwd, NTHREADS, LDS_BYTES) != hipSuccess || per_cu < 1) { fprintf(stderr, "kernel_launch: occupancy query says %d\n", per_cu); (void)hipGetLastError(); per_cu = 1; }
        grid = cus;
    }
    if (grid < 0) return;
    (void)hipMemsetAsync((char*)d_ws + WS_CTL, 0, CTL_ZERO_BYTES, stream);
    Args a{};
    for (int i = 0; i < 26; ++i) a.in[i] = (const float*)d_in[i];
    a.out = (float*)d_out; a.ws = (unsigned char*)d_ws;
    hipLaunchKernelGGL(hybrid_fwd, dim3(grid), dim3(NTHREADS), LDS_BYTES, stream, a);
}
```

```cpp
#define DBG_STOP 0
#define REP_DN 1
#define REP_S5 1
#define REP_P0 1
#define REPG 0
#define TPROBE 0
#define S5_GEMM 1
#define S5REP 1
#define DNP_S 0
#define DNP_E 0
#define RPA 1
#define RPB 1
#define RPE 1
#define RPF 1
#define RPO 1
#include <hip/hip_runtime.h>
#include <cstdio>
#include <cstdint>
namespace pg8 {
#define PG8_LAS __attribute__((address_space(3)))
typedef unsigned short bf16_t;
typedef short bf16x8 __attribute__((ext_vector_type(8)));
typedef float f32x4 __attribute__((ext_vector_type(4)));
typedef unsigned u32x4 __attribute__((ext_vector_type(4)));
constexpr int BM = 256, BK = 64, HALF = 128, HTB = HALF * BK * 2  , STAGE_BYTES = 8 * HTB, NXCD = 8, WGM = 6;

__host__ __device__ __forceinline__ int lds_byte(int r, int c) { const int st = (r >> 4) * 2 + (c >> 5), rr = r & 15, cc = c & 31, ob = rr * 64 + cc * 2; return st * 1024 + (ob ^ (((ob >> 9) & 1) << 5)); }
__host__ __device__ __forceinline__ void stage_rc(int b, int& R, int& C) { const int st = b / 1024, sb = b % 1024, swz = sb ^ (((sb >> 9) & 1) << 5); R = (st >> 1) * 16 + swz / 64; C = (st & 1) * 32 + (swz % 64) / 2; }
__host__ __device__ __forceinline__ int perm32(int rho) { const int n = rho >> 4, i = rho & 15; return 8 * (i >> 2) + 4 * n + (i & 3); }

struct Unit { int pm, pn; };
struct Gemm { const bf16_t* A; const bf16_t* Bt; int M, N, K; };

struct StaticOrder {
    int nM, nN, nwg, G, c;
    __host__ __device__ void init(int M, int N, int G_, int c_) { nM = M / BM; nN = N / BM; nwg = nM * nN; G = G_; c = c_; }
    __host__ __device__ bool next(int i, Unit& u) const {
        const long L = (long)i * G + c; if (L >= nwg) return false;
        int wgid = (int)L; { const int q = nwg / NXCD, r = nwg % NXCD, xcd = wgid % NXCD, off = wgid / NXCD; wgid = (xcd < r ? xcd * (q + 1) : r * (q + 1) + (xcd - r) * q) + off; }
        const int nig = WGM * nN, gid = wgid / nig, fm = gid * WGM, gsz = (nM - fm) < WGM ? (nM - fm) : WGM;
        u.pm = fm + ((wgid % nig) % gsz); u.pn = (wgid % nig) / gsz; return true;
    }
    __device__ __forceinline__ void a_ready(const Unit&) const {}
    __device__ __forceinline__ void done(const Unit&) const {}
};
typedef float f32x2c __attribute__((ext_vector_type(2))); typedef __bf16 bf16x2c __attribute__((ext_vector_type(2)));
__device__ __forceinline__ unsigned cvt_pk_bf16(float lo, float hi) { const f32x2c v = {lo, hi}; return __builtin_bit_cast(unsigned, __builtin_convertvector(v, bf16x2c)); }
typedef unsigned u32x2 __attribute__((ext_vector_type(2)));
constexpr int SS_LD = 32;
constexpr float RMS_EPS = 1e-6f;
__device__ __forceinline__ float silu_f(float x) { return x * __builtin_amdgcn_rcpf(1.0f + __expf(-x)); }
__device__ __forceinline__ float sigmoid_f(float x) { return __builtin_amdgcn_rcpf(1.0f + __expf(-x)); }
__device__ __forceinline__ float row_rstd(const float* ss, int row, int nparts) {
    const f32x4* p = (const f32x4*)(ss + (size_t)row * SS_LD); float s = 0.f;
    for (int i = 0; i < nparts / 4; ++i) { const f32x4 v = p[i]; s += (v[0] + v[1]) + (v[2] + v[3]); }
    return rsqrtf(s * (1.0f / 1024.0f) + RMS_EPS);
}
__device__ __forceinline__ void rows_rstd(const float* ss, int row0, int nparts, int fq, float (&rs)[2][4]) {
    f32x4 q[2][4];
#pragma unroll
    for (int ai = 0; ai < 2; ++ai)
#pragma unroll
        for (int m = 0; m < 4; ++m) { const float* p = ss + (size_t)(row0 + ai * HALF + m * 16) * SS_LD + 4 * fq; q[ai][m] = *(const f32x4*)p; if (nparts == 32) q[ai][m] += *(const f32x4*)(p + 16); }
#pragma unroll
    for (int ai = 0; ai < 2; ++ai)
#pragma unroll
        for (int m = 0; m < 4; ++m) { float s = (q[ai][m][0] + q[ai][m][1]) + (q[ai][m][2] + q[ai][m][3]); s += __shfl_xor(s, 16); s += __shfl_xor(s, 32); rs[ai][m] = rsqrtf(s * (1.0f / 1024.0f) + RMS_EPS); }
}
struct EpiProj {
    static constexpr bool PERM = true, AFTER_DRAIN = false;
    bf16_t* O; const float* ss; int nparts;
    __device__ __forceinline__ void operator()(const f32x4 (&acc)[2][2][4][2], const Unit& u, int wr, int wc, int fr, int fq) const {
        const int row0 = u.pm * BM + wr * 64 + fr;
        float rs[2][4]; rows_rstd(ss, row0, nparts, fq, rs);
        {
            const int col0 = u.pn * BM + wc * 32 + 8 * fq; const bool act = u.pn >= 16;
#pragma unroll
            for (int ai = 0; ai < 2; ++ai)
#pragma unroll
                for (int m = 0; m < 4; ++m) { const int row = row0 + ai * HALF + m * 16; bf16_t* rowp = O + (size_t)row * 6144 + col0; const float r = rs[ai][m];
#pragma unroll
                    for (int bj = 0; bj < 2; ++bj) { f32x4 v0 = acc[ai][bj][m][0] * r, v1 = acc[ai][bj][m][1] * r;
                        if (act) {
#pragma unroll
                            for (int j = 0; j < 4; ++j) { v0[j] = silu_f(v0[j]); v1[j] = silu_f(v1[j]); } }
                        u32x4 w; w.x = cvt_pk_bf16(v0[0], v0[1]); w.y = cvt_pk_bf16(v0[2], v0[3]); w.z = cvt_pk_bf16(v1[0], v1[1]); w.w = cvt_pk_bf16(v1[2], v1[3]);
                        __builtin_nontemporal_store(w, (u32x4*)(rowp + bj * HALF)); }
                    }
        }
    }
};
struct EpiSwiglu {
    static constexpr bool PERM = true, AFTER_DRAIN = false;
    bf16_t* O; int ldo; const float* ss; int nparts;
    __device__ __forceinline__ void operator()(const f32x4 (&acc)[2][2][4][2], const Unit& u, int wr, int wc, int fr, int fq) const {
        const int row0 = u.pm * BM + wr * 64 + fr, col0 = u.pn * HALF + wc * 32 + 8 * fq;
        float rs[2][4]; rows_rstd(ss, row0, nparts, fq, rs);
#pragma unroll
        for (int ai = 0; ai < 2; ++ai)
#pragma unroll
            for (int m = 0; m < 4; ++m) { const int row = row0 + ai * HALF + m * 16; const float r = rs[ai][m];
                f32x4 h0, h1;
#pragma unroll
                for (int j = 0; j < 4; ++j) { h0[j] = silu_f(acc[ai][0][m][0][j] * r) * (acc[ai][1][m][0][j] * r); h1[j] = silu_f(acc[ai][0][m][1][j] * r) * (acc[ai][1][m][1][j] * r); }
                u32x4 w; w.x = cvt_pk_bf16(h0[0], h0[1]); w.y = cvt_pk_bf16(h0[2], h0[3]); w.z = cvt_pk_bf16(h1[0], h1[1]); w.w = cvt_pk_bf16(h1[2], h1[3]);
                __builtin_nontemporal_store(w, (u32x4*)(O + (size_t)row * ldo + col0)); }
    }
};
template <bool GLU, int MODE> struct EpiRes {
    static constexpr bool PERM = true, AFTER_DRAIN = false;
    const float* base; float* out; bf16_t* XB; float* ss;
    __device__ __forceinline__ void operator()(const f32x4 (&acc)[2][2][4][2], const Unit& u, int wr, int wc, int fr, int fq) const {
        const int col0 = (GLU ? u.pn * HALF : u.pn * BM) + wc * 32 + 8 * fq;
#pragma unroll
        for (int ai = 0; ai < 2; ++ai) {
#pragma unroll
            for (int m = 0; m < 4; ++m) { const int row = u.pm * BM + ai * HALF + wr * 64 + m * 16 + fr;
                const size_t off = (size_t)row * 1024 + col0;
                float sq = 0.f;
#pragma unroll
                for (int bj = 0; bj < (GLU ? 1 : 2); ++bj) { const int c = bj * HALF; f32x4 v0, v1;
                    if (GLU) {
#pragma unroll
                        for (int j = 0; j < 4; ++j) { v0[j] = acc[ai][0][m][0][j] * sigmoid_f(acc[ai][1][m][0][j]); v1[j] = acc[ai][0][m][1][j] * sigmoid_f(acc[ai][1][m][1][j]); }
                    } else { v0 = acc[ai][bj][m][0]; v1 = acc[ai][bj][m][1]; }
                    f32x4 b0, b1;
                    if (MODE == 0) { b0 = *(const f32x4*)(base + off + c); b1 = *(const f32x4*)(base + off + c + 4); }
                    else { const u32x4 bw = *(const u32x4*)(XB + off + c);
                        b0 = (f32x4){__builtin_bit_cast(float, bw.x << 16), __builtin_bit_cast(float, bw.x & 0xffff0000u), __builtin_bit_cast(float, bw.y << 16), __builtin_bit_cast(float, bw.y & 0xffff0000u)};
                        b1 = (f32x4){__builtin_bit_cast(float, bw.z << 16), __builtin_bit_cast(float, bw.z & 0xffff0000u), __builtin_bit_cast(float, bw.w << 16), __builtin_bit_cast(float, bw.w & 0xffff0000u)}; }
                    const f32x4 o0 = b0 + v0, o1 = b1 + v1;
                    sq += ((o0[0] * o0[0] + o0[1] * o0[1]) + (o0[2] * o0[2] + o0[3] * o0[3])) + ((o1[0] * o1[0] + o1[1] * o1[1]) + (o1[2] * o1[2] + o1[3] * o1[3]));
                    if (MODE == 2) { *(f32x4*)(out + off + c) = o0; *(f32x4*)(out + off + c + 4) = o1; }
                    else { u32x4 w; w.x = cvt_pk_bf16(o0[0], o0[1]); w.y = cvt_pk_bf16(o0[2], o0[3]); w.z = cvt_pk_bf16(o1[0], o1[1]); w.w = cvt_pk_bf16(o1[2], o1[3]); *(u32x4*)(XB + off + c) = w; } }
                sq += __shfl_xor(sq, 16); sq += __shfl_xor(sq, 32);
                if (fq == 0) ss[(size_t)row * SS_LD + u.pn * 4 + wc] = sq; }
        }
    }
};

struct EpiFinal {
    static constexpr bool PERM = false, AFTER_DRAIN = true;
    const bf16_t* XB; float* out; const float* gfin; float* xbuf; unsigned* cnt;
    __device__ __forceinline__ void fused(f32x4 (&acc)[2][2][4][2], const Unit& u, int wr, int wc, int fr, int fq, PG8_LAS unsigned char* lds, int wid, int lane) const {
        PG8_LAS float* P = (PG8_LAS float*)lds;
        PG8_LAS float* S = (PG8_LAS float*)(lds + 8192);
        const int col0 = u.pn * BM + wc * 32 + 4 * fq;
#pragma unroll
        for (int ai = 0; ai < 2; ++ai)
#pragma unroll
            for (int m = 0; m < 4; ++m) { const int rl = ai * HALF + wr * 64 + m * 16 + fr; const size_t off = (size_t)(u.pm * BM + rl) * 1024 + col0; float sq = 0.f;
#pragma unroll
                for (int bj = 0; bj < 2; ++bj)
#pragma unroll
                    for (int n = 0; n < 2; ++n) { const u32x2 bw = *(const u32x2*)(XB + off + bj * HALF + n * 16);
                        const f32x4 b = (f32x4){__builtin_bit_cast(float, bw.x << 16), __builtin_bit_cast(float, bw.x & 0xffff0000u), __builtin_bit_cast(float, bw.y << 16), __builtin_bit_cast(float, bw.y & 0xffff0000u)};
                        const f32x4 o = b + acc[ai][bj][m][n]; acc[ai][bj][m][n] = o; sq += (o[0] * o[0] + o[1] * o[1]) + (o[2] * o[2] + o[3] * o[3]); }
                sq += __shfl_xor(sq, 16); sq += __shfl_xor(sq, 32);
                if (fq == 0) P[rl * 4 + wc] = sq; }
        asm volatile("s_waitcnt lgkmcnt(0)" ::: "memory"); __builtin_amdgcn_s_barrier(); asm volatile("" ::: "memory");
        const int row = wid * 32 + (lane & 31);
        if (lane < 32) { const float t = (P[row * 4 + 0] + P[row * 4 + 1]) + (P[row * 4 + 2] + P[row * 4 + 3]);
            __hip_atomic_store(xbuf + (size_t)(u.pm * BM + row) * 4 + u.pn, t, __ATOMIC_RELAXED, __HIP_MEMORY_SCOPE_AGENT); }
        asm volatile("s_waitcnt vmcnt(0)" ::: "memory");
        if (lane == 0) __hip_atomic_fetch_add(cnt + 64 * u.pm, 1u, __ATOMIC_RELAXED, __HIP_MEMORY_SCOPE_AGENT);
        if (wid == 0) {
            const unsigned long long t0 = __builtin_amdgcn_s_memrealtime();
            while ((unsigned)__builtin_amdgcn_readfirstlane(__hip_atomic_load(cnt + 64 * u.pm, __ATOMIC_RELAXED, __HIP_MEMORY_SCOPE_AGENT)) < 32u) {
                if (__builtin_amdgcn_s_memrealtime() - t0 > 2000000ull) break;
                __builtin_amdgcn_s_sleep(2); }
            __builtin_amdgcn_fence(__ATOMIC_ACQUIRE, "agent");
        }
        asm volatile("s_waitcnt vmcnt(0) lgkmcnt(0)" ::: "memory"); __builtin_amdgcn_s_barrier(); asm volatile("" ::: "memory");
        if (lane < 32) { const float* sl = xbuf + (size_t)(u.pm * BM + row) * 4; float t = 0.f;
#pragma unroll
            for (int k = 0; k < 4; ++k) t += __hip_atomic_load(sl + k, __ATOMIC_RELAXED, __HIP_MEMORY_SCOPE_AGENT);
            S[row] = rsqrtf(t * (1.0f / 1024.0f) + RMS_EPS); }
        asm volatile("s_waitcnt lgkmcnt(0)" ::: "memory"); __builtin_amdgcn_s_barrier(); asm volatile("" ::: "memory");
#pragma unroll
        for (int ai = 0; ai < 2; ++ai)
#pragma unroll
            for (int m = 0; m < 4; ++m) { const int rl = ai * HALF + wr * 64 + m * 16 + fr; const float rs = S[rl]; const size_t off = (size_t)(u.pm * BM + rl) * 1024 + col0;
#pragma unroll
                for (int bj = 0; bj < 2; ++bj)
#pragma unroll
                    for (int n = 0; n < 2; ++n) { const int c = bj * HALF + n * 16; const f32x4 g = *(const f32x4*)(gfin + col0 + c); *(f32x4*)(out + off + c) = acc[ai][bj][m][n] * rs * g; } }
    }
};

template <class Epi, class Sched, bool ALIGN_EPI = false, bool SP2 = false>
__device__ __forceinline__ void gemm_phase(PG8_LAS unsigned char* lds, const Gemm g, const Sched& S, const Epi& E) {
    int tid_o = threadIdx.x; asm volatile("" : "+v"(tid_o));
    const int tid = tid_o, wid = __builtin_amdgcn_readfirstlane(tid >> 6), lane = tid & 63, wr = wid >> 2, wc = wid & 3, fr = lane & 15, fq = lane >> 4;
    const int K = g.K, nt = K / BK;
    unsigned voffA[2], voffB[2];
#pragma unroll
    for (int i = 0; i < 2; ++i) { int R, C; stage_rc(tid * 16 + i * 8192, R, C); const int Rb = Epi::PERM ? ((R & ~31) + perm32(R & 31)) : R;
        voffA[i] = (unsigned)(R * K + C) * 2u; voffB[i] = (unsigned)(Rb * K + C) * 2u; }
    const size_t kstep = (size_t)(BK * 2);
    const size_t hstep = (size_t)HALF * K * 2;
    const size_t tstep = 2 * hstep;
    const unsigned ldsw = (unsigned)wid * 1024u;
    const int aoff = lds_byte(wr * 64 + fr, fq * 8), boff = lds_byte(wc * 32 + fr, fq * 8);
#define PG8_SA(b, h) (((b) * 2 + (h)) * HTB)
#define PG8_SB(b, h) ((4 + (b) * 2 + (h)) * HTB)
#define PG8_STAGE(bufoff, gbase, voff) do { _Pragma("unroll") for (int _i = 0; _i < 2; ++_i) \
        __builtin_amdgcn_global_load_lds((const unsigned*)((const char*)(gbase) + (voff)[_i]), (PG8_LAS unsigned*)(lds + (bufoff) + ldsw + _i * 8192), 16, 0, 0); } while (0)
#define PG8_LDA(dst, b, h) do { _Pragma("unroll") for (int m = 0; m < 4; ++m) _Pragma("unroll") for (int k = 0; k < 2; ++k) dst[m][k] = *(const PG8_LAS bf16x8*)(lds + PG8_SA(b, h) + aoff + m * 2048 + k * 1024); } while (0)
#define PG8_LDB(dst, b, h) do { _Pragma("unroll") for (int n = 0; n < 2; ++n) _Pragma("unroll") for (int k = 0; k < 2; ++k) dst[n][k] = *(const PG8_LAS bf16x8*)(lds + PG8_SB(b, h) + boff + n * 2048 + k * 1024); } while (0)
#define PG8_MMA(ai, bj, At, Bt) do { __builtin_amdgcn_s_setprio(1); _Pragma("unroll") for (int m = 0; m < 4; ++m) _Pragma("unroll") for (int n = 0; n < 2; ++n) _Pragma("unroll") for (int k = 0; k < 2; ++k) \
        acc[ai][bj][m][n] = __builtin_amdgcn_mfma_f32_16x16x32_bf16(Bt[n][k], At[m][k], acc[ai][bj][m][n], 0, 0, 0); __builtin_amdgcn_s_setprio(0); } while (0)
#define PG8_WAIT_V(n) asm volatile("s_waitcnt vmcnt(" #n ")" ::: "memory")
#define PG8_WAIT_L(n) asm volatile("s_waitcnt lgkmcnt(" #n ")" ::: "memory")
#define PG8_BAR __builtin_amdgcn_s_barrier()
#define PG8_SCHED __builtin_amdgcn_sched_barrier(0)
    Unit cur, nxt; int ui = 0;
    if (!S.next(0, cur)) return;
    f32x4 acc[2][2][4][2];
#pragma unroll
    for (int a = 0; a < 2; ++a)
#pragma unroll
        for (int b = 0; b < 2; ++b)
#pragma unroll
            for (int m = 0; m < 4; ++m)
#pragma unroll
                for (int n = 0; n < 2; ++n) acc[a][b][m][n] = (f32x4){0.f, 0.f, 0.f, 0.f};
    bf16x8 At[4][2], B0[2][2], B1[2][2];
    const char* cA = (const char*)g.A + (size_t)cur.pm * tstep; const char* cB = (const char*)g.Bt + (size_t)cur.pn * tstep;
    S.a_ready(cur);
    if constexpr (SP2) {
        PG8_STAGE(PG8_SB(0, 0), cB, voffB); PG8_STAGE(PG8_SB(0, 1), cB + hstep, voffB); PG8_STAGE(PG8_SA(0, 0), cA, voffA); PG8_STAGE(PG8_SA(0, 1), cA + hstep, voffA);
        if (wr == 1) PG8_BAR;
        PG8_WAIT_V(2); PG8_BAR;
        PG8_STAGE(PG8_SB(1, 0), cB + kstep, voffB); PG8_STAGE(PG8_SA(1, 0), cA + kstep, voffA); PG8_STAGE(PG8_SB(1, 1), cB + hstep + kstep, voffB);
        PG8_WAIT_V(6); PG8_BAR;
    } else {
        PG8_STAGE(PG8_SB(0, 0), cB, voffB); PG8_STAGE(PG8_SA(0, 0), cA, voffA); PG8_STAGE(PG8_SB(0, 1), cB + hstep, voffB); PG8_STAGE(PG8_SA(0, 1), cA + hstep, voffA);
        if (wr == 1) PG8_BAR;
        PG8_WAIT_V(4); PG8_BAR;
        PG8_STAGE(PG8_SB(1, 0), cB + kstep, voffB); PG8_STAGE(PG8_SA(1, 0), cA + kstep, voffA); PG8_STAGE(PG8_SB(1, 1), cB + hstep + kstep, voffB);
        PG8_WAIT_V(6); PG8_BAR;
    }
    for (;;) {
        const bool has_next = S.next(ui + 1, nxt);
        const char* nA = has_next ? (const char*)g.A + (size_t)nxt.pm * tstep : cA; const char* nB = has_next ? (const char*)g.Bt + (size_t)nxt.pn * tstep : cB;
        for (int t = 0; t < nt; t += 2) {
            const bool last = (t == nt - 2);
            const char* a1 = cA + (size_t)(t + 1) * kstep;
            const char* a2 = last ? nA : cA + (size_t)(t + 2) * kstep; const char* b2 = last ? nB : cB + (size_t)(t + 2) * kstep;
            const char* a3 = a2 + kstep; const char* b3 = b2 + kstep;
            if (last && has_next) S.a_ready(nxt);
            if constexpr (SP2) {
            PG8_LDB(B0, 0, 0); PG8_LDB(B1, 0, 1); PG8_SCHED; PG8_LDA(At, 0, 0); PG8_STAGE(PG8_SA(1, 1), a1 + hstep, voffA);
            PG8_WAIT_V(8); PG8_WAIT_L(0); PG8_BAR; PG8_MMA(0, 0, At, B0); PG8_MMA(0, 1, At, B1); PG8_BAR; PG8_SCHED;
            PG8_LDA(At, 0, 1); PG8_STAGE(PG8_SB(0, 0), b2, voffB); PG8_STAGE(PG8_SB(0, 1), b2 + hstep, voffB); PG8_STAGE(PG8_SA(0, 0), a2, voffA);
            PG8_WAIT_V(8); PG8_WAIT_L(0); PG8_BAR; PG8_MMA(1, 0, At, B0); PG8_MMA(1, 1, At, B1); PG8_BAR; PG8_SCHED;
            PG8_LDB(B0, 1, 0); PG8_LDB(B1, 1, 1); PG8_SCHED; PG8_LDA(At, 1, 0); PG8_STAGE(PG8_SA(0, 1), a2 + hstep, voffA);
            PG8_WAIT_V(8); PG8_WAIT_L(0); PG8_BAR; PG8_MMA(0, 0, At, B0); PG8_MMA(0, 1, At, B1); PG8_BAR; PG8_SCHED;
            PG8_LDA(At, 1, 1); PG8_STAGE(PG8_SB(1, 0), b3, voffB); PG8_STAGE(PG8_SB(1, 1), b3 + hstep, voffB); PG8_STAGE(PG8_SA(1, 0), a3, voffA);
            PG8_WAIT_V(8); PG8_WAIT_L(0); PG8_BAR; PG8_MMA(1, 0, At, B0); PG8_MMA(1, 1, At, B1); PG8_BAR; PG8_SCHED;
            } else {
            PG8_LDB(B0, 0, 0); PG8_SCHED; PG8_LDA(At, 0, 0); PG8_STAGE(PG8_SA(1, 1), a1 + hstep, voffA);
            PG8_WAIT_L(8); PG8_BAR; PG8_WAIT_L(0); PG8_MMA(0, 0, At, B0); PG8_BAR; PG8_SCHED;
            PG8_LDB(B1, 0, 1); PG8_STAGE(PG8_SB(0, 0), b2, voffB);
            PG8_BAR; PG8_WAIT_L(0); PG8_MMA(0, 1, At, B1); PG8_BAR;
            PG8_LDA(At, 0, 1); PG8_STAGE(PG8_SA(0, 0), a2, voffA);
            PG8_BAR; PG8_WAIT_L(0); PG8_MMA(1, 0, At, B0); PG8_BAR; PG8_SCHED;
            PG8_STAGE(PG8_SB(0, 1), b2 + hstep, voffB);
            PG8_WAIT_V(6); PG8_BAR; PG8_MMA(1, 1, At, B1); PG8_BAR;
            PG8_LDB(B0, 1, 0); PG8_SCHED; PG8_LDA(At, 1, 0); PG8_STAGE(PG8_SA(0, 1), a2 + hstep, voffA);
            PG8_WAIT_L(8); PG8_BAR; PG8_WAIT_L(0); PG8_MMA(0, 0, At, B0); PG8_BAR; PG8_SCHED;
            PG8_LDB(B1, 1, 1); PG8_STAGE(PG8_SB(1, 0), b3, voffB);
            PG8_BAR; PG8_WAIT_L(0); PG8_MMA(0, 1, At, B1); PG8_BAR;
            PG8_LDA(At, 1, 1); PG8_STAGE(PG8_SA(1, 0), a3, voffA);
            PG8_BAR; PG8_WAIT_L(0); PG8_MMA(1, 0, At, B0); PG8_BAR; PG8_SCHED;
            PG8_STAGE(PG8_SB(1, 1), b3 + hstep, voffB);
            PG8_WAIT_V(6); PG8_BAR; PG8_MMA(1, 1, At, B1); PG8_BAR;
            }
        }
        if constexpr (ALIGN_EPI) { if (wr == 0) PG8_BAR; }
        if constexpr (!Epi::AFTER_DRAIN) { E(acc, cur, wr, wc, fr, fq); S.done(cur); }
        if (!has_next) break;
#pragma unroll
        for (int a = 0; a < 2; ++a)
#pragma unroll
            for (int b = 0; b < 2; ++b)
#pragma unroll
                for (int m = 0; m < 4; ++m)
#pragma unroll
                    for (int n = 0; n < 2; ++n) acc[a][b][m][n] = (f32x4){0.f, 0.f, 0.f, 0.f};
        cur = nxt; cA = nA; cB = nB; ++ui;
        if constexpr (ALIGN_EPI) { if (wr == 1) PG8_BAR; }
    }
    PG8_WAIT_V(0);
    if constexpr (!ALIGN_EPI) { if (wr == 0) PG8_BAR; }
    PG8_BAR;
    if constexpr (Epi::AFTER_DRAIN) { E.fused(acc, cur, wr, wc, fr, fq, lds, wid, lane); S.done(cur); }
#undef PG8_SA
#undef PG8_SB
#undef PG8_STAGE
#undef PG8_LDA
#undef PG8_LDB
#undef PG8_MMA
#undef PG8_WAIT_V
#undef PG8_WAIT_L
#undef PG8_BAR
#undef PG8_SCHED
}
}
constexpr int NWAVES = 8, NTHREADS = 512;
constexpr int D = 1024, SEQ = 2048, NB = 8, MP = NB * SEQ  , MS = 128  ;
constexpr int DN_IN = 6176, PROJ_LD = 6144, VAL = 2048, FFN = 2816, NH = 16, CHUNK = 64, NCHUNK = SEQ / CHUNK;
constexpr size_t MiB = 1u << 20;
constexpr size_t WS_CTL = 0, CTL_ZERO_BYTES = 64 * 1024;
constexpr size_t WS_W1 = 1 * MiB;
constexpr size_t WS_W2 = WS_W1 + (size_t)6400 * D * 2;
constexpr size_t WS_W5 = WS_W2 + (size_t)D * VAL * 2;
constexpr size_t WS_W3 = WS_W5 + (size_t)2 * D * D * 2;
constexpr size_t WS_W4 = WS_W3 + (size_t)2 * 2 * FFN * D * 2;
constexpr size_t WS_SS = WS_W4 + (size_t)2 * D * FFN * 2;
constexpr size_t WS_BETA = WS_SS + (size_t)MP * 32 * 4;
constexpr size_t WS_GDEC = WS_BETA + (size_t)MP * 16 * 4;
constexpr size_t WS_SSS = WS_GDEC + (size_t)MP * 16 * 4;
constexpr size_t WS_SBETA = WS_SSS + (size_t)MS * 32 * 4;
constexpr size_t WS_SGDEC = WS_SBETA + (size_t)MS * 16 * 4;
constexpr size_t WS_SXB = WS_SGDEC + (size_t)MS * 16 * 4;
constexpr size_t WS_SX = WS_SXB + (size_t)MS * D * 2;
constexpr size_t WS_SPROJ = WS_SX + (size_t)MS * D * 4;
constexpr size_t WS_SGATED = WS_SPROJ + (size_t)MS * PROJ_LD * 2;
constexpr size_t WS_SH = WS_SGATED + (size_t)MS * VAL * 2;
constexpr size_t WS_SYB = WS_SH + (size_t)MS * FFN * 2;
constexpr size_t WS_S5LAM = WS_SYB + (size_t)MS * D * 2;
constexpr size_t WS_S5BB = WS_S5LAM + 64 * 64 * 2 * 4;
constexpr size_t WS_S5CM = WS_S5BB + 64 * 128 * 16 * 2;
constexpr size_t WS_S5DSK = WS_S5CM + 64 * 16 * 128 * 2;
constexpr size_t WS_GC = WS_S5DSK + 1024 * 4;
constexpr size_t WS_BT = WS_GC + (size_t)MP * 16 * 4;
constexpr size_t WS_POW = WS_BT + (size_t)MP * 16 * 4;
constexpr size_t WS_BBF = WS_POW + 64 * 64 * 17 * 2 * 4;
constexpr size_t WS_KT = WS_BBF + 64 * 64 * 2 * 16 * 4;
constexpr size_t WS_FX = WS_KT + 64 * 16 * 16 * 16 * 4;
constexpr size_t WS_XB = (WS_FX + (size_t)MP * 4 * 4 + 4095) / 4096 * 4096;
constexpr size_t WS_X = WS_XB + (size_t)MP * D * 2;
constexpr size_t WS_YB = WS_X + (size_t)MP * D * 4;
constexpr size_t WS_GATED = WS_YB + (size_t)MP * D * 2;
constexpr size_t WS_QKVC = WS_XB;
static_assert(WS_QKVC + (size_t)MP * 4096 * 2 <= WS_GATED, "QKVC overlay");
constexpr size_t WS_PROJ = WS_GATED + (size_t)MP * VAL * 2;
constexpr size_t WS_H = WS_PROJ;
constexpr size_t WS_END = WS_PROJ + (size_t)MP * PROJ_LD * 2;
constexpr int CW_BAR = 4096, CW_TEAM = 8192, CW_FIN = 8192 + 64, CW_TBAR = 12416;
constexpr size_t O_YP = 0, O_YS = O_YP + (size_t)MP * D, O_SSMP = O_YS + (size_t)MS * D, O_CONVP = O_SSMP + (size_t)NB * NH * 128 * 128, O_S5RP = O_CONVP + (size_t)NB * 3 * 4096,
                 O_S5IP = O_S5RP + (size_t)NB * 64 * 64, O_SSMS = O_S5IP + (size_t)NB * 64 * 64, O_CONVS = O_SSMS + (size_t)MS * NH * 128 * 128, O_S5RS = O_CONVS + (size_t)MS * 3 * 4096,
                 O_S5IS = O_S5RS + (size_t)MS * 64 * 64, O_END = O_S5IS + (size_t)MS * 64 * 64;
constexpr int LDS_BYTES = 163840, LDSCTL_OFF = LDS_BYTES - 256;

#define GAS __attribute__((address_space(1)))
#define LAS __attribute__((address_space(3)))
typedef unsigned short bf16;
typedef float f32x4 __attribute__((ext_vector_type(4)));
typedef float f32x2 __attribute__((ext_vector_type(2)));
typedef short bf16x8 __attribute__((ext_vector_type(8)));
typedef unsigned u32x4 __attribute__((ext_vector_type(4)));
typedef unsigned u32x2 __attribute__((ext_vector_type(2)));
typedef LAS unsigned char* ldsp;
__device__ __forceinline__ unsigned pkbf(float lo, float hi) { return pg8::cvt_pk_bf16(lo, hi); }
__device__ __forceinline__ float bflo(unsigned w) { return __builtin_bit_cast(float, w << 16); }
__device__ __forceinline__ float bfhi(unsigned w) { return __builtin_bit_cast(float, w & 0xffff0000u); }
__device__ __forceinline__ float bf1(bf16 h) { return __builtin_bit_cast(float, (unsigned)h << 16); }
__device__ __forceinline__ float wave_sum(float v) {
#pragma unroll
    for (int o = 1; o < 64; o <<= 1) v += __shfl_xor(v, o);
    return v;
}
#define MFMA16(a, b, c) __builtin_amdgcn_mfma_f32_16x16x32_bf16((a), (b), (c), 0, 0, 0)
#define MM_XROW(acc, xf, yf) (acc) = MFMA16((yf), (xf), (acc))
#define MM_YROW(acc, xf, yf) (acc) = MFMA16((xf), (yf), (acc))
#define LDS_FENCE() asm volatile("s_waitcnt lgkmcnt(0)" ::: "memory")

struct Args {
    const float* in[26]; float* out; unsigned char* ws; int pad0, pad1;
};
constexpr float RMS_EPSF = 1e-6f;
#define XB_TMO      128
#define XB_XCNT(j)  (256  + 64 * (j))
#define XB_XSUB(j)  (1280 + 64 * (j))
#define XB_XGEN(j)  (2304 + 64 * (j))
#define XB_TOP      3328
#define XB_TOPGEN   3392
#define XCD_BAR_WORDS 3456
#define XB_SPIN_CAP (1u << 18)

__device__ __forceinline__ unsigned xb_ld(unsigned* p)              { return __hip_atomic_load(p, __ATOMIC_RELAXED, __HIP_MEMORY_SCOPE_AGENT); }
__device__ __forceinline__ unsigned xb_add(unsigned* p, unsigned v) { return __hip_atomic_fetch_add(p, v, __ATOMIC_RELAXED, __HIP_MEMORY_SCOPE_AGENT); }
__device__ __forceinline__ unsigned xb_xcc_id() { return (unsigned)__builtin_amdgcn_s_getreg((3 << 11) | 20) & 0xFu; }
#define XB_SPIN(cond, bar) do { unsigned _sp = 0; while (cond) { __builtin_amdgcn_s_sleep(1); \
    if ((++_sp & 255u) == 0u) { if (xb_ld(&(bar)[XB_TMO])) break; if (_sp > XB_SPIN_CAP) { atomicAdd(&(bar)[XB_TMO], 1u); break; } } } } while (0)

struct XcdBarrier {
    unsigned* bar; unsigned x; unsigned tot;
    volatile LAS unsigned* st;
};

__device__ __forceinline__ XcdBarrier xcd_barrier_post(unsigned* bar, volatile LAS unsigned* st, unsigned tot = 0u) {
    XcdBarrier b; b.bar = bar; b.x = xb_xcc_id(); b.st = st; b.tot = tot ? tot : gridDim.x * gridDim.y * gridDim.z;
    if (threadIdx.x == 0) (void)xb_add(&bar[XB_XCNT(b.x)], 1u);
    return b;
}
__device__ __forceinline__ void xcd_barrier_complete(unsigned* bar, unsigned x, unsigned G, unsigned& nloc, unsigned& nx) {
    unsigned sum, cnt, mine, sp = 0u;
    for (;;) {
        sum = 0u; cnt = 0u; mine = 0u;
#pragma unroll
        for (unsigned j = 0; j < 16; ++j) { const unsigned c = xb_ld(&bar[XB_XCNT(j)]); sum += c; cnt += (c > 0u) ? 1u : 0u; mine = (j == x) ? c : mine; }
        if (sum == G) break;
        __builtin_amdgcn_s_sleep(1);
        if ((++sp & 255u) == 0u) { if (xb_ld(&bar[XB_TMO])) break; if (sp > XB_SPIN_CAP) { atomicAdd(&bar[XB_TMO], 1u); break; } }
    }
    nloc = mine > 0u ? mine : 1u; nx = cnt > 0u ? cnt : 1u;
}

__device__ __forceinline__ void xcd_barrier(const XcdBarrier& b) {
    asm volatile("s_waitcnt vmcnt(0)" ::: "memory");
    __syncthreads();
    if (threadIdx.x == 0) {
        unsigned* bar = b.bar;
        __builtin_amdgcn_s_waitcnt(0);
        unsigned nloc = b.st[0], nx = b.st[1];
        if (nloc == 0u) { xcd_barrier_complete(bar, b.x, b.tot, nloc, nx); b.st[0] = nloc; b.st[1] = nx; }
        const unsigned old = xb_add(&bar[XB_XSUB(b.x)], 1u);
        const unsigned gen = old / nloc;
        if (old + 1u == (gen + 1u) * nloc) {
            __builtin_amdgcn_fence(__ATOMIC_RELEASE, "agent");
            asm volatile("s_waitcnt vmcnt(0)" ::: "memory");
            const unsigned og = xb_add(&bar[XB_TOP], 1u);
            const unsigned tg = og / nx;
            if (og + 1u == (tg + 1u) * nx) xb_add(&bar[XB_TOPGEN], 1u);
            else XB_SPIN(xb_ld(&bar[XB_TOPGEN]) == tg, bar);
            __builtin_amdgcn_fence(__ATOMIC_ACQUIRE, "agent");
            xb_add(&bar[XB_XGEN(b.x)], 1u);
            asm volatile("s_waitcnt vmcnt(0)" ::: "memory");
        } else {
            XB_SPIN(xb_ld(&bar[XB_XGEN(b.x)]) == gen, bar);
            __builtin_amdgcn_fence(__ATOMIC_ACQUIRE, "agent");
            asm volatile("s_waitcnt vmcnt(0)" ::: "memory");
        }
    }
    __syncthreads();
}
__device__ __forceinline__ void sg_core(const bf16* ap, const bf16* bp, int K, int steps, f32x4 (&acc)[4][2]) {
    bf16x8 ra[4][4], rb[4][2];
    const bf16* pa[4]; const bf16* pb[2];
#pragma unroll
    for (int t = 0; t < 4; ++t) pa[t] = ap + (size_t)t * 16 * K;
    pb[0] = bp; pb[1] = bp + (size_t)16 * K;
#define SG_LOAD(slot, s) do { const int ko_ = 32 * (s); _Pragma("unroll") for (int t_ = 0; t_ < 4; ++t_) ra[slot][t_] = *(const bf16x8*)(pa[t_] + ko_); \
        rb[slot][0] = *(const bf16x8*)(pb[0] + ko_); rb[slot][1] = *(const bf16x8*)(pb[1] + ko_); } while (0)
#define SG_COMP(slot) do { _Pragma("unroll") for (int t_ = 0; t_ < 4; ++t_) { MM_XROW(acc[t_][0], ra[slot][t_], rb[slot][0]); MM_XROW(acc[t_][1], ra[slot][t_], rb[slot][1]); } } while (0)
    SG_LOAD(0, 0); SG_LOAD(1, 1); SG_LOAD(2, 2);
    int s = 0;
#pragma nounroll
    for (; s + 4 <= steps; s += 4) {
        SG_LOAD(3, s + 3);
        SG_COMP(0); if (s + 4 < steps) SG_LOAD(0, s + 4);
        SG_COMP(1); if (s + 5 < steps) SG_LOAD(1, s + 5);
        SG_COMP(2); if (s + 6 < steps) SG_LOAD(2, s + 6);
        SG_COMP(3);
    }
    const int r = steps - s;
    if (r >= 1) SG_COMP(0);
    if (r >= 2) SG_COMP(1);
    if (r >= 3) SG_COMP(2);
#undef SG_LOAD
#undef SG_COMP
}
template <int NBLK, class Epi>
__device__ __forceinline__ void sgemm_unit(ldsp lds, const bf16* A, const bf16* B0, const bf16* B1, int K, const Epi& E, int row0, int cb, int wave, int lane) {
    const int fr = lane & 15, fq = lane >> 4, rh = wave & 1, kq = wave >> 1; int steps = K / 128; asm volatile("" : "+s"(steps));
    int fro = fr; asm volatile("" : "+v"(fro));
    const bf16* ap = A + (size_t)(64 * rh + fro) * K + (size_t)kq * (K / 4) + 8 * fq;
    LAS f32x4* buf = (LAS f32x4*)lds;
#pragma unroll
    for (int pass = 0; pass < NBLK / 2; ++pass) {
        f32x4 acc[4][2];
#pragma unroll
        for (int t = 0; t < 4; ++t) { acc[t][0] = (f32x4){0.f, 0.f, 0.f, 0.f}; acc[t][1] = (f32x4){0.f, 0.f, 0.f, 0.f}; }
        sg_core(ap, (pass ? B1 : B0) + (size_t)fro * K + (size_t)kq * (K / 4) + 8 * fq, K, steps, acc);
#pragma unroll
        for (int t = 0; t < 4; ++t) { buf[(kq * 32 + (rh * 4 + t) * 4 + 2 * pass) * 64 + lane] = acc[t][0]; buf[(kq * 32 + (rh * 4 + t) * 4 + 2 * pass + 1) * 64 + lane] = acc[t][1]; }
    }
    __syncthreads();
    {
        const int rt = wave >> 1;
        f32x4 o[NBLK];
#pragma unroll
        for (int j = 0; j < NBLK; ++j) { const int slot = (rh * 4 + rt) * 4 + j; o[j] = (buf[slot * 64 + lane] + buf[(32 + slot) * 64 + lane]) + (buf[(64 + slot) * 64 + lane] + buf[(96 + slot) * 64 + lane]); }
        E(o, row0 + 64 * rh + 16 * rt + fr, cb, fq);
    }
    __syncthreads();
}
template <int NT, class Epi>
__device__ __forceinline__ void sgemm_unit64(ldsp lds, const bf16* A, const bf16* B, int K, const Epi& E, int row0, int cb, int cbmax, int wave, int lane) {
    int fro = lane & 15; asm volatile("" : "+v"(fro));
    const int fq = lane >> 4; int steps = K / 128; asm volatile("" : "+s"(steps));
    f32x4 acc[4][NT];
#pragma unroll
    for (int t = 0; t < 4; ++t)
#pragma unroll
        for (int n = 0; n < NT; ++n) acc[t][n] = (f32x4){0.f, 0.f, 0.f, 0.f};
#pragma nounroll
    for (int st = wave; st < steps; st += 8) { const int kb = 128 * st;
        bf16x8 af[4][4], bfr[NT][4];
#pragma unroll
        for (int t = 0; t < 4; ++t)
#pragma unroll
            for (int kk = 0; kk < 4; ++kk) af[t][kk] = *(const bf16x8*)(A + (size_t)(16 * t + fro) * K + kb + 32 * kk + 8 * fq);
#pragma unroll
        for (int n = 0; n < NT; ++n)
#pragma unroll
            for (int kk = 0; kk < 4; ++kk) bfr[n][kk] = *(const bf16x8*)(B + (size_t)(16 * n + fro) * K + kb + 32 * kk + 8 * fq);
#pragma unroll
        for (int t = 0; t < 4; ++t)
#pragma unroll
            for (int n = 0; n < NT; ++n)
#pragma unroll
                for (int kk = 0; kk < 4; ++kk) MM_XROW(acc[t][n], af[t][kk], bfr[n][kk]); }
    LAS f32x4* buf = (LAS f32x4*)lds;
#pragma unroll
    for (int t = 0; t < 4; ++t)
#pragma unroll
        for (int n = 0; n < NT; ++n) buf[(wave * 4 * NT + t * NT + n) * 64 + lane] = acc[t][n];
    __syncthreads();
    if (wave < 4) {
#pragma unroll
        for (int j = 0; j < NT / 2; ++j) { f32x4 o[2];
#pragma unroll
            for (int n = 0; n < 2; ++n) { f32x4 s = (f32x4){0.f, 0.f, 0.f, 0.f};
#pragma unroll
                for (int w = 0; w < 8; ++w) s += buf[(w * 4 * NT + wave * NT + 2 * j + n) * 64 + lane];
                o[n] = s; }
            if (cb + j < cbmax) E(o, row0 + 16 * wave + fro, cb + j, fq); } }
    __syncthreads();
}
template <class Epi>
__device__ __forceinline__ void sgemm_unit64d(ldsp lds, const bf16* A, const bf16* B0, const bf16* B1, int K, const Epi& E, int row0, int cb, int wave, int lane) {
    int fro = lane & 15; asm volatile("" : "+v"(fro));
    const int fq = lane >> 4; int steps = K / 128; asm volatile("" : "+s"(steps));
    f32x4 acc[4][4];
#pragma unroll
    for (int t = 0; t < 4; ++t)
#pragma unroll
        for (int n = 0; n < 4; ++n) acc[t][n] = (f32x4){0.f, 0.f, 0.f, 0.f};
#pragma nounroll
    for (int st = wave; st < steps; st += 8) { const int kb = 128 * st;
        bf16x8 af[4][4], bfr[4][4];
#pragma unroll
        for (int t = 0; t < 4; ++t)
#pragma unroll
            for (int kk = 0; kk < 4; ++kk) af[t][kk] = *(const bf16x8*)(A + (size_t)(16 * t + fro) * K + kb + 32 * kk + 8 * fq);
#pragma unroll
        for (int n = 0; n < 4; ++n)
#pragma unroll
            for (int kk = 0; kk < 4; ++kk) bfr[n][kk] = *(const bf16x8*)((n < 2 ? B0 : B1) + (size_t)(16 * (n & 1) + fro) * K + kb + 32 * kk + 8 * fq);
#pragma unroll
        for (int t = 0; t < 4; ++t)
#pragma unroll
            for (int n = 0; n < 4; ++n)
#pragma unroll
                for (int kk = 0; kk < 4; ++kk) MM_XROW(acc[t][n], af[t][kk], bfr[n][kk]); }
    LAS f32x4* buf = (LAS f32x4*)lds;
#pragma unroll
    for (int t = 0; t < 4; ++t)
#pragma unroll
        for (int n = 0; n < 4; ++n) buf[(wave * 16 + t * 4 + n) * 64 + lane] = acc[t][n];
    __syncthreads();
    if (wave < 4) { f32x4 o[4];
#pragma unroll
        for (int n = 0; n < 4; ++n) { f32x4 s = (f32x4){0.f, 0.f, 0.f, 0.f};
#pragma unroll
            for (int w = 0; w < 8; ++w) s += buf[(w * 16 + wave * 4 + n) * 64 + lane];
            o[n] = s; }
        E(o, row0 + 16 * wave + fro, cb, fq); }
    __syncthreads();
}
struct SEpiProj {
    bf16* O; const float* ss; int nparts; float* beta; float* gdec; const float* a_log; const float* dt_bias;
    __device__ __forceinline__ void operator()(const f32x4 (&acc)[2], int row, int cb, int fq) const {
        const float rs = pg8::row_rstd(ss, row, nparts);
        if (cb < 192) {
#pragma unroll
            for (int j = 0; j < 2; ++j) { f32x4 v = acc[j] * rs;
                if (cb >= 128) {
#pragma unroll
                    for (int r = 0; r < 4; ++r) v[r] = pg8::silu_f(v[r]); }
                u32x2 w; w.x = pkbf(v[0], v[1]); w.y = pkbf(v[2], v[3]); *(u32x2*)(O + (size_t)row * PROJ_LD + 32 * cb + 16 * j + 4 * fq) = w; }
        } else {
            f32x4 b, g;
#pragma unroll
            for (int r = 0; r < 4; ++r) { b[r] = pg8::sigmoid_f(acc[0][r] * rs); const int h = 4 * fq + r; const float xx = acc[1][r] * rs + dt_bias[h]; const float ex = __expf(xx);
                const float sp = xx > 15.f ? xx : (ex < 1e-3f ? ex * (1.0f - 0.5f * ex) : __logf(1.0f + ex)); g[r] = -__expf(a_log[h]) * sp; }
            *(f32x4*)(beta + (size_t)row * 16 + 4 * fq) = b; *(f32x4*)(gdec + (size_t)row * 16 + 4 * fq) = g;
        }
    }
};
template <bool GLU> struct SEpiRes {
    const float* base; float* out; bf16* XB; float* ss;
    __device__ __forceinline__ void operator()(const f32x4 (&acc)[GLU ? 4 : 2], int row, int cb, int fq) const {
        float sq = 0.f;
#pragma unroll
        for (int j = 0; j < 2; ++j) { f32x4 v = acc[j];
            if (GLU) {
#pragma unroll
                for (int r = 0; r < 4; ++r) v[r] = v[r] * pg8::sigmoid_f(acc[2 + j][r]); }
            const size_t off = (size_t)row * D + 32 * cb + 16 * j + 4 * fq;
            const f32x4 o = *(const f32x4*)(base + off) + v; *(f32x4*)(out + off) = o;
            sq += (o[0] * o[0] + o[1] * o[1]) + (o[2] * o[2] + o[3] * o[3]);
            u32x2 w; w.x = pkbf(o[0], o[1]); w.y = pkbf(o[2], o[3]); *(u32x2*)(XB + off) = w; }
        sq += __shfl_xor(sq, 16); sq += __shfl_xor(sq, 32);
        if (fq == 0) ss[(size_t)row * 32 + cb] = sq;
    }
};
struct SEpiSwiglu {
    bf16* H; const float* ss; int nparts;
    __device__ __forceinline__ void operator()(const f32x4 (&acc)[4], int row, int cb, int fq) const {
        const float rs = pg8::row_rstd(ss, row, nparts);
#pragma unroll
        for (int j = 0; j < 2; ++j) { f32x4 h;
#pragma unroll
            for (int r = 0; r < 4; ++r) h[r] = pg8::silu_f(acc[j][r] * rs) * (acc[2 + j][r] * rs);
            u32x2 w; w.x = pkbf(h[0], h[1]); w.y = pkbf(h[2], h[3]); *(u32x2*)(H + (size_t)row * FFN + 32 * cb + 16 * j + 4 * fq) = w; }
    }
};
__device__ __forceinline__ void team_barrier(unsigned* cnt, unsigned target) {
    asm volatile("s_waitcnt vmcnt(0)" ::: "memory");
    __syncthreads();
    if (threadIdx.x == 0) {
        __builtin_amdgcn_fence(__ATOMIC_RELEASE, "agent");
        asm volatile("s_waitcnt vmcnt(0)" ::: "memory");
        (void)__hip_atomic_fetch_add(cnt, 1u, __ATOMIC_RELAXED, __HIP_MEMORY_SCOPE_AGENT);
        unsigned sp = 0;
        while (__hip_atomic_load(cnt, __ATOMIC_RELAXED, __HIP_MEMORY_SCOPE_AGENT) < target) { __builtin_amdgcn_s_sleep(2); if (++sp > (1u << 22)) break; }
        __builtin_amdgcn_fence(__ATOMIC_ACQUIRE, "agent");
        asm volatile("s_waitcnt vmcnt(0)" ::: "memory");
    }
    __syncthreads();
}
__device__ __forceinline__ void sincos_cw(float x, float& s, float& c) {
    const float k = rintf(x * 0.636619772367581343f);
    float r = fmaf(-k, 1.57079625129699707031f, x); r = fmaf(-k, 7.54978941586159635e-08f, r); r = fmaf(-k, 5.39030285815811482e-15f, r);
    const float z = r * r;
    const float sp = fmaf(fmaf(fmaf(-1.9515295891e-4f, z, 8.3321608736e-3f), z, -1.6666654611e-1f) * z, r, r);
    const float cp = fmaf(fmaf(fmaf(2.443315711809948e-5f, z, -1.388731625493765e-3f), z, 4.166664568298827e-2f), z * z, fmaf(-0.5f, z, 1.0f));
    const int q = (int)k & 3;
    const float ss = (q & 1) ? cp : sp, cc = (q & 1) ? sp : cp;
    s = (q & 2) ? -ss : ss; c = ((q + 1) & 2) ? -cc : cc;
}
__device__ __forceinline__ void s5_disc(const Args& a, int g, int p, float dt, float& lr, float& li, float& fre, float& fim) {
    const float are = a.in[15][g * 64 + p], aim = a.in[16][g * 64 + p];
    const float mag = __expf(are * dt); float sn, cs; sincos_cw(aim * dt, sn, cs);
    lr = mag * cs; li = mag * sn;
    const float den = are * are + aim * aim, nre = lr - 1.0f, nim = li;
    fre = (nre * are + nim * aim) / den; fim = (nim * are - nre * aim) / den;
}
__device__ __forceinline__ float gelu_tanh(float x) { const float w = x * __builtin_fmaf(x * x, -0.10294324f, -2.3022082f);
    return x * __builtin_amdgcn_rcpf(1.0f + __builtin_amdgcn_exp2f(w)); }
__device__ __forceinline__ void s5_precompute(const Args& a, int idx) {
    unsigned char* ws = a.ws;
    if (idx < 4096) {
        const int g = idx >> 6, p = idx & 63;
        const float dt = __expf(a.in[17][g]);
        float lr, li, fre, fim; s5_disc(a, g, p, dt, lr, li, fre, fim);
        float* lam = (float*)(ws + WS_S5LAM) + (size_t)idx * 2; lam[0] = lr; lam[1] = li;
        const float* br = a.in[18] + (size_t)idx * 16; const float* bi = a.in[19] + (size_t)idx * 16; const float* gm = a.in[6] + D + g * 16;
        u32x4* bb = (u32x4*)((bf16*)(ws + WS_S5BB) + ((size_t)g * 128 + 2 * p) * 16);
        float vr[16], vi[16];
#pragma unroll
        for (int c = 0; c < 16; ++c) { const float re = br[c], im = bi[c], gg = gm[c]; vr[c] = (fre * re - fim * im) * gg; vi[c] = (fre * im + fim * re) * gg; }
        bb[0] = (u32x4){pkbf(vr[0], vr[1]), pkbf(vr[2], vr[3]), pkbf(vr[4], vr[5]), pkbf(vr[6], vr[7])};
        bb[1] = (u32x4){pkbf(vr[8], vr[9]), pkbf(vr[10], vr[11]), pkbf(vr[12], vr[13]), pkbf(vr[14], vr[15])};
        bb[2] = (u32x4){pkbf(vi[0], vi[1]), pkbf(vi[2], vi[3]), pkbf(vi[4], vi[5]), pkbf(vi[6], vi[7])};
        bb[3] = (u32x4){pkbf(vi[8], vi[9]), pkbf(vi[10], vi[11]), pkbf(vi[12], vi[13]), pkbf(vi[14], vi[15])};
        {
            f32x4* bf = (f32x4*)((float*)(ws + WS_BBF) + (size_t)idx * 32);
#pragma unroll
            for (int q = 0; q < 4; ++q) { bf[q] = (f32x4){vr[4 * q], vr[4 * q + 1], vr[4 * q + 2], vr[4 * q + 3]}; bf[4 + q] = (f32x4){vi[4 * q], vi[4 * q + 1], vi[4 * q + 2], vi[4 * q + 3]}; }
            const float are = a.in[15][idx], aim = a.in[16][idx];
            float* pw = (float*)(ws + WS_POW) + (size_t)idx * 34;
            for (int dd = 0; dd <= 16; ++dd) { const float mg = __expf(are * dt * (float)dd); float sn, cs; sincos_cw(aim * dt * (float)dd, sn, cs); pw[2 * dd] = mg * cs; pw[2 * dd + 1] = mg * sn; }
        }
        unsigned* cm = (unsigned*)((bf16*)(ws + WS_S5CM) + (size_t)g * 16 * 128 + 2 * p);
#pragma unroll
        for (int c = 0; c < 16; ++c) cm[c * 64] = pkbf(a.in[20][(size_t)(g * 16 + c) * 64 + p], -a.in[21][(size_t)(g * 16 + c) * 64 + p]);
    }
    if (idx < 1024) ((float*)(ws + WS_S5DSK))[idx] = a.in[22][idx] * a.in[6][D + idx];
}
__device__ __forceinline__ void s5_ktable(const Args& a, int t) {
    if (t >= 65536) return;
    unsigned char* ws = a.ws;
    const int g = t >> 10, dd = (t >> 6) & 15, c = (t >> 2) & 15, cq = t & 3;
    const float* pw = (const float*)(ws + WS_POW) + (size_t)g * 64 * 34 + 2 * dd; const float* bf = (const float*)(ws + WS_BBF) + (size_t)g * 64 * 32 + 4 * cq;
    const float* cre = a.in[20] + (size_t)(g * 16 + c) * 64; const float* cim = a.in[21] + (size_t)(g * 16 + c) * 64;
    f32x4 acc = (f32x4){0.f, 0.f, 0.f, 0.f};
    for (int p = 0; p < 64; ++p) {
        const float lr = pw[p * 34], li = pw[p * 34 + 1], cr = cre[p], ci = cim[p];
        const float zr = cr * lr - ci * li, zi = cr * li + ci * lr;
        const f32x4 br = *(const f32x4*)(bf + p * 32), bi = *(const f32x4*)(bf + p * 32 + 16);
        acc += br * zr - bi * zi;
    }
    if (dd == 0 && (c >> 2) == cq) acc[c & 3] += ((const float*)(ws + WS_S5DSK))[g * 16 + c];
    *(f32x4*)((float*)(ws + WS_KT) + ((size_t)(g * 16 + dd) * 16 + c) * 16 + 4 * cq) = acc;
}
__device__ __forceinline__ void p0_transpose_item(const float* W, int K, int N, const float* gain, int gluh, bf16* WT, LAS float* scr, int item, int lane) {
    const int nblk = N / 32, kb = item / nblk, nb = item % nblk, k0 = 64 * kb, n0 = 32 * nb;
    f32x4 v[8];
#pragma unroll
    for (int i = 0; i < 8; ++i) v[i] = __builtin_nontemporal_load((const f32x4*)(W + (size_t)(k0 + 8 * i + (lane >> 3)) * N + n0 + 4 * (lane & 7)));
#pragma unroll
    for (int i = 0; i < 8; ++i) { const int kk = 8 * i + (lane >> 3); const float gk = gain ? gain[k0 + kk] : 1.0f; LAS float* s = scr + kk * 33 + 4 * (lane & 7);
        s[0] = v[i][0] * gk; s[1] = v[i][1] * gk; s[2] = v[i][2] * gk; s[3] = v[i][3] * gk; }
    LDS_FENCE();
    int r0 = n0; if (gluh > 0) r0 = (n0 < gluh) ? (n0 / 128) * 256 + (n0 % 128) : ((n0 - gluh) / 128) * 256 + 128 + ((n0 - gluh) % 128);
    const int c = lane & 7;
#pragma unroll
    for (int j = 0; j < 4; ++j) { const int n = (lane >> 3) + 8 * j; const LAS float* s = scr + (8 * c) * 33 + n;
        u32x4 o; o.x = pkbf(s[0 * 33], s[1 * 33]); o.y = pkbf(s[2 * 33], s[3 * 33]); o.z = pkbf(s[4 * 33], s[5 * 33]); o.w = pkbf(s[6 * 33], s[7 * 33]);
        *(u32x4*)(WT + (size_t)(r0 + n) * K + k0 + 8 * c) = o; }
    LDS_FENCE();
}
__device__ __forceinline__ void p0_weights_late(const Args& a, ldsp lds, int gw, int ngw, int wave, int lane) {
    LAS float* scr = (LAS float*)(lds + wave * 16384);
    unsigned char* ws = a.ws;
    constexpr int I2 = (VAL / 64) * (D / 32), I5 = (D / 64) * (2 * D / 32), I3 = (D / 64) * (2 * FFN / 32), I4 = (FFN / 64) * (D / 32);
    constexpr int NITEMS = I2 + I5 + 2 * I3 + 2 * I4;
    for (int it = gw; it < NITEMS; it += ngw) {
        int r = it;
        if (r < I2) { p0_transpose_item(a.in[14], VAL, D, nullptr, 0, (bf16*)(ws + WS_W2), scr, r, lane); continue; } r -= I2;
        if (r < I3) { p0_transpose_item(a.in[24], D, 2 * FFN, a.in[7], FFN, (bf16*)(ws + WS_W3), scr, r, lane); continue; } r -= I3;
        if (r < I4) { p0_transpose_item(a.in[25], FFN, D, nullptr, 0, (bf16*)(ws + WS_W4), scr, r, lane); continue; } r -= I4;
        if (r < I5) { p0_transpose_item(a.in[23], D, 2 * D, nullptr, D, (bf16*)(ws + WS_W5), scr, r, lane); continue; } r -= I5;
        if (r < I3) { p0_transpose_item(a.in[24] + (size_t)D * 2 * FFN, D, 2 * FFN, a.in[7] + D, FFN, (bf16*)(ws + WS_W3) + (size_t)2 * FFN * D, scr, r, lane); continue; } r -= I3;
        p0_transpose_item(a.in[25] + (size_t)FFN * D, FFN, D, nullptr, 0, (bf16*)(ws + WS_W4) + (size_t)D * FFN, scr, r, lane);
    }
}
__device__ __forceinline__ void p0_prologue(const Args& a, ldsp lds, int gw, int ngw, int wave, int lane) {
    LAS float* scr = (LAS float*)(lds + wave * 16384);
    unsigned char* ws = a.ws;
    constexpr int I1 = (D / 64) * (DN_IN / 32);
    for (int it = gw; it < I1; it += ngw) p0_transpose_item(a.in[9], D, DN_IN, a.in[6], 0, (bf16*)(ws + WS_W1), scr, it, lane);
    {
        f32x4 nv[4]; int m = gw;
#define P0_XLOAD(mm) do { const bool smp_ = (mm) >= MP; const int r_ = smp_ ? (mm) - MP : (mm); const f32x4* xr_ = (const f32x4*)((smp_ ? a.in[1] : a.in[0]) + (size_t)r_ * D) + lane; \
        _Pragma("unroll") for (int j_ = 0; j_ < 4; ++j_) nv[j_] = xr_[64 * j_]; } while (0)
        if (m < MP + MS) P0_XLOAD(m);
        for (; m < MP + MS; m += ngw) {
            const bool smp = m >= MP; const int r = smp ? m - MP : m;
            f32x4 v[4]; float s = 0.f;
#pragma unroll
            for (int j = 0; j < 4; ++j) { v[j] = nv[j]; s += (v[j][0] * v[j][0] + v[j][1] * v[j][1]) + (v[j][2] * v[j][2] + v[j][3] * v[j][3]); }
            if (m + ngw < MP + MS) P0_XLOAD(m + ngw);
            s = wave_sum(s);
            u32x2* o8 = (u32x2*)((bf16*)(ws + (smp ? WS_SXB : WS_XB)) + (size_t)r * D) + lane;
#pragma unroll
            for (int j = 0; j < 4; ++j) { u32x2 w; w.x = pkbf(v[j][0], v[j][1]); w.y = pkbf(v[j][2], v[j][3]); o8[64 * j] = w; }
            float* ssr = (float*)(ws + (smp ? WS_SSS : WS_SS)) + (size_t)r * 32;
            if (lane < (smp ? 32 : 16)) ssr[lane] = (lane == 0) ? s : 0.f;
        }
#undef P0_XLOAD
    }
}
constexpr int DL_K = 0, DL_V = 17408, DL_QK = 34816, DL_X = 44032, DL_SLOT = 9216, DL_ST = 99328, DL_GC = 134144, DL_BETA = 134400, DL_RED = 134656, DL_Q = 135680, DL_END = 135680 + 17408;
static_assert(DL_END <= LDSCTL_OFF, "DN LDS map");
__device__ __forceinline__ bf16x8 ldfrag(ldsp base, int row, int ld, int k) { return *(const LAS bf16x8*)(base + (row * ld + k) * 2); }
__device__ __forceinline__ void st4(ldsp base, int row, int ld, int col, const f32x4 v) { u32x2 w; w.x = pkbf(v[0], v[1]); w.y = pkbf(v[2], v[3]); *(LAS u32x2*)(base + (row * ld + col) * 2) = w; }
__device__ __forceinline__ void st1(ldsp base, int row, int ld, int col, float v) { *(LAS unsigned short*)(base + (row * ld + col) * 2) = (unsigned short)(pkbf(v, 0.f) & 0xffffu); }

typedef short s16x4 __attribute__((ext_vector_type(4)));
__device__ __forceinline__ bf16x8 ldfrag_tr(ldsp base, int k0, int ld, int c0, int fr, int fq) {
    const ldsp p = base + ((k0 + 8 * fq + (fr >> 2)) * ld + c0 + 4 * (fr & 3)) * 2;
    const s16x4 lo = __builtin_amdgcn_ds_read_tr16_b64_v4i16((LAS s16x4*)p);
    const s16x4 hi = __builtin_amdgcn_ds_read_tr16_b64_v4i16((LAS s16x4*)(p + 8 * ld));
    return (bf16x8){lo[0], lo[1], lo[2], lo[3], hi[0], hi[1], hi[2], hi[3]};
}
__device__ __forceinline__ void dn_prep(const Args& a, int gw, int ngw, int lane) {
    const bf16* PROJ = (const bf16*)(a.ws + WS_PROJ); bf16* QKVC = (bf16*)(a.ws + WS_QKVC);
    {
        const float* BETA = (const float*)(a.ws + WS_BETA); const float* GDEC = (const float*)(a.ws + WS_GDEC);
        float* GC = (float*)(a.ws + WS_GC); float* BT = (float*)(a.ws + WS_BT);
        for (int u = gw; u < NB * NH * NCHUNK; u += ngw) {
            const int c = u % NCHUNK, h = (u / NCHUNK) % NH, b = u / (NCHUNK * NH); const int row = b * SEQ + c * CHUNK + lane;
            float g = GDEC[(size_t)row * 16 + h]; const float bt = BETA[(size_t)row * 16 + h];
#pragma unroll
            for (int o = 1; o < 64; o <<= 1) { const float t = __shfl_up(g, o); if (lane >= o) g += t; }
            GC[(size_t)(b * NH + h) * SEQ + c * CHUNK + lane] = g; BT[(size_t)(b * NH + h) * SEQ + c * CHUNK + lane] = bt;
        }
    }
    for (int u = gw; u < NB * 8 * (SEQ / 32); u += ngw) {
        const int cb = u & 7, run = (u >> 3) & 63, b = u >> 9, ch0 = cb * 512 + lane * 8, t0 = run * 32, row0 = b * SEQ + t0;
        float w[4][8];
#pragma unroll
        for (int j = 0; j < 4; ++j) { const f32x4 w0 = *(const f32x4*)(a.in[10] + j * 4096 + ch0), w1 = *(const f32x4*)(a.in[10] + j * 4096 + ch0 + 4);
#pragma unroll
            for (int e = 0; e < 4; ++e) { w[j][e] = w0[e]; w[j][4 + e] = w1[e]; } }
        u32x4 xm[3];
#pragma unroll
        for (int j = 0; j < 3; ++j) { xm[j] = (u32x4){0u, 0u, 0u, 0u}; if (t0 - 3 + j >= 0) xm[j] = *(const u32x4*)(PROJ + (size_t)(row0 - 3 + j) * PROJ_LD + ch0); }
        const float scl = cb < 2 ? 0.08838834764831845f : 1.0f;
        u32x4 xr[8];
#pragma unroll
        for (int t = 0; t < 8; ++t) xr[t] = *(const u32x4*)(PROJ + (size_t)(row0 + t) * PROJ_LD + ch0);
#pragma unroll
        for (int t = 0; t < 32; ++t) {
            const u32x4 x0 = xr[t & 7];
            if (t + 8 < 32) xr[t & 7] = *(const u32x4*)(PROJ + (size_t)(row0 + t + 8) * PROJ_LD + ch0);
            float y[8];
#pragma unroll
            for (int e = 0; e < 4; ++e) {
                const unsigned a3 = xm[0][e], a2 = xm[1][e], a1 = xm[2][e], a0 = x0[e];
                y[2 * e] = w[0][2 * e] * bflo(a3) + w[1][2 * e] * bflo(a2) + w[2][2 * e] * bflo(a1) + w[3][2 * e] * bflo(a0);
                y[2 * e + 1] = w[0][2 * e + 1] * bfhi(a3) + w[1][2 * e + 1] * bfhi(a2) + w[2][2 * e + 1] * bfhi(a1) + w[3][2 * e + 1] * bfhi(a0); }
            float ssq = 0.f;
#pragma unroll
            for (int e = 0; e < 8; ++e) { y[e] = y[e] * __builtin_amdgcn_rcpf(1.0f + __expf(-y[e])); ssq += y[e] * y[e]; }
            if (cb < 4) { ssq += __shfl_xor(ssq, 1); ssq += __shfl_xor(ssq, 2); ssq += __shfl_xor(ssq, 4); ssq += __shfl_xor(ssq, 8); const float sc = rsqrtf(ssq + 1e-6f) * scl;
#pragma unroll
                for (int e = 0; e < 8; ++e) y[e] *= sc; }
            u32x4 o; o.x = pkbf(y[0], y[1]); o.y = pkbf(y[2], y[3]); o.z = pkbf(y[4], y[5]); o.w = pkbf(y[6], y[7]);
            *(u32x4*)(QKVC + (size_t)(row0 + t) * 4096 + ch0) = o;
            xm[0] = xm[1]; xm[1] = xm[2]; xm[2] = x0;
        }
    }
}

#ifndef RPA
#define RPA 1
#endif
#ifndef RPB
#define RPB 1
#endif
#ifndef RPE
#define RPE 1
#endif
#ifndef RPF
#define RPF 1
#endif
#ifndef RPO
#define RPO 1
#endif
__device__ __forceinline__ void dn_prompt(const Args& a, ldsp lds, int b, int h, int tid, int wave, int lane) {
    unsigned char* ws = a.ws;
    const bf16* PROJ = (const bf16*)(ws + WS_PROJ); const bf16* QKVC = (const bf16*)(ws + WS_QKVC); bf16* GATED = (bf16*)(ws + WS_GATED);
    const float* GC = (const float*)(ws + WS_GC) + (size_t)(b * NH + h) * SEQ; const float* BT = (const float*)(ws + WS_BT) + (size_t)(b * NH + h) * SEQ;
    const int mt = wave & 3, ch = wave >> 2, hq = h >> 1;
    LAS float* gcs = (LAS float*)(lds + DL_GC); LAS float* betas = (LAS float*)(lds + DL_BETA); LAS float* red = (LAS float*)(lds + DL_RED);
    const ldsp LK = lds + DL_K, LV = lds + DL_V, LQK = lds + DL_QK, LST = lds + DL_ST, LQ = lds + DL_Q;
#define SLOT(s) (lds + DL_X + (s) * DL_SLOT)
#define PRs(s) ((s) == 0 ? 0 : (((s) & 1) ? 2 : 4))
#define PTs(s) ((s) == 0 ? 1 : (((s) & 1) ? 3 : 5))
#define NRs(s) ((s) & 1)
    for (int i = tid; i < 128 * 136 / 2; i += NTHREADS) ((LAS unsigned*)LST)[i] = 0u;
    f32x4 S[2][4];
#pragma unroll
    for (int x = 0; x < 2; ++x)
#pragma unroll
        for (int q = 0; q < 4; ++q) S[x][q] = (f32x4){0.f, 0.f, 0.f, 0.f};
    LAS float* ngl = (LAS float*)(lds + DL_RED + 512);
    if (tid < 128) ngl[tid] = a.in[13][tid];
    u32x4 nQt[2], nKt[2], nVt[2]; float ngd = 0.f, nbt = 0.f;
#define DN_PREFETCH(cc) do { const int rowc_ = b * SEQ + (cc) * CHUNK; const bf16* krow_ = QKVC + (size_t)(rowc_ + (tid >> 3)) * 4096; \
        _Pragma("unroll") for (int p2_ = 0; p2_ < 2; ++p2_) { const int col_ = 8 * ((tid & 7) + 8 * p2_); nQt[p2_] = *(const u32x4*)(krow_ + hq * 128 + col_); nKt[p2_] = *(const u32x4*)(krow_ + 1024 + hq * 128 + col_); nVt[p2_] = *(const u32x4*)(krow_ + 2048 + h * 128 + col_); } \
        ngd = GC[(cc) * CHUNK + lane]; nbt = BT[(cc) * CHUNK + lane]; } while (0)
    DN_PREFETCH(0);
#define DN_TILES_TO_LDS() do { const int r_ = tid >> 3, pc_ = tid & 7; \
        _Pragma("unroll") for (int p2_ = 0; p2_ < 2; ++p2_) { const int col_ = 8 * (pc_ + 8 * p2_); *(LAS u32x4*)(LQ + (r_ * 136 + col_) * 2) = nQt[p2_]; *(LAS u32x4*)(LK + (r_ * 136 + col_) * 2) = nKt[p2_]; *(LAS u32x4*)(LV + (r_ * 136 + col_) * 2) = nVt[p2_]; } \
        if (wave == 0) { gcs[lane] = ngd; betas[lane] = nbt; } } while (0)
    DN_TILES_TO_LDS();
    DN_PREFETCH(NCHUNK > 1 ? 1 : 0);
    __syncthreads();
    for (int c = 0; c < NCHUNK; ++c) {
        int lane_c = lane; asm volatile("" : "+v"(lane_c));
        const int fr = lane_c & 15, fq = lane_c >> 4, i_own = 16 * mt + fr;
        const int t_own = c * CHUNK + i_own, row_own = b * SEQ + t_own;
        bf16x8 qf[4], kf[4]; u32x2 zc[4];
#pragma unroll
        for (int q = 0; q < 4; ++q) zc[q] = *(const u32x2*)(PROJ + (size_t)row_own * PROJ_LD + 4096 + h * 128 + 16 * (4 * ch + q) + 4 * fq);
#pragma unroll
        for (int kk = 0; kk < 4; ++kk) { kf[kk] = ldfrag(LK, i_own, 136, 32 * kk + 8 * fq); qf[kk] = ldfrag(LQ, i_own, 136, 32 * kk + 8 * fq); }
        for (int rpB = 0; rpB < RPB; ++rpB) {
        {
            const float gi = gcs[i_own], bi = betas[i_own];
#pragma unroll
            for (int q2 = 0; q2 < 2; ++q2) { const int nt = 2 * ch + q2;
                f32x4 akk = (f32x4){0.f, 0.f, 0.f, 0.f}, aqk = akk;
#pragma unroll
                for (int kk = 0; kk < 4; ++kk) { const bf16x8 yf = ldfrag(LK, 16 * nt + fr, 136, 32 * kk + 8 * fq); MM_XROW(akk, kf[kk], yf); MM_XROW(aqk, qf[kk], yf); }
                const f32x4 gj = *(const LAS f32x4*)(gcs + 16 * nt + 4 * fq);
                f32x4 qkv, m0;
#pragma unroll
                for (int r = 0; r < 4; ++r) { const int j = 16 * nt + 4 * fq + r; const float d = (i_own >= j) ? __expf(gi - gj[r]) : 0.f; qkv[r] = aqk[r] * d; m0[r] = (i_own > j) ? -bi * akk[r] * d : 0.f; }
                st4(LQK, i_own, 72, 16 * nt + 4 * fq, qkv);
                st4(SLOT(0), i_own, 72, 16 * nt + 4 * fq, m0); }
        }
        __syncthreads();
        {
            const int ws_ = __builtin_amdgcn_readfirstlane(wave) * 4;
            const int ui0 = (int)((0x01222333u >> ws_) & 15u), uj0 = (int)((0x00210210u >> ws_) & 15u), uh0 = (int)((0x00100100u >> ws_) & 15u);
            const int ui1 = (int)((0x01022333u >> ws_) & 15u), uj1 = (int)((0x01010310u >> ws_) & 15u), uh1 = (int)((0x00011111u >> ws_) & 15u);
            const bool same = ((0x00011011u >> ws_) & 1u) != 0u, active = ws_ != 28;
            const f32x4 zero4 = (f32x4){0.f, 0.f, 0.f, 0.f};
            const int row0 = 16 * ui0 + fr, col0 = 16 * uj0 + 4 * fq, row1 = 16 * ui1 + fr, col1 = 16 * uj1 + 4 * fq;
            f32x4 Pc0, Nc0, Pc1, Nc1;
            { const u32x2 mw = *(const LAS u32x2*)(SLOT(0) + (row0 * 72 + col0) * 2); Pc0 = (f32x4){bflo(mw.x), bfhi(mw.x), bflo(mw.y), bfhi(mw.y)}; Nc0 = Pc0;
              const u32x2 mv = *(const LAS u32x2*)(SLOT(0) + (row1 * 72 + col1) * 2); Pc1 = (f32x4){bflo(mv.x), bfhi(mv.x), bflo(mv.y), bfhi(mv.y)}; if (same) Pc1 = zero4; Nc1 = Pc1; }
#pragma unroll
            for (int s = 1; s <= 6; ++s) {
                if (active) {
                    const bf16x8 y0 = ldfrag_tr(SLOT(PRs(s - 1)), 32 * uh0, 72, 16 * uj0, fr, fq), y1 = ldfrag_tr(SLOT(PRs(s - 1)), 32 * uh1, 72, 16 * uj1, fr, fq);
                    f32x4 aN0 = Nc0 + Pc0, aN1 = Nc1 + Pc1, aP0 = zero4, aP1 = zero4;
                    if (s >= 2) { const bf16x8 xn0 = ldfrag(SLOT(NRs(s - 2)), row0, 72, 32 * uh0 + 8 * fq), xn1 = ldfrag(SLOT(NRs(s - 2)), row1, 72, 32 * uh1 + 8 * fq); MM_XROW(aN0, xn0, y0); MM_XROW(aN1, xn1, y1); }
                    if (s <= 5) { const bf16x8 xp0 = ldfrag(SLOT(PRs(s - 1)), row0, 72, 32 * uh0 + 8 * fq), xp1 = ldfrag(SLOT(PRs(s - 1)), row1, 72, 32 * uh1 + 8 * fq); MM_XROW(aP0, xp0, y0); MM_XROW(aP1, xp1, y1); }
                    if (same) { aN0 += aN1; aP0 += aP1; aN1 = zero4; aP1 = zero4; }
                    if (s >= 2) { Nc0 = aN0; Nc1 = aN1; }
                    if (s <= 5) { Pc0 = aP0; Pc1 = aP1; st4(SLOT(PRs(s)), row0, 72, col0, aP0); if (!same) st4(SLOT(PRs(s)), row1, 72, col1, aP1); }
                    if (s >= 2 && s <= 5) { st4(SLOT(NRs(s - 1)), row0, 72, col0, Nc0); if (!same) st4(SLOT(NRs(s - 1)), row1, 72, col1, Nc1); }
                    if (s == 6) {
                        { const f32x4 gj = *(const LAS f32x4*)(gcs + col0), bj = *(const LAS f32x4*)(betas + col0); f32x4 t1, t2;
#pragma unroll
                          for (int r = 0; r < 4; ++r) { const float tv = Nc0[r] + ((row0 == col0 + r) ? 1.f : 0.f); t2[r] = tv * bj[r]; t1[r] = t2[r] * __expf(gj[r]); }
                          st4(SLOT(1), row0, 72, col0, t1); st4(SLOT(3), row0, 72, col0, t2); }
                        if (!same) { const f32x4 gj = *(const LAS f32x4*)(gcs + col1), bj = *(const LAS f32x4*)(betas + col1); f32x4 t1, t2;
#pragma unroll
                          for (int r = 0; r < 4; ++r) { const float tv = Nc1[r] + ((row1 == col1 + r) ? 1.f : 0.f); t2[r] = tv * bj[r]; t1[r] = t2[r] * __expf(gj[r]); }
                          st4(SLOT(1), row1, 72, col1, t1); st4(SLOT(3), row1, 72, col1, t2); } }
                } else {
                    if (s <= 5) { st4(SLOT(PRs(s)), fr, 72, 16 + 4 * fq, zero4); st4(SLOT(PRs(s)), 32 + fr, 72, 48 + 4 * fq, zero4); }
                    if (s >= 2 && s <= 5) { st4(SLOT(NRs(s - 1)), fr, 72, 16 + 4 * fq, zero4); st4(SLOT(NRs(s - 1)), 32 + fr, 72, 48 + 4 * fq, zero4); }
                    if (s == 6) {
#pragma unroll
                        for (int u = 0; u < 6; ++u) { const int ui = u < 3 ? 0 : (u < 5 ? 1 : 2), uj = u < 3 ? u + 1 : (u < 5 ? u - 1 : 3);
                            st4(SLOT(1), 16 * ui + fr, 72, 16 * uj + 4 * fq, zero4); st4(SLOT(3), 16 * ui + fr, 72, 16 * uj + 4 * fq, zero4); } }
                }
                __syncthreads();
            }
        }
        }
        f32x4 U[4]; bf16x8 ka[2][2];
        for (int rpE = 0; rpE < RPE; ++rpE) {
        {
#pragma unroll
            for (int x = 0; x < 2; ++x) { ka[x][0] = ldfrag_tr(LK, 0, 136, 16 * (2 * mt + x), fr, fq); ka[x][1] = ldfrag_tr(LK, 32, 136, 16 * (2 * mt + x), fr, fq); }
            if (mt >= 2) {
                const bf16x8 t1a = ldfrag(SLOT(1), i_own, 72, 8 * fq), t1b = ldfrag(SLOT(1), i_own, 72, 32 + 8 * fq), t2a = ldfrag(SLOT(3), i_own, 72, 8 * fq), t2b = ldfrag(SLOT(3), i_own, 72, 32 + 8 * fq);
#pragma unroll
                for (int q = 0; q < 4; ++q) { const int nt = 4 * ch + q;
                    if (q < 2) { f32x4 aw = (f32x4){0.f, 0.f, 0.f, 0.f};
                        MM_XROW(aw, t1a, ldfrag_tr(LK, 0, 136, 16 * nt, fr, fq)); MM_XROW(aw, t1b, ldfrag_tr(LK, 32, 136, 16 * nt, fr, fq));
                        st4(SLOT(4), i_own, 136, 16 * nt + 4 * fq, -aw); }
                    f32x4 au = (f32x4){0.f, 0.f, 0.f, 0.f};
                    MM_YROW(au, t2a, ldfrag_tr(LV, 0, 136, 16 * nt, fr, fq)); MM_YROW(au, t2b, ldfrag_tr(LV, 32, 136, 16 * nt, fr, fq));
                    U[q] = au; }
            } else {
                const int i_hi = i_own + 32;
                const bf16x8 t1a = ldfrag(SLOT(1), i_own, 72, 8 * fq), t2a = ldfrag(SLOT(3), i_own, 72, 8 * fq), h1a = ldfrag(SLOT(1), i_hi, 72, 8 * fq), h1b = ldfrag(SLOT(1), i_hi, 72, 32 + 8 * fq);
#pragma unroll
                for (int q = 0; q < 4; ++q) { const int nt = 4 * ch + q;
                    const bf16x8 k0 = ldfrag_tr(LK, 0, 136, 16 * nt, fr, fq);
                    f32x4 aw = (f32x4){0.f, 0.f, 0.f, 0.f};
                    MM_XROW(aw, t1a, k0);
                    st4(SLOT(4), i_own, 136, 16 * nt + 4 * fq, -aw);
                    if (q >= 2) { f32x4 ah = (f32x4){0.f, 0.f, 0.f, 0.f};
                        MM_XROW(ah, h1a, k0); MM_XROW(ah, h1b, ldfrag_tr(LK, 32, 136, 16 * nt, fr, fq));
                        st4(SLOT(4), i_hi, 136, 16 * nt + 4 * fq, -ah); }
                    f32x4 au = (f32x4){0.f, 0.f, 0.f, 0.f};
                    MM_YROW(au, t2a, ldfrag_tr(LV, 0, 136, 16 * nt, fr, fq));
                    U[q] = au; }
            }
        }
        __syncthreads();
        }
        f32x4 O[4];
        const float gl = gcs[63];
        for (int rpF = 0; rpF < RPF; ++rpF) {
        {
            bf16x8 wf[4];
#pragma unroll
            for (int kk = 0; kk < 4; ++kk) wf[kk] = ldfrag(SLOT(4), i_own, 136, 32 * kk + 8 * fq);
            const float ei = __expf(gcs[i_own]);
            const f32x4 gq = *(const LAS f32x4*)(gcs + 16 * mt + 4 * fq);
#pragma unroll
            for (int q = 0; q < 4; ++q) { const int nt = 4 * ch + q;
                f32x4 ao = (f32x4){0.f, 0.f, 0.f, 0.f}, av = U[q];
#pragma unroll
                for (int kk = 0; kk < 4; ++kk) { const bf16x8 sf = ldfrag(LST, 16 * nt + fr, 136, 32 * kk + 8 * fq); MM_YROW(av, wf[kk], sf); MM_XROW(ao, qf[kk], sf); }
                O[q] = ao * ei;
                st4(SLOT(0), 16 * nt + fr, 72, 16 * mt + 4 * fq, av);
                f32x4 avd;
#pragma unroll
                for (int r = 0; r < 4; ++r) avd[r] = av[r] * __expf(gl - gq[r]);
                st4(SLOT(2), 16 * nt + fr, 72, 16 * mt + 4 * fq, avd); }
        }
        __syncthreads();
        }
        {
            const bf16x8 qa = ldfrag(LQK, i_own, 72, 8 * fq), qb = ldfrag(LQK, i_own, 72, 32 + 8 * fq);
            DN_TILES_TO_LDS();
            const float el = __expf(gl);
            float ssq = 0.f;
#pragma unroll
            for (int q = 0; q < 4; ++q) { const int nt = 4 * ch + q;
                MM_XROW(O[q], qa, ldfrag(SLOT(0), 16 * nt + fr, 72, 8 * fq)); MM_XROW(O[q], qb, ldfrag(SLOT(0), 16 * nt + fr, 72, 32 + 8 * fq));
                ssq += (O[q][0] * O[q][0] + O[q][1] * O[q][1]) + (O[q][2] * O[q][2] + O[q][3] * O[q][3]);
                const bf16x8 v0 = ldfrag(SLOT(2), 16 * nt + fr, 72, 8 * fq), v1 = ldfrag(SLOT(2), 16 * nt + fr, 72, 32 + 8 * fq);
#pragma unroll
                for (int x = 0; x < 2; ++x) { f32x4 sacc = S[x][q] * el; MM_YROW(sacc, ka[x][0], v0); MM_YROW(sacc, ka[x][1], v1); S[x][q] = sacc;
                    st4(LST, 16 * nt + fr, 136, 16 * (2 * mt + x) + 4 * fq, sacc); } }
            ssq += __shfl_xor(ssq, 16); ssq += __shfl_xor(ssq, 32);
            if (fq == 0) red[i_own * 2 + ch] = ssq;
            { const int cn = (c + 2 < NCHUNK) ? c + 2 : NCHUNK - 1; DN_PREFETCH(cn); }
        }
        __syncthreads();
        for (int rpO = 0; rpO < RPO; ++rpO) {
        {
            const float rstd = rsqrtf((red[i_own * 2] + red[i_own * 2 + 1]) * (1.0f / 128.0f) + RMS_EPSF);
#pragma unroll
            for (int q = 0; q < 4; ++q) { const int dv = 16 * (4 * ch + q) + 4 * fq;
                const u32x2 z = zc[q];
                const f32x4 ngv = *(const LAS f32x4*)(ngl + dv);
                u32x2 w; w.x = pkbf(O[q][0] * rstd * ngv[0] * bflo(z.x), O[q][1] * rstd * ngv[1] * bfhi(z.x)); w.y = pkbf(O[q][2] * rstd * ngv[2] * bflo(z.y), O[q][3] * rstd * ngv[3] * bfhi(z.y));
                *(u32x2*)(GATED + (size_t)row_own * VAL + h * 128 + dv) = w; }
        }
        }
    }
    const int fr = lane & 15, fq = lane >> 4;
    float* so = a.out + O_SSMP + (size_t)(b * NH + h) * 128 * 128;
#pragma unroll
    for (int x = 0; x < 2; ++x)
#pragma unroll
        for (int q = 0; q < 4; ++q)
#pragma unroll
            for (int r = 0; r < 4; ++r) so[(size_t)(16 * (2 * mt + x) + 4 * fq + r) * 128 + 16 * (4 * ch + q) + fr] = S[x][q][r];
    for (int i = tid; i < 3 * 384; i += NTHREADS) { const int j = i / 384, cc = i % 384; if (cc < 256 && (h & 1)) continue;
        const int gch = cc < 128 ? hq * 128 + cc : (cc < 256 ? 1024 + hq * 128 + (cc - 128) : 2048 + h * 128 + (cc - 256));
        a.out[O_CONVP + (size_t)(b * 3 + j) * 4096 + gch] = bf1(PROJ[(size_t)(b * SEQ + SEQ - 3 + j) * PROJ_LD + gch]); }
    __syncthreads();
#undef SLOT
#undef DN_PREFETCH
#undef DN_TILES_TO_LDS
#undef PRs
#undef PTs
#undef NRs
}
__device__ __forceinline__ void dn_sample_all(const Args& a, ldsp lds, int ti, int nt, int tid, int wave, int lane) {
    unsigned char* ws = a.ws;
    const bf16* PROJ = (const bf16*)(ws + WS_SPROJ); bf16* GATED = (bf16*)(ws + WS_SGATED);
    const float* BETA = (const float*)(ws + WS_SBETA); const float* GDEC = (const float*)(ws + WS_SGDEC);
    LAS float* qkv = (LAS float*)lds;
    LAS float* red = qkv + 384;
    LAS float* part = qkv + 512;
    const int kg = tid >> 5, v4 = tid & 31, p = tid >> 7, c = tid & 127;
    f32x4 sn[8]; float nx3 = 0.f, nc0 = 0.f, nc1 = 0.f, nc2 = 0.f, nbeta = 0.f, ngd = 0.f; u32x2 nz = (u32x2){0u, 0u};
    float w0 = 0.f, w1 = 0.f, w2 = 0.f, w3 = 0.f; int gch_cur = -1;
#define DNS_LOAD(it_) do { const int bs_ = (it_) / NH, h_ = (it_) % NH, hq_ = h_ >> 1; \
        const float* sin_ = a.in[2] + ((size_t)(bs_ * NH + h_) * 128 + kg * 8) * 128 + 4 * v4; \
        _Pragma("unroll") for (int r_ = 0; r_ < 8; ++r_) sn[r_] = *(const f32x4*)(sin_ + r_ * 128); \
        if (tid < 384) { const int gch_ = p == 0 ? hq_ * 128 + c : (p == 1 ? 1024 + hq_ * 128 + c : 2048 + h_ * 128 + c); \
            nx3 = bf1(PROJ[(size_t)bs_ * PROJ_LD + gch_]); const float* cs_ = a.in[3] + (size_t)bs_ * 3 * 4096 + gch_; nc0 = cs_[0]; nc1 = cs_[4096]; nc2 = cs_[8192]; } \
        nbeta = BETA[(size_t)bs_ * 16 + h_]; ngd = GDEC[(size_t)bs_ * 16 + h_]; \
        if (tid < 32) nz = *(const u32x2*)(PROJ + (size_t)bs_ * PROJ_LD + 4096 + h_ * 128 + 4 * v4); } while (0)
    int it = ti;
    if (it < MS * NH) DNS_LOAD(it);
    for (; it < MS * NH; it += nt) {
        const int bs = it / NH, h = it % NH, hq = h >> 1;
        f32x4 s[8];
#pragma unroll
        for (int r = 0; r < 8; ++r) s[r] = sn[r];
        const float x3 = nx3, c0 = nc0, c1 = nc1, c2 = nc2, beta = nbeta, eg = __expf(ngd); const u32x2 z = nz;
        const int gch = p == 0 ? hq * 128 + c : (p == 1 ? 1024 + hq * 128 + c : 2048 + h * 128 + c);
        if (tid < 384 && gch != gch_cur) { const float* w = a.in[10] + gch; w0 = w[0]; w1 = w[4096]; w2 = w[8192]; w3 = w[12288]; gch_cur = gch; }
        if (it + nt < MS * NH) DNS_LOAD(it + nt);
        float sq = 0.f;
        if (tid < 384) {
            float y = c0 * w0 + c1 * w1 + c2 * w2 + x3 * w3; y = y / (1.0f + __expf(-y));
            if (p == 2 || (h & 1) == 0) { float* co = a.out + O_CONVS + (size_t)bs * 3 * 4096 + gch; co[0] = c1; co[4096] = c2; co[8192] = x3; }
            qkv[tid] = y; sq = y * y; }
        sq = wave_sum(sq);
        if (lane == 0) red[wave] = sq;
        __syncthreads();
        const float qs = rsqrtf(red[0] + red[1] + 1e-6f) * 0.08838834764831845f, ks = rsqrtf(red[2] + red[3] + 1e-6f);
        float* sout = a.out + O_SSMS + ((size_t)(bs * NH + h) * 128 + kg * 8) * 128 + 4 * v4;
        f32x4 kv = (f32x4){0.f, 0.f, 0.f, 0.f};
#pragma unroll
        for (int r = 0; r < 8; ++r) { s[r] = s[r] * eg; kv += s[r] * (qkv[128 + kg * 8 + r] * ks); }
        *(LAS f32x4*)(part + kg * 128 + 4 * v4) = kv;
        __syncthreads();
        kv = (f32x4){0.f, 0.f, 0.f, 0.f};
#pragma unroll
        for (int g = 0; g < 16; ++g) kv += *(const LAS f32x4*)(part + g * 128 + 4 * v4);
        const f32x4 vv = *(const LAS f32x4*)(qkv + 256 + 4 * v4);
        const f32x4 delta = (vv - kv) * beta;
        f32x4 op = (f32x4){0.f, 0.f, 0.f, 0.f};
#pragma unroll
        for (int r = 0; r < 8; ++r) { s[r] += delta * (qkv[128 + kg * 8 + r] * ks); *(f32x4*)(sout + r * 128) = s[r]; op += s[r] * (qkv[kg * 8 + r] * qs); }
        __syncthreads();
        *(LAS f32x4*)(part + kg * 128 + 4 * v4) = op;
        __syncthreads();
        if (tid < 32) {
            f32x4 o = (f32x4){0.f, 0.f, 0.f, 0.f};
#pragma unroll
            for (int g = 0; g < 16; ++g) o += *(const LAS f32x4*)(part + g * 128 + 4 * v4);
            float ss = (o[0] * o[0] + o[1] * o[1]) + (o[2] * o[2] + o[3] * o[3]);
#pragma unroll
            for (int m = 1; m < 32; m <<= 1) ss += __shfl_xor(ss, m);
            const float rstd = rsqrtf(ss * (1.0f / 128.0f) + RMS_EPSF);
            const f32x4 ng = *(const f32x4*)(a.in[13] + 4 * v4);
            u32x2 w; w.x = pkbf(o[0] * rstd * ng[0] * bflo(z.x), o[1] * rstd * ng[1] * bfhi(z.x)); w.y = pkbf(o[2] * rstd * ng[2] * bflo(z.y), o[3] * rstd * ng[3] * bfhi(z.y));
            *(u32x2*)(GATED + (size_t)bs * VAL + h * 128 + 4 * v4) = w;
        }
        __syncthreads();
    }
#undef DNS_LOAD
}
__device__ __forceinline__ void s5_wave(const Args& a, ldsp wl, bool sample, int b, int e0, int g, int lane) {
    unsigned char* ws = a.ws;
    const bf16* XB = (const bf16*)(ws + (sample ? WS_SXB : WS_XB)); bf16* YB = (bf16*)(ws + (sample ? WS_SYB : WS_YB)); const float* SS = (const float*)(ws + (sample ? WS_SSS : WS_SS));
    const int fr = lane & 15, fq = lane >> 4;
    LAS float* bubuf = (LAS float*)wl;
    const ldsp stbuf = wl + 16 * 132 * 4;
    const f32x2 lam = *(const f32x2*)((const float*)(ws + WS_S5LAM) + (size_t)(g * 64 + lane) * 2); const float lr = lam[0], li = lam[1];
    bf16x8 bbf[8];
#pragma unroll
    for (int nt = 0; nt < 8; ++nt) { u32x4 w = (u32x4){0u, 0u, 0u, 0u}; if (fq < 2) w = *(const u32x4*)((const bf16*)(ws + WS_S5BB) + ((size_t)g * 128 + 16 * nt + fr) * 16 + 8 * fq); bbf[nt] = __builtin_bit_cast(bf16x8, w); }
    bf16x8 cf[4];
#pragma unroll
    for (int kk = 0; kk < 4; ++kk) cf[kk] = *(const bf16x8*)((const bf16*)(ws + WS_S5CM) + ((size_t)g * 16 + fr) * 128 + 32 * kk + 8 * fq);
    const f32x4 dskv = *(const f32x4*)((const float*)(ws + WS_S5DSK) + g * 16 + 4 * fq); const float dsk[4] = {dskv[0], dskv[1], dskv[2], dskv[3]};
    float sre = 0.f, sim = 0.f;
    const int ntile = sample ? 1 : SEQ / 16;
    const int rowb0 = sample ? e0 : b * SEQ;
    u32x4 pxw[4]; f32x4 pss[4]; u32x2 puw[4];
#define S5_LOAD(k, tile) do { const int row_ = rowb0 + (tile) * 16 + fr; pxw[k] = (u32x4){0u, 0u, 0u, 0u}; if (fq < 2) pxw[k] = *(const u32x4*)(XB + (size_t)row_ * D + g * 16 + 8 * fq); \
        pss[k] = *(const f32x4*)(SS + (size_t)row_ * 32 + 4 * fq); if (sample) pss[k] += *(const f32x4*)(SS + (size_t)row_ * 32 + 16 + 4 * fq); puw[k] = *(const u32x2*)(XB + (size_t)row_ * D + g * 16 + 4 * fq); } while (0)
#pragma unroll
    for (int k = 0; k < 4; ++k) if (k < ntile) S5_LOAD(k, k);
    for (int t0 = 0; t0 < ntile; t0 += 4) {
#pragma unroll
        for (int k = 0; k < 4; ++k) {
            const int tile = t0 + k; if (tile >= ntile) break;
            const int row = rowb0 + tile * 16 + fr;
            const bf16x8 xf = __builtin_bit_cast(bf16x8, pxw[k]);
            float ssum = (pss[k][0] + pss[k][1]) + (pss[k][2] + pss[k][3]); ssum += __shfl_xor(ssum, 16); ssum += __shfl_xor(ssum, 32);
            const float rs = rsqrtf(ssum * (1.0f / 1024.0f) + RMS_EPSF);
            const u32x2 uw = puw[k];
            if (tile + 4 < ntile) S5_LOAD(k, tile + 4);
#pragma unroll
            for (int nt = 0; nt < 8; ++nt) { f32x4 acc = (f32x4){0.f, 0.f, 0.f, 0.f}; MM_XROW(acc, xf, bbf[nt]); *(LAS f32x4*)(bubuf + fr * 132 + 16 * nt + 4 * fq) = acc * rs; }
            LDS_FENCE();
            f32x2 buv[16];
#pragma unroll
            for (int t = 0; t < 16; ++t) buv[t] = *(const LAS f32x2*)(bubuf + t * 132 + 2 * lane);
            LDS_FENCE();
#pragma unroll
            for (int t = 0; t < 16; ++t) {
                const f32x2 bu = buv[t];
                if (sample) { sre = a.in[4][(size_t)(e0 + t) * 4096 + g * 64 + lane]; sim = a.in[5][(size_t)(e0 + t) * 4096 + g * 64 + lane]; }
                const float nr = fmaf(lr, sre, fmaf(-li, sim, bu[0])), ni = fmaf(lr, sim, fmaf(li, sre, bu[1]));
                sre = nr; sim = ni;
                *(LAS unsigned*)(stbuf + (t * 136 + 2 * lane) * 2) = pkbf(sre, sim);
                if (sample) { a.out[O_S5RS + (size_t)(e0 + t) * 4096 + g * 64 + lane] = sre; a.out[O_S5IS + (size_t)(e0 + t) * 4096 + g * 64 + lane] = sim; }
            }
            LDS_FENCE();
            f32x4 y = (f32x4){0.f, 0.f, 0.f, 0.f};
#pragma unroll
            for (int kk = 0; kk < 4; ++kk) MM_XROW(y, ldfrag(stbuf, fr, 136, 32 * kk + 8 * fq), cf[kk]);
            y[0] += dsk[0] * bflo(uw.x) * rs; y[1] += dsk[1] * bfhi(uw.x) * rs; y[2] += dsk[2] * bflo(uw.y) * rs; y[3] += dsk[3] * bfhi(uw.y) * rs;
            u32x2 w; w.x = pkbf(gelu_tanh(y[0]), gelu_tanh(y[1])); w.y = pkbf(gelu_tanh(y[2]), gelu_tanh(y[3]));
            *(u32x2*)(YB + (size_t)row * D + g * 16 + 4 * fq) = w;
            LDS_FENCE();
        }
    }
#undef S5_LOAD
    if (!sample) { a.out[O_S5RP + (size_t)(b * 64 + g) * 64 + lane] = sre; a.out[O_S5IP + (size_t)(b * 64 + g) * 64 + lane] = sim; }
}
template <bool EMIT>
__device__ __forceinline__ void s5_tiles(const bf16* XB, bf16* YB, const float* SS, ldsp wl, int rowb0, int ntile, int g, int lane, float lr, float li,
                                         const bf16x8 (&bbf)[8], const bf16x8 (&cf)[4], const float (&dsk)[4], float& sre, float& sim) {
    const int fr = lane & 15, fq = lane >> 4;
    LAS float* bubuf = (LAS float*)wl; const ldsp stbuf = wl + 16 * 132 * 4;
    u32x4 pxw[4]; f32x4 pss[4]; u32x2 puw[4];
#define S5_LOAD(k, tile) do { const int row_ = rowb0 + (tile) * 16 + fr; pxw[k] = (u32x4){0u, 0u, 0u, 0u}; if (fq < 2) pxw[k] = *(const u32x4*)(XB + (size_t)row_ * D + g * 16 + 8 * fq); \
        pss[k] = *(const f32x4*)(SS + (size_t)row_ * 32 + 4 * fq); if (EMIT) puw[k] = *(const u32x2*)(XB + (size_t)row_ * D + g * 16 + 4 * fq); } while (0)
#pragma unroll
    for (int k = 0; k < 4; ++k) if (k < ntile) S5_LOAD(k, k);
    for (int t0 = 0; t0 < ntile; t0 += 4) {
#pragma unroll
        for (int k = 0; k < 4; ++k) {
            const int tile = t0 + k; if (tile >= ntile) break;
            const int row = rowb0 + tile * 16 + fr;
            const bf16x8 xf = __builtin_bit_cast(bf16x8, pxw[k]);
            float ssum = (pss[k][0] + pss[k][1]) + (pss[k][2] + pss[k][3]); ssum += __shfl_xor(ssum, 16); ssum += __shfl_xor(ssum, 32);
            const float rs = rsqrtf(ssum * (1.0f / 1024.0f) + RMS_EPSF);
            u32x2 uw = (u32x2){0u, 0u}; if (EMIT) uw = puw[k];
            if (tile + 4 < ntile) S5_LOAD(k, tile + 4);
#pragma unroll
            for (int nt = 0; nt < 8; ++nt) { f32x4 acc = (f32x4){0.f, 0.f, 0.f, 0.f}; MM_XROW(acc, xf, bbf[nt]); *(LAS f32x4*)(bubuf + fr * 132 + 16 * nt + 4 * fq) = acc * rs; }
            LDS_FENCE();
            f32x2 buv[16];
#pragma unroll
            for (int t = 0; t < 16; ++t) buv[t] = *(const LAS f32x2*)(bubuf + t * 132 + 2 * lane);
            LDS_FENCE();
#pragma unroll
            for (int t = 0; t < 16; ++t) {
                const float nr = fmaf(lr, sre, fmaf(-li, sim, buv[t][0])), ni = fmaf(lr, sim, fmaf(li, sre, buv[t][1]));
                sre = nr; sim = ni;
                if (EMIT) *(LAS unsigned*)(stbuf + (t * 136 + 2 * lane) * 2) = pkbf(sre, sim);
            }
            if (EMIT) {
                LDS_FENCE();
                f32x4 y = (f32x4){0.f, 0.f, 0.f, 0.f};
#pragma unroll
                for (int kk = 0; kk < 4; ++kk) MM_XROW(y, ldfrag(stbuf, fr, 136, 32 * kk + 8 * fq), cf[kk]);
                y[0] += dsk[0] * bflo(uw.x) * rs; y[1] += dsk[1] * bfhi(uw.x) * rs; y[2] += dsk[2] * bflo(uw.y) * rs; y[3] += dsk[3] * bfhi(uw.y) * rs;
                u32x2 w; w.x = pkbf(gelu_tanh(y[0]), gelu_tanh(y[1])); w.y = pkbf(gelu_tanh(y[2]), gelu_tanh(y[3]));
                *(u32x2*)(YB + (size_t)row * D + g * 16 + 4 * fq) = w;
            }
            LDS_FENCE();
        }
    }
#undef S5_LOAD
}
__device__ __forceinline__ void s5_prompt_wg(const Args& a, ldsp lds, int vcu, int G, int wave, int lane) {
    unsigned char* ws = a.ws;
    const bf16* XB = (const bf16*)(ws + WS_XB); bf16* YB = (bf16*)(ws + WS_YB); const float* SS = (const float*)(ws + WS_SS);
    const int fr = lane & 15, fq = lane >> 4, p = wave >> 2, seg = wave & 3;
    const ldsp wl = lds + wave * 12800;
    LAS f32x2* exch = (LAS f32x2*)(lds + 8 * 12800);
    const int nrounds = (256 + G - 1) / G;
    for (int k = 0; k < nrounds; ++k) {
        const bool valid = vcu + k * G < 256;
        const int it = valid ? (vcu + k * G) * 2 + p : 0, b = it >> 6, g = it & 63;
        const f32x2 lam = *(const f32x2*)((const float*)(ws + WS_S5LAM) + (size_t)(g * 64 + lane) * 2); const float lr = lam[0], li = lam[1];
        bf16x8 bbf[8];
#pragma unroll
        for (int nt = 0; nt < 8; ++nt) { u32x4 w = (u32x4){0u, 0u, 0u, 0u}; if (fq < 2) w = *(const u32x4*)((const bf16*)(ws + WS_S5BB) + ((size_t)g * 128 + 16 * nt + fr) * 16 + 8 * fq); bbf[nt] = __builtin_bit_cast(bf16x8, w); }
        bf16x8 cf[4];
#pragma unroll
        for (int kk = 0; kk < 4; ++kk) cf[kk] = *(const bf16x8*)((const bf16*)(ws + WS_S5CM) + ((size_t)g * 16 + fr) * 128 + 32 * kk + 8 * fq);
        const f32x4 dskv = *(const f32x4*)((const float*)(ws + WS_S5DSK) + g * 16 + 4 * fq); const float dsk[4] = {dskv[0], dskv[1], dskv[2], dskv[3]};
        const int rowb0 = b * SEQ + seg * 512;
        float sre = 0.f, sim = 0.f;
        if (valid && seg < 3) s5_tiles<false>(XB, YB, SS, wl, rowb0, 32, g, lane, lr, li, bbf, cf, dsk, sre, sim);
        exch[(p * 4 + seg) * 64 + lane] = (f32x2){sre, sim};
        __syncthreads();
        if (valid) {
            float Lr = lr, Li = li;
#pragma unroll
            for (int q = 0; q < 9; ++q) { const float r2 = Lr * Lr - Li * Li, i2 = 2.0f * Lr * Li; Lr = r2; Li = i2; }
            float cr = 0.f, ci = 0.f;
            for (int j = 0; j < seg; ++j) { const f32x2 e = exch[(p * 4 + j) * 64 + lane]; const float nr = Lr * cr - Li * ci + e[0], ni = Lr * ci + Li * cr + e[1]; cr = nr; ci = ni; }
            sre = cr; sim = ci;
            s5_tiles<true>(XB, YB, SS, wl, rowb0, 32, g, lane, lr, li, bbf, cf, dsk, sre, sim);
            if (seg == 3) { a.out[O_S5RP + (size_t)(b * 64 + g) * 64 + lane] = sre; a.out[O_S5IP + (size_t)(b * 64 + g) * 64 + lane] = sim; }
        }
        __syncthreads();
    }
}
template <int KK, bool SCAN>
__device__ __forceinline__ void s5_gemm_role(const Args& a, ldsp lds, int g, int bp, int tid, int wave, int lane) {
    unsigned char* ws = a.ws;
    const bf16* XB = (const bf16*)(ws + WS_XB); bf16* YB = (bf16*)(ws + WS_YB); const float* SS = (const float*)(ws + WS_SS);
    asm volatile("" : "+v"(lane), "+s"(wave), "+v"(tid));
    const int fr = lane & 15, fq = lane >> 4;
    const ldsp UT = lds, SIN = lds + 3 * 8448;
    const float* kt = (const float*)(ws + WS_KT) + (size_t)g * 4096;
    const float* pw = (const float*)(ws + WS_POW) + (size_t)g * 64 * 34;
    const float* bfp = (const float*)(ws + WS_BBF) + (size_t)g * 64 * 32;
    const float* cre = a.in[20] + (size_t)g * 16 * 64; const float* cim = a.in[21] + (size_t)g * 16 * 64;
#define S5_LD_WAIT() asm volatile("s_waitcnt vmcnt(0)" ::: "memory")
    bf16x8 vf[2][4], Fw[2][KK];
#pragma unroll
    for (int x = 0; x < 2; ++x) { const int tau = 2 * wave + x;
#pragma unroll
        for (int kk = 0; kk < 4; ++kk) { const int p0 = 16 * kk + 4 * fq; const f32x4 cr4 = *(const f32x4*)(cre + fr * 64 + p0), ci4 = *(const f32x4*)(cim + fr * 64 + p0); float v[8];
            float lrq[4], liq[4];
#pragma unroll
            for (int q = 0; q < 4; ++q) { lrq[q] = pw[(p0 + q) * 34 + 2 * (tau + 1)]; liq[q] = pw[(p0 + q) * 34 + 2 * (tau + 1) + 1]; }
            S5_LD_WAIT();
#pragma unroll
            for (int q = 0; q < 4; ++q) { const float lr = lrq[q], li = liq[q]; v[2 * q] = cr4[q] * lr - ci4[q] * li; v[2 * q + 1] = -(cr4[q] * li + ci4[q] * lr); }
            u32x4 w; w.x = pkbf(v[0], v[1]); w.y = pkbf(v[2], v[3]); w.z = pkbf(v[4], v[5]); w.w = pkbf(v[6], v[7]); vf[x][kk] = __builtin_bit_cast(bf16x8, w); }
#pragma unroll
        for (int kk = 0; kk < KK; ++kk) { const int lag = tau - 2 * kk - (fq >> 1); u32x4 w = (u32x4){0u, 0u, 0u, 0u};
            if (lag >= 0) { const float* kp = kt + ((size_t)lag * 16 + fr) * 16 + 8 * (fq & 1); const f32x4 k0 = *(const f32x4*)kp, k1 = *(const f32x4*)(kp + 4);
                w.x = pkbf(k0[0], k0[1]); w.y = pkbf(k0[2], k0[3]); w.z = pkbf(k1[0], k1[1]); w.w = pkbf(k1[2], k1[3]); }
            Fw[x][kk] = __builtin_bit_cast(bf16x8, w); } }
    float l1r = 0.f, l1i = 0.f, l4r = 0.f, l4i = 0.f;
    bf16x8 wr[SCAN ? 8 : 1], wi[SCAN ? 8 : 1];
    const int ps = 16 * (wave & 3) + fr;
    if (SCAN) {
#pragma unroll
        for (int kk = 0; kk < 8; ++kk) { const int j = 2 * kk + (fq >> 1); const float lr = pw[ps * 34 + 2 * (15 - j)], li = pw[ps * 34 + 2 * (15 - j) + 1];
            const float* bp_ = bfp + ps * 32 + 8 * (fq & 1); const f32x4 r0 = *(const f32x4*)bp_, r1 = *(const f32x4*)(bp_ + 4), i0 = *(const f32x4*)(bp_ + 16), i1 = *(const f32x4*)(bp_ + 20);
            S5_LD_WAIT();
            u32x4 wa, wb;
            wa.x = pkbf(lr * r0[0] - li * i0[0], lr * r0[1] - li * i0[1]); wa.y = pkbf(lr * r0[2] - li * i0[2], lr * r0[3] - li * i0[3]); wa.z = pkbf(lr * r1[0] - li * i1[0], lr * r1[1] - li * i1[1]); wa.w = pkbf(lr * r1[2] - li * i1[2], lr * r1[3] - li * i1[3]);
            wb.x = pkbf(lr * i0[0] + li * r0[0], lr * i0[1] + li * r0[1]); wb.y = pkbf(lr * i0[2] + li * r0[2], lr * i0[3] + li * r0[3]); wb.z = pkbf(lr * i1[0] + li * r1[0], lr * i1[1] + li * r1[1]); wb.w = pkbf(lr * i1[2] + li * r1[2], lr * i1[3] + li * r1[3]);
            wr[kk] = __builtin_bit_cast(bf16x8, wa); wi[kk] = __builtin_bit_cast(bf16x8, wb); }
        l1r = pw[ps * 34 + 32]; l1i = pw[ps * 34 + 33]; S5_LD_WAIT();
        const float l2r = l1r * l1r - l1i * l1i, l2i = 2.0f * l1r * l1i; l4r = l2r * l2r - l2i * l2i; l4i = 2.0f * l2r * l2i;
    }
    const int token = tid >> 1, half = tid & 1;
    u32x4 pxwA, pxwB; f32x4 psaA, psbA, psaB, psbB;
#define S5G_ULOAD(SET, ct_) do { const int c__ = (ct_) < 16 ? (ct_) : 15; const size_t row_ = (size_t)(2 * bp + (c__ >> 3)) * SEQ + 256 * (c__ & 7) + token; pxw##SET = *(const u32x4*)(XB + row_ * D + g * 16 + 8 * half); \
        psa##SET = *(const f32x4*)(SS + row_ * 32 + 8 * half); psb##SET = *(const f32x4*)(SS + row_ * 32 + 8 * half + 4); } while (0)
#define S5G_USTORE(SET, ct_) do { float s_ = ((psa##SET[0] + psa##SET[1]) + (psa##SET[2] + psa##SET[3])) + ((psb##SET[0] + psb##SET[1]) + (psb##SET[2] + psb##SET[3])); s_ += __shfl_xor(s_, 1); const float rs_ = rsqrtf(s_ * (1.0f / 1024.0f) + RMS_EPSF); \
        u32x4 w_; w_.x = pkbf(bflo(pxw##SET.x) * rs_, bfhi(pxw##SET.x) * rs_); w_.y = pkbf(bflo(pxw##SET.y) * rs_, bfhi(pxw##SET.y) * rs_); w_.z = pkbf(bflo(pxw##SET.z) * rs_, bfhi(pxw##SET.z) * rs_); w_.w = pkbf(bflo(pxw##SET.w) * rs_, bfhi(pxw##SET.w) * rs_); \
        *(LAS u32x4*)(UT + ((ct_) % 3) * 8448 + ((token >> 4) * 264 + (token & 15) * 16 + 8 * half) * 2) = w_; } while (0)
    float car = 0.f, cai = 0.f;
#define S5G_SCAN(cs) do { if (SCAN) { const ldsp ut_ = UT + ((cs) % 3) * 8448; const ldsp sin_ = SIN + ((cs) & 1) * 4352; \
            if (((cs) & 7) == 0) { car = 0.f; cai = 0.f; } \
            f32x4 er = (f32x4){0.f, 0.f, 0.f, 0.f}, ei = er; \
            _Pragma("unroll") for (int kk = 0; kk < 8; ++kk) { const bf16x8 u_ = ldfrag(ut_, fr, 264, 32 * kk + 8 * fq); MM_XROW(er, wr[kk], u_); MM_XROW(ei, wi[kk], u_); } \
            float br = er[0], bi = ei[0]; \
            _Pragma("unroll") for (int r = 1; r < 4; ++r) { const float nr = l1r * br - l1i * bi + er[r], ni = l1r * bi + l1i * br + ei[r]; br = nr; bi = ni; } \
            float s0r = car, s0i = cai, cr_ = car, ci_ = cai; \
            _Pragma("unroll") for (int k = 0; k < 4; ++k) { const float qr = __shfl(br, fr + 16 * k), qi = __shfl(bi, fr + 16 * k); \
                const float nr = l4r * cr_ - l4i * ci_ + qr, ni = l4r * ci_ + l4i * cr_ + qi; cr_ = nr; ci_ = ni; if (k < fq) { s0r = nr; s0i = ni; } } \
            car = cr_; cai = ci_; \
            float sr = s0r, si = s0i; \
            _Pragma("unroll") for (int r = 0; r < 4; ++r) { *(LAS unsigned*)(sin_ + ((4 * fq + r) * 136 + 2 * ps) * 2) = pkbf(sr, si); \
                const float nr = l1r * sr - l1i * si + er[r], ni = l1r * si + l1i * sr + ei[r]; sr = nr; si = ni; } \
            if (((cs) & 7) == 7 && fq == 0) { const int b_ = 2 * bp + ((cs) >> 3); a.out[O_S5RP + (size_t)(b_ * 64 + g) * 64 + ps] = car; a.out[O_S5IP + (size_t)(b_ * 64 + g) * 64 + ps] = cai; } } } while (0)
#define S5G_Y(ct_) do { const ldsp ut_ = UT + ((ct_) % 3) * 8448; const ldsp sin_ = SIN + ((ct_) & 1) * 4352; bf16x8 uf[KK], sf[4]; \
        _Pragma("unroll") for (int kk = 0; kk < KK; ++kk) uf[kk] = ldfrag(ut_, fr, 264, 32 * kk + 8 * fq); \
        _Pragma("unroll") for (int kk = 0; kk < 4; ++kk) sf[kk] = ldfrag(sin_, fr, 136, 32 * kk + 8 * fq); \
        _Pragma("unroll") for (int x = 0; x < 2; ++x) { const int tau = 2 * wave + x; f32x4 acc = (f32x4){0.f, 0.f, 0.f, 0.f}; \
            _Pragma("unroll") for (int kk = 0; kk < KK; ++kk) MM_YROW(acc, Fw[x][kk], uf[kk]);     \
            _Pragma("unroll") for (int kk = 0; kk < 4; ++kk) MM_YROW(acc, vf[x][kk], sf[kk]); \
            const size_t row = (size_t)(2 * bp + ((ct_) >> 3)) * SEQ + 256 * ((ct_) & 7) + 16 * fr + tau; \
            u32x2 w; w.x = pkbf(gelu_tanh(acc[0]), gelu_tanh(acc[1])); w.y = pkbf(gelu_tanh(acc[2]), gelu_tanh(acc[3])); \
            *(u32x2*)(YB + row * D + g * 16 + 4 * fq) = w; } } while (0)
#ifndef S5REP
#define S5REP 1
#endif
    for (int rep_ = 0; rep_ < S5REP; ++rep_) {
    S5G_ULOAD(A, 0); S5G_ULOAD(B, 1); S5G_USTORE(A, 0); S5G_USTORE(B, 1);
    S5G_ULOAD(A, 2); S5G_ULOAD(B, 3);
    __syncthreads();
    S5G_SCAN(0);
    __syncthreads();
    for (int ct = 0; ct < 16; ct += 2) {
        S5G_USTORE(A, ct + 2); S5G_ULOAD(A, ct + 4);
        S5G_SCAN(ct + 1);
        S5G_Y(ct);
        __syncthreads();
        S5G_USTORE(B, ct + 3); S5G_ULOAD(B, ct + 5);
        if (ct + 2 < 16) S5G_SCAN(ct + 2);
        S5G_Y(ct + 1);
        __syncthreads();
    }
    }
#undef S5G_ULOAD
#undef S5G_USTORE
#undef S5G_SCAN
#undef S5G_Y
}
__device__ __forceinline__ void s5_gemm_wg(const Args& a, ldsp lds, int vcu, int G, int tid, int wave, int lane) {
    for (int it = vcu; it < 256; it += G) {
        if (wave < 4) s5_gemm_role<4, true>(a, lds, it >> 2, it & 3, tid, wave, lane);
        else s5_gemm_role<8, false>(a, lds, it >> 2, it & 3, tid, wave, lane);
    }
}
__global__ void __launch_bounds__(NTHREADS, 2) hybrid_fwd(Args a) {
    extern __shared__ __attribute__((aligned(16))) unsigned char lds_raw[];
    const ldsp lds = (ldsp)lds_raw;
    const int tid = threadIdx.x, lane = tid & 63, wave = __builtin_amdgcn_readfirstlane(tid >> 6);
    const int G = gridDim.x, bx = blockIdx.x;
    const int vcu = (G % 8 == 0) ? (bx % 8) * (G / 8) + bx / 8 : bx;
    unsigned char* ws = a.ws;
    unsigned* ctl = (unsigned*)(ws + WS_CTL);
    for (int u = tid; u < (LDS_BYTES - LDSCTL_OFF) / 4; u += NTHREADS) ((LAS unsigned*)(lds + LDSCTL_OFF))[u] = 0u;
    __syncthreads();
    XcdBarrier bar = xcd_barrier_post(ctl + CW_BAR, (volatile LAS unsigned*)(lds + LDSCTL_OFF) + 8);
    const int gw = vcu * NWAVES + wave, ngw = G * NWAVES;
    bf16* XB = (bf16*)(ws + WS_XB); float* X = (float*)(ws + WS_X); float* SS = (float*)(ws + WS_SS);
    bf16* PROJ = (bf16*)(ws + WS_PROJ); bf16* GATED = (bf16*)(ws + WS_GATED); bf16* YB = (bf16*)(ws + WS_YB); bf16* HB = (bf16*)(ws + WS_H);
    const bf16* W1 = (const bf16*)(ws + WS_W1); const bf16* W2 = (const bf16*)(ws + WS_W2); const bf16* W5 = (const bf16*)(ws + WS_W5);
    const bf16* W3 = (const bf16*)(ws + WS_W3); const bf16* W4 = (const bf16*)(ws + WS_W4);
#define SINGLE_ARG(...) __VA_ARGS__
#define GEMM_PHASE(EPI, Aop, Bop, N_, K_, E_) do { pg8::Gemm g_{(const pg8::bf16_t*)(Aop), (const pg8::bf16_t*)(Bop), MP, (N_), (K_)}; pg8::StaticOrder S_; S_.init(MP, (N_), G, bx); \
        pg8::gemm_phase<EPI, pg8::StaticOrder, true, true>(lds, g_, S_, (E_)); } while (0)
#ifndef DBG_STOP
#define DBG_STOP 0
#endif
#ifndef REPG
#define REPG 0
#endif
#define DBG_DIGEST(k, SRC, NEL) do { if (DBG_STOP == (k)) { xcd_barrier(bar); const bf16* s_ = (const bf16*)(SRC); for (size_t i_ = (size_t)bx * NTHREADS + tid; i_ < (size_t)(NEL) && i_ < O_SSMP; i_ += (size_t)G * NTHREADS) a.out[i_] = bf1(s_[i_]); return; } } while (0)

#ifndef TPROBE
#define TPROBE 0
#endif
#define TP_BLK ((TPROBE) / 10000)
#define TP_S (((TPROBE) / 100) % 100)
#define TP_E ((TPROBE) % 100)
    unsigned long long tp_s = 0, tp_e = 0;
#define STAMPV(id) do { if (TPROBE && vcu == TP_BLK && tid == 0) { const unsigned long long t_ = __builtin_amdgcn_s_memrealtime(); if ((id) == TP_S && tp_s == 0) tp_s = t_; if ((id) == TP_E && tp_e == 0) tp_e = t_; } } while (0)
#define STAMP(id) do { if (TPROBE && vcu == TP_BLK && tid == 0) { const unsigned long long t_ = __builtin_amdgcn_s_memrealtime(); if ((id) == TP_S) tp_s = t_; if ((id) == TP_E) tp_e = t_; } } while (0)
    STAMP(0);
    p0_prologue(a, lds, gw, ngw, wave, lane);
    STAMP(1);
    xcd_barrier(bar);
    STAMP(2);
    { pg8::EpiProj E{(pg8::bf16_t*)PROJ, SS, 16};
      GEMM_PHASE(pg8::EpiProj, XB, W1, PROJ_LD, D, E); }
#if REPG == 1
    xcd_barrier(bar);
    { pg8::EpiProj E{(pg8::bf16_t*)PROJ, SS, 16};
      GEMM_PHASE(pg8::EpiProj, XB, W1, PROJ_LD, D, E); }
#endif
    {
        const SEpiProj Ep{nullptr, SS, 16, (float*)(ws + WS_BETA), (float*)(ws + WS_GDEC), a.in[11], a.in[12]};
        for (int u = vcu; u < 256; u += G) sgemm_unit64<2>(lds, XB + (size_t)u * 64 * D, W1 + (size_t)6144 * D, D, Ep, u * 64, 192, 193, wave, lane);
    }
    DBG_DIGEST(1, PROJ, (size_t)MP * PROJ_LD);
    STAMP(3);
    xcd_barrier(bar);
    STAMP(4);
    dn_prep(a, gw, ngw, lane);
    DBG_DIGEST(2, ws + WS_QKVC, (size_t)MP * 4096);
    STAMP(5);
    xcd_barrier(bar);
    STAMP(6);
    if (vcu < NB * NH) dn_prompt(a, lds, vcu / NH, vcu % NH, tid, wave, lane);
    else {
        const int nt = G - NB * NH, ti = vcu - NB * NH;
        unsigned* tcnt = ctl + CW_TEAM; unsigned ep = 0;
        float* SX = (float*)(ws + WS_SX); bf16* SXB = (bf16*)(ws + WS_SXB); float* SSS = (float*)(ws + WS_SSS);
        bf16* SGATED = (bf16*)(ws + WS_SGATED); bf16* SH = (bf16*)(ws + WS_SH); bf16* SYB = (bf16*)(ws + WS_SYB);
        const XcdBarrier tbar = xcd_barrier_post(ctl + CW_TBAR, (volatile LAS unsigned*)(lds + LDSCTL_OFF) + 16, (unsigned)nt);
#define TEAM_BAR() xcd_barrier(tbar)
        p0_weights_late(a, lds, ti * NWAVES + wave, nt * NWAVES, wave, lane);
        if (wave == 7 && ti < 64) s5_precompute(a, ti * 64 + lane);
        __syncthreads();
        {
            const SEpiProj Es{(bf16*)(ws + WS_SPROJ), (const float*)(ws + WS_SSS), 32, (float*)(ws + WS_SBETA), (float*)(ws + WS_SGDEC), a.in[11], a.in[12]};
            for (int v = ti; v < 194; v += nt) { const int rh = v & 1, cb64 = v >> 1;
                sgemm_unit64<4>(lds, (const bf16*)(ws + WS_SXB) + (size_t)rh * 64 * D, W1 + (size_t)cb64 * 64 * D, D, Es, 64 * rh, 2 * cb64, 193, wave, lane); }
        }
        TEAM_BAR();
        dn_sample_all(a, lds, ti, nt, tid, wave, lane);
        STAMP(20);
        TEAM_BAR();
        STAMP(21);
        for (int t = (ti * NWAVES + wave) * 64 + lane; t < 65536; t += nt * NWAVES * 64) s5_ktable(a, t);
        { const SEpiRes<false> E{a.in[1], SX, SXB, SSS};
          for (int v = ti; v < 2 * (D / 32); v += nt) { const int rh = v & 1, cbk = v >> 1; sgemm_unit64<2>(lds, SGATED + (size_t)rh * 64 * VAL, W2 + (size_t)cbk * 32 * VAL, VAL, E, 64 * rh, cbk, 32, wave, lane); } }
        STAMPV(22);
        TEAM_BAR();
        STAMPV(23);
        {
            { const SEpiSwiglu E{SH, SSS, 32};
              for (int v = ti; v < 2 * (FFN / 32); v += nt) { const int rh = v & 1, u = v >> 1; const bf16* bg = W3 + (size_t)((u >> 2) * 256 + (u & 3) * 32) * D;
                  sgemm_unit64d(lds, SXB + (size_t)rh * 64 * D, bg, bg + (size_t)128 * D, D, E, 64 * rh, u, wave, lane); } }
            STAMPV(24);
            TEAM_BAR();
            STAMPV(25);
            { const SEpiRes<false> E{SX, SX, SXB, SSS};
              for (int v = ti; v < 2 * (D / 32); v += nt) { const int rh = v & 1, cbk = v >> 1; sgemm_unit64<2>(lds, SH + (size_t)rh * 64 * FFN, W4 + (size_t)cbk * 32 * FFN, FFN, E, 64 * rh, cbk, 32, wave, lane); } }
            STAMPV(26);
            TEAM_BAR();
            STAMPV(27);
            {
                const ldsp wl = lds + wave * 12800;
                for (int j = ti * NWAVES + wave; j < 512; j += nt * NWAVES) s5_wave(a, wl, true, 0, (j & 7) * 16, j >> 3, lane);
                STAMPV(28);
                TEAM_BAR();
                STAMPV(29);
                { const SEpiRes<true> E{SX, SX, SXB, SSS};
                  for (int v = ti; v < 2 * (D / 32); v += nt) { const int rh = v & 1, u = v >> 1; const bf16* bv = W5 + (size_t)((u >> 2) * 256 + (u & 3) * 32) * D;
                      sgemm_unit64d(lds, SYB + (size_t)rh * 64 * D, bv, bv + (size_t)128 * D, D, E, 64 * rh, u, wave, lane); } }
            }
        }
#undef TEAM_BAR
    }
    DBG_DIGEST(3, GATED, (size_t)MP * VAL);
    STAMP(7);
    xcd_barrier(bar);
    STAMP(8);
    { pg8::EpiRes<false, 0> E{a.in[0], nullptr, (pg8::bf16_t*)XB, SS};
      GEMM_PHASE(SINGLE_ARG(pg8::EpiRes<false, 0>), GATED, W2, D, VAL, E); }
#if REPG == 2
    xcd_barrier(bar);
    { pg8::EpiRes<false, 0> E{a.in[0], nullptr, (pg8::bf16_t*)XB, SS};
      GEMM_PHASE(SINGLE_ARG(pg8::EpiRes<false, 0>), GATED, W2, D, VAL, E); }
#endif
    xcd_barrier(bar);
    STAMP(30);
    { pg8::EpiSwiglu E{(pg8::bf16_t*)HB, FFN, SS, 16};
      GEMM_PHASE(pg8::EpiSwiglu, XB, W3, 2 * FFN, D, E); }
    if (bx >= 128) {
        const SEpiSwiglu Es{(bf16*)(ws + WS_SH), (const float*)(ws + WS_SSS), 32};
        for (int v = bx - 128; v < 2 * (FFN / 32); v += 128) { const int rh = v & 1, u = v >> 1; const bf16* bg = W3 + (size_t)2 * FFN * D + (size_t)((u >> 2) * 256 + (u & 3) * 32) * D;
            sgemm_unit64d(lds, (const bf16*)(ws + WS_SXB) + (size_t)rh * 64 * D, bg, bg + (size_t)128 * D, D, Es, 64 * rh, u, wave, lane); } }
#if REPG == 3
    xcd_barrier(bar);
    { pg8::EpiSwiglu E{(pg8::bf16_t*)HB, FFN, SS, 16};
      GEMM_PHASE(pg8::EpiSwiglu, XB, W3, 2 * FFN, D, E); }
#endif
    xcd_barrier(bar);
    STAMP(31);
    { pg8::EpiRes<false, 1> E{nullptr, nullptr, (pg8::bf16_t*)XB, SS};
      GEMM_PHASE(SINGLE_ARG(pg8::EpiRes<false, 1>), HB, W4, D, FFN, E); }
    xcd_barrier(bar);
    STAMP(32);
    {
        const ldsp wl = lds + wave * 12800;
        STAMP(9);
        (void)wl;
#if S5_GEMM
        s5_gemm_wg(a, lds, vcu, G, tid, wave, lane);
#else
        s5_prompt_wg(a, lds, vcu, G, wave, lane);
#endif
        STAMP(10);
    }
    xcd_barrier(bar);
    STAMP(11);
    { pg8::EpiRes<true, 1> E{nullptr, nullptr, (pg8::bf16_t*)XB, SS};
      GEMM_PHASE(SINGLE_ARG(pg8::EpiRes<true, 1>), YB, W5, 2 * D, D, E); }
    xcd_barrier(bar);
    STAMP(33);
    { pg8::EpiSwiglu E{(pg8::bf16_t*)HB, FFN, SS, 32};
      GEMM_PHASE(pg8::EpiSwiglu, XB, W3 + (size_t)2 * FFN * D, 2 * FFN, D, E); }
    if (bx >= 128 && bx - 128 < 2 * (D / 32)) {
        const int u = bx - 128, cbk = u >> 1, rh = u & 1; const SEpiRes<false> Es{(const float*)(ws + WS_SX), a.out + O_YS, (bf16*)(ws + WS_SXB), (float*)(ws + WS_SSS)};
        sgemm_unit64<2>(lds, (const bf16*)(ws + WS_SH) + (size_t)rh * 64 * FFN, W4 + (size_t)D * FFN + (size_t)cbk * 32 * FFN, FFN, Es, 64 * rh, cbk, 32, wave, lane); }
    xcd_barrier(bar);
    STAMP(34);
    { pg8::EpiRes<false, 2> E{nullptr, a.out + O_YP, (pg8::bf16_t*)XB, SS};
      GEMM_PHASE(SINGLE_ARG(pg8::EpiRes<false, 2>), HB, W4 + (size_t)D * FFN, D, FFN, E); }
    xcd_barrier(bar);
    STAMP(35);
    for (int m = (G * NWAVES - 1 - gw); m < MS; m += ngw) {
        f32x4* xr = (f32x4*)(a.out + O_YS + (size_t)m * D) + lane;
        const float rs = pg8::row_rstd((const float*)(ws + WS_SSS), m, 32);
#pragma unroll
        for (int j = 0; j < 4; ++j) { const f32x4 gn = *((const f32x4*)a.in[8] + lane + 64 * j); xr[64 * j] = xr[64 * j] * rs * gn; }
    }
    for (int m = gw; m < MP; m += ngw) {
        f32x4* xr = (f32x4*)(a.out + O_YP + (size_t)m * D) + lane;
        const float rs = pg8::row_rstd(SS, m, 16);
#pragma unroll
        for (int j = 0; j < 4; ++j) { const f32x4 gn = *((const f32x4*)a.in[8] + lane + 64 * j); const f32x4 xv = __builtin_nontemporal_load(xr + 64 * j); __builtin_nontemporal_store(xv * rs * gn, xr + 64 * j); }
    }
    STAMP(12);
#if TPROBE
    xcd_barrier(bar);
    if (vcu == TP_BLK && tid == 0) { const unsigned long long t0_ = __builtin_amdgcn_s_memrealtime(), dt_ = tp_e - tp_s; while (__builtin_amdgcn_s_memrealtime() - t0_ < dt_) __builtin_amdgcn_s_sleep(8); }
#endif
#undef GEMM_PHASE
}

extern "C" void kernel_launch(void* const* d_in, const int* in_sizes, int n_in, void* d_out, int out_size, void* d_ws, size_t ws_size, hipStream_t stream) {
    static int grid = 0;
    if (grid == 0) {
        if (n_in != 26 || (size_t)out_size != O_END || ws_size < WS_END) { fprintf(stderr, "kernel_launch: unexpected shapes: n_in %d out %d ws %zu (need %zu)\n", n_in, out_size, ws_size, (size_t)WS_END); grid = -1; return; }
        int dev = 0, cus = 0, per_cu = 0;
        if (hipGetDevice(&dev) != hipSuccess || hipDeviceGetAttribute(&cus, hipDeviceAttributeMultiprocessorCount, dev) != hipSuccess) { grid = -1; return; }
        if (hipFuncSetAttribute((const void*)hybrid_fwd, hipFuncAttributeMaxDynamicSharedMemorySize, LDS_BYTES) != hipSuccess) { fprintf(stderr, "kernel_launch: hipFuncSetAttribute failed\n"); grid = -1; return; }
        if (hipOccupancyMaxActiveBlocksPerMultiprocessor(&per_cu, (const void*)hybrid_fwd, NTHREADS, LDS_BYTES) != hipSuccess || per_cu < 1) { fprintf(stderr, "kernel_launch: occupancy query says %d\n", per_cu); (void)hipGetLastError(); per_cu = 1; }
        grid = cus;
    }
    if (grid < 0) return;
    (void)hipMemsetAsync((char*)d_ws + WS_CTL, 0, CTL_ZERO_BYTES, stream);
    Args a{};
    for (int i = 0; i < 26; ++i) a.in[i] = (const float*)d_in[i];
    a.out = (float*)d_out; a.ws = (unsigned char*)d_ws;
    hipLaunchKernelGGL(hybrid_fwd, dim3(grid), dim3(NTHREADS), LDS_BYTES, stream, a);
}
```
